# Optimizing an MI355X kernel written in HIP

```python
import jax, jax.numpy as jnp
from jax import lax
import numpy as np

D_MODEL = 1024
BATCH = 8
SEQ = 4096
DEPTH = 2

D_MIX = 2 * D_MODEL
ATTN_HEAD_DIM = 128
N_ATTN_HEADS = D_MODEL // ATTN_HEAD_DIM
D_ATTN = N_ATTN_HEADS * ATTN_HEAD_DIM
MOBA_BLOCK = 256
MOBA_TOPK = 3
Q_BLOCK = 128
SSD_HEAD_DIM = 64
D_SSD = D_MIX - D_ATTN
N_SSD_HEADS = D_SSD // SSD_HEAD_DIM
SSD_GROUPS = 2
SSD_STATE = 128
SSD_CONV = 4
SSD_CHUNK = 256
D_CONV_CH = D_SSD + 2 * SSD_GROUPS * SSD_STATE
D_IN_PROJ = 4 * D_ATTN + D_SSD + D_CONV_CH + N_SSD_HEADS
SEQ_ALIGN = 256
EPS = 1e-6

kernel_name = "hymba_moba_ssd_hybrid"


def rms_norm(x, w):
    xf = x.astype(jnp.float32)
    y = xf * lax.rsqrt(jnp.mean(xf * xf, axis=-1, keepdims=True) + EPS)
    return (y * w.astype(jnp.float32)).astype(x.dtype)


def alibi_slopes():
    h = jnp.arange(1, N_ATTN_HEADS + 1, dtype=jnp.float32)
    return jnp.exp2(-8.0 * h / N_ATTN_HEADS)


def moba_attention(q, k, v):
    b, s, h, dh = q.shape
    nb = s // MOBA_BLOCK
    nqc = s // Q_BLOCK
    n_sel = min(MOBA_TOPK, nb)
    scale = dh ** -0.5
    slopes = alibi_slopes()
    qh = q.transpose(0, 2, 1, 3)
    kblk = k.transpose(0, 2, 1, 3).reshape(b, h, nb, MOBA_BLOCK, dh)
    vblk = v.transpose(0, 2, 1, 3).reshape(b, h, nb, MOBA_BLOCK, dh)
    k_mean = jnp.mean(kblk.astype(jnp.float32), axis=3)
    gate = jnp.einsum('bhsd,bhnd->bhsn', qh.astype(jnp.float32), k_mean)
    q_blk = jnp.arange(s) // MOBA_BLOCK
    past = jnp.arange(nb)[None, :] < q_blk[:, None]
    gate = jnp.where(past, gate, -jnp.inf)
    _, sel = lax.top_k(gate, n_sel)
    q_c = qh.reshape(b, h, nqc, Q_BLOCK, dh).transpose(0, 2, 1, 3, 4).reshape(b * nqc, h, Q_BLOCK, dh)
    sel_c = sel.reshape(b, h, nqc, Q_BLOCK, n_sel).transpose(0, 2, 1, 3, 4).reshape(b * nqc, h, Q_BLOCK, n_sel)
    b_id = jnp.repeat(jnp.arange(b), nqc)
    c_id = jnp.tile(jnp.arange(nqc), b)
    head_ix = jnp.arange(h)[:, None, None]
    key_off = jnp.arange(MOBA_BLOCK)

    def one_block(args):
        qc, selc, bi, ci = args
        kb = lax.dynamic_index_in_dim(kblk, bi, 0, keepdims=False)
        vb = lax.dynamic_index_in_dim(vblk, bi, 0, keepdims=False)
        t = ci * Q_BLOCK + jnp.arange(Q_BLOCK)
        own = (ci * Q_BLOCK) // MOBA_BLOCK
        k_sel = kb[head_ix, selc]
        v_sel = vb[head_ix, selc]
        s_sel = jnp.einsum('hqd,hqkcd->hqkc', qc, k_sel, preferred_element_type=jnp.float32) * scale
        pos_sel = selc[..., None] * MOBA_BLOCK + key_off
        s_sel = s_sel - slopes[:, None, None, None] * (t[None, :, None, None] - pos_sel).astype(jnp.float32)
        valid = jnp.arange(n_sel)[None, :] < (t // MOBA_BLOCK)[:, None]
        s_sel = jnp.where(valid[None, :, :, None], s_sel, -jnp.inf)
        k_own = lax.dynamic_index_in_dim(kb, own, 1, keepdims=False)
        v_own = lax.dynamic_index_in_dim(vb, own, 1, keepdims=False)
        s_own = jnp.einsum('hqd,hcd->hqc', qc, k_own, preferred_element_type=jnp.float32) * scale
        dist = t[:, None] - (own * MOBA_BLOCK + key_off)[None, :]
        s_own = s_own - slopes[:, None, None] * dist.astype(jnp.float32)[None]
        s_own = jnp.where((dist >= 0)[None], s_own, -jnp.inf)
        scores = jnp.concatenate([s_sel.reshape(h, Q_BLOCK, n_sel * MOBA_BLOCK), s_own], axis=-1)
        p = jax.nn.softmax(scores, axis=-1).astype(v.dtype)
        p_sel = p[..., :n_sel * MOBA_BLOCK].reshape(h, Q_BLOCK, n_sel, MOBA_BLOCK)
        p_own = p[..., n_sel * MOBA_BLOCK:]
        return (jnp.einsum('hqkc,hqkcd->hqd', p_sel, v_sel)
                + jnp.einsum('hqc,hcd->hqd', p_own, v_own))

    out = lax.map(one_block, (q_c, sel_c, b_id, c_id))
    return out.reshape(b, nqc, h, Q_BLOCK, dh).transpose(0, 1, 3, 2, 4).reshape(b, s, h * dh)


def causal_depthwise_conv(u, w, bias):
    out = lax.conv_general_dilated(u, w[:, None, :], window_strides=(1,),
                                   padding=[(SSD_CONV - 1, 0)],
                                   dimension_numbers=('NWC', 'WIO', 'NWC'),
                                   feature_group_count=u.shape[-1])
    return out + bias


def ssd_scan(xs, bm, cm, dt, a_log, d_skip):
    b, s = xs.shape[:2]
    nc = s // SSD_CHUNK
    hg = N_SSD_HEADS // SSD_GROUPS
    a = -jnp.exp(a_log.astype(jnp.float32)).reshape(SSD_GROUPS, hg)
    x = xs.reshape(b, nc, SSD_CHUNK, SSD_GROUPS, hg, SSD_HEAD_DIM)
    bc = bm.reshape(b, nc, SSD_CHUNK, SSD_GROUPS, SSD_STATE)
    cc = cm.reshape(b, nc, SSD_CHUNK, SSD_GROUPS, SSD_STATE)
    dtc = dt.reshape(b, nc, SSD_CHUNK, SSD_GROUPS, hg)
    xdt = x * dtc[..., None]
    a_cs = jnp.cumsum((dtc * a).transpose(0, 1, 3, 4, 2), axis=-1)
    causal = jnp.tril(jnp.ones((SSD_CHUNK, SSD_CHUNK), dtype=bool))
    decay = jnp.exp(jnp.where(causal, a_cs[..., :, None] - a_cs[..., None, :], -jnp.inf))
    cb = jnp.einsum('bclgn,bcsgn->bcgls', cc, bc)
    y_diag = jnp.einsum('bcgls,bcghls,bcsghp->bclghp', cb, decay, xdt)
    decay_states = jnp.exp(a_cs[..., -1:] - a_cs)
    states = jnp.einsum('bclgn,bcghl,bclghp->bcghpn', bc, decay_states, xdt)
    chunk_decay = jnp.exp(a_cs[..., -1])

    def step(carry, inp):
        st, dec = inp
        return carry * dec[..., None, None] + st, carry

    init = jnp.zeros((b, SSD_GROUPS, hg, SSD_HEAD_DIM, SSD_STATE), jnp.float32)
    _, prev = lax.scan(step, init, (jnp.moveaxis(states, 1, 0), jnp.moveaxis(chunk_decay, 1, 0)))
    prev = jnp.moveaxis(prev, 0, 1)
    y_off = jnp.einsum('bclgn,bcghpn,bcghl->bclghp', cc, prev, jnp.exp(a_cs))
    y = y_diag + y_off + x * d_skip.astype(jnp.float32).reshape(SSD_GROUPS, hg)[:, :, None]
    return y.reshape(b, s, N_SSD_HEADS * SSD_HEAD_DIM)


def hybrid_layer(x, ln_w, w_in, q_norm_w, k_norm_w, conv_w, conv_b, dt_bias, a_log, d_skip, ssd_norm_w, w_out):
    b, s, _ = x.shape
    h = rms_norm(x, ln_w)
    proj = h @ w_in
    cuts = [D_ATTN, 2 * D_ATTN, 3 * D_ATTN, 4 * D_ATTN, 4 * D_ATTN + D_SSD, 4 * D_ATTN + D_SSD + D_CONV_CH]
    q, k, v, g_attn, z, xbc, dt_raw = jnp.split(proj, cuts, axis=-1)
    q = rms_norm(q.reshape(b, s, N_ATTN_HEADS, ATTN_HEAD_DIM), q_norm_w)
    k = rms_norm(k.reshape(b, s, N_ATTN_HEADS, ATTN_HEAD_DIM), k_norm_w)
    v = v.reshape(b, s, N_ATTN_HEADS, ATTN_HEAD_DIM)
    attn = moba_attention(q, k, v) * jax.nn.silu(g_attn)
    xbc = jax.nn.silu(causal_depthwise_conv(xbc, conv_w, conv_b)).astype(jnp.float32)
    xs, bm, cm = jnp.split(xbc, [D_SSD, D_SSD + SSD_GROUPS * SSD_STATE], axis=-1)
    dt = jax.nn.softplus(dt_raw.astype(jnp.float32) + dt_bias.astype(jnp.float32))
    y = ssd_scan(xs.reshape(b, s, N_SSD_HEADS, SSD_HEAD_DIM),
                 bm.reshape(b, s, SSD_GROUPS, SSD_STATE),
                 cm.reshape(b, s, SSD_GROUPS, SSD_STATE), dt, a_log, d_skip)
    y = y * jax.nn.silu(z.astype(jnp.float32))
    y = rms_norm(y.reshape(b, s, SSD_GROUPS, D_SSD // SSD_GROUPS),
                 ssd_norm_w.reshape(SSD_GROUPS, D_SSD // SSD_GROUPS)).reshape(b, s, D_SSD).astype(x.dtype)
    mixed = jnp.concatenate([attn, y], axis=-1)
    return x + mixed @ w_out


def setup_inputs(seed: int = 0) -> dict:
    key = jax.random.key(seed)
    ks = jax.random.split(key, 13)
    f32 = jnp.float32
    x = jax.random.normal(ks[0], (BATCH, SEQ, D_MODEL), f32)
    ln_w = 1.0 + 0.01 * jax.random.normal(ks[1], (DEPTH, D_MODEL), f32)
    w_in = jax.random.normal(ks[2], (DEPTH, D_MODEL, D_IN_PROJ), f32) * D_MODEL ** -0.5
    q_norm_w = 1.0 + 0.01 * jax.random.normal(ks[3], (DEPTH, ATTN_HEAD_DIM), f32)
    k_norm_w = 1.0 + 0.01 * jax.random.normal(ks[4], (DEPTH, ATTN_HEAD_DIM), f32)
    conv_w = jax.random.normal(ks[5], (DEPTH, SSD_CONV, D_CONV_CH), f32) * SSD_CONV ** -0.5
    conv_b = 0.01 * jax.random.normal(ks[6], (DEPTH, D_CONV_CH), f32)
    dt0 = jnp.exp(jax.random.uniform(ks[7], (DEPTH, N_SSD_HEADS), f32,
                                     minval=float(np.log(1e-3)), maxval=float(np.log(1e-1))))
    dt_bias = dt0 + jnp.log(-jnp.expm1(-dt0))
    a_log = jnp.log(jax.random.uniform(ks[8], (DEPTH, N_SSD_HEADS), f32, minval=1.0, maxval=16.0))
    d_skip = 1.0 + 0.01 * jax.random.normal(ks[9], (DEPTH, N_SSD_HEADS), f32)
    ssd_norm_w = 1.0 + 0.01 * jax.random.normal(ks[10], (DEPTH, D_SSD), f32)
    w_out = jax.random.normal(ks[11], (DEPTH, D_MIX, D_MODEL), f32) * D_MIX ** -0.5
    return {"x": x, "ln_w": ln_w, "w_in": w_in, "q_norm_w": q_norm_w, "k_norm_w": k_norm_w,
            "conv_w": conv_w, "conv_b": conv_b, "dt_bias": dt_bias, "a_log": a_log,
            "d_skip": d_skip, "ssd_norm_w": ssd_norm_w, "w_out": w_out}


def reference(x, ln_w, w_in, q_norm_w, k_norm_w, conv_w, conv_b, dt_bias, a_log, d_skip, ssd_norm_w, w_out):
    s = x.shape[1]
    pad = (-s) % SEQ_ALIGN
    h = jnp.pad(x, ((0, 0), (0, pad), (0, 0)))
    for i in range(DEPTH):
        h = hybrid_layer(h, ln_w[i], w_in[i], q_norm_w[i], k_norm_w[i], conv_w[i], conv_b[i],
                         dt_bias[i], a_log[i], d_skip[i], ssd_norm_w[i], w_out[i])
    return h[:, :s]
```

```cpp
#include <hip/hip_runtime.h>
#include <cstdio>
#include <cstdint>
namespace pg8 {
#define PG8_LAS __attribute__((address_space(3)))
typedef unsigned short bf16_t;
typedef short bf16x8 __attribute__((ext_vector_type(8)));
typedef float f32x4 __attribute__((ext_vector_type(4)));
typedef unsigned u32x4 __attribute__((ext_vector_type(4)));
constexpr int BM = 256, BK = 64, HALF = 128, HTB = HALF * BK * 2  , STAGE_BYTES = 8 * HTB, NXCD = 8, WGM = 8;

__host__ __device__ __forceinline__ int lds_byte(int r, int c) { const int st = (r >> 4) * 2 + (c >> 5), rr = r & 15, cc = c & 31, ob = rr * 64 + cc * 2; return st * 1024 + (ob ^ (((ob >> 9) & 1) << 5)); }
__host__ __device__ __forceinline__ void stage_rc(int b, int& R, int& C) { const int st = b / 1024, sb = b % 1024, swz = sb ^ (((sb >> 9) & 1) << 5); R = (st >> 1) * 16 + swz / 64; C = (st & 1) * 32 + (swz % 64) / 2; }
__host__ __device__ __forceinline__ int perm32(int rho) { const int n = rho >> 4, i = rho & 15; return 8 * (i >> 2) + 4 * n + (i & 3); }

struct Unit { int pm, pn; };
struct Gemm { const bf16_t* A; const bf16_t* Bt; int M, N, K, lda; };

struct StaticOrder {
    int nM, nN, nwg, G, c;
    __host__ __device__ void init(int M, int N, int G_, int c_) { nM = M / BM; nN = N / BM; nwg = nM * nN; G = G_; c = c_; }
    __host__ __device__ bool next(int i, Unit& u) const {
        const long L = (long)i * G + c; if (L >= nwg) return false;
        int wgid = (int)L; { const int q = nwg / NXCD, r = nwg % NXCD, xcd = wgid % NXCD, off = wgid / NXCD; wgid = (xcd < r ? xcd * (q + 1) : r * (q + 1) + (xcd - r) * q) + off; }
        const int nig = WGM * nN, gid = wgid / nig, fm = gid * WGM, gsz = (nM - fm) < WGM ? (nM - fm) : WGM;
        u.pm = fm + ((wgid % nig) % gsz); u.pn = (wgid % nig) / gsz; return true;
    }
    __device__ __forceinline__ void a_ready(const Unit&) const {}
    __device__ __forceinline__ void done(const Unit&) const {}
};

__device__ __forceinline__ unsigned cvt_pk_bf16(float lo, float hi) { unsigned r; asm volatile("v_cvt_pk_bf16_f32 %0, %1, %2" : "=v"(r) : "v"(lo), "v"(hi)); return r; }
typedef float f32x2 __attribute__((ext_vector_type(2)));
__device__ __forceinline__ f32x2 gelu_pk(f32x2 v) {
    const f32x2 av = __builtin_elementwise_abs(v), d = av * 0.2316418882f + 1.0f;
    f32x2 t; t.x = __builtin_amdgcn_rcpf(d.x); t.y = __builtin_amdgcn_rcpf(d.y);
    f32x2 q = t * 0.5307027145f + (-0.7265760135f); q = q * t + 0.7107068705f; q = q * t + (-0.142248368f); q = q * t + 0.127414796f; q = q * t;
    const f32x2 s = (v * v) * (-0.72134752044f);
    f32x2 e; e.x = __builtin_amdgcn_exp2f(s.x); e.y = __builtin_amdgcn_exp2f(s.y);
    const f32x2 m = v * (q * e), r = v - m;
    f32x2 o; o.x = v.x < 0.f ? m.x : r.x; o.y = v.y < 0.f ? m.y : r.y; return o;
}

template <int ACT  > struct EpiBf16 {
    static constexpr bool PERM = true, AFTER_DRAIN = false; static_assert(ACT == 0 || ACT == 1, "EpiBf16: ACT is 0 (none) or 1 (gelu_pk)");
    bf16_t* O; int ldc; const float* bias; int split_cols; size_t split_stride; float scale0;
    __device__ __forceinline__ void operator()(const f32x4 (&acc)[2][2][4][2], const Unit& u, int wr, int wc, int fr, int fq) const {
        const int row0 = u.pm * BM + wr * 64 + fr; int colt = u.pn * BM; bf16_t* base = O;
        float sc = 1.f; if (split_cols) { const int t = colt / split_cols; base += (size_t)t * split_stride; colt -= t * split_cols; if (t == 0) sc = scale0; }
        const int col0 = colt + wc * 32 + 8 * fq, bcol0 = u.pn * BM + wc * 32 + 8 * fq;
        f32x4 bv[2][2];
#pragma unroll
        for (int bj = 0; bj < 2; ++bj)
#pragma unroll
            for (int n = 0; n < 2; ++n) bv[bj][n] = bias ? *(const f32x4*)(bias + bcol0 + bj * HALF + 4 * n) : (f32x4){0.f, 0.f, 0.f, 0.f};
#pragma unroll
        for (int ai = 0; ai < 2; ++ai)
#pragma unroll
            for (int m = 0; m < 4; ++m) { bf16_t* rowp = base + (size_t)(row0 + ai * HALF + m * 16) * ldc + col0;
#pragma unroll
                for (int bj = 0; bj < 2; ++bj) { f32x4 v0 = acc[ai][bj][m][0] + bv[bj][0], v1 = acc[ai][bj][m][1] + bv[bj][1];
                    if (ACT == 1) { f32x2 a = gelu_pk((f32x2){v0[0], v0[1]}), b = gelu_pk((f32x2){v0[2], v0[3]}), c = gelu_pk((f32x2){v1[0], v1[1]}), d = gelu_pk((f32x2){v1[2], v1[3]});
                        v0 = (f32x4){a.x, a.y, b.x, b.y}; v1 = (f32x4){c.x, c.y, d.x, d.y}; }
                    v0 = v0 * sc; v1 = v1 * sc; u32x4 w; w.x = cvt_pk_bf16(v0[0], v0[1]); w.y = cvt_pk_bf16(v0[2], v0[3]); w.z = cvt_pk_bf16(v1[0], v1[1]); w.w = cvt_pk_bf16(v1[2], v1[3]);
                    *(u32x4*)(rowp + bj * HALF) = w; } }
    }
};
template <class Epi, class Sched, bool ALIGN_EPI = false, bool SP2 = false>
__device__ __forceinline__ void gemm_phase(PG8_LAS unsigned char* lds, const Gemm g, const Sched& S, const Epi& E) {
    int tid_ = threadIdx.x; asm volatile("" : "+v"(tid_));
    const int tid = tid_, wid = __builtin_amdgcn_readfirstlane(tid >> 6), lane = tid & 63, wr = wid >> 2, wc = wid & 3, fr = lane & 15, fq = lane >> 4;
    const int K = g.K, nt = K / BK;
    unsigned voffA[2], voffB[2];
#pragma unroll
    for (int i = 0; i < 2; ++i) { int R, C; stage_rc(tid * 16 + i * 8192, R, C); const int Rb = Epi::PERM ? ((R & ~31) + perm32(R & 31)) : R;
        voffA[i] = (unsigned)(R * g.lda + C) * 2u; voffB[i] = (unsigned)(Rb * K + C) * 2u; }
    const size_t kstep = (size_t)(BK * 2);
    const size_t hstep = (size_t)HALF * K * 2;
    const size_t tstep = 2 * hstep; const size_t hstepA = (size_t)HALF * g.lda * 2, tstepA = 2 * hstepA;
    const unsigned ldsw = (unsigned)wid * 1024u;
    const int aoff = lds_byte(wr * 64 + fr, fq * 8), boff = lds_byte(wc * 32 + fr, fq * 8);
#define PG8_SA(b, h) (((b) * 2 + (h)) * HTB)
#define PG8_SB(b, h) ((4 + (b) * 2 + (h)) * HTB)
#define PG8_STAGE(bufoff, gbase, voff) do { _Pragma("unroll") for (int _i = 0; _i < 2; ++_i) \
        __builtin_amdgcn_global_load_lds((const unsigned*)((const char*)(gbase) + (voff)[_i]), (PG8_LAS unsigned*)(lds + (bufoff) + ldsw + _i * 8192), 16, 0, 0); } while (0)
#define PG8_LDA(dst, b, h) do { _Pragma("unroll") for (int m = 0; m < 4; ++m) _Pragma("unroll") for (int k = 0; k < 2; ++k) dst[m][k] = *(const PG8_LAS bf16x8*)(lds + PG8_SA(b, h) + aoff + m * 2048 + k * 1024); } while (0)
#define PG8_LDB(dst, b, h) do { _Pragma("unroll") for (int n = 0; n < 2; ++n) _Pragma("unroll") for (int k = 0; k < 2; ++k) dst[n][k] = *(const PG8_LAS bf16x8*)(lds + PG8_SB(b, h) + boff + n * 2048 + k * 1024); } while (0)
#define PG8_MMA(ai, bj, At, Bt) do { __builtin_amdgcn_s_setprio(1); _Pragma("unroll") for (int m = 0; m < 4; ++m) _Pragma("unroll") for (int n = 0; n < 2; ++n) _Pragma("unroll") for (int k = 0; k < 2; ++k) \
        acc[ai][bj][m][n] = __builtin_amdgcn_mfma_f32_16x16x32_bf16(Bt[n][k], At[m][k], acc[ai][bj][m][n], 0, 0, 0); __builtin_amdgcn_s_setprio(0); } while (0)
#define PG8_WAIT_V(n) asm volatile("s_waitcnt vmcnt(" #n ")" ::: "memory")
#define PG8_WAIT_L(n) asm volatile("s_waitcnt lgkmcnt(" #n ")" ::: "memory")
#define PG8_BAR __builtin_amdgcn_s_barrier()
#define PG8_SCHED __builtin_amdgcn_sched_barrier(0)
    Unit cur, nxt; int ui = 0;
    if (!S.next(0, cur)) return;
    f32x4 acc[2][2][4][2];
#pragma unroll
    for (int a = 0; a < 2; ++a)
#pragma unroll
        for (int b = 0; b < 2; ++b)
#pragma unroll
            for (int m = 0; m < 4; ++m)
#pragma unroll
                for (int n = 0; n < 2; ++n) acc[a][b][m][n] = (f32x4){0.f, 0.f, 0.f, 0.f};
    bf16x8 At[4][2], B0[2][2], B1[2][2];
    const char* cA = (const char*)g.A + (size_t)cur.pm * tstepA; const char* cB = (const char*)g.Bt + (size_t)cur.pn * tstep;
    S.a_ready(cur);
    if constexpr (SP2) {
        PG8_STAGE(PG8_SB(0, 0), cB, voffB); PG8_STAGE(PG8_SB(0, 1), cB + hstep, voffB); PG8_STAGE(PG8_SA(0, 0), cA, voffA); PG8_STAGE(PG8_SA(0, 1), cA + hstepA, voffA);
        if (wr == 1) PG8_BAR;
        PG8_WAIT_V(2); PG8_BAR;
        PG8_STAGE(PG8_SB(1, 0), cB + kstep, voffB); PG8_STAGE(PG8_SA(1, 0), cA + kstep, voffA); PG8_STAGE(PG8_SB(1, 1), cB + hstep + kstep, voffB);
        PG8_WAIT_V(6); PG8_BAR;
    } else {
        PG8_STAGE(PG8_SB(0, 0), cB, voffB); PG8_STAGE(PG8_SA(0, 0), cA, voffA); PG8_STAGE(PG8_SB(0, 1), cB + hstep, voffB); PG8_STAGE(PG8_SA(0, 1), cA + hstepA, voffA);
        if (wr == 1) PG8_BAR;
        PG8_WAIT_V(4); PG8_BAR;
        PG8_STAGE(PG8_SB(1, 0), cB + kstep, voffB); PG8_STAGE(PG8_SA(1, 0), cA + kstep, voffA); PG8_STAGE(PG8_SB(1, 1), cB + hstep + kstep, voffB);
        PG8_WAIT_V(6); PG8_BAR;
    }
    for (;;) {
        const bool has_next = S.next(ui + 1, nxt);
        const char* nA = has_next ? (const char*)g.A + (size_t)nxt.pm * tstepA : cA; const char* nB = has_next ? (const char*)g.Bt + (size_t)nxt.pn * tstep : cB;
        for (int t = 0; t < nt; t += 2) {
            const bool last = (t == nt - 2);
            const char* a1 = cA + (size_t)(t + 1) * kstep;
            const char* a2 = last ? nA : cA + (size_t)(t + 2) * kstep; const char* b2 = last ? nB : cB + (size_t)(t + 2) * kstep;
            const char* a3 = a2 + kstep; const char* b3 = b2 + kstep;
            if (last && has_next) S.a_ready(nxt);
            if constexpr (SP2) {
            PG8_LDB(B0, 0, 0); PG8_LDB(B1, 0, 1); PG8_SCHED; PG8_LDA(At, 0, 0); PG8_STAGE(PG8_SA(1, 1), a1 + hstepA, voffA);
            PG8_WAIT_V(8); PG8_WAIT_L(0); PG8_BAR; PG8_MMA(0, 0, At, B0); PG8_MMA(0, 1, At, B1); PG8_BAR; PG8_SCHED;
            PG8_LDA(At, 0, 1); PG8_STAGE(PG8_SB(0, 0), b2, voffB); PG8_STAGE(PG8_SB(0, 1), b2 + hstep, voffB); PG8_STAGE(PG8_SA(0, 0), a2, voffA);
            PG8_WAIT_V(8); PG8_WAIT_L(0); PG8_BAR; PG8_MMA(1, 0, At, B0); PG8_MMA(1, 1, At, B1); PG8_BAR; PG8_SCHED;
            PG8_LDB(B0, 1, 0); PG8_LDB(B1, 1, 1); PG8_SCHED; PG8_LDA(At, 1, 0); PG8_STAGE(PG8_SA(0, 1), a2 + hstepA, voffA);
            PG8_WAIT_V(8); PG8_WAIT_L(0); PG8_BAR; PG8_MMA(0, 0, At, B0); PG8_MMA(0, 1, At, B1); PG8_BAR; PG8_SCHED;
            PG8_LDA(At, 1, 1); PG8_STAGE(PG8_SB(1, 0), b3, voffB); PG8_STAGE(PG8_SB(1, 1), b3 + hstep, voffB); PG8_STAGE(PG8_SA(1, 0), a3, voffA);
            PG8_WAIT_V(8); PG8_WAIT_L(0); PG8_BAR; PG8_MMA(1, 0, At, B0); PG8_MMA(1, 1, At, B1); PG8_BAR; PG8_SCHED;
            } else {
            PG8_LDB(B0, 0, 0); PG8_SCHED; PG8_LDA(At, 0, 0); PG8_STAGE(PG8_SA(1, 1), a1 + hstepA, voffA);
            PG8_WAIT_L(8); PG8_BAR; PG8_WAIT_L(0); PG8_MMA(0, 0, At, B0); PG8_BAR; PG8_SCHED;
            PG8_LDB(B1, 0, 1); PG8_STAGE(PG8_SB(0, 0), b2, voffB);
            PG8_BAR; PG8_WAIT_L(0); PG8_MMA(0, 1, At, B1); PG8_BAR;
            PG8_LDA(At, 0, 1); PG8_STAGE(PG8_SA(0, 0), a2, voffA);
            PG8_BAR; PG8_WAIT_L(0); PG8_MMA(1, 0, At, B0); PG8_BAR; PG8_SCHED;
            PG8_STAGE(PG8_SB(0, 1), b2 + hstep, voffB);
            PG8_WAIT_V(6); PG8_BAR; PG8_MMA(1, 1, At, B1); PG8_BAR;
            PG8_LDB(B0, 1, 0); PG8_SCHED; PG8_LDA(At, 1, 0); PG8_STAGE(PG8_SA(0, 1), a2 + hstepA, voffA);
            PG8_WAIT_L(8); PG8_BAR; PG8_WAIT_L(0); PG8_MMA(0, 0, At, B0); PG8_BAR; PG8_SCHED;
            PG8_LDB(B1, 1, 1); PG8_STAGE(PG8_SB(1, 0), b3, voffB);
            PG8_BAR; PG8_WAIT_L(0); PG8_MMA(0, 1, At, B1); PG8_BAR;
            PG8_LDA(At, 1, 1); PG8_STAGE(PG8_SA(1, 0), a3, voffA);
            PG8_BAR; PG8_WAIT_L(0); PG8_MMA(1, 0, At, B0); PG8_BAR; PG8_SCHED;
            PG8_STAGE(PG8_SB(1, 1), b3 + hstep, voffB);
            PG8_WAIT_V(6); PG8_BAR; PG8_MMA(1, 1, At, B1); PG8_BAR;
            }
        }
        if constexpr (ALIGN_EPI) { if (wr == 0) PG8_BAR; }
        if constexpr (!Epi::AFTER_DRAIN) { E(acc, cur, wr, wc, fr, fq); S.done(cur); }
        if (!has_next) break;
#pragma unroll
        for (int a = 0; a < 2; ++a)
#pragma unroll
            for (int b = 0; b < 2; ++b)
#pragma unroll
                for (int m = 0; m < 4; ++m)
#pragma unroll
                    for (int n = 0; n < 2; ++n) acc[a][b][m][n] = (f32x4){0.f, 0.f, 0.f, 0.f};
        cur = nxt; cA = nA; cB = nB; ++ui;
        if constexpr (ALIGN_EPI) { if (wr == 1) PG8_BAR; }
    }
    PG8_WAIT_V(0);
    if constexpr (!ALIGN_EPI) { if (wr == 0) PG8_BAR; }
    PG8_BAR;
    if constexpr (Epi::AFTER_DRAIN) { E.fused(acc, cur, wr, wc, fr, fq, lds, wid, lane); S.done(cur); }
#undef PG8_SA
#undef PG8_SB
#undef PG8_STAGE
#undef PG8_LDA
#undef PG8_LDB
#undef PG8_MMA
#undef PG8_WAIT_V
#undef PG8_WAIT_L
#undef PG8_BAR
#undef PG8_SCHED
}
}

namespace pg8 {
struct EpiResF32 {
    static constexpr bool PERM = false, AFTER_DRAIN = false;
    const float* base; float* out; int ldc;
    __device__ __forceinline__ void operator()(const f32x4 (&acc)[2][2][4][2], const Unit& u, int wr, int wc, int fr, int fq) const {
        const int col0 = u.pn * BM + wc * 32 + 4 * fq;
#pragma unroll
        for (int ai = 0; ai < 2; ++ai)
#pragma unroll
            for (int m = 0; m < 4; ++m) { const size_t off = (size_t)(u.pm * BM + ai * HALF + wr * 64 + m * 16 + fr) * ldc + col0;
#pragma unroll
                for (int bj = 0; bj < 2; ++bj)
#pragma unroll
                    for (int n = 0; n < 2; ++n) { const f32x4 bs = *(const f32x4*)(base + off + bj * HALF + n * 16); *(f32x4*)(out + off + bj * HALF + n * 16) = bs + acc[ai][bj][m][n]; } }
    }
};
}

#ifndef DBG_MASK
#define DBG_MASK 127
#endif
constexpr int NWAVES = 8;
#ifndef MK_N_LAUNCHES
#define MK_N_LAUNCHES 1
#endif
constexpr int N_PHASES = 12;
constexpr int N_LAUNCHES = MK_N_LAUNCHES;

constexpr int BATCH = 8, SEQ = 4096, DM = 1024, DEPTH = 2;
constexpr int M = BATCH * SEQ;
constexpr int NH = 8, HD = 128;
constexpr int NSH = 16, SHD = 64, NST = 128;
constexpr int NIN = 6672;
constexpr int PITCH = 6656;
constexpr int C_Q = 0, C_Z = 1024, C_K = 2048, C_V = 3072, C_G = 4096, C_X = 5120, C_B = 6144, C_C = 6400;
constexpr int MOBA = 256, NBLK = SEQ / MOBA;
constexpr float EPS = 1e-6f;

constexpr size_t MiB = 1u << 20;
constexpr size_t WS_CTL = 0, CTL_ZERO_BYTES = 1 * MiB;
constexpr size_t WS_WIN = 1 * MiB;
constexpr size_t WS_WOUT = 14 * MiB;
constexpr size_t WS_KM = 18 * MiB;
constexpr size_t WS_DT = 19 * MiB;
constexpr size_t WS_SSQ = 21 * MiB;
constexpr size_t WS_A = 32 * MiB;
constexpr size_t WS_PROJ = 96 * MiB;
constexpr size_t WS_END = 512 * MiB;
static_assert(WS_PROJ + (size_t)M * PITCH * 2 <= WS_END, "d_ws map");
constexpr int CW_TMO = 0;
constexpr int CW_BAR = 4096;

constexpr int RING_OFF = 0, RING_BYTES = 131072;
constexpr int LDSCTL_OFF = RING_BYTES, MISC_OFF = LDSCTL_OFF + 320;
constexpr int LDS_BYTES = 147456;
static_assert(MISC_OFF + 128 <= LDS_BYTES, "LDS map");

#define GAS __attribute__((address_space(1)))
#define LAS __attribute__((address_space(3)))
typedef unsigned short bf16;
typedef unsigned v4u __attribute__((ext_vector_type(4)));
typedef unsigned v2u __attribute__((ext_vector_type(2)));
typedef float f32x4 __attribute__((ext_vector_type(4)));
typedef short bf16x8 __attribute__((ext_vector_type(8)));
typedef GAS unsigned gu32;
#define RLX_AGENT __ATOMIC_RELAXED, __HIP_MEMORY_SCOPE_AGENT
#define LDS_WAIT() asm volatile("s_waitcnt lgkmcnt(0)" ::: "memory")
#define VM_WAIT() asm volatile("s_waitcnt vmcnt(0)" ::: "memory")
__device__ __forceinline__ unsigned f2bf(float f) { unsigned u = __builtin_bit_cast(unsigned, f); return (u + 0x7fffu + ((u >> 16) & 1u)) >> 16; }
__device__ __forceinline__ unsigned pk2(float lo, float hi) { return f2bf(lo) | (f2bf(hi) << 16); }
__device__ __forceinline__ float bflo(unsigned u) { return __builtin_bit_cast(float, u << 16); }
__device__ __forceinline__ float bfhi(unsigned u) { return __builtin_bit_cast(float, u & 0xffff0000u); }
__device__ __forceinline__ float silu_f(float v) { return v / (1.f + __expf(-v)); }
__device__ __forceinline__ float wave_sum(float v) {
#pragma unroll
    for (int o = 1; o < 64; o <<= 1) v += __shfl_xor(v, o);
    return v;
}
__device__ __forceinline__ float wave_max(float v) {
#pragma unroll
    for (int o = 1; o < 64; o <<= 1) v = fmaxf(v, __shfl_xor(v, o));
    return v;
}

#define XB_TMO      128
#define XB_XCNT(j)  (256  + 64 * (j))
#define XB_XSUB(j)  (1280 + 64 * (j))
#define XB_XGEN(j)  (2304 + 64 * (j))
#define XB_TOP      3328
#define XB_TOPGEN   3392
#define XCD_BAR_WORDS 3456
#define XB_SPIN_CAP (1u << 22)

__device__ __forceinline__ unsigned xb_ld(unsigned* p)              { return __hip_atomic_load(p, __ATOMIC_RELAXED, __HIP_MEMORY_SCOPE_AGENT); }
__device__ __forceinline__ unsigned xb_add(unsigned* p, unsigned v) { return __hip_atomic_fetch_add(p, v, __ATOMIC_RELAXED, __HIP_MEMORY_SCOPE_AGENT); }
__device__ __forceinline__ unsigned xb_xcc_id() { return (unsigned)__builtin_amdgcn_s_getreg((3 << 11) | 20) & 0xFu; }
#define XB_SPIN(cond, bar) do { unsigned _sp = 0; while (cond) { __builtin_amdgcn_s_sleep(1); \
    if ((++_sp & 255u) == 0u) { if (xb_ld(&(bar)[XB_TMO])) break; if (_sp > XB_SPIN_CAP) { atomicAdd(&(bar)[XB_TMO], 1u); break; } } } } while (0)

struct XcdBarrier { unsigned* bar; unsigned x; volatile LAS unsigned* st; };

__device__ __forceinline__ XcdBarrier xcd_barrier_post(unsigned* bar, volatile LAS unsigned* st) {
    XcdBarrier b; b.bar = bar; b.x = xb_xcc_id(); b.st = st;
    if (threadIdx.x == 0) (void)xb_add(&bar[XB_XCNT(b.x)], 1u);
    return b;
}
__device__ __forceinline__ void xcd_barrier_complete(unsigned* bar, unsigned x, unsigned& nloc, unsigned& nx) {
    const unsigned G = gridDim.x * gridDim.y * gridDim.z;
    unsigned sum, cnt, mine, sp = 0u;
    for (;;) {
        sum = 0u; cnt = 0u; mine = 0u;
#pragma unroll
        for (unsigned j = 0; j < 16; ++j) { const unsigned c = xb_ld(&bar[XB_XCNT(j)]); sum += c; cnt += (c > 0u) ? 1u : 0u; mine = (j == x) ? c : mine; }
        if (sum == G) break;
        __builtin_amdgcn_s_sleep(1);
        if ((++sp & 255u) == 0u) { if (xb_ld(&bar[XB_TMO])) break; if (sp > XB_SPIN_CAP) { atomicAdd(&bar[XB_TMO], 1u); break; } }
    }
    nloc = mine > 0u ? mine : 1u; nx = cnt > 0u ? cnt : 1u;
}
__device__ __forceinline__ void xcd_barrier(const XcdBarrier& b) {
    asm volatile("s_waitcnt vmcnt(0)" ::: "memory");
    __syncthreads();
    if (threadIdx.x == 0) {
        unsigned* bar = b.bar;
        __builtin_amdgcn_s_waitcnt(0);
        unsigned nloc = b.st[0], nx = b.st[1];
        if (nloc == 0u) { xcd_barrier_complete(bar, b.x, nloc, nx); b.st[0] = nloc; b.st[1] = nx; }
        const unsigned old = xb_add(&bar[XB_XSUB(b.x)], 1u);
        const unsigned gen = old / nloc;
        if (old + 1u == (gen + 1u) * nloc) {
            __builtin_amdgcn_fence(__ATOMIC_RELEASE, "agent");
            asm volatile("s_waitcnt vmcnt(0)" ::: "memory");
            const unsigned og = xb_add(&bar[XB_TOP], 1u);
            const unsigned tg = og / nx;
            if (og + 1u == (tg + 1u) * nx) xb_add(&bar[XB_TOPGEN], 1u);
            else XB_SPIN(xb_ld(&bar[XB_TOPGEN]) == tg, bar);
            __builtin_amdgcn_fence(__ATOMIC_ACQUIRE, "agent");
            xb_add(&bar[XB_XGEN(b.x)], 1u);
            asm volatile("s_waitcnt vmcnt(0)" ::: "memory");
        } else {
            XB_SPIN(xb_ld(&bar[XB_XGEN(b.x)]) == gen, bar);
            __builtin_amdgcn_fence(__ATOMIC_ACQUIRE, "agent");
            asm volatile("s_waitcnt vmcnt(0)" ::: "memory");
        }
    }
    __syncthreads();
}

struct Frame {
    LAS unsigned char* lds;
    volatile LAS unsigned* MISC;
    int tid, lane, wave;
    int vcu, G;
};
struct Args { const float* in[12]; float* out; unsigned char* ws; int ph_lo, ph_hi, li, pad; };
template <class T> __device__ __forceinline__ T* karg_ptr(int byte_off) {
    const char __attribute__((address_space(4)))* p = (const char __attribute__((address_space(4)))*)__builtin_amdgcn_kernarg_segment_ptr();
    int o = byte_off; asm volatile("" : "+s"(o));
    return *(T* const __attribute__((address_space(4)))*)(p + o);
}
__device__ __forceinline__ const float* in_ptr(int i) { return karg_ptr<const float>(8 * i); }
__device__ __forceinline__ float* out_ptr() { return karg_ptr<float>(96); }
__device__ __forceinline__ unsigned char* ws_ptr() { return karg_ptr<unsigned char>(104); }
#define WSP(T, off) ((T*)(ws_ptr() + (off)))

__device__ __forceinline__ void transpose_item(const float* Wsrc, int ldw, int K, int ncols, bf16* WT, int row_off, LAS float* scr, int item, int lane) {
    const int nblk = ncols / 32, kb = item / nblk, nb = item % nblk, k0 = 64 * kb, n0 = 32 * nb;
#pragma unroll 8
    for (int i = 0; i < 32; ++i) { const int kk = 2 * i + (lane >> 5); scr[kk * 33 + (lane & 31)] = Wsrc[(size_t)(k0 + kk) * ldw + n0 + (lane & 31)]; }
    LDS_WAIT(); asm volatile("" ::: "memory");
    const int c = lane & 7;
#pragma unroll
    for (int j = 0; j < 4; ++j) { const int n = (lane >> 3) + 8 * j; const LAS float* s = scr + (8 * c) * 33 + n;
        v4u o; o.x = pk2(s[0 * 33], s[1 * 33]); o.y = pk2(s[2 * 33], s[3 * 33]); o.z = pk2(s[4 * 33], s[5 * 33]); o.w = pk2(s[6 * 33], s[7 * 33]);
        *(v4u*)(WT + (size_t)(row_off + n0 + n) * K + k0 + 8 * c) = o; }
    LDS_WAIT(); asm volatile("" ::: "memory");
}

__device__ __forceinline__ void phase_a(Frame& F, int layer) {
    bf16* const WinT = WSP(bf16, WS_WIN); bf16* const WoutT = WSP(bf16, WS_WOUT); bf16* const XN = WSP(bf16, WS_A); float* const DT = WSP(float, WS_DT); const float* const OUTP = out_ptr();
    const int gw = F.vcu * NWAVES + F.wave, NGW = F.G * NWAVES;
    {
        LAS float* scr = (LAS float*)(F.lds + RING_OFF + F.wave * 16384);
        const float* win = in_ptr(2) + (size_t)layer * DM * NIN;
        const float* wout = in_ptr(11) + (size_t)layer * 2048 * DM;
        constexpr int KB_IN = DM / 64;
        constexpr int I_1K = KB_IN * (1024 / 32), I_X = KB_IN * (1536 / 32), I_OUT = (2048 / 64) * (1024 / 32);
        constexpr int NITEMS = 5 * I_1K + I_X + I_OUT;
        for (int it = gw; it < NITEMS; it += NGW) {
            int r = it;
            if (r < I_1K) { transpose_item(win + 0,    NIN, DM, 1024, WinT, C_Q, scr, r, F.lane); continue; } r -= I_1K;
            if (r < I_1K) { transpose_item(win + 4096, NIN, DM, 1024, WinT, C_Z, scr, r, F.lane); continue; } r -= I_1K;
            if (r < I_1K) { transpose_item(win + 1024, NIN, DM, 1024, WinT, C_K, scr, r, F.lane); continue; } r -= I_1K;
            if (r < I_1K) { transpose_item(win + 2048, NIN, DM, 1024, WinT, C_V, scr, r, F.lane); continue; } r -= I_1K;
            if (r < I_1K) { transpose_item(win + 3072, NIN, DM, 1024, WinT, C_G, scr, r, F.lane); continue; } r -= I_1K;
            if (r < I_X)  { transpose_item(win + 5120, NIN, DM, 1536, WinT, C_X, scr, r, F.lane); continue; } r -= I_X;
            transpose_item(wout, DM, 2048, 1024, WoutT, 0, scr, r, F.lane);
        }
    }
    __syncthreads();
    LAS float* wdt = (LAS float*)(F.lds + RING_OFF);
    {
        const float* win = in_ptr(2) + (size_t)layer * DM * NIN + 6656;
        for (int i = F.tid; i < 16 * 1024; i += NWAVES * 64) { const int k = i >> 4, c = i & 15; wdt[c * 1024 + k] = win[(size_t)k * NIN + c]; }
    }
    __syncthreads();
    const float* xin = layer == 0 ? in_ptr(0) : OUTP;
    const float* lnw = in_ptr(1) + layer * DM;
    const float* dtb = in_ptr(7) + layer * NSH;
    f32x4 lw[4];
#pragma unroll
    for (int j = 0; j < 4; ++j) lw[j] = *(const f32x4*)(lnw + 4 * F.lane + 256 * j);
    for (int m = gw; m < M; m += NGW) {
        asm volatile("" ::: "memory");
        const f32x4* xr = (const f32x4*)(xin + (size_t)m * DM) + F.lane;
        f32x4 v[4]; float s = 0.f;
#pragma unroll
        for (int j = 0; j < 4; ++j) { v[j] = xr[64 * j]; s += (v[j].x * v[j].x + v[j].y * v[j].y) + (v[j].z * v[j].z + v[j].w * v[j].w); }
        const float rstd = 1.f / sqrtf(wave_sum(s) * (1.f / DM) + EPS);
#pragma unroll
        for (int j = 0; j < 4; ++j) v[j] = v[j] * rstd * lw[j];
        unsigned long long* o8 = (unsigned long long*)(XN + (size_t)m * DM) + F.lane;
#pragma unroll
        for (int j = 0; j < 4; ++j) o8[64 * j] = (unsigned long long)pk2(v[j].x, v[j].y) | ((unsigned long long)pk2(v[j].z, v[j].w) << 32);
        float mine = 0.f;
#pragma unroll
        for (int c = 0; c < 16; ++c) {
            float p = 0.f;
#pragma unroll
            for (int j = 0; j < 4; ++j) { const f32x4 w = *(const LAS f32x4*)(wdt + c * 1024 + 4 * F.lane + 256 * j); p += (v[j].x * w.x + v[j].y * w.y) + (v[j].z * w.z + v[j].w * w.w); }
            p = wave_sum(p);
            if (F.lane == c) mine = p;
        }
        if (F.lane < 16) { const float a = mine + dtb[F.lane]; DT[(size_t)m * 16 + F.lane] = fmaxf(a, 0.f) + log1pf(__expf(-fabsf(a))); }
    }
}

__device__ __forceinline__ void phase_c(Frame& F, int layer) {
    bf16* const PROJ = WSP(bf16, WS_PROJ); bf16* const BCc = WSP(bf16, WS_A); float* const KM = WSP(float, WS_KM);
    const float* qw = in_ptr(3) + layer * HD; const float* kw = in_ptr(4) + layer * HD;
    const float qw0 = qw[2 * F.lane], qw1 = qw[2 * F.lane + 1], kw0 = kw[2 * F.lane], kw1 = kw[2 * F.lane + 1];
    LAS float* red = (LAS float*)(F.lds + RING_OFF);
    for (int item = F.vcu; item < BATCH * NBLK * NH; item += F.G) {
        const int h = item & 7, n = (item >> 3) & 15, b = item >> 7;
        const size_t m0 = (size_t)b * SEQ + n * MOBA + F.wave * 32;
        float ks0 = 0.f, ks1 = 0.f;
        for (int r = 0; r < 32; ++r) {
            bf16* qp = PROJ + (m0 + r) * PITCH + C_Q + h * HD + 2 * F.lane;
            bf16* kp = PROJ + (m0 + r) * PITCH + C_K + h * HD + 2 * F.lane;
            const unsigned qu = *(const unsigned*)qp, ku = *(const unsigned*)kp;
            float q0 = bflo(qu), q1 = bfhi(qu), k0 = bflo(ku), k1 = bfhi(ku);
            const float qs = wave_sum(q0 * q0 + q1 * q1), kss = wave_sum(k0 * k0 + k1 * k1);
            const float qr = 1.f / sqrtf(qs * (1.f / HD) + EPS), kr = 1.f / sqrtf(kss * (1.f / HD) + EPS);
            q0 = q0 * qr * qw0; q1 = q1 * qr * qw1; k0 = k0 * kr * kw0; k1 = k1 * kr * kw1;
            *(unsigned*)qp = pk2(q0, q1); *(unsigned*)kp = pk2(k0, k1);
            ks0 += k0; ks1 += k1;
        }
        red[F.wave * 128 + 2 * F.lane] = ks0; red[F.wave * 128 + 2 * F.lane + 1] = ks1;
        __syncthreads();
        if (F.tid < 128) { float s = 0.f;
#pragma unroll
            for (int w = 0; w < 8; ++w) s += red[w * 128 + F.tid];
            KM[(((size_t)b * NH + h) * NBLK + n) * HD + F.tid] = s * (1.f / MOBA); }
        __syncthreads();
    }
    const float* cw = in_ptr(5) + (size_t)layer * 4 * 1536 + 1024;
    const float* cb = in_ptr(6) + (size_t)layer * 1536 + 1024;
    const int gt = F.vcu * (NWAVES * 64) + F.tid, NGT = F.G * NWAVES * 64;
    for (int i = gt; i < M * 64; i += NGT) {
        const int m = i >> 6, c8 = (i & 63) * 8, t = m & (SEQ - 1);
        float acc[8];
#pragma unroll
        for (int e = 0; e < 8; ++e) acc[e] = cb[c8 + e];
#pragma unroll
        for (int k = 0; k < 4; ++k) {
            if (t - 3 + k >= 0) {
                const v4u u = *(const v4u*)(PROJ + (size_t)(m - 3 + k) * PITCH + C_B + c8);
                const float* w = cw + k * 1536 + c8;
                acc[0] += w[0] * bflo(u.x); acc[1] += w[1] * bfhi(u.x); acc[2] += w[2] * bflo(u.y); acc[3] += w[3] * bfhi(u.y);
                acc[4] += w[4] * bflo(u.z); acc[5] += w[5] * bfhi(u.z); acc[6] += w[6] * bflo(u.w); acc[7] += w[7] * bfhi(u.w);
            }
        }
        v4u o; o.x = pk2(silu_f(acc[0]), silu_f(acc[1])); o.y = pk2(silu_f(acc[2]), silu_f(acc[3])); o.z = pk2(silu_f(acc[4]), silu_f(acc[5])); o.w = pk2(silu_f(acc[6]), silu_f(acc[7]));
        *(v4u*)(BCc + (size_t)m * 512 + c8) = o;
    }
}

__device__ __forceinline__ void ssd_simple(Frame& F, int layer) {
    bf16* const PROJ = WSP(bf16, WS_PROJ); const bf16* const BCc = WSP(bf16, WS_A); const float* const DT = WSP(float, WS_DT); float* const SSQ = WSP(float, WS_SSQ);
    const int gw = F.wave * F.G + F.vcu;
    if (gw >= BATCH * NSH) return;
    const int b = gw >> 4, h = gw & 15, g = h >> 3, p = F.lane;
    LAS unsigned* st = (LAS unsigned*)(F.lds + 32768 + F.wave * 8192);
    const float* cwp = in_ptr(5) + (size_t)layer * 4 * 1536 + h * SHD + p;
    const float cw0 = cwp[0], cw1 = cwp[1536], cw2 = cwp[2 * 1536], cw3 = cwp[3 * 1536], cbias = in_ptr(6)[(size_t)layer * 1536 + h * SHD + p];
    const float A = -__expf(in_ptr(8)[layer * NSH + h]), Dh = in_ptr(9)[layer * NSH + h];
    float s[NST];
#pragma unroll
    for (int n = 0; n < NST; ++n) s[n] = 0.f;
    float x0 = 0.f, x1 = 0.f, x2 = 0.f;
    for (int t0 = 0; t0 < SEQ; t0 += 16) {
        const size_t mb = (size_t)b * SEQ + t0;
#pragma unroll
        for (int i = 0; i < 8; ++i) { const int ch = i * 64 + F.lane, row = ch >> 5, c = ch & 31;
            const v4u u = *(const v4u*)(BCc + (mb + row) * 512 + (c < 16 ? g * 128 + c * 8 : 256 + g * 128 + (c - 16) * 8));
            *(LAS v4u*)(st + row * 128 + c * 4) = u; }
        LDS_WAIT(); asm volatile("" ::: "memory");
        for (int tt = 0; tt < 16; ++tt) {
            const size_t m = mb + tt;
            const float xr = bflo((unsigned)PROJ[m * PITCH + C_X + h * SHD + p]);
            const float xc = silu_f(cw0 * x0 + cw1 * x1 + cw2 * x2 + cw3 * xr + cbias);
            x0 = x1; x1 = x2; x2 = xr;
            const float dt = DT[m * 16 + h], dA = __expf(dt * A), dtx = dt * xc;
            float y = 0.f;
#pragma unroll
            for (int n8 = 0; n8 < 16; ++n8) {
                const v4u bu = *(const LAS v4u*)(st + tt * 128 + n8 * 4), cu = *(const LAS v4u*)(st + tt * 128 + 64 + n8 * 4);
                const float bb[8] = {bflo(bu.x), bfhi(bu.x), bflo(bu.y), bfhi(bu.y), bflo(bu.z), bfhi(bu.z), bflo(bu.w), bfhi(bu.w)};
                const float cc[8] = {bflo(cu.x), bfhi(cu.x), bflo(cu.y), bfhi(cu.y), bflo(cu.z), bfhi(cu.z), bflo(cu.w), bfhi(cu.w)};
#pragma unroll
                for (int e = 0; e < 8; ++e) { s[n8 * 8 + e] = s[n8 * 8 + e] * dA + dtx * bb[e]; y += cc[e] * s[n8 * 8 + e]; }
            }
            y += Dh * xc;
            bf16* zp = PROJ + m * PITCH + C_Z + h * SHD + p;
            const float z = bflo((unsigned)*zp), yz = y * silu_f(z);
            *zp = (bf16)f2bf(yz);
            const float q = wave_sum(yz * yz);
            if (F.lane == 0) { SSQ[m * 32 + h * 2] = q; SSQ[m * 32 + h * 2 + 1] = 0.f; }
        }
        asm volatile("" ::: "memory");
    }
}

__device__ __forceinline__ void attn_simple(Frame& F, int layer) {
    bf16* const PROJ = WSP(bf16, WS_PROJ); const float* const KM = WSP(float, WS_KM);
    LAS float* qs = (LAS float*)(F.lds + F.wave * 1024);
    const int gw = F.vcu * NWAVES + F.wave, NGW = F.G * NWAVES;
    const float scale = 0.08838834764831845f;
    for (int it = gw; it < M * NH; it += NGW) {
        const int m = it >> 3, h = it & 7, b = m >> 12, t = m & (SEQ - 1), own = t >> 8;
        const float slope = exp2f(-(float)(h + 1));
        bf16* qp = PROJ + (size_t)m * PITCH + C_Q + h * HD + 2 * F.lane;
        const unsigned qu = *(const unsigned*)qp;
        const float q0 = bflo(qu), q1 = bfhi(qu);
        qs[2 * F.lane] = q0; qs[2 * F.lane + 1] = q1;
        LDS_WAIT(); asm volatile("" ::: "memory");
        float v0 = -INFINITY, v1 = -INFINITY, v2 = -INFINITY; int i0 = 0, i1 = 0, i2 = 0;
        const float* km = KM + ((size_t)b * NH + h) * NBLK * HD + 2 * F.lane;
        for (int n = 0; n < own; ++n) {
            const float gt = wave_sum(q0 * km[n * HD] + q1 * km[n * HD + 1]);
            if (gt > v0) { v2 = v1; i2 = i1; v1 = v0; i1 = i0; v0 = gt; i0 = n; }
            else if (gt > v1) { v2 = v1; i2 = i1; v1 = gt; i1 = n; }
            else if (gt > v2) { v2 = gt; i2 = n; }
        }
        const int nsel = own < 3 ? own : 3;
        float sc[16];
#pragma unroll
        for (int sl = 0; sl < 4; ++sl) {
            const int blk = sl == 0 ? i0 : sl == 1 ? i1 : sl == 2 ? i2 : own;
            const bool on = sl == 3 || sl < nsel;
#pragma unroll
            for (int j = 0; j < 4; ++j) {
                float s = -INFINITY;
                if (on) {
                    const int pos = blk * MOBA + j * 64 + F.lane;
                    const bf16* kp = PROJ + ((size_t)b * SEQ + pos) * PITCH + C_K + h * HD;
                    float d = 0.f;
#pragma unroll
                    for (int c = 0; c < 16; ++c) {
                        const v4u u = *(const v4u*)(kp + c * 8);
                        const f32x4 qa = *(const LAS f32x4*)(qs + c * 8), qb = *(const LAS f32x4*)(qs + c * 8 + 4);
                        d += (qa.x * bflo(u.x) + qa.y * bfhi(u.x)) + (qa.z * bflo(u.y) + qa.w * bfhi(u.y)) + (qb.x * bflo(u.z) + qb.y * bfhi(u.z)) + (qb.z * bflo(u.w) + qb.w * bfhi(u.w));
                    }
                    s = d * scale - slope * (float)(t - pos);
                    if (pos > t) s = -INFINITY;
                }
                sc[sl * 4 + j] = s;
            }
        }
        float mx = sc[0];
#pragma unroll
        for (int i = 1; i < 16; ++i) mx = fmaxf(mx, sc[i]);
        mx = wave_max(mx);
        float l = 0.f;
#pragma unroll
        for (int i = 0; i < 16; ++i) { sc[i] = __expf(sc[i] - mx); l += sc[i]; }
        l = wave_sum(l);
        float a0 = 0.f, a1 = 0.f;
#pragma unroll
        for (int sl = 0; sl < 4; ++sl) {
            const int blk = sl == 0 ? i0 : sl == 1 ? i1 : sl == 2 ? i2 : own;
#pragma unroll
            for (int j = 0; j < 4; ++j) {
                const float pj = sc[sl * 4 + j];
                if (wave_max(pj) > 0.f) {
                    const bf16* vp = PROJ + ((size_t)b * SEQ + blk * MOBA + j * 64) * PITCH + C_V + h * HD + 2 * F.lane;
                    for (int kk = 0; kk < 64; ++kk) {
                        const float pk = __shfl(pj, kk);
                        const unsigned vu = *(const unsigned*)(vp + (size_t)kk * PITCH);
                        a0 += pk * bflo(vu); a1 += pk * bfhi(vu);
                    }
                }
            }
        }
        const unsigned gu = *(const unsigned*)(PROJ + (size_t)m * PITCH + C_G + h * HD + 2 * F.lane);
        const float inv = 1.f / l;
        *(unsigned*)qp = pk2(a0 * inv * silu_f(bflo(gu)), a1 * inv * silu_f(bfhi(gu)));
    }
}

__device__ __forceinline__ void phase_e(Frame& F, int layer) {
    bf16* const PROJ = WSP(bf16, WS_PROJ); const float* const SSQ = WSP(float, WS_SSQ);
    const int gw = F.vcu * NWAVES + F.wave, NGW = F.G * NWAVES;
    const float* w = in_ptr(10) + (size_t)layer * 1024 + 16 * F.lane;
    float wv[16];
#pragma unroll
    for (int e = 0; e < 16; ++e) wv[e] = w[e];
    const int g = F.lane >> 5;
    for (int m = gw; m < M; m += NGW) {
        const f32x4* sp = (const f32x4*)(SSQ + (size_t)m * 32 + g * 16);
        const f32x4 s0 = sp[0], s1 = sp[1], s2 = sp[2], s3 = sp[3];
        const float ssq = ((s0.x + s0.y) + (s0.z + s0.w)) + ((s1.x + s1.y) + (s1.z + s1.w)) + ((s2.x + s2.y) + (s2.z + s2.w)) + ((s3.x + s3.y) + (s3.z + s3.w));
        const float r = 1.f / sqrtf(ssq * (1.f / 512.f) + EPS);
        v4u* yp = (v4u*)(PROJ + (size_t)m * PITCH + C_Z + 16 * F.lane);
        v4u a = yp[0], c = yp[1];
        a.x = pk2(bflo(a.x) * r * wv[0], bfhi(a.x) * r * wv[1]); a.y = pk2(bflo(a.y) * r * wv[2], bfhi(a.y) * r * wv[3]);
        a.z = pk2(bflo(a.z) * r * wv[4], bfhi(a.z) * r * wv[5]); a.w = pk2(bflo(a.w) * r * wv[6], bfhi(a.w) * r * wv[7]);
        c.x = pk2(bflo(c.x) * r * wv[8], bfhi(c.x) * r * wv[9]); c.y = pk2(bflo(c.y) * r * wv[10], bfhi(c.y) * r * wv[11]);
        c.z = pk2(bflo(c.z) * r * wv[12], bfhi(c.z) * r * wv[13]); c.w = pk2(bflo(c.w) * r * wv[14], bfhi(c.w) * r * wv[15]);
        yp[0] = a; yp[1] = c;
    }
}

__global__ void __launch_bounds__(NWAVES * 64, 2) mk_fwd(Args args) {
    extern __shared__ __attribute__((aligned(16))) unsigned char lds[];
    Frame F;
    F.lds = (LAS unsigned char*)lds;
    F.MISC = (volatile LAS unsigned*)(F.lds + MISC_OFF);
    F.tid = threadIdx.x; F.lane = F.tid & 63; F.wave = __builtin_amdgcn_readfirstlane(F.tid >> 6);
    F.G = gridDim.x; { const int bx = blockIdx.x; F.vcu = (F.G % 8 == 0) ? (bx % 8) * (F.G / 8) + bx / 8 : bx; }
    for (int u = F.tid; u < (LDS_BYTES - LDSCTL_OFF) / 4; u += NWAVES * 64) ((LAS unsigned*)(F.lds + LDSCTL_OFF))[u] = 0u;
    __syncthreads();
    XcdBarrier bar; bar.bar = nullptr; bar.x = 0; bar.st = nullptr;
    if (N_LAUNCHES == 1) bar = xcd_barrier_post(WSP(unsigned, WS_CTL) + CW_BAR, F.MISC + 8);
    const int lo = args.ph_lo, hi = args.ph_hi;
#define IN(k) (lo <= (k) && (k) < hi)
#define REFRESH() do { asm volatile("" : "+v"(F.tid)); F.lane = F.tid & 63; F.wave = __builtin_amdgcn_readfirstlane(F.tid >> 6); asm volatile("" : "+s"(F.vcu), "+s"(F.G)); } while (0)
#define SEAM(k) do { if (IN(k) && IN((k) + 1)) { bar.bar = WSP(unsigned, WS_CTL) + CW_BAR; xcd_barrier(bar); } } while (0)

#pragma unroll 1
    for (int layer = 0; layer < DEPTH; ++layer) {
        const int pb = layer * 6;
        if (IN(pb + 0) && (DBG_MASK & 1)) { REFRESH(); phase_a(F, layer); } SEAM(pb + 0);
        if (IN(pb + 1) && (DBG_MASK & 2)) {
            REFRESH();
            pg8::Gemm g{WSP(bf16, WS_A), WSP(bf16, WS_WIN), M, PITCH, DM, DM}; pg8::StaticOrder S; S.init(M, PITCH, F.G, (int)blockIdx.x);
            pg8::EpiBf16<0> E{WSP(bf16, WS_PROJ), PITCH, nullptr, 0, 0, 1.f};
            pg8::gemm_phase<pg8::EpiBf16<0>, pg8::StaticOrder, true, true>(F.lds + RING_OFF, g, S, E);
        } SEAM(pb + 1);
        if (IN(pb + 2) && (DBG_MASK & 4)) { REFRESH(); phase_c(F, layer); } SEAM(pb + 2);
        if (IN(pb + 3)) { if (DBG_MASK & 8) { REFRESH(); ssd_simple(F, layer); } if (DBG_MASK & 16) { REFRESH(); attn_simple(F, layer); } } SEAM(pb + 3);
        if (IN(pb + 4) && (DBG_MASK & 32)) { REFRESH(); phase_e(F, layer); } SEAM(pb + 4);
        if (IN(pb + 5) && (DBG_MASK & 64)) {
            REFRESH();
            float* const OUTP = out_ptr(); const float* base = layer == 0 ? in_ptr(0) : OUTP;
            pg8::Gemm g{WSP(bf16, WS_PROJ), WSP(bf16, WS_WOUT), M, DM, 2048, PITCH}; pg8::StaticOrder S; S.init(M, DM, F.G, (int)blockIdx.x);
            pg8::EpiResF32 E{base, OUTP, DM};
            pg8::gemm_phase<pg8::EpiResF32, pg8::StaticOrder, true, true>(F.lds + RING_OFF, g, S, E);
        } SEAM(pb + 5);
    }
#undef IN
#undef SEAM
}

extern "C" void kernel_launch(void* const* d_in, const int* in_sizes, int n_in, void* d_out, int out_size, void* d_ws, size_t ws_size, hipStream_t stream) {
    static int grid = 0;
    if (grid == 0) {
        if (n_in != 12 || in_sizes[0] != M * DM || out_size != M * DM || ws_size < WS_END) {
            fprintf(stderr, "kernel_launch: unexpected shapes (n_in %d, in0 %d, out %d, ws %zu); nothing launched\n", n_in, n_in > 0 ? in_sizes[0] : -1, out_size, ws_size); grid = -1; return; }
        int dev = 0, cus = 0, per_cu = 0;
        if (hipGetDevice(&dev) != hipSuccess || hipDeviceGetAttribute(&cus, hipDeviceAttributeMultiprocessorCount, dev) != hipSuccess) { grid = -1; return; }
        if (hipFuncSetAttribute((const void*)mk_fwd, hipFuncAttributeMaxDynamicSharedMemorySize, LDS_BYTES) != hipSuccess) { fprintf(stderr, "kernel_launch: hipFuncSetAttribute failed\n"); grid = -1; return; }
        if (hipOccupancyMaxActiveBlocksPerMultiprocessor(&per_cu, (const void*)mk_fwd, NWAVES * 64, LDS_BYTES) != hipSuccess || per_cu < 1) {
            fprintf(stderr, "kernel_launch: occupancy query reports %d workgroups per CU; nothing launched\n", per_cu); (void)hipGetLastError(); grid = -1; return; }
        grid = cus;
    }
    if (grid < 0) return;
    if (hipMemsetAsync((char*)d_ws + WS_CTL, 0, CTL_ZERO_BYTES, stream) != hipSuccess) { fprintf(stderr, "kernel_launch: hipMemsetAsync failed\n"); return; }
    Args a{};
    for (int i = 0; i < 12; ++i) a.in[i] = (const float*)d_in[i];
    a.out = (float*)d_out; a.ws = (unsigned char*)d_ws;
    for (int li = 0; li < N_LAUNCHES; ++li) {
        a.ph_lo = (N_LAUNCHES == 1) ? 0 : li; a.ph_hi = (N_LAUNCHES == 1) ? N_PHASES : li + 1; a.li = li;
        hipLaunchKernelGGL(mk_fwd, dim3(grid), dim3(NWAVES * 64), LDS_BYTES, stream, a);
        const hipError_t le = hipPeekAtLastError();
        if (le != hipSuccess) { fprintf(stderr, "kernel_launch: launch %d failed: %s\n", li, hipGetErrorName(le)); break; }
    }
}
```

```cpp
#include <hip/hip_runtime.h>
#include <cstdio>
#include <cstdint>
namespace pg8 {
#define PG8_LAS __attribute__((address_space(3)))
typedef unsigned short bf16_t;
typedef short bf16x8 __attribute__((ext_vector_type(8)));
typedef float f32x4 __attribute__((ext_vector_type(4)));
typedef unsigned u32x4 __attribute__((ext_vector_type(4)));
constexpr int BM = 256, BK = 64, HALF = 128, HTB = HALF * BK * 2  , STAGE_BYTES = 8 * HTB, NXCD = 8, WGM = 8;

__host__ __device__ __forceinline__ int lds_byte(int r, int c) { const int st = (r >> 4) * 2 + (c >> 5), rr = r & 15, cc = c & 31, ob = rr * 64 + cc * 2; return st * 1024 + (ob ^ (((ob >> 9) & 1) << 5)); }
__host__ __device__ __forceinline__ void stage_rc(int b, int& R, int& C) { const int st = b / 1024, sb = b % 1024, swz = sb ^ (((sb >> 9) & 1) << 5); R = (st >> 1) * 16 + swz / 64; C = (st & 1) * 32 + (swz % 64) / 2; }
__host__ __device__ __forceinline__ int perm32(int rho) { const int n = rho >> 4, i = rho & 15; return 8 * (i >> 2) + 4 * n + (i & 3); }

struct Unit { int pm, pn; };
struct Gemm { const bf16_t* A; const bf16_t* Bt; int M, N, K, lda; };

struct StaticOrder {
    int nM, nN, nwg, G, c;
    __host__ __device__ void init(int M, int N, int G_, int c_) { nM = M / BM; nN = N / BM; nwg = nM * nN; G = G_; c = c_; }
    __host__ __device__ bool next(int i, Unit& u) const {
        const long L = (long)i * G + c; if (L >= nwg) return false;
        int wgid = (int)L; { const int q = nwg / NXCD, r = nwg % NXCD, xcd = wgid % NXCD, off = wgid / NXCD; wgid = (xcd < r ? xcd * (q + 1) : r * (q + 1) + (xcd - r) * q) + off; }
        const int nig = WGM * nN, gid = wgid / nig, fm = gid * WGM, gsz = (nM - fm) < WGM ? (nM - fm) : WGM;
        u.pm = fm + ((wgid % nig) % gsz); u.pn = (wgid % nig) / gsz; return true;
    }
    __device__ __forceinline__ void a_ready(const Unit&) const {}
    __device__ __forceinline__ void done(const Unit&) const {}
};

__device__ __forceinline__ unsigned cvt_pk_bf16(float lo, float hi) { unsigned r; asm volatile("v_cvt_pk_bf16_f32 %0, %1, %2" : "=v"(r) : "v"(lo), "v"(hi)); return r; }
typedef float f32x2 __attribute__((ext_vector_type(2)));
__device__ __forceinline__ f32x2 gelu_pk(f32x2 v) {
    const f32x2 av = __builtin_elementwise_abs(v), d = av * 0.2316418882f + 1.0f;
    f32x2 t; t.x = __builtin_amdgcn_rcpf(d.x); t.y = __builtin_amdgcn_rcpf(d.y);
    f32x2 q = t * 0.5307027145f + (-0.7265760135f); q = q * t + 0.7107068705f; q = q * t + (-0.142248368f); q = q * t + 0.127414796f; q = q * t;
    const f32x2 s = (v * v) * (-0.72134752044f);
    f32x2 e; e.x = __builtin_amdgcn_exp2f(s.x); e.y = __builtin_amdgcn_exp2f(s.y);
    const f32x2 m = v * (q * e), r = v - m;
    f32x2 o; o.x = v.x < 0.f ? m.x : r.x; o.y = v.y < 0.f ? m.y : r.y; return o;
}

template <int ACT  > struct EpiBf16 {
    static constexpr bool PERM = true, AFTER_DRAIN = false; static_assert(ACT == 0 || ACT == 1, "EpiBf16: ACT is 0 (none) or 1 (gelu_pk)");
    bf16_t* O; int ldc; const float* bias; int split_cols; size_t split_stride; float scale0;
    __device__ __forceinline__ void operator()(const f32x4 (&acc)[2][2][4][2], const Unit& u, int wr, int wc, int fr, int fq) const {
        const int row0 = u.pm * BM + wr * 64 + fr; int colt = u.pn * BM; bf16_t* base = O;
        float sc = 1.f; if (split_cols) { const int t = colt / split_cols; base += (size_t)t * split_stride; colt -= t * split_cols; if (t == 0) sc = scale0; }
        const int col0 = colt + wc * 32 + 8 * fq, bcol0 = u.pn * BM + wc * 32 + 8 * fq;
        f32x4 bv[2][2];
#pragma unroll
        for (int bj = 0; bj < 2; ++bj)
#pragma unroll
            for (int n = 0; n < 2; ++n) bv[bj][n] = bias ? *(const f32x4*)(bias + bcol0 + bj * HALF + 4 * n) : (f32x4){0.f, 0.f, 0.f, 0.f};
#pragma unroll
        for (int ai = 0; ai < 2; ++ai)
#pragma unroll
            for (int m = 0; m < 4; ++m) { bf16_t* rowp = base + (size_t)(row0 + ai * HALF + m * 16) * ldc + col0;
#pragma unroll
                for (int bj = 0; bj < 2; ++bj) { f32x4 v0 = acc[ai][bj][m][0] + bv[bj][0], v1 = acc[ai][bj][m][1] + bv[bj][1];
                    if (ACT == 1) { f32x2 a = gelu_pk((f32x2){v0[0], v0[1]}), b = gelu_pk((f32x2){v0[2], v0[3]}), c = gelu_pk((f32x2){v1[0], v1[1]}), d = gelu_pk((f32x2){v1[2], v1[3]});
                        v0 = (f32x4){a.x, a.y, b.x, b.y}; v1 = (f32x4){c.x, c.y, d.x, d.y}; }
                    v0 = v0 * sc; v1 = v1 * sc; u32x4 w; w.x = cvt_pk_bf16(v0[0], v0[1]); w.y = cvt_pk_bf16(v0[2], v0[3]); w.z = cvt_pk_bf16(v1[0], v1[1]); w.w = cvt_pk_bf16(v1[2], v1[3]);
                    *(u32x4*)(rowp + bj * HALF) = w; } }
    }
};
template <class Epi, class Sched, bool ALIGN_EPI = false, bool SP2 = false>
__device__ __forceinline__ void gemm_phase(PG8_LAS unsigned char* lds, const Gemm g, const Sched& S, const Epi& E) {
    int tid_ = threadIdx.x; asm volatile("" : "+v"(tid_));
    const int tid = tid_, wid = __builtin_amdgcn_readfirstlane(tid >> 6), lane = tid & 63, wr = wid >> 2, wc = wid & 3, fr = lane & 15, fq = lane >> 4;
    const int K = g.K, nt = K / BK;
    unsigned voffA[2], voffB[2];
#pragma unroll
    for (int i = 0; i < 2; ++i) { int R, C; stage_rc(tid * 16 + i * 8192, R, C); const int Rb = Epi::PERM ? ((R & ~31) + perm32(R & 31)) : R;
        voffA[i] = (unsigned)(R * g.lda + C) * 2u; voffB[i] = (unsigned)(Rb * K + C) * 2u; }
    const size_t kstep = (size_t)(BK * 2);
    const size_t hstep = (size_t)HALF * K * 2;
    const size_t tstep = 2 * hstep; const size_t hstepA = (size_t)HALF * g.lda * 2, tstepA = 2 * hstepA;
    const unsigned ldsw = (unsigned)wid * 1024u;
    const int aoff = lds_byte(wr * 64 + fr, fq * 8), boff = lds_byte(wc * 32 + fr, fq * 8);
#define PG8_SA(b, h) (((b) * 2 + (h)) * HTB)
#define PG8_SB(b, h) ((4 + (b) * 2 + (h)) * HTB)
#define PG8_STAGE(bufoff, gbase, voff) do { _Pragma("unroll") for (int _i = 0; _i < 2; ++_i) \
        __builtin_amdgcn_global_load_lds((const unsigned*)((const char*)(gbase) + (voff)[_i]), (PG8_LAS unsigned*)(lds + (bufoff) + ldsw + _i * 8192), 16, 0, 0); } while (0)
#define PG8_LDA(dst, b, h) do { _Pragma("unroll") for (int m = 0; m < 4; ++m) _Pragma("unroll") for (int k = 0; k < 2; ++k) dst[m][k] = *(const PG8_LAS bf16x8*)(lds + PG8_SA(b, h) + aoff + m * 2048 + k * 1024); } while (0)
#define PG8_LDB(dst, b, h) do { _Pragma("unroll") for (int n = 0; n < 2; ++n) _Pragma("unroll") for (int k = 0; k < 2; ++k) dst[n][k] = *(const PG8_LAS bf16x8*)(lds + PG8_SB(b, h) + boff + n * 2048 + k * 1024); } while (0)
#define PG8_MMA(ai, bj, At, Bt) do { __builtin_amdgcn_s_setprio(1); _Pragma("unroll") for (int m = 0; m < 4; ++m) _Pragma("unroll") for (int n = 0; n < 2; ++n) _Pragma("unroll") for (int k = 0; k < 2; ++k) \
        acc[ai][bj][m][n] = __builtin_amdgcn_mfma_f32_16x16x32_bf16(Bt[n][k], At[m][k], acc[ai][bj][m][n], 0, 0, 0); __builtin_amdgcn_s_setprio(0); } while (0)
#define PG8_WAIT_V(n) asm volatile("s_waitcnt vmcnt(" #n ")" ::: "memory")
#define PG8_WAIT_L(n) asm volatile("s_waitcnt lgkmcnt(" #n ")" ::: "memory")
#define PG8_BAR __builtin_amdgcn_s_barrier()
#define PG8_SCHED __builtin_amdgcn_sched_barrier(0)
    Unit cur, nxt; int ui = 0;
    if (!S.next(0, cur)) return;
    f32x4 acc[2][2][4][2];
#pragma unroll
    for (int a = 0; a < 2; ++a)
#pragma unroll
        for (int b = 0; b < 2; ++b)
#pragma unroll
            for (int m = 0; m < 4; ++m)
#pragma unroll
                for (int n = 0; n < 2; ++n) acc[a][b][m][n] = (f32x4){0.f, 0.f, 0.f, 0.f};
    bf16x8 At[4][2], B0[2][2], B1[2][2];
    const char* cA = (const char*)g.A + (size_t)cur.pm * tstepA; const char* cB = (const char*)g.Bt + (size_t)cur.pn * tstep;
    S.a_ready(cur);
    if constexpr (SP2) {
        PG8_STAGE(PG8_SB(0, 0), cB, voffB); PG8_STAGE(PG8_SB(0, 1), cB + hstep, voffB); PG8_STAGE(PG8_SA(0, 0), cA, voffA); PG8_STAGE(PG8_SA(0, 1), cA + hstepA, voffA);
        if (wr == 1) PG8_BAR;
        PG8_WAIT_V(2); PG8_BAR;
        PG8_STAGE(PG8_SB(1, 0), cB + kstep, voffB); PG8_STAGE(PG8_SA(1, 0), cA + kstep, voffA); PG8_STAGE(PG8_SB(1, 1), cB + hstep + kstep, voffB);
        PG8_WAIT_V(6); PG8_BAR;
    } else {
        PG8_STAGE(PG8_SB(0, 0), cB, voffB); PG8_STAGE(PG8_SA(0, 0), cA, voffA); PG8_STAGE(PG8_SB(0, 1), cB + hstep, voffB); PG8_STAGE(PG8_SA(0, 1), cA + hstepA, voffA);
        if (wr == 1) PG8_BAR;
        PG8_WAIT_V(4); PG8_BAR;
        PG8_STAGE(PG8_SB(1, 0), cB + kstep, voffB); PG8_STAGE(PG8_SA(1, 0), cA + kstep, voffA); PG8_STAGE(PG8_SB(1, 1), cB + hstep + kstep, voffB);
        PG8_WAIT_V(6); PG8_BAR;
    }
    for (;;) {
        const bool has_next = S.next(ui + 1, nxt);
        const char* nA = has_next ? (const char*)g.A + (size_t)nxt.pm * tstepA : cA; const char* nB = has_next ? (const char*)g.Bt + (size_t)nxt.pn * tstep : cB;
        for (int t = 0; t < nt; t += 2) {
            const bool last = (t == nt - 2);
            const char* a1 = cA + (size_t)(t + 1) * kstep;
            const char* a2 = last ? nA : cA + (size_t)(t + 2) * kstep; const char* b2 = last ? nB : cB + (size_t)(t + 2) * kstep;
            const char* a3 = a2 + kstep; const char* b3 = b2 + kstep;
            if (last && has_next) S.a_ready(nxt);
            if constexpr (SP2) {
            PG8_LDB(B0, 0, 0); PG8_LDB(B1, 0, 1); PG8_SCHED; PG8_LDA(At, 0, 0); PG8_STAGE(PG8_SA(1, 1), a1 + hstepA, voffA);
            PG8_WAIT_V(8); PG8_WAIT_L(0); PG8_BAR; PG8_MMA(0, 0, At, B0); PG8_MMA(0, 1, At, B1); PG8_BAR; PG8_SCHED;
            PG8_LDA(At, 0, 1); PG8_STAGE(PG8_SB(0, 0), b2, voffB); PG8_STAGE(PG8_SB(0, 1), b2 + hstep, voffB); PG8_STAGE(PG8_SA(0, 0), a2, voffA);
            PG8_WAIT_V(8); PG8_WAIT_L(0); PG8_BAR; PG8_MMA(1, 0, At, B0); PG8_MMA(1, 1, At, B1); PG8_BAR; PG8_SCHED;
            PG8_LDB(B0, 1, 0); PG8_LDB(B1, 1, 1); PG8_SCHED; PG8_LDA(At, 1, 0); PG8_STAGE(PG8_SA(0, 1), a2 + hstepA, voffA);
            PG8_WAIT_V(8); PG8_WAIT_L(0); PG8_BAR; PG8_MMA(0, 0, At, B0); PG8_MMA(0, 1, At, B1); PG8_BAR; PG8_SCHED;
            PG8_LDA(At, 1, 1); PG8_STAGE(PG8_SB(1, 0), b3, voffB); PG8_STAGE(PG8_SB(1, 1), b3 + hstep, voffB); PG8_STAGE(PG8_SA(1, 0), a3, voffA);
            PG8_WAIT_V(8); PG8_WAIT_L(0); PG8_BAR; PG8_MMA(1, 0, At, B0); PG8_MMA(1, 1, At, B1); PG8_BAR; PG8_SCHED;
            } else {
            PG8_LDB(B0, 0, 0); PG8_SCHED; PG8_LDA(At, 0, 0); PG8_STAGE(PG8_SA(1, 1), a1 + hstepA, voffA);
            PG8_WAIT_L(8); PG8_BAR; PG8_WAIT_L(0); PG8_MMA(0, 0, At, B0); PG8_BAR; PG8_SCHED;
            PG8_LDB(B1, 0, 1); PG8_STAGE(PG8_SB(0, 0), b2, voffB);
            PG8_BAR; PG8_WAIT_L(0); PG8_MMA(0, 1, At, B1); PG8_BAR;
            PG8_LDA(At, 0, 1); PG8_STAGE(PG8_SA(0, 0), a2, voffA);
            PG8_BAR; PG8_WAIT_L(0); PG8_MMA(1, 0, At, B0); PG8_BAR; PG8_SCHED;
            PG8_STAGE(PG8_SB(0, 1), b2 + hstep, voffB);
            PG8_WAIT_V(6); PG8_BAR; PG8_MMA(1, 1, At, B1); PG8_BAR;
            PG8_LDB(B0, 1, 0); PG8_SCHED; PG8_LDA(At, 1, 0); PG8_STAGE(PG8_SA(0, 1), a2 + hstepA, voffA);
            PG8_WAIT_L(8); PG8_BAR; PG8_WAIT_L(0); PG8_MMA(0, 0, At, B0); PG8_BAR; PG8_SCHED;
            PG8_LDB(B1, 1, 1); PG8_STAGE(PG8_SB(1, 0), b3, voffB);
            PG8_BAR; PG8_WAIT_L(0); PG8_MMA(0, 1, At, B1); PG8_BAR;
            PG8_LDA(At, 1, 1); PG8_STAGE(PG8_SA(1, 0), a3, voffA);
            PG8_BAR; PG8_WAIT_L(0); PG8_MMA(1, 0, At, B0); PG8_BAR; PG8_SCHED;
            PG8_STAGE(PG8_SB(1, 1), b3 + hstep, voffB);
            PG8_WAIT_V(6); PG8_BAR; PG8_MMA(1, 1, At, B1); PG8_BAR;
            }
        }
        if constexpr (ALIGN_EPI) { if (wr == 0) PG8_BAR; }
        if constexpr (!Epi::AFTER_DRAIN) { E(acc, cur, wr, wc, fr, fq); S.done(cur); }
        if (!has_next) break;
#pragma unroll
        for (int a = 0; a < 2; ++a)
#pragma unroll
            for (int b = 0; b < 2; ++b)
#pragma unroll
                for (int m = 0; m < 4; ++m)
#pragma unroll
                    for (int n = 0; n < 2; ++n) acc[a][b][m][n] = (f32x4){0.f, 0.f, 0.f, 0.f};
        cur = nxt; cA = nA; cB = nB; ++ui;
        if constexpr (ALIGN_EPI) { if (wr == 1) PG8_BAR; }
    }
    PG8_WAIT_V(0);
    if constexpr (!ALIGN_EPI) { if (wr == 0) PG8_BAR; }
    PG8_BAR;
    if constexpr (Epi::AFTER_DRAIN) { E.fused(acc, cur, wr, wc, fr, fq, lds, wid, lane); S.done(cur); }
#undef PG8_SA
#undef PG8_SB
#undef PG8_STAGE
#undef PG8_LDA
#undef PG8_LDB
#undef PG8_MMA
#undef PG8_WAIT_V
#undef PG8_WAIT_L
#undef PG8_BAR
#undef PG8_SCHED
}
}

namespace pg8 {
struct EpiResF32 {
    static constexpr bool PERM = false, AFTER_DRAIN = false;
    const float* base; float* out; int ldc;
    __device__ __forceinline__ void operator()(const f32x4 (&acc)[2][2][4][2], const Unit& u, int wr, int wc, int fr, int fq) const {
        const int col0 = u.pn * BM + wc * 32 + 4 * fq;
#pragma unroll
        for (int ai = 0; ai < 2; ++ai)
#pragma unroll
            for (int m = 0; m < 4; ++m) { const size_t off = (size_t)(u.pm * BM + ai * HALF + wr * 64 + m * 16 + fr) * ldc + col0;
#pragma unroll
                for (int bj = 0; bj < 2; ++bj)
#pragma unroll
                    for (int n = 0; n < 2; ++n) { const f32x4 bs = *(const f32x4*)(base + off + bj * HALF + n * 16); *(f32x4*)(out + off + bj * HALF + n * 16) = bs + acc[ai][bj][m][n]; } }
    }
};
}

#ifndef USE_FAST_ATTN
#define USE_FAST_ATTN 1
#endif
#ifndef DBG_MASK
#define DBG_MASK 127
#endif
constexpr int NWAVES = 8;
#ifndef MK_N_LAUNCHES
#define MK_N_LAUNCHES 1
#endif
constexpr int N_PHASES = 12;
constexpr int N_LAUNCHES = MK_N_LAUNCHES;

constexpr int BATCH = 8, SEQ = 4096, DM = 1024, DEPTH = 2;
constexpr int M = BATCH * SEQ;
constexpr int NH = 8, HD = 128;
constexpr int NSH = 16, SHD = 64, NST = 128;
constexpr int NIN = 6672;
constexpr int PITCH = 6656;
constexpr int C_Q = 0, C_Z = 1024, C_K = 2048, C_V = 3072, C_G = 4096, C_X = 5120, C_B = 6144, C_C = 6400;
constexpr int MOBA = 256, NBLK = SEQ / MOBA;
constexpr float EPS = 1e-6f;

constexpr size_t MiB = 1u << 20;
constexpr size_t WS_CTL = 0, CTL_ZERO_BYTES = 1 * MiB;
constexpr size_t WS_WIN = 1 * MiB;
constexpr size_t WS_WOUT = 14 * MiB;
constexpr size_t WS_KM = 18 * MiB;
constexpr size_t WS_DT = 19 * MiB;
constexpr size_t WS_SSQ = 21 * MiB;
constexpr size_t WS_A = 32 * MiB;
constexpr size_t WS_PROJ = 96 * MiB;
constexpr size_t WS_END = 512 * MiB;
static_assert(WS_PROJ + (size_t)M * PITCH * 2 <= WS_END, "d_ws map");
constexpr int CW_TMO = 0;
constexpr int CW_BAR = 4096;

constexpr int RING_OFF = 0, RING_BYTES = 131072;
constexpr int LDSCTL_OFF = RING_BYTES, MISC_OFF = LDSCTL_OFF + 320;
constexpr int LDS_BYTES = 147456;
static_assert(MISC_OFF + 128 <= LDS_BYTES, "LDS map");

#define GAS __attribute__((address_space(1)))
#define LAS __attribute__((address_space(3)))
typedef unsigned short bf16;
typedef unsigned v4u __attribute__((ext_vector_type(4)));
typedef unsigned v2u __attribute__((ext_vector_type(2)));
typedef float f32x4 __attribute__((ext_vector_type(4)));
typedef short bf16x8 __attribute__((ext_vector_type(8)));
typedef GAS unsigned gu32;
#define RLX_AGENT __ATOMIC_RELAXED, __HIP_MEMORY_SCOPE_AGENT
#define LDS_WAIT() asm volatile("s_waitcnt lgkmcnt(0)" ::: "memory")
#define VM_WAIT() asm volatile("s_waitcnt vmcnt(0)" ::: "memory")
__device__ __forceinline__ unsigned f2bf(float f) { unsigned u = __builtin_bit_cast(unsigned, f); return (u + 0x7fffu + ((u >> 16) & 1u)) >> 16; }
__device__ __forceinline__ unsigned pk2(float lo, float hi) { return f2bf(lo) | (f2bf(hi) << 16); }
__device__ __forceinline__ float bflo(unsigned u) { return __builtin_bit_cast(float, u << 16); }
__device__ __forceinline__ float bfhi(unsigned u) { return __builtin_bit_cast(float, u & 0xffff0000u); }
__device__ __forceinline__ float silu_f(float v) { return v / (1.f + __expf(-v)); }
__device__ __forceinline__ float wave_sum(float v) {
#pragma unroll
    for (int o = 1; o < 64; o <<= 1) v += __shfl_xor(v, o);
    return v;
}
__device__ __forceinline__ float wave_max(float v) {
#pragma unroll
    for (int o = 1; o < 64; o <<= 1) v = fmaxf(v, __shfl_xor(v, o));
    return v;
}

#define XB_TMO      128
#define XB_XCNT(j)  (256  + 64 * (j))
#define XB_XSUB(j)  (1280 + 64 * (j))
#define XB_XGEN(j)  (2304 + 64 * (j))
#define XB_TOP      3328
#define XB_TOPGEN   3392
#define XCD_BAR_WORDS 3456
#define XB_SPIN_CAP (1u << 22)

__device__ __forceinline__ unsigned xb_ld(unsigned* p)              { return __hip_atomic_load(p, __ATOMIC_RELAXED, __HIP_MEMORY_SCOPE_AGENT); }
__device__ __forceinline__ unsigned xb_add(unsigned* p, unsigned v) { return __hip_atomic_fetch_add(p, v, __ATOMIC_RELAXED, __HIP_MEMORY_SCOPE_AGENT); }
__device__ __forceinline__ unsigned xb_xcc_id() { return (unsigned)__builtin_amdgcn_s_getreg((3 << 11) | 20) & 0xFu; }
#define XB_SPIN(cond, bar) do { unsigned _sp = 0; while (cond) { __builtin_amdgcn_s_sleep(1); \
    if ((++_sp & 255u) == 0u) { if (xb_ld(&(bar)[XB_TMO])) break; if (_sp > XB_SPIN_CAP) { atomicAdd(&(bar)[XB_TMO], 1u); break; } } } } while (0)

struct XcdBarrier { unsigned* bar; unsigned x; volatile LAS unsigned* st; };

__device__ __forceinline__ XcdBarrier xcd_barrier_post(unsigned* bar, volatile LAS unsigned* st) {
    XcdBarrier b; b.bar = bar; b.x = xb_xcc_id(); b.st = st;
    if (threadIdx.x == 0) (void)xb_add(&bar[XB_XCNT(b.x)], 1u);
    return b;
}
__device__ __forceinline__ void xcd_barrier_complete(unsigned* bar, unsigned x, unsigned& nloc, unsigned& nx) {
    const unsigned G = gridDim.x * gridDim.y * gridDim.z;
    unsigned sum, cnt, mine, sp = 0u;
    for (;;) {
        sum = 0u; cnt = 0u; mine = 0u;
#pragma unroll
        for (unsigned j = 0; j < 16; ++j) { const unsigned c = xb_ld(&bar[XB_XCNT(j)]); sum += c; cnt += (c > 0u) ? 1u : 0u; mine = (j == x) ? c : mine; }
        if (sum == G) break;
        __builtin_amdgcn_s_sleep(1);
        if ((++sp & 255u) == 0u) { if (xb_ld(&bar[XB_TMO])) break; if (sp > XB_SPIN_CAP) { atomicAdd(&bar[XB_TMO], 1u); break; } }
    }
    nloc = mine > 0u ? mine : 1u; nx = cnt > 0u ? cnt : 1u;
}
__device__ __forceinline__ void xcd_barrier(const XcdBarrier& b) {
    asm volatile("s_waitcnt vmcnt(0)" ::: "memory");
    __syncthreads();
    if (threadIdx.x == 0) {
        unsigned* bar = b.bar;
        __builtin_amdgcn_s_waitcnt(0);
        unsigned nloc = b.st[0], nx = b.st[1];
        if (nloc == 0u) { xcd_barrier_complete(bar, b.x, nloc, nx); b.st[0] = nloc; b.st[1] = nx; }
        const unsigned old = xb_add(&bar[XB_XSUB(b.x)], 1u);
        const unsigned gen = old / nloc;
        if (old + 1u == (gen + 1u) * nloc) {
            __builtin_amdgcn_fence(__ATOMIC_RELEASE, "agent");
            asm volatile("s_waitcnt vmcnt(0)" ::: "memory");
            const unsigned og = xb_add(&bar[XB_TOP], 1u);
            const unsigned tg = og / nx;
            if (og + 1u == (tg + 1u) * nx) xb_add(&bar[XB_TOPGEN], 1u);
            else XB_SPIN(xb_ld(&bar[XB_TOPGEN]) == tg, bar);
            __builtin_amdgcn_fence(__ATOMIC_ACQUIRE, "agent");
            xb_add(&bar[XB_XGEN(b.x)], 1u);
            asm volatile("s_waitcnt vmcnt(0)" ::: "memory");
        } else {
            XB_SPIN(xb_ld(&bar[XB_XGEN(b.x)]) == gen, bar);
            __builtin_amdgcn_fence(__ATOMIC_ACQUIRE, "agent");
            asm volatile("s_waitcnt vmcnt(0)" ::: "memory");
        }
    }
    __syncthreads();
}

struct Frame {
    LAS unsigned char* lds;
    volatile LAS unsigned* MISC;
    int tid, lane, wave;
    int vcu, G;
};
struct Args { const float* in[12]; float* out; unsigned char* ws; int ph_lo, ph_hi, li, pad; };
template <class T> __device__ __forceinline__ T* karg_ptr(int byte_off) {
    const char __attribute__((address_space(4)))* p = (const char __attribute__((address_space(4)))*)__builtin_amdgcn_kernarg_segment_ptr();
    int o = byte_off; asm volatile("" : "+s"(o));
    return *(T* const __attribute__((address_space(4)))*)(p + o);
}
__device__ __forceinline__ const float* in_ptr(int i) { return karg_ptr<const float>(8 * i); }
__device__ __forceinline__ float* out_ptr() { return karg_ptr<float>(96); }
__device__ __forceinline__ unsigned char* ws_ptr() { return karg_ptr<unsigned char>(104); }
#define WSP(T, off) ((T*)(ws_ptr() + (off)))

__device__ __forceinline__ void transpose_item(const float* Wsrc, int ldw, int K, int ncols, bf16* WT, int row_off, LAS float* scr, int item, int lane) {
    const int nblk = ncols / 32, kb = item / nblk, nb = item % nblk, k0 = 64 * kb, n0 = 32 * nb;
#pragma unroll 8
    for (int i = 0; i < 32; ++i) { const int kk = 2 * i + (lane >> 5); scr[kk * 33 + (lane & 31)] = Wsrc[(size_t)(k0 + kk) * ldw + n0 + (lane & 31)]; }
    LDS_WAIT(); asm volatile("" ::: "memory");
    const int c = lane & 7;
#pragma unroll
    for (int j = 0; j < 4; ++j) { const int n = (lane >> 3) + 8 * j; const LAS float* s = scr + (8 * c) * 33 + n;
        v4u o; o.x = pk2(s[0 * 33], s[1 * 33]); o.y = pk2(s[2 * 33], s[3 * 33]); o.z = pk2(s[4 * 33], s[5 * 33]); o.w = pk2(s[6 * 33], s[7 * 33]);
        *(v4u*)(WT + (size_t)(row_off + n0 + n) * K + k0 + 8 * c) = o; }
    LDS_WAIT(); asm volatile("" ::: "memory");
}

__device__ __forceinline__ void phase_a(Frame& F, int layer) {
    bf16* const WinT = WSP(bf16, WS_WIN); bf16* const WoutT = WSP(bf16, WS_WOUT); bf16* const XN = WSP(bf16, WS_A); float* const DT = WSP(float, WS_DT); const float* const OUTP = out_ptr();
    const int gw = F.vcu * NWAVES + F.wave, NGW = F.G * NWAVES;
    {
        LAS float* scr = (LAS float*)(F.lds + RING_OFF + F.wave * 16384);
        const float* win = in_ptr(2) + (size_t)layer * DM * NIN;
        const float* wout = in_ptr(11) + (size_t)layer * 2048 * DM;
        constexpr int KB_IN = DM / 64;
        constexpr int I_1K = KB_IN * (1024 / 32), I_X = KB_IN * (1536 / 32), I_OUT = (2048 / 64) * (1024 / 32);
        constexpr int NITEMS = 5 * I_1K + I_X + I_OUT;
        for (int it = gw; it < NITEMS; it += NGW) {
            int r = it;
            if (r < I_1K) { transpose_item(win + 0,    NIN, DM, 1024, WinT, C_Q, scr, r, F.lane); continue; } r -= I_1K;
            if (r < I_1K) { transpose_item(win + 4096, NIN, DM, 1024, WinT, C_Z, scr, r, F.lane); continue; } r -= I_1K;
            if (r < I_1K) { transpose_item(win + 1024, NIN, DM, 1024, WinT, C_K, scr, r, F.lane); continue; } r -= I_1K;
            if (r < I_1K) { transpose_item(win + 2048, NIN, DM, 1024, WinT, C_V, scr, r, F.lane); continue; } r -= I_1K;
            if (r < I_1K) { transpose_item(win + 3072, NIN, DM, 1024, WinT, C_G, scr, r, F.lane); continue; } r -= I_1K;
            if (r < I_X)  { transpose_item(win + 5120, NIN, DM, 1536, WinT, C_X, scr, r, F.lane); continue; } r -= I_X;
            transpose_item(wout, DM, 2048, 1024, WoutT, 0, scr, r, F.lane);
        }
    }
    __syncthreads();
    LAS float* wdt = (LAS float*)(F.lds + RING_OFF);
    {
        const float* win = in_ptr(2) + (size_t)layer * DM * NIN + 6656;
        for (int i = F.tid; i < 16 * 1024; i += NWAVES * 64) { const int k = i >> 4, c = i & 15; wdt[c * 1024 + k] = win[(size_t)k * NIN + c]; }
    }
    __syncthreads();
    const float* xin = layer == 0 ? in_ptr(0) : OUTP;
    const float* lnw = in_ptr(1) + layer * DM;
    const float* dtb = in_ptr(7) + layer * NSH;
    f32x4 lw[4];
#pragma unroll
    for (int j = 0; j < 4; ++j) lw[j] = *(const f32x4*)(lnw + 4 * F.lane + 256 * j);
    for (int m = gw; m < M; m += NGW) {
        asm volatile("" ::: "memory");
        const f32x4* xr = (const f32x4*)(xin + (size_t)m * DM) + F.lane;
        f32x4 v[4]; float s = 0.f;
#pragma unroll
        for (int j = 0; j < 4; ++j) { v[j] = xr[64 * j]; s += (v[j].x * v[j].x + v[j].y * v[j].y) + (v[j].z * v[j].z + v[j].w * v[j].w); }
        const float rstd = 1.f / sqrtf(wave_sum(s) * (1.f / DM) + EPS);
#pragma unroll
        for (int j = 0; j < 4; ++j) v[j] = v[j] * rstd * lw[j];
        unsigned long long* o8 = (unsigned long long*)(XN + (size_t)m * DM) + F.lane;
#pragma unroll
        for (int j = 0; j < 4; ++j) o8[64 * j] = (unsigned long long)pk2(v[j].x, v[j].y) | ((unsigned long long)pk2(v[j].z, v[j].w) << 32);
        float mine = 0.f;
#pragma unroll
        for (int c = 0; c < 16; ++c) {
            float p = 0.f;
#pragma unroll
            for (int j = 0; j < 4; ++j) { const f32x4 w = *(const LAS f32x4*)(wdt + c * 1024 + 4 * F.lane + 256 * j); p += (v[j].x * w.x + v[j].y * w.y) + (v[j].z * w.z + v[j].w * w.w); }
            p = wave_sum(p);
            if (F.lane == c) mine = p;
        }
        if (F.lane < 16) { const float a = mine + dtb[F.lane]; DT[(size_t)m * 16 + F.lane] = fmaxf(a, 0.f) + log1pf(__expf(-fabsf(a))); }
    }
}

__device__ __forceinline__ void phase_c(Frame& F, int layer) {
    bf16* const PROJ = WSP(bf16, WS_PROJ); bf16* const BCc = WSP(bf16, WS_A); float* const KM = WSP(float, WS_KM);
    const float* qw = in_ptr(3) + layer * HD; const float* kw = in_ptr(4) + layer * HD;
    const float qw0 = qw[2 * F.lane], qw1 = qw[2 * F.lane + 1], kw0 = kw[2 * F.lane], kw1 = kw[2 * F.lane + 1];
    LAS float* red = (LAS float*)(F.lds + RING_OFF);
    for (int item = F.vcu; item < BATCH * NBLK * NH; item += F.G) {
        const int h = item & 7, n = (item >> 3) & 15, b = item >> 7;
        const size_t m0 = (size_t)b * SEQ + n * MOBA + F.wave * 32;
        float ks0 = 0.f, ks1 = 0.f;
        for (int r = 0; r < 32; ++r) {
            bf16* qp = PROJ + (m0 + r) * PITCH + C_Q + h * HD + 2 * F.lane;
            bf16* kp = PROJ + (m0 + r) * PITCH + C_K + h * HD + 2 * F.lane;
            const unsigned qu = *(const unsigned*)qp, ku = *(const unsigned*)kp;
            float q0 = bflo(qu), q1 = bfhi(qu), k0 = bflo(ku), k1 = bfhi(ku);
            const float qs = wave_sum(q0 * q0 + q1 * q1), kss = wave_sum(k0 * k0 + k1 * k1);
            const float qr = 1.f / sqrtf(qs * (1.f / HD) + EPS), kr = 1.f / sqrtf(kss * (1.f / HD) + EPS);
            q0 = q0 * qr * qw0; q1 = q1 * qr * qw1; k0 = k0 * kr * kw0; k1 = k1 * kr * kw1;
            *(unsigned*)qp = pk2(q0, q1); *(unsigned*)kp = pk2(k0, k1);
            ks0 += k0; ks1 += k1;
        }
        red[F.wave * 128 + 2 * F.lane] = ks0; red[F.wave * 128 + 2 * F.lane + 1] = ks1;
        __syncthreads();
        if (F.tid < 128) { float s = 0.f;
#pragma unroll
            for (int w = 0; w < 8; ++w) s += red[w * 128 + F.tid];
            KM[(((size_t)b * NH + h) * NBLK + n) * HD + F.tid] = s * (1.f / MOBA); }
        __syncthreads();
    }
    const float* cw = in_ptr(5) + (size_t)layer * 4 * 1536 + 1024;
    const float* cb = in_ptr(6) + (size_t)layer * 1536 + 1024;
    const int gt = F.vcu * (NWAVES * 64) + F.tid, NGT = F.G * NWAVES * 64;
    for (int i = gt; i < M * 64; i += NGT) {
        const int m = i >> 6, c8 = (i & 63) * 8, t = m & (SEQ - 1);
        float acc[8];
#pragma unroll
        for (int e = 0; e < 8; ++e) acc[e] = cb[c8 + e];
#pragma unroll
        for (int k = 0; k < 4; ++k) {
            if (t - 3 + k >= 0) {
                const v4u u = *(const v4u*)(PROJ + (size_t)(m - 3 + k) * PITCH + C_B + c8);
                const float* w = cw + k * 1536 + c8;
                acc[0] += w[0] * bflo(u.x); acc[1] += w[1] * bfhi(u.x); acc[2] += w[2] * bflo(u.y); acc[3] += w[3] * bfhi(u.y);
                acc[4] += w[4] * bflo(u.z); acc[5] += w[5] * bfhi(u.z); acc[6] += w[6] * bflo(u.w); acc[7] += w[7] * bfhi(u.w);
            }
        }
        v4u o; o.x = pk2(silu_f(acc[0]), silu_f(acc[1])); o.y = pk2(silu_f(acc[2]), silu_f(acc[3])); o.z = pk2(silu_f(acc[4]), silu_f(acc[5])); o.w = pk2(silu_f(acc[6]), silu_f(acc[7]));
        *(v4u*)(BCc + (size_t)m * 512 + c8) = o;
    }
}

__device__ __forceinline__ void ssd_simple(Frame& F, int layer) {
    bf16* const PROJ = WSP(bf16, WS_PROJ); const bf16* const BCc = WSP(bf16, WS_A); const float* const DT = WSP(float, WS_DT); float* const SSQ = WSP(float, WS_SSQ);
    const int gw = F.wave * F.G + F.vcu;
    if (gw >= BATCH * NSH) return;
    const int b = gw >> 4, h = gw & 15, g = h >> 3, p = F.lane;
    LAS unsigned* st = (LAS unsigned*)(F.lds + 32768 + F.wave * 8192);
    const float* cwp = in_ptr(5) + (size_t)layer * 4 * 1536 + h * SHD + p;
    const float cw0 = cwp[0], cw1 = cwp[1536], cw2 = cwp[2 * 1536], cw3 = cwp[3 * 1536], cbias = in_ptr(6)[(size_t)layer * 1536 + h * SHD + p];
    const float A = -__expf(in_ptr(8)[layer * NSH + h]), Dh = in_ptr(9)[layer * NSH + h];
    float s[NST];
#pragma unroll
    for (int n = 0; n < NST; ++n) s[n] = 0.f;
    float x0 = 0.f, x1 = 0.f, x2 = 0.f;
    for (int t0 = 0; t0 < SEQ; t0 += 16) {
        const size_t mb = (size_t)b * SEQ + t0;
#pragma unroll
        for (int i = 0; i < 8; ++i) { const int ch = i * 64 + F.lane, row = ch >> 5, c = ch & 31;
            const v4u u = *(const v4u*)(BCc + (mb + row) * 512 + (c < 16 ? g * 128 + c * 8 : 256 + g * 128 + (c - 16) * 8));
            *(LAS v4u*)(st + row * 128 + c * 4) = u; }
        LDS_WAIT(); asm volatile("" ::: "memory");
        for (int tt = 0; tt < 16; ++tt) {
            const size_t m = mb + tt;
            const float xr = bflo((unsigned)PROJ[m * PITCH + C_X + h * SHD + p]);
            const float xc = silu_f(cw0 * x0 + cw1 * x1 + cw2 * x2 + cw3 * xr + cbias);
            x0 = x1; x1 = x2; x2 = xr;
            const float dt = DT[m * 16 + h], dA = __expf(dt * A), dtx = dt * xc;
            float y = 0.f;
#pragma unroll
            for (int n8 = 0; n8 < 16; ++n8) {
                const v4u bu = *(const LAS v4u*)(st + tt * 128 + n8 * 4), cu = *(const LAS v4u*)(st + tt * 128 + 64 + n8 * 4);
                const float bb[8] = {bflo(bu.x), bfhi(bu.x), bflo(bu.y), bfhi(bu.y), bflo(bu.z), bfhi(bu.z), bflo(bu.w), bfhi(bu.w)};
                const float cc[8] = {bflo(cu.x), bfhi(cu.x), bflo(cu.y), bfhi(cu.y), bflo(cu.z), bfhi(cu.z), bflo(cu.w), bfhi(cu.w)};
#pragma unroll
                for (int e = 0; e < 8; ++e) { s[n8 * 8 + e] = s[n8 * 8 + e] * dA + dtx * bb[e]; y += cc[e] * s[n8 * 8 + e]; }
            }
            y += Dh * xc;
            bf16* zp = PROJ + m * PITCH + C_Z + h * SHD + p;
            const float z = bflo((unsigned)*zp), yz = y * silu_f(z);
            *zp = (bf16)f2bf(yz);
            const float q = wave_sum(yz * yz);
            if (F.lane == 0) { SSQ[m * 32 + h * 2] = q; SSQ[m * 32 + h * 2 + 1] = 0.f; }
        }
        asm volatile("" ::: "memory");
    }
}

__device__ __forceinline__ void attn_simple(Frame& F, int layer) {
    bf16* const PROJ = WSP(bf16, WS_PROJ); const float* const KM = WSP(float, WS_KM);
    LAS float* qs = (LAS float*)(F.lds + F.wave * 1024);
    const int gw = F.vcu * NWAVES + F.wave, NGW = F.G * NWAVES;
    const float scale = 0.08838834764831845f;
    for (int it = gw; it < M * NH; it += NGW) {
        const int m = it >> 3, h = it & 7, b = m >> 12, t = m & (SEQ - 1), own = t >> 8;
        const float slope = exp2f(-(float)(h + 1));
        bf16* qp = PROJ + (size_t)m * PITCH + C_Q + h * HD + 2 * F.lane;
        const unsigned qu = *(const unsigned*)qp;
        const float q0 = bflo(qu), q1 = bfhi(qu);
        qs[2 * F.lane] = q0; qs[2 * F.lane + 1] = q1;
        LDS_WAIT(); asm volatile("" ::: "memory");
        float v0 = -INFINITY, v1 = -INFINITY, v2 = -INFINITY; int i0 = 0, i1 = 0, i2 = 0;
        const float* km = KM + ((size_t)b * NH + h) * NBLK * HD + 2 * F.lane;
        for (int n = 0; n < own; ++n) {
            const float gt = wave_sum(q0 * km[n * HD] + q1 * km[n * HD + 1]);
            if (gt > v0) { v2 = v1; i2 = i1; v1 = v0; i1 = i0; v0 = gt; i0 = n; }
            else if (gt > v1) { v2 = v1; i2 = i1; v1 = gt; i1 = n; }
            else if (gt > v2) { v2 = gt; i2 = n; }
        }
        const int nsel = own < 3 ? own : 3;
        float sc[16];
#pragma unroll
        for (int sl = 0; sl < 4; ++sl) {
            const int blk = sl == 0 ? i0 : sl == 1 ? i1 : sl == 2 ? i2 : own;
            const bool on = sl == 3 || sl < nsel;
#pragma unroll
            for (int j = 0; j < 4; ++j) {
                float s = -INFINITY;
                if (on) {
                    const int pos = blk * MOBA + j * 64 + F.lane;
                    const bf16* kp = PROJ + ((size_t)b * SEQ + pos) * PITCH + C_K + h * HD;
                    float d = 0.f;
#pragma unroll
                    for (int c = 0; c < 16; ++c) {
                        const v4u u = *(const v4u*)(kp + c * 8);
                        const f32x4 qa = *(const LAS f32x4*)(qs + c * 8), qb = *(const LAS f32x4*)(qs + c * 8 + 4);
                        d += (qa.x * bflo(u.x) + qa.y * bfhi(u.x)) + (qa.z * bflo(u.y) + qa.w * bfhi(u.y)) + (qb.x * bflo(u.z) + qb.y * bfhi(u.z)) + (qb.z * bflo(u.w) + qb.w * bfhi(u.w));
                    }
                    s = d * scale - slope * (float)(t - pos);
                    if (pos > t) s = -INFINITY;
                }
                sc[sl * 4 + j] = s;
            }
        }
        float mx = sc[0];
#pragma unroll
        for (int i = 1; i < 16; ++i) mx = fmaxf(mx, sc[i]);
        mx = wave_max(mx);
        float l = 0.f;
#pragma unroll
        for (int i = 0; i < 16; ++i) { sc[i] = __expf(sc[i] - mx); l += sc[i]; }
        l = wave_sum(l);
        float a0 = 0.f, a1 = 0.f;
#pragma unroll
        for (int sl = 0; sl < 4; ++sl) {
            const int blk = sl == 0 ? i0 : sl == 1 ? i1 : sl == 2 ? i2 : own;
#pragma unroll
            for (int j = 0; j < 4; ++j) {
                const float pj = sc[sl * 4 + j];
                if (wave_max(pj) > 0.f) {
                    const bf16* vp = PROJ + ((size_t)b * SEQ + blk * MOBA + j * 64) * PITCH + C_V + h * HD + 2 * F.lane;
                    for (int kk = 0; kk < 64; ++kk) {
                        const float pk = __shfl(pj, kk);
                        const unsigned vu = *(const unsigned*)(vp + (size_t)kk * PITCH);
                        a0 += pk * bflo(vu); a1 += pk * bfhi(vu);
                    }
                }
            }
        }
        const unsigned gu = *(const unsigned*)(PROJ + (size_t)m * PITCH + C_G + h * HD + 2 * F.lane);
        const float inv = 1.f / l;
        *(unsigned*)qp = pk2(a0 * inv * silu_f(bflo(gu)), a1 * inv * silu_f(bfhi(gu)));
    }
}


namespace moba {
typedef float f32x16 __attribute__((ext_vector_type(16)));
typedef short s16x4 __attribute__((ext_vector_type(4)));
typedef unsigned u32x4 __attribute__((ext_vector_type(4)));
constexpr int NW = 8, QBLK = 32, KVBLK = 64, QB = NW * QBLK;
constexpr int SHM_V = KVBLK * HD * 2, SHM_K = KVBLK * HD * 2;
constexpr int OFF_V = 0, OFF_K = 2 * SHM_V, OFF_WS = 2 * SHM_V + 2 * SHM_K, OFF_KM = OFF_WS + NW * 64 * 4;
constexpr int ATTN_LDS = OFF_KM + 32 * 256;
constexpr float SCALE = 0.08838834764831845f, LOG2E = 1.4426950408889634f;

#define KSWZ(row, colB) ((row) * 256 + ((colB) ^ (((row) & 7) << 4)))
#define SBAR() __builtin_amdgcn_sched_barrier(0)
__device__ __forceinline__ int v_st(int k, int c) { const int kk = (k & ~0xC) | ((k & 4) << 1) | ((k & 8) >> 1); return ((kk >> 3) * 4 + (c >> 5)) * 512 + ((kk & 7) * 32 + (c & 31)) * 2; }
__device__ __forceinline__ int v_rd_base(int lane) { return ((lane & 3) << 3) | (((lane >> 2) & 3) << 6) | (((lane >> 4) & 1) << 5) | (((lane >> 5) & 1) << 8); }
constexpr int v_rd_off(int d0, int ks, int half) { return d0 * 512 + ks * 4096 + half * 2048; }
__device__ __forceinline__ int crow(int r, int hi) { return (r & 3) + 8 * (r >> 2) + 4 * hi; }
__device__ __forceinline__ unsigned cvtpk(float lo, float hi) { unsigned r; asm volatile("v_cvt_pk_bf16_f32 %0, %1, %2" : "=v"(r) : "v"(lo), "v"(hi)); return r; }

struct Unit { const bf16* Q; const bf16* K; const bf16* V; const float* KM; int qb, h; };
struct Seam { bf16x8 qr[8]; bf16x8 st_v0, st_v1, st_k0, st_k1; };

__device__ __forceinline__ void mask_tile(f32x16& p0, f32x16& p1, int dq) {
    const float NEG = -__builtin_inff();
#pragma unroll
    for (int r = 0; r < 16; ++r) { const int c = (r & 3) + 8 * (r >> 2); if (dq - c < 0) p0[r] = NEG; if (dq - c - 32 < 0) p1[r] = NEG; }
}
__device__ __forceinline__ void partialSM(f32x16& p0, f32x16& p1, float base, float slope2) {
    constexpr float C2 = LOG2E * SCALE;
#pragma unroll
    for (int r = 0; r < 16; ++r) { const float c = (float)((r & 3) + 8 * (r >> 2)); p0[r] = fmaf(p0[r], C2, fmaf(slope2, c, base)); p1[r] = fmaf(p1[r], C2, fmaf(slope2, c + 32.f, base)); }
#pragma unroll
    for (int r = 0; r < 16; ++r) p0[r] = __builtin_amdgcn_exp2f(p0[r]);
}
__device__ __forceinline__ void finishSM(f32x16& p0, f32x16& p1, float& l_reg, bf16x8& pa0, bf16x8& pa1, bf16x8& pa2, bf16x8& pa3) {
#pragma unroll
    for (int r = 0; r < 16; ++r) p1[r] = __builtin_amdgcn_exp2f(p1[r]);
    float ps = 0;
#pragma unroll
    for (int r = 0; r < 16; ++r) ps += p0[r];
#pragma unroll
    for (int r = 0; r < 16; ++r) ps += p1[r];
    { auto rr = __builtin_amdgcn_permlane32_swap(__float_as_uint(ps), __float_as_uint(ps), false, false); ps = __uint_as_float(rr[0]) + __uint_as_float(rr[1]); }
    l_reg += ps;
#define PK4(P, B_, OUT) do { unsigned a0 = cvtpk(P[B_+0], P[B_+1]), a1 = cvtpk(P[B_+2], P[B_+3]); unsigned b0 = cvtpk(P[B_+4], P[B_+5]), b1 = cvtpk(P[B_+6], P[B_+7]); \
        auto r0 = __builtin_amdgcn_permlane32_swap(a0, b0, false, false); auto r1 = __builtin_amdgcn_permlane32_swap(a1, b1, false, false); \
        u32x4 w = {r0[0], r1[0], r0[1], r1[1]}; OUT = *reinterpret_cast<bf16x8*>(&w); } while (0)
    PK4(p0, 0, pa0); PK4(p0, 8, pa1); PK4(p1, 0, pa2); PK4(p1, 8, pa3);
#undef PK4
}
template <int KB>
__device__ __forceinline__ void qkt(f32x16& p0, f32x16& p1, const LAS char* K_lds, int r32, int hi, const bf16x8* qr) {
    p0 = f32x16{}; p1 = f32x16{};
    const LAS char* kb[4];
#pragma unroll
    for (int dd = 0; dd < 4; ++dd) kb[dd] = K_lds + KB * SHM_K + KSWZ(r32, (dd * 16 + hi * 8) * 2);
#pragma unroll
    for (int d0 = 0; d0 < 8; ++d0) { const LAS char* a = kb[d0 & 3] + (d0 >> 2) * 128;
        bf16x8 b0 = *reinterpret_cast<const LAS bf16x8*>(a);
        bf16x8 b1 = *reinterpret_cast<const LAS bf16x8*>(a + 32 * 256);
        p0 = __builtin_amdgcn_mfma_f32_32x32x16_bf16(b0, qr[d0], p0, 0, 0, 0);
        p1 = __builtin_amdgcn_mfma_f32_32x32x16_bf16(b1, qr[d0], p1, 0, 0, 0); }
}
template <int VB>
__device__ __forceinline__ void pv_tile(f32x16* o, int vb0, bf16x8 pa0, bf16x8 pa1, bf16x8 pa2, bf16x8 pa3) {
#define TRRD(dst, off) asm volatile("ds_read_b64_tr_b16 %0, %1 offset:%2" : "=&v"(dst) : "v"(vb0), "i"(off) : "memory")
#define PV_D0(d0) do { s16x4 l0, l1, l2, l3, h0, h1, h2, h3; constexpr int b_ = VB * SHM_V + v_rd_off(d0, 0, 0); \
        TRRD(l0, b_); TRRD(h0, b_ + 2048); TRRD(l1, b_ + 4096); TRRD(h1, b_ + 6144); TRRD(l2, b_ + 8192); TRRD(h2, b_ + 10240); TRRD(l3, b_ + 12288); TRRD(h3, b_ + 14336); \
        asm volatile("s_waitcnt lgkmcnt(0)" ::: "memory"); SBAR(); \
        o[d0] = __builtin_amdgcn_mfma_f32_32x32x16_bf16(pa0, (bf16x8){l0[0], l0[1], l0[2], l0[3], h0[0], h0[1], h0[2], h0[3]}, o[d0], 0, 0, 0); \
        o[d0] = __builtin_amdgcn_mfma_f32_32x32x16_bf16(pa1, (bf16x8){l1[0], l1[1], l1[2], l1[3], h1[0], h1[1], h1[2], h1[3]}, o[d0], 0, 0, 0); \
        o[d0] = __builtin_amdgcn_mfma_f32_32x32x16_bf16(pa2, (bf16x8){l2[0], l2[1], l2[2], l2[3], h2[0], h2[1], h2[2], h2[3]}, o[d0], 0, 0, 0); \
        o[d0] = __builtin_amdgcn_mfma_f32_32x32x16_bf16(pa3, (bf16x8){l3[0], l3[1], l3[2], l3[3], h3[0], h3[1], h3[2], h3[3]}, o[d0], 0, 0, 0); } while (0)
    PV_D0(0); PV_D0(1); PV_D0(2); PV_D0(3);
#undef PV_D0
#undef TRRD
}

#define TILEP(p, k0) ((const char*)((p) + (size_t)(k0) * PITCH))
#define VMW() asm volatile("s_waitcnt vmcnt(0)" ::: "memory")
#define VMWN(n) asm volatile("s_waitcnt vmcnt(%0)" :: "i"(n) : "memory")
#define LD8(p) (*reinterpret_cast<const bf16x8*>(p))
#define LD8O(base, off) (*reinterpret_cast<const bf16x8*>((base) + (off)))
#define SLOAD_H(Kp, Vp, k0) do { const char* vt_ = TILEP(Vp, k0); const char* kt_ = TILEP(Kp, k0); S.st_v0 = LD8O(vt_, roff0); S.st_v1 = LD8O(vt_, roff1); S.st_k0 = LD8O(kt_, roff0); S.st_k1 = LD8O(kt_, roff1); } while (0)
#define SWRITE_HK(bf) do { *(LAS bf16x8*)(K_lds + (bf) * SHM_K + kws) = S.st_k0; *(LAS bf16x8*)(K_lds + (bf) * SHM_K + kws + 32 * 256) = S.st_k1; } while (0)
#define SWRITE_HV(bf) do { *(LAS bf16x8*)(V_lds + (bf) * SHM_V + vst0) = S.st_v0; *(LAS bf16x8*)(V_lds + (bf) * SHM_V + vst1) = S.st_v1; } while (0)
#define SWRITE_H(bf) do { SWRITE_HV(bf); SWRITE_HK(bf); } while (0)

__device__ __forceinline__ void prime(const Unit& cur, LAS char* lds, Seam& S, int tid_) {
    int tid = tid_; asm volatile("" : "+v"(tid));
    const int wid = __builtin_amdgcn_readfirstlane(tid >> 6), lane = tid & 63, r32 = lane & 31, hi = lane >> 5;
    const int sr = tid >> 4, sc = (tid & 15) * 8, kws = KSWZ(sr, sc * 2); LAS char* K_lds = lds + OFF_K;
    const unsigned roff0 = (unsigned)(sr * PITCH + sc) * 2u, roff1 = roff0 + 32u * PITCH * 2u, qoff = (unsigned)(r32 * PITCH + hi * 8) * 2u;
    { const char* qb_ = (const char*)(cur.Q + (size_t)(wid * QBLK) * PITCH);
#pragma unroll
    for (int d0 = 0; d0 < 8; ++d0) S.qr[d0] = LD8O(qb_, qoff + d0 * 32); }
    SLOAD_H(cur.K, cur.V, 0); VMW(); SWRITE_HK(0);
    __syncthreads();
}
__device__ __forceinline__ void block(const Unit& cur, const Unit& nxt, float slope2, float M2, LAS char* lds, Seam& S, int tid_) {
    int tid = tid_; asm volatile("" : "+v"(tid));
    const int wid = __builtin_amdgcn_readfirstlane(tid >> 6), lane = tid & 63, r32 = lane & 31, hi = lane >> 5;
    const unsigned roff0 = (unsigned)((tid >> 4) * PITCH + (tid & 15) * 8) * 2u, roff1 = roff0 + 32u * PITCH * 2u, qoff = (unsigned)(r32 * PITCH + hi * 8) * 2u;
    const int NT = 4 * (cur.qb + 1);
    LAS char* V_lds = lds + OFF_V; LAS char* K_lds = lds + OFF_K;
    LAS float* li_l = (LAS float*)(lds + OFF_WS) + wid * 64;
    float l_reg = 0; f32x16 o[4] = {};
    const int sr = tid >> 4, sc = (tid & 15) * 8, vst0 = v_st(sr, sc), vst1 = v_st(32 + sr, sc), kws = KSWZ(sr, sc * 2);
    const int vb0 = (int)(unsigned)(size_t)V_lds + v_rd_base(lane);
    const bf16* Kh = cur.K; const bf16* Vh = cur.V;
    const int tq = cur.qb * QB + wid * QBLK + r32;
    {
        const int n = sr & 15; const float* kp = cur.KM + n * HD + sc;
        const f32x4 a = *(const f32x4*)kp, b = *(const f32x4*)(kp + 4);
        float v[8] = {a.x, a.y, a.z, a.w, b.x, b.y, b.z, b.w}; unsigned w[4];
#pragma unroll
        for (int e = 0; e < 4; ++e) { const unsigned h0 = f2bf(v[2 * e]), h1 = f2bf(v[2 * e + 1]);
            if (sr < 16) w[e] = h0 | (h1 << 16); else w[e] = pk2(v[2 * e] - bflo(h0), v[2 * e + 1] - bflo(h1)); }
        *(LAS u32x4*)(lds + OFF_KM + KSWZ(sr, sc * 2)) = (u32x4){w[0], w[1], w[2], w[3]};
    }
    __syncthreads();
    unsigned selmask = 0;
    {
        f32x16 pg = f32x16{};
#pragma unroll
        for (int d0 = 0; d0 < 8; ++d0) { const bf16x8 a = *reinterpret_cast<const LAS bf16x8*>(lds + OFF_KM + KSWZ(r32, (d0 * 16 + hi * 8) * 2));
            pg = __builtin_amdgcn_mfma_f32_32x32x16_bf16(a, S.qr[d0], pg, 0, 0, 0); }
        float g[16];
#pragma unroll
        for (int j = 0; j < 8; ++j) { const float mine = pg[j] + pg[j + 8], oth = __shfl_xor(mine, 32); const int n0 = (j & 3) + 8 * (j >> 2);
            g[n0] = hi ? oth : mine; g[n0 + 4] = hi ? mine : oth; }
        float v0 = -__builtin_inff(), v1 = v0, v2 = v0; int i0 = 0, i1 = 0, i2 = 0;
#pragma unroll
        for (int n = 0; n < 16; ++n) { const float gt = n < cur.qb ? g[n] : -__builtin_inff();
            if (gt > v0) { v2 = v1; i2 = i1; v1 = v0; i1 = i0; v0 = gt; i0 = n; }
            else if (gt > v1) { v2 = v1; i2 = i1; v1 = gt; i1 = n; }
            else if (gt > v2) { v2 = gt; i2 = n; } }
        if (v0 > -__builtin_inff()) selmask |= 1u << i0;
        if (v1 > -__builtin_inff()) selmask |= 1u << i1;
        if (v2 > -__builtin_inff()) selmask |= 1u << i2;
    }
    const float basec = -M2 + slope2 * (float)(4 * hi - tq);
    const int ownt = 4 * cur.qb;
#define KBASE(t) ((t) * KVBLK)
#define TBASE(t) (((t) >= ownt || ((selmask >> ((t) >> 2)) & 1u)) ? fmaf(slope2, (float)KBASE(t), basec) : -__builtin_inff())
#define MASKT(P0_, P1_, t) do { if ((t) >= ownt && KBASE(t) + KVBLK - 1 > cur.qb * QB + wid * QBLK) mask_tile(P0_, P1_, tq - 4 * hi - KBASE(t)); } while (0)
    f32x16 pA0, pA1, pB0, pB1; bf16x8 pa0, pa1, pa2, pa3;
    SWRITE_HV(0); SBAR();
    SLOAD_H(Kh, Vh, KBASE(1));
    SBAR(); qkt<0>(pA0, pA1, K_lds, r32, hi, S.qr);
    MASKT(pA0, pA1, 0); partialSM(pA0, pA1, TBASE(0), slope2);
    VMW(); SWRITE_H(1);
    __syncthreads();
#define HALF_STEP(PX0, PX1, PY0, PY1, t, KB, VB, SB) do { \
        SBAR(); qkt<KB>(PX0, PX1, K_lds, r32, hi, S.qr); \
        finishSM(PY0, PY1, l_reg, pa0, pa1, pa2, pa3); SBAR(); \
        if ((t) + 1 < NT) { SLOAD_H(Kh, Vh, KBASE((t) + 1)); SBAR(); } \
        pv_tile<VB>(o, vb0, pa0, pa1, pa2, pa3); MASKT(PX0, PX1, (t)); partialSM(PX0, PX1, TBASE(t), slope2); \
        __syncthreads(); \
        if ((t) + 1 < NT) { VMW(); SWRITE_H(SB); } \
        __syncthreads(); } while (0)
    for (int t = 1; t + 1 < NT; t += 2) {
        HALF_STEP(pB0, pB1, pA0, pA1, t, 1, 0, 0);
        HALF_STEP(pA0, pA1, pB0, pB1, t + 1, 0, 1, 1);
    }
    SBAR(); qkt<1>(pB0, pB1, K_lds, r32, hi, S.qr); SBAR();
    SLOAD_H(nxt.K, nxt.V, 0); SBAR();
    { const char* qb_ = (const char*)(nxt.Q + (size_t)(wid * QBLK) * PITCH);
#pragma unroll
    for (int d0 = 0; d0 < 8; ++d0) S.qr[d0] = LD8O(qb_, qoff + d0 * 32); }
    SBAR();
    finishSM(pA0, pA1, l_reg, pa0, pa1, pa2, pa3); SBAR();
    pv_tile<0>(o, vb0, pa0, pa1, pa2, pa3);
    MASKT(pB0, pB1, NT - 1); partialSM(pB0, pB1, TBASE(NT - 1), slope2); __syncthreads();
    finishSM(pB0, pB1, l_reg, pa0, pa1, pa2, pa3); SBAR(); pv_tile<1>(o, vb0, pa0, pa1, pa2, pa3);
    SBAR(); VMWN(8); SWRITE_HK(0); SBAR();
    if (hi == 0) li_l[r32] = l_reg; asm volatile("s_waitcnt lgkmcnt(0)" ::: "memory");
    char* Ow = (char*)(const_cast<bf16*>(cur.Q) + (size_t)(wid * QBLK) * PITCH);
    const char* Gw = Ow + (C_G - C_Q) * 2;
    const unsigned eoff = (unsigned)(4 * hi * PITCH + r32) * 2u;
#pragma unroll
    for (int r = 0; r < 16; ++r) { const int orow = crow(r, hi); const float rl = __builtin_amdgcn_rcpf(li_l[orow]);
        const unsigned ro = eoff + (unsigned)(((r & 3) + 8 * (r >> 2)) * PITCH) * 2u;
#pragma unroll
        for (int d0 = 0; d0 < 4; ++d0) { const float gg = bflo((unsigned)*(const bf16*)(Gw + ro + d0 * 64));
            const float v = o[d0][r] * rl * silu_f(gg);
            const float vn = __shfl_xor(v, 1);
            if ((r32 & 1) == 0) *(unsigned*)(Ow + ro + d0 * 64) = cvtpk(v, vn); } }
    __syncthreads();
#undef KBASE
#undef TBASE
#undef MASKT
#undef HALF_STEP
}
#undef TILEP
#undef LD8O
#undef VMW
#undef VMWN
#undef LD8
#undef SLOAD_H
#undef SWRITE_HK
#undef SWRITE_HV
#undef SWRITE_H
#undef KSWZ
#undef SBAR
}

__device__ __forceinline__ bool attn_unit_of(int k, int v, int G, bf16* PROJ, const float* KM, moba::Unit& u) {
    const int item = v + (k >> 1) * G; if (item >= BATCH * NH * 8) return false;
    const int bh = item >> 3, s = item & 7, b = bh >> 3, h = bh & 7, qb = (k & 1) ? s : 15 - s;
    const bf16* base = PROJ + (size_t)b * SEQ * PITCH + h * HD;
    u.Q = base + (size_t)qb * MOBA * PITCH + C_Q; u.K = base + C_K; u.V = base + C_V; u.KM = KM + (size_t)bh * NBLK * HD; u.qb = qb; u.h = h;
    return true;
}
__device__ __forceinline__ void attn_phase(Frame& F, int layer) {
    bf16* const PROJ = WSP(bf16, WS_PROJ); const float* const KM = WSP(float, WS_KM);
    const float* qw = in_ptr(3) + layer * HD; const float* kw = in_ptr(4) + layer * HD;
    const float mq = wave_max(fmaxf(fabsf(qw[2 * F.lane]), fabsf(qw[2 * F.lane + 1]))), mk = wave_max(fmaxf(fabsf(kw[2 * F.lane]), fabsf(kw[2 * F.lane + 1])));
    const float M2 = 11.313708499f * mq * mk * 1.02f * moba::LOG2E;
    LAS char* lds = (LAS char*)(F.lds + RING_OFF);
    moba::Unit cur, nxt; moba::Seam S;
    if (!attn_unit_of(0, F.vcu, F.G, PROJ, KM, cur)) return;
    moba::prime(cur, lds, S, F.tid);
    for (int k = 0;; ++k) {
        const bool more = attn_unit_of(k + 1, F.vcu, F.G, PROJ, KM, nxt);
        if (!more) nxt = cur;
        const float slope2 = exp2f(-(float)(cur.h + 1)) * moba::LOG2E;
        moba::block(cur, nxt, slope2, M2, lds, S, F.tid);
        if (!more) break;
        cur = nxt;
    }
}

__device__ __forceinline__ void phase_e(Frame& F, int layer) {
    bf16* const PROJ = WSP(bf16, WS_PROJ); const float* const SSQ = WSP(float, WS_SSQ);
    const int gw = F.vcu * NWAVES + F.wave, NGW = F.G * NWAVES;
    const float* w = in_ptr(10) + (size_t)layer * 1024 + 16 * F.lane;
    float wv[16];
#pragma unroll
    for (int e = 0; e < 16; ++e) wv[e] = w[e];
    const int g = F.lane >> 5;
    for (int m = gw; m < M; m += NGW) {
        const f32x4* sp = (const f32x4*)(SSQ + (size_t)m * 32 + g * 16);
        const f32x4 s0 = sp[0], s1 = sp[1], s2 = sp[2], s3 = sp[3];
        const float ssq = ((s0.x + s0.y) + (s0.z + s0.w)) + ((s1.x + s1.y) + (s1.z + s1.w)) + ((s2.x + s2.y) + (s2.z + s2.w)) + ((s3.x + s3.y) + (s3.z + s3.w));
        const float r = 1.f / sqrtf(ssq * (1.f / 512.f) + EPS);
        v4u* yp = (v4u*)(PROJ + (size_t)m * PITCH + C_Z + 16 * F.lane);
        v4u a = yp[0], c = yp[1];
        a.x = pk2(bflo(a.x) * r * wv[0], bfhi(a.x) * r * wv[1]); a.y = pk2(bflo(a.y) * r * wv[2], bfhi(a.y) * r * wv[3]);
        a.z = pk2(bflo(a.z) * r * wv[4], bfhi(a.z) * r * wv[5]); a.w = pk2(bflo(a.w) * r * wv[6], bfhi(a.w) * r * wv[7]);
        c.x = pk2(bflo(c.x) * r * wv[8], bfhi(c.x) * r * wv[9]); c.y = pk2(bflo(c.y) * r * wv[10], bfhi(c.y) * r * wv[11]);
        c.z = pk2(bflo(c.z) * r * wv[12], bfhi(c.z) * r * wv[13]); c.w = pk2(bflo(c.w) * r * wv[14], bfhi(c.w) * r * wv[15]);
        yp[0] = a; yp[1] = c;
    }
}

__global__ void __launch_bounds__(NWAVES * 64, 2) mk_fwd(Args args) {
    extern __shared__ __attribute__((aligned(16))) unsigned char lds[];
    Frame F;
    F.lds = (LAS unsigned char*)lds;
    F.MISC = (volatile LAS unsigned*)(F.lds + MISC_OFF);
    F.tid = threadIdx.x; F.lane = F.tid & 63; F.wave = __builtin_amdgcn_readfirstlane(F.tid >> 6);
    F.G = gridDim.x; { const int bx = blockIdx.x; F.vcu = (F.G % 8 == 0) ? (bx % 8) * (F.G / 8) + bx / 8 : bx; }
    for (int u = F.tid; u < (LDS_BYTES - LDSCTL_OFF) / 4; u += NWAVES * 64) ((LAS unsigned*)(F.lds + LDSCTL_OFF))[u] = 0u;
    __syncthreads();
    XcdBarrier bar; bar.bar = nullptr; bar.x = 0; bar.st = nullptr;
    if (N_LAUNCHES == 1) bar = xcd_barrier_post(WSP(unsigned, WS_CTL) + CW_BAR, F.MISC + 8);
    const int lo = args.ph_lo, hi = args.ph_hi;
#define IN(k) (lo <= (k) && (k) < hi)
#define REFRESH() do { asm volatile("" : "+v"(F.tid)); F.lane = F.tid & 63; F.wave = __builtin_amdgcn_readfirstlane(F.tid >> 6); asm volatile("" : "+s"(F.vcu), "+s"(F.G)); } while (0)
#define SEAM(k) do { if (IN(k) && IN((k) + 1)) { bar.bar = WSP(unsigned, WS_CTL) + CW_BAR; xcd_barrier(bar); } } while (0)

#pragma unroll 1
    for (int layer = 0; layer < DEPTH; ++layer) {
        const int pb = layer * 6;
        if (IN(pb + 0) && (DBG_MASK & 1)) { REFRESH(); phase_a(F, layer); } SEAM(pb + 0);
        if (IN(pb + 1) && (DBG_MASK & 2)) {
            REFRESH();
            pg8::Gemm g{WSP(bf16, WS_A), WSP(bf16, WS_WIN), M, PITCH, DM, DM}; pg8::StaticOrder S; S.init(M, PITCH, F.G, (int)blockIdx.x);
            pg8::EpiBf16<0> E{WSP(bf16, WS_PROJ), PITCH, nullptr, 0, 0, 1.f};
            pg8::gemm_phase<pg8::EpiBf16<0>, pg8::StaticOrder, true, true>(F.lds + RING_OFF, g, S, E);
        } SEAM(pb + 1);
        if (IN(pb + 2) && (DBG_MASK & 4)) { REFRESH(); phase_c(F, layer); } SEAM(pb + 2);
        if (IN(pb + 3)) { if (DBG_MASK & 8) { REFRESH(); ssd_simple(F, layer); __syncthreads(); }     if (DBG_MASK & 16) { REFRESH(); if (USE_FAST_ATTN) attn_phase(F, layer); else attn_simple(F, layer); } } SEAM(pb + 3);
        if (IN(pb + 4) && (DBG_MASK & 32)) { REFRESH(); phase_e(F, layer); } SEAM(pb + 4);
        if (IN(pb + 5) && (DBG_MASK & 64)) {
            REFRESH();
            float* const OUTP = out_ptr(); const float* base = layer == 0 ? in_ptr(0) : OUTP;
            pg8::Gemm g{WSP(bf16, WS_PROJ), WSP(bf16, WS_WOUT), M, DM, 2048, PITCH}; pg8::StaticOrder S; S.init(M, DM, F.G, (int)blockIdx.x);
            pg8::EpiResF32 E{base, OUTP, DM};
            pg8::gemm_phase<pg8::EpiResF32, pg8::StaticOrder, true, true>(F.lds + RING_OFF, g, S, E);
        } SEAM(pb + 5);
    }
#undef IN
#undef SEAM
}

extern "C" void kernel_launch(void* const* d_in, const int* in_sizes, int n_in, void* d_out, int out_size, void* d_ws, size_t ws_size, hipStream_t stream) {
    static int grid = 0;
    if (grid == 0) {
        if (n_in != 12 || in_sizes[0] != M * DM || out_size != M * DM || ws_size < WS_END) {
            fprintf(stderr, "kernel_launch: unexpected shapes (n_in %d, in0 %d, out %d, ws %zu); nothing launched\n", n_in, n_in > 0 ? in_sizes[0] : -1, out_size, ws_size); grid = -1; return; }
        int dev = 0, cus = 0, per_cu = 0;
        if (hipGetDevice(&dev) != hipSuccess || hipDeviceGetAttribute(&cus, hipDeviceAttributeMultiprocessorCount, dev) != hipSuccess) { grid = -1; return; }
        if (hipFuncSetAttribute((const void*)mk_fwd, hipFuncAttributeMaxDynamicSharedMemorySize, LDS_BYTES) != hipSuccess) { fprintf(stderr, "kernel_launch: hipFuncSetAttribute failed\n"); grid = -1; return; }
        if (hipOccupancyMaxActiveBlocksPerMultiprocessor(&per_cu, (const void*)mk_fwd, NWAVES * 64, LDS_BYTES) != hipSuccess || per_cu < 1) {
            fprintf(stderr, "kernel_launch: occupancy query reports %d workgroups per CU; nothing launched\n", per_cu); (void)hipGetLastError(); grid = -1; return; }
        grid = cus;
    }
    if (grid < 0) return;
    if (hipMemsetAsync((char*)d_ws + WS_CTL, 0, CTL_ZERO_BYTES, stream) != hipSuccess) { fprintf(stderr, "kernel_launch: hipMemsetAsync failed\n"); return; }
    Args a{};
    for (int i = 0; i < 12; ++i) a.in[i] = (const float*)d_in[i];
    a.out = (float*)d_out; a.ws = (unsigned char*)d_ws;
    for (int li = 0; li < N_LAUNCHES; ++li) {
        a.ph_lo = (N_LAUNCHES == 1) ? 0 : li; a.ph_hi = (N_LAUNCHES == 1) ? N_PHASES : li + 1; a.li = li;
        hipLaunchKernelGGL(mk_fwd, dim3(grid), dim3(NWAVES * 64), LDS_BYTES, stream, a);
        const hipError_t le = hipPeekAtLastError();
        if (le != hipSuccess) { fprintf(stderr, "kernel_launch: launch %d failed: %s\n", li, hipGetErrorName(le)); break; }
    }
}
```

```cpp
#include <hip/hip_runtime.h>
#include <cstdio>
#include <cstdint>
namespace pg8 {
#define PG8_LAS __attribute__((address_space(3)))
typedef unsigned short bf16_t;
typedef short bf16x8 __attribute__((ext_vector_type(8)));
typedef float f32x4 __attribute__((ext_vector_type(4)));
typedef unsigned u32x4 __attribute__((ext_vector_type(4)));
constexpr int BM = 256, BK = 64, HALF = 128, HTB = HALF * BK * 2  , STAGE_BYTES = 8 * HTB, NXCD = 8, WGM = 8;

__host__ __device__ __forceinline__ int lds_byte(int r, int c) { const int st = (r >> 4) * 2 + (c >> 5), rr = r & 15, cc = c & 31, ob = rr * 64 + cc * 2; return st * 1024 + (ob ^ (((ob >> 9) & 1) << 5)); }
__host__ __device__ __forceinline__ void stage_rc(int b, int& R, int& C) { const int st = b / 1024, sb = b % 1024, swz = sb ^ (((sb >> 9) & 1) << 5); R = (st >> 1) * 16 + swz / 64; C = (st & 1) * 32 + (swz % 64) / 2; }
__host__ __device__ __forceinline__ int perm32(int rho) { const int n = rho >> 4, i = rho & 15; return 8 * (i >> 2) + 4 * n + (i & 3); }

struct Unit { int pm, pn; };
struct Gemm { const bf16_t* A; const bf16_t* Bt; int M, N, K, lda; };

struct StaticOrder {
    int nM, nN, nwg, G, c;
    __host__ __device__ void init(int M, int N, int G_, int c_) { nM = M / BM; nN = N / BM; nwg = nM * nN; G = G_; c = c_; }
    __host__ __device__ bool next(int i, Unit& u) const {
        const long L = (long)i * G + c; if (L >= nwg) return false;
        int wgid = (int)L; { const int q = nwg / NXCD, r = nwg % NXCD, xcd = wgid % NXCD, off = wgid / NXCD; wgid = (xcd < r ? xcd * (q + 1) : r * (q + 1) + (xcd - r) * q) + off; }
        const int nig = WGM * nN, gid = wgid / nig, fm = gid * WGM, gsz = (nM - fm) < WGM ? (nM - fm) : WGM;
        u.pm = fm + ((wgid % nig) % gsz); u.pn = (wgid % nig) / gsz; return true;
    }
    __device__ __forceinline__ void a_ready(const Unit&) const {}
    __device__ __forceinline__ void done(const Unit&) const {}
};

__device__ __forceinline__ unsigned cvt_pk_bf16(float lo, float hi) { unsigned r; asm volatile("v_cvt_pk_bf16_f32 %0, %1, %2" : "=v"(r) : "v"(lo), "v"(hi)); return r; }
typedef float f32x2 __attribute__((ext_vector_type(2)));
__device__ __forceinline__ f32x2 gelu_pk(f32x2 v) {
    const f32x2 av = __builtin_elementwise_abs(v), d = av * 0.2316418882f + 1.0f;
    f32x2 t; t.x = __builtin_amdgcn_rcpf(d.x); t.y = __builtin_amdgcn_rcpf(d.y);
    f32x2 q = t * 0.5307027145f + (-0.7265760135f); q = q * t + 0.7107068705f; q = q * t + (-0.142248368f); q = q * t + 0.127414796f; q = q * t;
    const f32x2 s = (v * v) * (-0.72134752044f);
    f32x2 e; e.x = __builtin_amdgcn_exp2f(s.x); e.y = __builtin_amdgcn_exp2f(s.y);
    const f32x2 m = v * (q * e), r = v - m;
    f32x2 o; o.x = v.x < 0.f ? m.x : r.x; o.y = v.y < 0.f ? m.y : r.y; return o;
}

template <int ACT  > struct EpiBf16 {
    static constexpr bool PERM = true, AFTER_DRAIN = false; static_assert(ACT == 0 || ACT == 1, "EpiBf16: ACT is 0 (none) or 1 (gelu_pk)");
    bf16_t* O; int ldc; const float* bias; int split_cols; size_t split_stride; float scale0;
    __device__ __forceinline__ void operator()(const f32x4 (&acc)[2][2][4][2], const Unit& u, int wr, int wc, int fr, int fq) const {
        const int row0 = u.pm * BM + wr * 64 + fr; int colt = u.pn * BM; bf16_t* base = O;
        float sc = 1.f; if (split_cols) { const int t = colt / split_cols; base += (size_t)t * split_stride; colt -= t * split_cols; if (t == 0) sc = scale0; }
        const int col0 = colt + wc * 32 + 8 * fq, bcol0 = u.pn * BM + wc * 32 + 8 * fq;
        f32x4 bv[2][2];
#pragma unroll
        for (int bj = 0; bj < 2; ++bj)
#pragma unroll
            for (int n = 0; n < 2; ++n) bv[bj][n] = bias ? *(const f32x4*)(bias + bcol0 + bj * HALF + 4 * n) : (f32x4){0.f, 0.f, 0.f, 0.f};
#pragma unroll
        for (int ai = 0; ai < 2; ++ai)
#pragma unroll
            for (int m = 0; m < 4; ++m) { bf16_t* rowp = base + (size_t)(row0 + ai * HALF + m * 16) * ldc + col0;
#pragma unroll
                for (int bj = 0; bj < 2; ++bj) { f32x4 v0 = acc[ai][bj][m][0] + bv[bj][0], v1 = acc[ai][bj][m][1] + bv[bj][1];
                    if (ACT == 1) { f32x2 a = gelu_pk((f32x2){v0[0], v0[1]}), b = gelu_pk((f32x2){v0[2], v0[3]}), c = gelu_pk((f32x2){v1[0], v1[1]}), d = gelu_pk((f32x2){v1[2], v1[3]});
                        v0 = (f32x4){a.x, a.y, b.x, b.y}; v1 = (f32x4){c.x, c.y, d.x, d.y}; }
                    v0 = v0 * sc; v1 = v1 * sc; u32x4 w; w.x = cvt_pk_bf16(v0[0], v0[1]); w.y = cvt_pk_bf16(v0[2], v0[3]); w.z = cvt_pk_bf16(v1[0], v1[1]); w.w = cvt_pk_bf16(v1[2], v1[3]);
                    *(u32x4*)(rowp + bj * HALF) = w; } }
    }
};
template <class Epi, class Sched, bool ALIGN_EPI = false, bool SP2 = false>
__device__ __forceinline__ void gemm_phase(PG8_LAS unsigned char* lds, const Gemm g, const Sched& S, const Epi& E) {
    int tid_ = threadIdx.x; asm volatile("" : "+v"(tid_));
    const int tid = tid_, wid = __builtin_amdgcn_readfirstlane(tid >> 6), lane = tid & 63, wr = wid >> 2, wc = wid & 3, fr = lane & 15, fq = lane >> 4;
    const int K = g.K, nt = K / BK;
    unsigned voffA[2], voffB[2];
#pragma unroll
    for (int i = 0; i < 2; ++i) { int R, C; stage_rc(tid * 16 + i * 8192, R, C); const int Rb = Epi::PERM ? ((R & ~31) + perm32(R & 31)) : R;
        voffA[i] = (unsigned)(R * g.lda + C) * 2u; voffB[i] = (unsigned)(Rb * K + C) * 2u; }
    const size_t kstep = (size_t)(BK * 2);
    const size_t hstep = (size_t)HALF * K * 2;
    const size_t tstep = 2 * hstep; const size_t hstepA = (size_t)HALF * g.lda * 2, tstepA = 2 * hstepA;
    const unsigned ldsw = (unsigned)wid * 1024u;
    const int aoff = lds_byte(wr * 64 + fr, fq * 8), boff = lds_byte(wc * 32 + fr, fq * 8);
#define PG8_SA(b, h) (((b) * 2 + (h)) * HTB)
#define PG8_SB(b, h) ((4 + (b) * 2 + (h)) * HTB)
#define PG8_STAGE(bufoff, gbase, voff) do { _Pragma("unroll") for (int _i = 0; _i < 2; ++_i) \
        __builtin_amdgcn_global_load_lds((const unsigned*)((const char*)(gbase) + (voff)[_i]), (PG8_LAS unsigned*)(lds + (bufoff) + ldsw + _i * 8192), 16, 0, 0); } while (0)
#define PG8_LDA(dst, b, h) do { _Pragma("unroll") for (int m = 0; m < 4; ++m) _Pragma("unroll") for (int k = 0; k < 2; ++k) dst[m][k] = *(const PG8_LAS bf16x8*)(lds + PG8_SA(b, h) + aoff + m * 2048 + k * 1024); } while (0)
#define PG8_LDB(dst, b, h) do { _Pragma("unroll") for (int n = 0; n < 2; ++n) _Pragma("unroll") for (int k = 0; k < 2; ++k) dst[n][k] = *(const PG8_LAS bf16x8*)(lds + PG8_SB(b, h) + boff + n * 2048 + k * 1024); } while (0)
#define PG8_MMA(ai, bj, At, Bt) do { __builtin_amdgcn_s_setprio(1); _Pragma("unroll") for (int m = 0; m < 4; ++m) _Pragma("unroll") for (int n = 0; n < 2; ++n) _Pragma("unroll") for (int k = 0; k < 2; ++k) \
        acc[ai][bj][m][n] = __builtin_amdgcn_mfma_f32_16x16x32_bf16(Bt[n][k], At[m][k], acc[ai][bj][m][n], 0, 0, 0); __builtin_amdgcn_s_setprio(0); } while (0)
#define PG8_WAIT_V(n) asm volatile("s_waitcnt vmcnt(" #n ")" ::: "memory")
#define PG8_WAIT_L(n) asm volatile("s_waitcnt lgkmcnt(" #n ")" ::: "memory")
#define PG8_BAR __builtin_amdgcn_s_barrier()
#define PG8_SCHED __builtin_amdgcn_sched_barrier(0)
    Unit cur, nxt; int ui = 0;
    if (!S.next(0, cur)) return;
    f32x4 acc[2][2][4][2];
#pragma unroll
    for (int a = 0; a < 2; ++a)
#pragma unroll
        for (int b = 0; b < 2; ++b)
#pragma unroll
            for (int m = 0; m < 4; ++m)
#pragma unroll
                for (int n = 0; n < 2; ++n) acc[a][b][m][n] = (f32x4){0.f, 0.f, 0.f, 0.f};
    bf16x8 At[4][2], B0[2][2], B1[2][2];
    const char* cA = (const char*)g.A + (size_t)cur.pm * tstepA; const char* cB = (const char*)g.Bt + (size_t)cur.pn * tstep;
    S.a_ready(cur);
    if constexpr (SP2) {
        PG8_STAGE(PG8_SB(0, 0), cB, voffB); PG8_STAGE(PG8_SB(0, 1), cB + hstep, voffB); PG8_STAGE(PG8_SA(0, 0), cA, voffA); PG8_STAGE(PG8_SA(0, 1), cA + hstepA, voffA);
        if (wr == 1) PG8_BAR;
        PG8_WAIT_V(2); PG8_BAR;
        PG8_STAGE(PG8_SB(1, 0), cB + kstep, voffB); PG8_STAGE(PG8_SA(1, 0), cA + kstep, voffA); PG8_STAGE(PG8_SB(1, 1), cB + hstep + kstep, voffB);
        PG8_WAIT_V(6); PG8_BAR;
    } else {
        PG8_STAGE(PG8_SB(0, 0), cB, voffB); PG8_STAGE(PG8_SA(0, 0), cA, voffA); PG8_STAGE(PG8_SB(0, 1), cB + hstep, voffB); PG8_STAGE(PG8_SA(0, 1), cA + hstepA, voffA);
        if (wr == 1) PG8_BAR;
        PG8_WAIT_V(4); PG8_BAR;
        PG8_STAGE(PG8_SB(1, 0), cB + kstep, voffB); PG8_STAGE(PG8_SA(1, 0), cA + kstep, voffA); PG8_STAGE(PG8_SB(1, 1), cB + hstep + kstep, voffB);
        PG8_WAIT_V(6); PG8_BAR;
    }
    for (;;) {
        const bool has_next = S.next(ui + 1, nxt);
        const char* nA = has_next ? (const char*)g.A + (size_t)nxt.pm * tstepA : cA; const char* nB = has_next ? (const char*)g.Bt + (size_t)nxt.pn * tstep : cB;
        for (int t = 0; t < nt; t += 2) {
            const bool last = (t == nt - 2);
            const char* a1 = cA + (size_t)(t + 1) * kstep;
            const char* a2 = last ? nA : cA + (size_t)(t + 2) * kstep; const char* b2 = last ? nB : cB + (size_t)(t + 2) * kstep;
            const char* a3 = a2 + kstep; const char* b3 = b2 + kstep;
            if (last && has_next) S.a_ready(nxt);
            if constexpr (SP2) {
            PG8_LDB(B0, 0, 0); PG8_LDB(B1, 0, 1); PG8_SCHED; PG8_LDA(At, 0, 0); PG8_STAGE(PG8_SA(1, 1), a1 + hstepA, voffA);
            PG8_WAIT_V(8); PG8_WAIT_L(0); PG8_BAR; PG8_MMA(0, 0, At, B0); PG8_MMA(0, 1, At, B1); PG8_BAR; PG8_SCHED;
            PG8_LDA(At, 0, 1); PG8_STAGE(PG8_SB(0, 0), b2, voffB); PG8_STAGE(PG8_SB(0, 1), b2 + hstep, voffB); PG8_STAGE(PG8_SA(0, 0), a2, voffA);
            PG8_WAIT_V(8); PG8_WAIT_L(0); PG8_BAR; PG8_MMA(1, 0, At, B0); PG8_MMA(1, 1, At, B1); PG8_BAR; PG8_SCHED;
            PG8_LDB(B0, 1, 0); PG8_LDB(B1, 1, 1); PG8_SCHED; PG8_LDA(At, 1, 0); PG8_STAGE(PG8_SA(0, 1), a2 + hstepA, voffA);
            PG8_WAIT_V(8); PG8_WAIT_L(0); PG8_BAR; PG8_MMA(0, 0, At, B0); PG8_MMA(0, 1, At, B1); PG8_BAR; PG8_SCHED;
            PG8_LDA(At, 1, 1); PG8_STAGE(PG8_SB(1, 0), b3, voffB); PG8_STAGE(PG8_SB(1, 1), b3 + hstep, voffB); PG8_STAGE(PG8_SA(1, 0), a3, voffA);
            PG8_WAIT_V(8); PG8_WAIT_L(0); PG8_BAR; PG8_MMA(1, 0, At, B0); PG8_MMA(1, 1, At, B1); PG8_BAR; PG8_SCHED;
            } else {
            PG8_LDB(B0, 0, 0); PG8_SCHED; PG8_LDA(At, 0, 0); PG8_STAGE(PG8_SA(1, 1), a1 + hstepA, voffA);
            PG8_WAIT_L(8); PG8_BAR; PG8_WAIT_L(0); PG8_MMA(0, 0, At, B0); PG8_BAR; PG8_SCHED;
            PG8_LDB(B1, 0, 1); PG8_STAGE(PG8_SB(0, 0), b2, voffB);
            PG8_BAR; PG8_WAIT_L(0); PG8_MMA(0, 1, At, B1); PG8_BAR;
            PG8_LDA(At, 0, 1); PG8_STAGE(PG8_SA(0, 0), a2, voffA);
            PG8_BAR; PG8_WAIT_L(0); PG8_MMA(1, 0, At, B0); PG8_BAR; PG8_SCHED;
            PG8_STAGE(PG8_SB(0, 1), b2 + hstep, voffB);
            PG8_WAIT_V(6); PG8_BAR; PG8_MMA(1, 1, At, B1); PG8_BAR;
            PG8_LDB(B0, 1, 0); PG8_SCHED; PG8_LDA(At, 1, 0); PG8_STAGE(PG8_SA(0, 1), a2 + hstepA, voffA);
            PG8_WAIT_L(8); PG8_BAR; PG8_WAIT_L(0); PG8_MMA(0, 0, At, B0); PG8_BAR; PG8_SCHED;
            PG8_LDB(B1, 1, 1); PG8_STAGE(PG8_SB(1, 0), b3, voffB);
            PG8_BAR; PG8_WAIT_L(0); PG8_MMA(0, 1, At, B1); PG8_BAR;
            PG8_LDA(At, 1, 1); PG8_STAGE(PG8_SA(1, 0), a3, voffA);
            PG8_BAR; PG8_WAIT_L(0); PG8_MMA(1, 0, At, B0); PG8_BAR; PG8_SCHED;
            PG8_STAGE(PG8_SB(1, 1), b3 + hstep, voffB);
            PG8_WAIT_V(6); PG8_BAR; PG8_MMA(1, 1, At, B1); PG8_BAR;
            }
        }
        if constexpr (ALIGN_EPI) { if (wr == 0) PG8_BAR; }
        if constexpr (!Epi::AFTER_DRAIN) { E(acc, cur, wr, wc, fr, fq); S.done(cur); }
        if (!has_next) break;
#pragma unroll
        for (int a = 0; a < 2; ++a)
#pragma unroll
            for (int b = 0; b < 2; ++b)
#pragma unroll
                for (int m = 0; m < 4; ++m)
#pragma unroll
                    for (int n = 0; n < 2; ++n) acc[a][b][m][n] = (f32x4){0.f, 0.f, 0.f, 0.f};
        cur = nxt; cA = nA; cB = nB; ++ui;
        if constexpr (ALIGN_EPI) { if (wr == 1) PG8_BAR; }
    }
    PG8_WAIT_V(0);
    if constexpr (!ALIGN_EPI) { if (wr == 0) PG8_BAR; }
    PG8_BAR;
    if constexpr (Epi::AFTER_DRAIN) { E.fused(acc, cur, wr, wc, fr, fq, lds, wid, lane); S.done(cur); }
#undef PG8_SA
#undef PG8_SB
#undef PG8_STAGE
#undef PG8_LDA
#undef PG8_LDB
#undef PG8_MMA
#undef PG8_WAIT_V
#undef PG8_WAIT_L
#undef PG8_BAR
#undef PG8_SCHED
}
}

namespace pg8 {
struct EpiResF32 {
    static constexpr bool PERM = false, AFTER_DRAIN = false;
    const float* base; float* out; int ldc;
    __device__ __forceinline__ void operator()(const f32x4 (&acc)[2][2][4][2], const Unit& u, int wr, int wc, int fr, int fq) const {
        const int col0 = u.pn * BM + wc * 32 + 4 * fq;
#pragma unroll
        for (int ai = 0; ai < 2; ++ai)
#pragma unroll
            for (int m = 0; m < 4; ++m) { const size_t off = (size_t)(u.pm * BM + ai * HALF + wr * 64 + m * 16 + fr) * ldc + col0;
#pragma unroll
                for (int bj = 0; bj < 2; ++bj)
#pragma unroll
                    for (int n = 0; n < 2; ++n) { const f32x4 bs = *(const f32x4*)(base + off + bj * HALF + n * 16); *(f32x4*)(out + off + bj * HALF + n * 16) = bs + acc[ai][bj][m][n]; } }
    }
};
}

#ifndef USE_FAST_SSD
#define USE_FAST_SSD 1
#endif
#ifndef USE_FAST_ATTN
#define USE_FAST_ATTN 1
#endif
#ifndef DBG_MASK
#define DBG_MASK 127
#endif
constexpr int NWAVES = 8;
#ifndef MK_N_LAUNCHES
#define MK_N_LAUNCHES 1
#endif
constexpr int N_PHASES = 12;
constexpr int N_LAUNCHES = MK_N_LAUNCHES;

constexpr int BATCH = 8, SEQ = 4096, DM = 1024, DEPTH = 2;
constexpr int M = BATCH * SEQ;
constexpr int NH = 8, HD = 128;
constexpr int NSH = 16, SHD = 64, NST = 128;
constexpr int NIN = 6672;
constexpr int PITCH = 6656;
constexpr int C_Q = 0, C_Z = 1024, C_K = 2048, C_V = 3072, C_G = 4096, C_X = 5120, C_B = 6144, C_C = 6400;
constexpr int MOBA = 256, NBLK = SEQ / MOBA;
constexpr float EPS = 1e-6f;

constexpr size_t MiB = 1u << 20;
constexpr size_t WS_CTL = 0, CTL_ZERO_BYTES = 1 * MiB;
constexpr size_t WS_WIN = 1 * MiB;
constexpr size_t WS_WOUT = 14 * MiB;
constexpr size_t WS_KM = 18 * MiB;
constexpr size_t WS_DT = 19 * MiB;
constexpr size_t WS_SSQ = 21 * MiB;
constexpr size_t WS_A = 32 * MiB;
constexpr size_t WS_PROJ = 96 * MiB;
constexpr size_t WS_END = 512 * MiB;
static_assert(WS_PROJ + (size_t)M * PITCH * 2 <= WS_END, "d_ws map");
constexpr int CW_TMO = 0;
constexpr int CW_BAR = 4096;

constexpr int RING_OFF = 0, RING_BYTES = 131072;
constexpr int LDSCTL_OFF = RING_BYTES, MISC_OFF = LDSCTL_OFF + 320;
constexpr int LDS_BYTES = 147456;
static_assert(MISC_OFF + 128 <= LDS_BYTES, "LDS map");

#define GAS __attribute__((address_space(1)))
#define LAS __attribute__((address_space(3)))
typedef unsigned short bf16;
typedef unsigned v4u __attribute__((ext_vector_type(4)));
typedef unsigned v2u __attribute__((ext_vector_type(2)));
typedef float f32x4 __attribute__((ext_vector_type(4)));
typedef short bf16x8 __attribute__((ext_vector_type(8)));
typedef GAS unsigned gu32;
#define RLX_AGENT __ATOMIC_RELAXED, __HIP_MEMORY_SCOPE_AGENT
#define LDS_WAIT() asm volatile("s_waitcnt lgkmcnt(0)" ::: "memory")
#define VM_WAIT() asm volatile("s_waitcnt vmcnt(0)" ::: "memory")
__device__ __forceinline__ unsigned f2bf(float f) { unsigned u = __builtin_bit_cast(unsigned, f); return (u + 0x7fffu + ((u >> 16) & 1u)) >> 16; }
__device__ __forceinline__ unsigned pk2(float lo, float hi) { return f2bf(lo) | (f2bf(hi) << 16); }
__device__ __forceinline__ float bflo(unsigned u) { return __builtin_bit_cast(float, u << 16); }
__device__ __forceinline__ float bfhi(unsigned u) { return __builtin_bit_cast(float, u & 0xffff0000u); }
__device__ __forceinline__ float silu_f(float v) { return v / (1.f + __expf(-v)); }
__device__ __forceinline__ float wave_sum(float v) {
#pragma unroll
    for (int o = 1; o < 64; o <<= 1) v += __shfl_xor(v, o);
    return v;
}
__device__ __forceinline__ float wave_max(float v) {
#pragma unroll
    for (int o = 1; o < 64; o <<= 1) v = fmaxf(v, __shfl_xor(v, o));
    return v;
}

#define XB_TMO      128
#define XB_XCNT(j)  (256  + 64 * (j))
#define XB_XSUB(j)  (1280 + 64 * (j))
#define XB_XGEN(j)  (2304 + 64 * (j))
#define XB_TOP      3328
#define XB_TOPGEN   3392
#define XCD_BAR_WORDS 3456
#define XB_SPIN_CAP (1u << 22)

__device__ __forceinline__ unsigned xb_ld(unsigned* p)              { return __hip_atomic_load(p, __ATOMIC_RELAXED, __HIP_MEMORY_SCOPE_AGENT); }
__device__ __forceinline__ unsigned xb_add(unsigned* p, unsigned v) { return __hip_atomic_fetch_add(p, v, __ATOMIC_RELAXED, __HIP_MEMORY_SCOPE_AGENT); }
__device__ __forceinline__ unsigned xb_xcc_id() { return (unsigned)__builtin_amdgcn_s_getreg((3 << 11) | 20) & 0xFu; }
#define XB_SPIN(cond, bar) do { unsigned _sp = 0; while (cond) { __builtin_amdgcn_s_sleep(1); \
    if ((++_sp & 255u) == 0u) { if (xb_ld(&(bar)[XB_TMO])) break; if (_sp > XB_SPIN_CAP) { atomicAdd(&(bar)[XB_TMO], 1u); break; } } } } while (0)

struct XcdBarrier { unsigned* bar; unsigned x; volatile LAS unsigned* st; };

__device__ __forceinline__ XcdBarrier xcd_barrier_post(unsigned* bar, volatile LAS unsigned* st) {
    XcdBarrier b; b.bar = bar; b.x = xb_xcc_id(); b.st = st;
    if (threadIdx.x == 0) (void)xb_add(&bar[XB_XCNT(b.x)], 1u);
    return b;
}
__device__ __forceinline__ void xcd_barrier_complete(unsigned* bar, unsigned x, unsigned& nloc, unsigned& nx) {
    const unsigned G = gridDim.x * gridDim.y * gridDim.z;
    unsigned sum, cnt, mine, sp = 0u;
    for (;;) {
        sum = 0u; cnt = 0u; mine = 0u;
#pragma unroll
        for (unsigned j = 0; j < 16; ++j) { const unsigned c = xb_ld(&bar[XB_XCNT(j)]); sum += c; cnt += (c > 0u) ? 1u : 0u; mine = (j == x) ? c : mine; }
        if (sum == G) break;
        __builtin_amdgcn_s_sleep(1);
        if ((++sp & 255u) == 0u) { if (xb_ld(&bar[XB_TMO])) break; if (sp > XB_SPIN_CAP) { atomicAdd(&bar[XB_TMO], 1u); break; } }
    }
    nloc = mine > 0u ? mine : 1u; nx = cnt > 0u ? cnt : 1u;
}
__device__ __forceinline__ void xcd_barrier(const XcdBarrier& b) {
    asm volatile("s_waitcnt vmcnt(0)" ::: "memory");
    __syncthreads();
    if (threadIdx.x == 0) {
        unsigned* bar = b.bar;
        __builtin_amdgcn_s_waitcnt(0);
        unsigned nloc = b.st[0], nx = b.st[1];
        if (nloc == 0u) { xcd_barrier_complete(bar, b.x, nloc, nx); b.st[0] = nloc; b.st[1] = nx; }
        const unsigned old = xb_add(&bar[XB_XSUB(b.x)], 1u);
        const unsigned gen = old / nloc;
        if (old + 1u == (gen + 1u) * nloc) {
            __builtin_amdgcn_fence(__ATOMIC_RELEASE, "agent");
            asm volatile("s_waitcnt vmcnt(0)" ::: "memory");
            const unsigned og = xb_add(&bar[XB_TOP], 1u);
            const unsigned tg = og / nx;
            if (og + 1u == (tg + 1u) * nx) xb_add(&bar[XB_TOPGEN], 1u);
            else XB_SPIN(xb_ld(&bar[XB_TOPGEN]) == tg, bar);
            __builtin_amdgcn_fence(__ATOMIC_ACQUIRE, "agent");
            xb_add(&bar[XB_XGEN(b.x)], 1u);
            asm volatile("s_waitcnt vmcnt(0)" ::: "memory");
        } else {
            XB_SPIN(xb_ld(&bar[XB_XGEN(b.x)]) == gen, bar);
            __builtin_amdgcn_fence(__ATOMIC_ACQUIRE, "agent");
            asm volatile("s_waitcnt vmcnt(0)" ::: "memory");
        }
    }
    __syncthreads();
}

struct Frame {
    LAS unsigned char* lds;
    volatile LAS unsigned* MISC;
    int tid, lane, wave;
    int vcu, G;
};
struct Args { const float* in[12]; float* out; unsigned char* ws; int ph_lo, ph_hi, li, pad; };
template <class T> __device__ __forceinline__ T* karg_ptr(int byte_off) {
    const char __attribute__((address_space(4)))* p = (const char __attribute__((address_space(4)))*)__builtin_amdgcn_kernarg_segment_ptr();
    int o = byte_off; asm volatile("" : "+s"(o));
    return *(T* const __attribute__((address_space(4)))*)(p + o);
}
__device__ __forceinline__ const float* in_ptr(int i) { return karg_ptr<const float>(8 * i); }
__device__ __forceinline__ float* out_ptr() { return karg_ptr<float>(96); }
__device__ __forceinline__ unsigned char* ws_ptr() { return karg_ptr<unsigned char>(104); }
#define WSP(T, off) ((T*)(ws_ptr() + (off)))

__device__ __forceinline__ void transpose_item(const float* Wsrc, int ldw, int K, int ncols, bf16* WT, int row_off, LAS float* scr, int item, int lane) {
    const int nblk = ncols / 32, kb = item / nblk, nb = item % nblk, k0 = 64 * kb, n0 = 32 * nb;
#pragma unroll 8
    for (int i = 0; i < 32; ++i) { const int kk = 2 * i + (lane >> 5); scr[kk * 33 + (lane & 31)] = Wsrc[(size_t)(k0 + kk) * ldw + n0 + (lane & 31)]; }
    LDS_WAIT(); asm volatile("" ::: "memory");
    const int c = lane & 7;
#pragma unroll
    for (int j = 0; j < 4; ++j) { const int n = (lane >> 3) + 8 * j; const LAS float* s = scr + (8 * c) * 33 + n;
        v4u o; o.x = pk2(s[0 * 33], s[1 * 33]); o.y = pk2(s[2 * 33], s[3 * 33]); o.z = pk2(s[4 * 33], s[5 * 33]); o.w = pk2(s[6 * 33], s[7 * 33]);
        *(v4u*)(WT + (size_t)(row_off + n0 + n) * K + k0 + 8 * c) = o; }
    LDS_WAIT(); asm volatile("" ::: "memory");
}

__device__ __forceinline__ void phase_a(Frame& F, int layer) {
    bf16* const WinT = WSP(bf16, WS_WIN); bf16* const WoutT = WSP(bf16, WS_WOUT); bf16* const XN = WSP(bf16, WS_A); float* const DT = WSP(float, WS_DT); const float* const OUTP = out_ptr();
    const int gw = F.vcu * NWAVES + F.wave, NGW = F.G * NWAVES;
    {
        LAS float* scr = (LAS float*)(F.lds + RING_OFF + F.wave * 16384);
        const float* win = in_ptr(2) + (size_t)layer * DM * NIN;
        const float* wout = in_ptr(11) + (size_t)layer * 2048 * DM;
        constexpr int KB_IN = DM / 64;
        constexpr int I_1K = KB_IN * (1024 / 32), I_X = KB_IN * (1536 / 32), I_OUT = (2048 / 64) * (1024 / 32);
        constexpr int NITEMS = 5 * I_1K + I_X + I_OUT;
        for (int it = gw; it < NITEMS; it += NGW) {
            int r = it;
            if (r < I_1K) { transpose_item(win + 0,    NIN, DM, 1024, WinT, C_Q, scr, r, F.lane); continue; } r -= I_1K;
            if (r < I_1K) { transpose_item(win + 4096, NIN, DM, 1024, WinT, C_Z, scr, r, F.lane); continue; } r -= I_1K;
            if (r < I_1K) { transpose_item(win + 1024, NIN, DM, 1024, WinT, C_K, scr, r, F.lane); continue; } r -= I_1K;
            if (r < I_1K) { transpose_item(win + 2048, NIN, DM, 1024, WinT, C_V, scr, r, F.lane); continue; } r -= I_1K;
            if (r < I_1K) { transpose_item(win + 3072, NIN, DM, 1024, WinT, C_G, scr, r, F.lane); continue; } r -= I_1K;
            if (r < I_X)  { transpose_item(win + 5120, NIN, DM, 1536, WinT, C_X, scr, r, F.lane); continue; } r -= I_X;
            transpose_item(wout, DM, 2048, 1024, WoutT, 0, scr, r, F.lane);
        }
    }
    __syncthreads();
    LAS float* wdt = (LAS float*)(F.lds + RING_OFF);
    {
        const float* win = in_ptr(2) + (size_t)layer * DM * NIN + 6656;
        for (int i = F.tid; i < 16 * 1024; i += NWAVES * 64) { const int k = i >> 4, c = i & 15; wdt[c * 1024 + k] = win[(size_t)k * NIN + c]; }
    }
    __syncthreads();
    const float* xin = layer == 0 ? in_ptr(0) : OUTP;
    const float* lnw = in_ptr(1) + layer * DM;
    const float* dtb = in_ptr(7) + layer * NSH;
    f32x4 lw[4];
#pragma unroll
    for (int j = 0; j < 4; ++j) lw[j] = *(const f32x4*)(lnw + 4 * F.lane + 256 * j);
    for (int m = gw; m < M; m += NGW) {
        asm volatile("" ::: "memory");
        const f32x4* xr = (const f32x4*)(xin + (size_t)m * DM) + F.lane;
        f32x4 v[4]; float s = 0.f;
#pragma unroll
        for (int j = 0; j < 4; ++j) { v[j] = xr[64 * j]; s += (v[j].x * v[j].x + v[j].y * v[j].y) + (v[j].z * v[j].z + v[j].w * v[j].w); }
        const float rstd = 1.f / sqrtf(wave_sum(s) * (1.f / DM) + EPS);
#pragma unroll
        for (int j = 0; j < 4; ++j) v[j] = v[j] * rstd * lw[j];
        unsigned long long* o8 = (unsigned long long*)(XN + (size_t)m * DM) + F.lane;
#pragma unroll
        for (int j = 0; j < 4; ++j) o8[64 * j] = (unsigned long long)pk2(v[j].x, v[j].y) | ((unsigned long long)pk2(v[j].z, v[j].w) << 32);
        float mine = 0.f;
#pragma unroll
        for (int c = 0; c < 16; ++c) {
            float p = 0.f;
#pragma unroll
            for (int j = 0; j < 4; ++j) { const f32x4 w = *(const LAS f32x4*)(wdt + c * 1024 + 4 * F.lane + 256 * j); p += (v[j].x * w.x + v[j].y * w.y) + (v[j].z * w.z + v[j].w * w.w); }
            p = wave_sum(p);
            if (F.lane == c) mine = p;
        }
        if (F.lane < 16) { const float a = mine + dtb[F.lane]; DT[(size_t)m * 16 + F.lane] = fmaxf(a, 0.f) + log1pf(__expf(-fabsf(a))); }
    }
}

__device__ __forceinline__ void phase_c(Frame& F, int layer) {
    bf16* const PROJ = WSP(bf16, WS_PROJ); bf16* const BCc = WSP(bf16, WS_A); float* const KM = WSP(float, WS_KM);
    const float* qw = in_ptr(3) + layer * HD; const float* kw = in_ptr(4) + layer * HD;
    const float qw0 = qw[2 * F.lane], qw1 = qw[2 * F.lane + 1], kw0 = kw[2 * F.lane], kw1 = kw[2 * F.lane + 1];
    LAS float* red = (LAS float*)(F.lds + RING_OFF);
    for (int item = F.vcu; item < BATCH * NBLK * NH; item += F.G) {
        const int h = item & 7, n = (item >> 3) & 15, b = item >> 7;
        const size_t m0 = (size_t)b * SEQ + n * MOBA + F.wave * 32;
        float ks0 = 0.f, ks1 = 0.f;
        for (int r = 0; r < 32; ++r) {
            bf16* qp = PROJ + (m0 + r) * PITCH + C_Q + h * HD + 2 * F.lane;
            bf16* kp = PROJ + (m0 + r) * PITCH + C_K + h * HD + 2 * F.lane;
            const unsigned qu = *(const unsigned*)qp, ku = *(const unsigned*)kp;
            float q0 = bflo(qu), q1 = bfhi(qu), k0 = bflo(ku), k1 = bfhi(ku);
            const float qs = wave_sum(q0 * q0 + q1 * q1), kss = wave_sum(k0 * k0 + k1 * k1);
            const float qr = 1.f / sqrtf(qs * (1.f / HD) + EPS), kr = 1.f / sqrtf(kss * (1.f / HD) + EPS);
            q0 = q0 * qr * qw0; q1 = q1 * qr * qw1; k0 = k0 * kr * kw0; k1 = k1 * kr * kw1;
            *(unsigned*)qp = pk2(q0, q1); *(unsigned*)kp = pk2(k0, k1);
            ks0 += k0; ks1 += k1;
        }
        red[F.wave * 128 + 2 * F.lane] = ks0; red[F.wave * 128 + 2 * F.lane + 1] = ks1;
        __syncthreads();
        if (F.tid < 128) { float s = 0.f;
#pragma unroll
            for (int w = 0; w < 8; ++w) s += red[w * 128 + F.tid];
            KM[(((size_t)b * NH + h) * NBLK + n) * HD + F.tid] = s * (1.f / MOBA); }
        __syncthreads();
    }
    const float* cw = in_ptr(5) + (size_t)layer * 4 * 1536 + 1024;
    const float* cb = in_ptr(6) + (size_t)layer * 1536 + 1024;
    const int gt = F.vcu * (NWAVES * 64) + F.tid, NGT = F.G * NWAVES * 64;
    for (int i = gt; i < M * 64; i += NGT) {
        const int m = i >> 6, c8 = (i & 63) * 8, t = m & (SEQ - 1);
        float acc[8];
#pragma unroll
        for (int e = 0; e < 8; ++e) acc[e] = cb[c8 + e];
#pragma unroll
        for (int k = 0; k < 4; ++k) {
            if (t - 3 + k >= 0) {
                const v4u u = *(const v4u*)(PROJ + (size_t)(m - 3 + k) * PITCH + C_B + c8);
                const float* w = cw + k * 1536 + c8;
                acc[0] += w[0] * bflo(u.x); acc[1] += w[1] * bfhi(u.x); acc[2] += w[2] * bflo(u.y); acc[3] += w[3] * bfhi(u.y);
                acc[4] += w[4] * bflo(u.z); acc[5] += w[5] * bfhi(u.z); acc[6] += w[6] * bflo(u.w); acc[7] += w[7] * bfhi(u.w);
            }
        }
        v4u o; o.x = pk2(silu_f(acc[0]), silu_f(acc[1])); o.y = pk2(silu_f(acc[2]), silu_f(acc[3])); o.z = pk2(silu_f(acc[4]), silu_f(acc[5])); o.w = pk2(silu_f(acc[6]), silu_f(acc[7]));
        *(v4u*)(BCc + (size_t)m * 512 + c8) = o;
    }
}

__device__ __forceinline__ void ssd_simple(Frame& F, int layer) {
    bf16* const PROJ = WSP(bf16, WS_PROJ); const bf16* const BCc = WSP(bf16, WS_A); const float* const DT = WSP(float, WS_DT); float* const SSQ = WSP(float, WS_SSQ);
    const int gw = F.wave * F.G + F.vcu;
    if (gw >= BATCH * NSH) return;
    const int b = gw >> 4, h = gw & 15, g = h >> 3, p = F.lane;
    LAS unsigned* st = (LAS unsigned*)(F.lds + 32768 + F.wave * 8192);
    const float* cwp = in_ptr(5) + (size_t)layer * 4 * 1536 + h * SHD + p;
    const float cw0 = cwp[0], cw1 = cwp[1536], cw2 = cwp[2 * 1536], cw3 = cwp[3 * 1536], cbias = in_ptr(6)[(size_t)layer * 1536 + h * SHD + p];
    const float A = -__expf(in_ptr(8)[layer * NSH + h]), Dh = in_ptr(9)[layer * NSH + h];
    float s[NST];
#pragma unroll
    for (int n = 0; n < NST; ++n) s[n] = 0.f;
    float x0 = 0.f, x1 = 0.f, x2 = 0.f;
    for (int t0 = 0; t0 < SEQ; t0 += 16) {
        const size_t mb = (size_t)b * SEQ + t0;
#pragma unroll
        for (int i = 0; i < 8; ++i) { const int ch = i * 64 + F.lane, row = ch >> 5, c = ch & 31;
            const v4u u = *(const v4u*)(BCc + (mb + row) * 512 + (c < 16 ? g * 128 + c * 8 : 256 + g * 128 + (c - 16) * 8));
            *(LAS v4u*)(st + row * 128 + c * 4) = u; }
        LDS_WAIT(); asm volatile("" ::: "memory");
        for (int tt = 0; tt < 16; ++tt) {
            const size_t m = mb + tt;
            const float xr = bflo((unsigned)PROJ[m * PITCH + C_X + h * SHD + p]);
            const float xc = silu_f(cw0 * x0 + cw1 * x1 + cw2 * x2 + cw3 * xr + cbias);
            x0 = x1; x1 = x2; x2 = xr;
            const float dt = DT[m * 16 + h], dA = __expf(dt * A), dtx = dt * xc;
            float y = 0.f;
#pragma unroll
            for (int n8 = 0; n8 < 16; ++n8) {
                const v4u bu = *(const LAS v4u*)(st + tt * 128 + n8 * 4), cu = *(const LAS v4u*)(st + tt * 128 + 64 + n8 * 4);
                const float bb[8] = {bflo(bu.x), bfhi(bu.x), bflo(bu.y), bfhi(bu.y), bflo(bu.z), bfhi(bu.z), bflo(bu.w), bfhi(bu.w)};
                const float cc[8] = {bflo(cu.x), bfhi(cu.x), bflo(cu.y), bfhi(cu.y), bflo(cu.z), bfhi(cu.z), bflo(cu.w), bfhi(cu.w)};
#pragma unroll
                for (int e = 0; e < 8; ++e) { s[n8 * 8 + e] = s[n8 * 8 + e] * dA + dtx * bb[e]; y += cc[e] * s[n8 * 8 + e]; }
            }
            y += Dh * xc;
            bf16* zp = PROJ + m * PITCH + C_Z + h * SHD + p;
            const float z = bflo((unsigned)*zp), yz = y * silu_f(z);
            *zp = (bf16)f2bf(yz);
            const float q = wave_sum(yz * yz);
            if (F.lane == 0) { SSQ[m * 64 + h * 4] = q; SSQ[m * 64 + h * 4 + 1] = 0.f; SSQ[m * 64 + h * 4 + 2] = 0.f; SSQ[m * 64 + h * 4 + 3] = 0.f; }
        }
        asm volatile("" ::: "memory");
    }
}

__device__ __forceinline__ void attn_simple(Frame& F, int layer) {
    bf16* const PROJ = WSP(bf16, WS_PROJ); const float* const KM = WSP(float, WS_KM);
    LAS float* qs = (LAS float*)(F.lds + F.wave * 1024);
    const int gw = F.vcu * NWAVES + F.wave, NGW = F.G * NWAVES;
    const float scale = 0.08838834764831845f;
    for (int it = gw; it < M * NH; it += NGW) {
        const int m = it >> 3, h = it & 7, b = m >> 12, t = m & (SEQ - 1), own = t >> 8;
        const float slope = exp2f(-(float)(h + 1));
        bf16* qp = PROJ + (size_t)m * PITCH + C_Q + h * HD + 2 * F.lane;
        const unsigned qu = *(const unsigned*)qp;
        const float q0 = bflo(qu), q1 = bfhi(qu);
        qs[2 * F.lane] = q0; qs[2 * F.lane + 1] = q1;
        LDS_WAIT(); asm volatile("" ::: "memory");
        float v0 = -INFINITY, v1 = -INFINITY, v2 = -INFINITY; int i0 = 0, i1 = 0, i2 = 0;
        const float* km = KM + ((size_t)b * NH + h) * NBLK * HD + 2 * F.lane;
        for (int n = 0; n < own; ++n) {
            const float gt = wave_sum(q0 * km[n * HD] + q1 * km[n * HD + 1]);
            if (gt > v0) { v2 = v1; i2 = i1; v1 = v0; i1 = i0; v0 = gt; i0 = n; }
            else if (gt > v1) { v2 = v1; i2 = i1; v1 = gt; i1 = n; }
            else if (gt > v2) { v2 = gt; i2 = n; }
        }
        const int nsel = own < 3 ? own : 3;
        float sc[16];
#pragma unroll
        for (int sl = 0; sl < 4; ++sl) {
            const int blk = sl == 0 ? i0 : sl == 1 ? i1 : sl == 2 ? i2 : own;
            const bool on = sl == 3 || sl < nsel;
#pragma unroll
            for (int j = 0; j < 4; ++j) {
                float s = -INFINITY;
                if (on) {
                    const int pos = blk * MOBA + j * 64 + F.lane;
                    const bf16* kp = PROJ + ((size_t)b * SEQ + pos) * PITCH + C_K + h * HD;
                    float d = 0.f;
#pragma unroll
                    for (int c = 0; c < 16; ++c) {
                        const v4u u = *(const v4u*)(kp + c * 8);
                        const f32x4 qa = *(const LAS f32x4*)(qs + c * 8), qb = *(const LAS f32x4*)(qs + c * 8 + 4);
                        d += (qa.x * bflo(u.x) + qa.y * bfhi(u.x)) + (qa.z * bflo(u.y) + qa.w * bfhi(u.y)) + (qb.x * bflo(u.z) + qb.y * bfhi(u.z)) + (qb.z * bflo(u.w) + qb.w * bfhi(u.w));
                    }
                    s = d * scale - slope * (float)(t - pos);
                    if (pos > t) s = -INFINITY;
                }
                sc[sl * 4 + j] = s;
            }
        }
        float mx = sc[0];
#pragma unroll
        for (int i = 1; i < 16; ++i) mx = fmaxf(mx, sc[i]);
        mx = wave_max(mx);
        float l = 0.f;
#pragma unroll
        for (int i = 0; i < 16; ++i) { sc[i] = __expf(sc[i] - mx); l += sc[i]; }
        l = wave_sum(l);
        float a0 = 0.f, a1 = 0.f;
#pragma unroll
        for (int sl = 0; sl < 4; ++sl) {
            const int blk = sl == 0 ? i0 : sl == 1 ? i1 : sl == 2 ? i2 : own;
#pragma unroll
            for (int j = 0; j < 4; ++j) {
                const float pj = sc[sl * 4 + j];
                if (wave_max(pj) > 0.f) {
                    const bf16* vp = PROJ + ((size_t)b * SEQ + blk * MOBA + j * 64) * PITCH + C_V + h * HD + 2 * F.lane;
                    for (int kk = 0; kk < 64; ++kk) {
                        const float pk = __shfl(pj, kk);
                        const unsigned vu = *(const unsigned*)(vp + (size_t)kk * PITCH);
                        a0 += pk * bflo(vu); a1 += pk * bfhi(vu);
                    }
                }
            }
        }
        const unsigned gu = *(const unsigned*)(PROJ + (size_t)m * PITCH + C_G + h * HD + 2 * F.lane);
        const float inv = 1.f / l;
        *(unsigned*)qp = pk2(a0 * inv * silu_f(bflo(gu)), a1 * inv * silu_f(bfhi(gu)));
    }
}


namespace ssd {
typedef float f32x4v __attribute__((ext_vector_type(4)));
constexpr int L = 64, S256 = 272, S128 = 144;
constexpr int O_BS = 0, O_CS = O_BS + 64 * S256, O_CE = O_CS + 64 * S256, O_BT = O_CE + 64 * S256, O_MT = O_BT + 128 * S128, O_XT = O_MT + 64 * S128,
              O_XW = O_XT + 32 * S128, O_XS = O_XW + 32 * S128, O_ST = O_XS + 64 * 33 * 4, O_END = O_ST + 2 * 32 * S256;
static_assert(O_END <= RING_BYTES, "SSD LDS map");
#define LD128(off) (*(const LAS bf16x8*)(lds + (off)))
#define MFMA16(a, b, c) __builtin_amdgcn_mfma_f32_16x16x32_bf16(a, b, c, 0, 0, 0)

__device__ __forceinline__ void item(LAS unsigned char* lds, int tid_, int layer, int b, int h, int ph) {
    int tid = tid_; asm volatile("" : "+v"(tid));
    const int wid = __builtin_amdgcn_readfirstlane(tid >> 6), lane = tid & 63, fr = lane & 15, fq = lane >> 4;
    bf16* const PROJ = WSP(bf16, WS_PROJ); const bf16* const BCc = WSP(bf16, WS_A); const float* const DT = WSP(float, WS_DT); float* const SSQ = WSP(float, WS_SSQ);
    const int g = h >> 3;
    const float A = -__expf(in_ptr(8)[layer * NSH + h]), Dh = in_ptr(9)[layer * NSH + h];
    const int brow = tid >> 4, bch = tid & 15;
    const int xl = tid >> 3, xpg = tid & 7;
    const int xcol = h * SHD + ph * 32 + 4 * xpg;
    float cw[4][4], cbv[4];
    { const float* cwp = in_ptr(5) + (size_t)layer * 4 * 1536 + xcol; const float* cbp = in_ptr(6) + (size_t)layer * 1536 + xcol;
#pragma unroll
      for (int k = 0; k < 4; ++k)
#pragma unroll
          for (int e = 0; e < 4; ++e) cw[k][e] = cwp[k * 1536 + e];
#pragma unroll
      for (int e = 0; e < 4; ++e) cbv[e] = cbp[e]; }
    const size_t mb = (size_t)b * SEQ;
    const int tl = wid >> 1, ts0 = 2 * (wid & 1), tpC = wid & 1, tn = wid;
    const int zcol = C_Z + h * SHD + ph * 32 + 16 * tpC + fr;
    f32x4v accS[2] = {};
    for (int i = tid; i < 32 * S256 / 4; i += NWAVES * 64) ((LAS unsigned*)(lds + O_ST))[i] = 0u;
    v4u bu0, bu1, cu0, cu1; v2u xr[4]; float dtn;
#define SSD_LOAD(c) do { const size_t m0_ = mb + (size_t)(c) * L; \
        const bf16* bp_ = BCc + (m0_ + brow) * 512 + g * 128 + bch * 8; \
        bu0 = *(const v4u*)bp_; bu1 = *(const v4u*)(bp_ + 32 * 512); cu0 = *(const v4u*)(bp_ + 256); cu1 = *(const v4u*)(bp_ + 32 * 512 + 256); \
        _Pragma("unroll") for (int k = 0; k < 4; ++k) { const int t_ = (c) * L + xl - 3 + k; \
            xr[k] = t_ >= 0 ? *(const v2u*)(PROJ + (mb + t_) * PITCH + C_X + xcol) : (v2u){0u, 0u}; } \
        dtn = DT[(m0_ + lane) * 16 + h]; } while (0)
    SSD_LOAD(0);
    int cur = 0;
#pragma unroll 1
    for (int c = 0; c < SEQ / L; ++c) {
        const size_t m0 = mb + (size_t)c * L;
        unsigned short zr[4];
#pragma unroll
        for (int r = 0; r < 4; ++r) zr[r] = PROJ[(m0 + 16 * tl + 4 * fq + r) * PITCH + zcol];
        const float dtv = dtn; float acs = dtv * A;
#pragma unroll
        for (int o = 1; o < 64; o <<= 1) { const float t = __shfl_up(acs, o); if (lane >= o) acs += t; }
        const float tot = __shfl(acs, 63);
        const float wv = __expf(tot - acs) * dtv, ea = __expf(acs);
        {
            *(LAS v4u*)(lds + O_BS + brow * S256 + bch * 16) = bu0; *(LAS v4u*)(lds + O_BS + (32 + brow) * S256 + bch * 16) = bu1;
            *(LAS v4u*)(lds + O_CS + brow * S256 + bch * 16) = cu0; *(LAS v4u*)(lds + O_CS + (32 + brow) * S256 + bch * 16) = cu1;
            const unsigned bw0[4] = {bu0.x, bu0.y, bu0.z, bu0.w}, bw1[4] = {bu1.x, bu1.y, bu1.z, bu1.w};
#pragma unroll
            for (int e = 0; e < 4; ++e) {
                LAS unsigned short* t0 = (LAS unsigned short*)(lds + O_BT + (bch * 8 + 2 * e) * S128);
                t0[brow] = (unsigned short)bw0[e]; t0[S128 / 2 + brow] = (unsigned short)(bw0[e] >> 16);
                t0[32 + brow] = (unsigned short)bw1[e]; t0[S128 / 2 + 32 + brow] = (unsigned short)(bw1[e] >> 16);
            }
            const float e0 = __shfl(ea, brow), e1 = __shfl(ea, 32 + brow);
            v4u o0, o1;
            o0.x = pk2(bflo(cu0.x) * e0, bfhi(cu0.x) * e0); o0.y = pk2(bflo(cu0.y) * e0, bfhi(cu0.y) * e0); o0.z = pk2(bflo(cu0.z) * e0, bfhi(cu0.z) * e0); o0.w = pk2(bflo(cu0.w) * e0, bfhi(cu0.w) * e0);
            o1.x = pk2(bflo(cu1.x) * e1, bfhi(cu1.x) * e1); o1.y = pk2(bflo(cu1.y) * e1, bfhi(cu1.y) * e1); o1.z = pk2(bflo(cu1.z) * e1, bfhi(cu1.z) * e1); o1.w = pk2(bflo(cu1.w) * e1, bfhi(cu1.w) * e1);
            *(LAS v4u*)(lds + O_CE + brow * S256 + bch * 16) = o0; *(LAS v4u*)(lds + O_CE + (32 + brow) * S256 + bch * 16) = o1;
            float xv[4];
#pragma unroll
            for (int e = 0; e < 4; ++e) xv[e] = cbv[e];
#pragma unroll
            for (int k = 0; k < 4; ++k) { xv[0] += cw[k][0] * bflo(xr[k].x); xv[1] += cw[k][1] * bfhi(xr[k].x); xv[2] += cw[k][2] * bflo(xr[k].y); xv[3] += cw[k][3] * bfhi(xr[k].y); }
            const float wl = __shfl(wv, xl);
#pragma unroll
            for (int e = 0; e < 4; ++e) { xv[e] = silu_f(xv[e]);
                ((LAS float*)(lds + O_XS))[xl * 33 + 4 * xpg + e] = xv[e];
                ((LAS unsigned short*)(lds + O_XT + (4 * xpg + e) * S128))[xl] = (unsigned short)f2bf(xv[e]);
                ((LAS unsigned short*)(lds + O_XW + (4 * xpg + e) * S128))[xl] = (unsigned short)f2bf(xv[e] * wl); }
        }
        __syncthreads();
        if (c + 1 < SEQ / L) SSD_LOAD(c + 1);
        {
            bf16x8 a[4];
#pragma unroll
            for (int kk = 0; kk < 4; ++kk) a[kk] = LD128(O_CS + (16 * tl + fr) * S256 + (32 * kk + 8 * fq) * 2);
            float al[4];
#pragma unroll
            for (int r = 0; r < 4; ++r) al[r] = __shfl(acs, 16 * tl + 4 * fq + r);
#pragma unroll
            for (int j = 0; j < 2; ++j) {
                const int ts = ts0 + j; f32x4v gacc = {};
                if (ts <= tl) {
#pragma unroll
                    for (int kk = 0; kk < 4; ++kk) gacc = MFMA16(a[kk], LD128(O_BS + (16 * ts + fr) * S256 + (32 * kk + 8 * fq) * 2), gacc);
                }
                const int s = 16 * ts + fr; const float as_ = __shfl(acs, s), ds_ = __shfl(dtv, s);
#pragma unroll
                for (int r = 0; r < 4; ++r) { const int l = 16 * tl + 4 * fq + r;
                    const float mval = (ts <= tl && s <= l) ? gacc[r] * __expf(al[r] - as_) * ds_ : 0.f;
                    ((LAS unsigned short*)(lds + O_MT + l * S128))[s] = (unsigned short)f2bf(mval); }
            }
            const float dec = __expf(tot);
#pragma unroll
            for (int tp = 0; tp < 2; ++tp) {
                accS[tp] = accS[tp] * dec;
#pragma unroll
                for (int kk = 0; kk < 2; ++kk) accS[tp] = MFMA16(LD128(O_XW + (16 * tp + fr) * S128 + (32 * kk + 8 * fq) * 2), LD128(O_BT + (16 * tn + fr) * S128 + (32 * kk + 8 * fq) * 2), accS[tp]);
#pragma unroll
                for (int r = 0; r < 4; ++r) ((LAS unsigned short*)(lds + O_ST + (cur ^ 1) * 32 * S256 + (16 * tp + 4 * fq + r) * S256))[16 * tn + fr] = (unsigned short)f2bf(accS[tp][r]);
            }
        }
        __syncthreads();
        {
            f32x4v y = {};
#pragma unroll
            for (int kk = 0; kk < 2; ++kk) y = MFMA16(LD128(O_MT + (16 * tl + fr) * S128 + (32 * kk + 8 * fq) * 2), LD128(O_XT + (16 * tpC + fr) * S128 + (32 * kk + 8 * fq) * 2), y);
#pragma unroll
            for (int kk = 0; kk < 4; ++kk) y = MFMA16(LD128(O_CE + (16 * tl + fr) * S256 + (32 * kk + 8 * fq) * 2), LD128(O_ST + cur * 32 * S256 + (16 * tpC + fr) * S256 + (32 * kk + 8 * fq) * 2), y);
#pragma unroll
            for (int r = 0; r < 4; ++r) { const int l = 16 * tl + 4 * fq + r;
                const float yv = y[r] + Dh * ((const LAS float*)(lds + O_XS))[l * 33 + 16 * tpC + fr];
                const float yz = yv * silu_f(bflo((unsigned)zr[r]));
                PROJ[(m0 + l) * PITCH + zcol] = (bf16)f2bf(yz);
                float q = yz * yz;
                q += __shfl_xor(q, 1); q += __shfl_xor(q, 2); q += __shfl_xor(q, 4); q += __shfl_xor(q, 8);
                if (fr == 0) SSQ[(m0 + l) * 64 + h * 4 + ph * 2 + tpC] = q; }
        }
        __syncthreads();
        cur ^= 1;
    }
#undef SSD_LOAD
}
#undef LD128
#undef MFMA16
}


__device__ __forceinline__ void ssd_phase(Frame& F, int layer) {
    for (int it = F.vcu; it < BATCH * NSH * 2; it += F.G) ssd::item(F.lds + RING_OFF, F.tid, layer, it >> 5, (it >> 1) & 15, it & 1);
}


namespace moba {
typedef float f32x16 __attribute__((ext_vector_type(16)));
typedef short s16x4 __attribute__((ext_vector_type(4)));
typedef unsigned u32x4 __attribute__((ext_vector_type(4)));
constexpr int NW = 8, QBLK = 32, KVBLK = 64, QB = NW * QBLK;
constexpr int SHM_V = KVBLK * HD * 2, SHM_K = KVBLK * HD * 2;
constexpr int OFF_V = 0, OFF_K = 2 * SHM_V, OFF_WS = 2 * SHM_V + 2 * SHM_K, OFF_KM = OFF_WS + NW * 64 * 4;
constexpr int ATTN_LDS = OFF_KM + 32 * 256;
constexpr float SCALE = 0.08838834764831845f, LOG2E = 1.4426950408889634f;

#define KSWZ(row, colB) ((row) * 256 + ((colB) ^ (((row) & 7) << 4)))
#define SBAR() __builtin_amdgcn_sched_barrier(0)
__device__ __forceinline__ int v_st(int k, int c) { const int kk = (k & ~0xC) | ((k & 4) << 1) | ((k & 8) >> 1); return ((kk >> 3) * 4 + (c >> 5)) * 512 + ((kk & 7) * 32 + (c & 31)) * 2; }
__device__ __forceinline__ int v_rd_base(int lane) { return ((lane & 3) << 3) | (((lane >> 2) & 3) << 6) | (((lane >> 4) & 1) << 5) | (((lane >> 5) & 1) << 8); }
constexpr int v_rd_off(int d0, int ks, int half) { return d0 * 512 + ks * 4096 + half * 2048; }
__device__ __forceinline__ int crow(int r, int hi) { return (r & 3) + 8 * (r >> 2) + 4 * hi; }
__device__ __forceinline__ unsigned cvtpk(float lo, float hi) { unsigned r; asm volatile("v_cvt_pk_bf16_f32 %0, %1, %2" : "=v"(r) : "v"(lo), "v"(hi)); return r; }

struct Unit { const bf16* Q; const bf16* K; const bf16* V; const float* KM; int qb, h; };
struct Seam { bf16x8 qr[8]; bf16x8 st_v0, st_v1, st_k0, st_k1; };

__device__ __forceinline__ void mask_tile(f32x16& p0, f32x16& p1, int dq) {
    const float NEG = -__builtin_inff();
#pragma unroll
    for (int r = 0; r < 16; ++r) { const int c = (r & 3) + 8 * (r >> 2); if (dq - c < 0) p0[r] = NEG; if (dq - c - 32 < 0) p1[r] = NEG; }
}
__device__ __forceinline__ void partialSM(f32x16& p0, f32x16& p1, float base, float slope2) {
    constexpr float C2 = LOG2E * SCALE;
#pragma unroll
    for (int r = 0; r < 16; ++r) { const float c = (float)((r & 3) + 8 * (r >> 2)); p0[r] = fmaf(p0[r], C2, fmaf(slope2, c, base)); p1[r] = fmaf(p1[r], C2, fmaf(slope2, c + 32.f, base)); }
#pragma unroll
    for (int r = 0; r < 16; ++r) p0[r] = __builtin_amdgcn_exp2f(p0[r]);
}
__device__ __forceinline__ void finishSM(f32x16& p0, f32x16& p1, float& l_reg, bf16x8& pa0, bf16x8& pa1, bf16x8& pa2, bf16x8& pa3) {
#pragma unroll
    for (int r = 0; r < 16; ++r) p1[r] = __builtin_amdgcn_exp2f(p1[r]);
    float ps = 0;
#pragma unroll
    for (int r = 0; r < 16; ++r) ps += p0[r];
#pragma unroll
    for (int r = 0; r < 16; ++r) ps += p1[r];
    { auto rr = __builtin_amdgcn_permlane32_swap(__float_as_uint(ps), __float_as_uint(ps), false, false); ps = __uint_as_float(rr[0]) + __uint_as_float(rr[1]); }
    l_reg += ps;
#define PK4(P, B_, OUT) do { unsigned a0 = cvtpk(P[B_+0], P[B_+1]), a1 = cvtpk(P[B_+2], P[B_+3]); unsigned b0 = cvtpk(P[B_+4], P[B_+5]), b1 = cvtpk(P[B_+6], P[B_+7]); \
        auto r0 = __builtin_amdgcn_permlane32_swap(a0, b0, false, false); auto r1 = __builtin_amdgcn_permlane32_swap(a1, b1, false, false); \
        u32x4 w = {r0[0], r1[0], r0[1], r1[1]}; OUT = *reinterpret_cast<bf16x8*>(&w); } while (0)
    PK4(p0, 0, pa0); PK4(p0, 8, pa1); PK4(p1, 0, pa2); PK4(p1, 8, pa3);
#undef PK4
}
template <int KB>
__device__ __forceinline__ void qkt(f32x16& p0, f32x16& p1, const LAS char* K_lds, int r32, int hi, const bf16x8* qr) {
    p0 = f32x16{}; p1 = f32x16{};
    const LAS char* kb[4];
#pragma unroll
    for (int dd = 0; dd < 4; ++dd) kb[dd] = K_lds + KB * SHM_K + KSWZ(r32, (dd * 16 + hi * 8) * 2);
#pragma unroll
    for (int d0 = 0; d0 < 8; ++d0) { const LAS char* a = kb[d0 & 3] + (d0 >> 2) * 128;
        bf16x8 b0 = *reinterpret_cast<const LAS bf16x8*>(a);
        bf16x8 b1 = *reinterpret_cast<const LAS bf16x8*>(a + 32 * 256);
        p0 = __builtin_amdgcn_mfma_f32_32x32x16_bf16(b0, qr[d0], p0, 0, 0, 0);
        p1 = __builtin_amdgcn_mfma_f32_32x32x16_bf16(b1, qr[d0], p1, 0, 0, 0); }
}
template <int VB>
__device__ __forceinline__ void pv_tile(f32x16* o, int vb0, bf16x8 pa0, bf16x8 pa1, bf16x8 pa2, bf16x8 pa3) {
#define TRRD(dst, off) asm volatile("ds_read_b64_tr_b16 %0, %1 offset:%2" : "=&v"(dst) : "v"(vb0), "i"(off) : "memory")
#define PV_D0(d0) do { s16x4 l0, l1, l2, l3, h0, h1, h2, h3; constexpr int b_ = VB * SHM_V + v_rd_off(d0, 0, 0); \
        TRRD(l0, b_); TRRD(h0, b_ + 2048); TRRD(l1, b_ + 4096); TRRD(h1, b_ + 6144); TRRD(l2, b_ + 8192); TRRD(h2, b_ + 10240); TRRD(l3, b_ + 12288); TRRD(h3, b_ + 14336); \
        asm volatile("s_waitcnt lgkmcnt(0)" ::: "memory"); SBAR(); \
        o[d0] = __builtin_amdgcn_mfma_f32_32x32x16_bf16(pa0, (bf16x8){l0[0], l0[1], l0[2], l0[3], h0[0], h0[1], h0[2], h0[3]}, o[d0], 0, 0, 0); \
        o[d0] = __builtin_amdgcn_mfma_f32_32x32x16_bf16(pa1, (bf16x8){l1[0], l1[1], l1[2], l1[3], h1[0], h1[1], h1[2], h1[3]}, o[d0], 0, 0, 0); \
        o[d0] = __builtin_amdgcn_mfma_f32_32x32x16_bf16(pa2, (bf16x8){l2[0], l2[1], l2[2], l2[3], h2[0], h2[1], h2[2], h2[3]}, o[d0], 0, 0, 0); \
        o[d0] = __builtin_amdgcn_mfma_f32_32x32x16_bf16(pa3, (bf16x8){l3[0], l3[1], l3[2], l3[3], h3[0], h3[1], h3[2], h3[3]}, o[d0], 0, 0, 0); } while (0)
    PV_D0(0); PV_D0(1); PV_D0(2); PV_D0(3);
#undef PV_D0
#undef TRRD
}

#define TILEP(p, k0) ((const char*)((p) + (size_t)(k0) * PITCH))
#define VMW() asm volatile("s_waitcnt vmcnt(0)" ::: "memory")
#define VMWN(n) asm volatile("s_waitcnt vmcnt(%0)" :: "i"(n) : "memory")
#define LD8(p) (*reinterpret_cast<const bf16x8*>(p))
#define LD8O(base, off) (*reinterpret_cast<const bf16x8*>((base) + (off)))
#define SLOAD_H(Kp, Vp, k0) do { const char* vt_ = TILEP(Vp, k0); const char* kt_ = TILEP(Kp, k0); S.st_v0 = LD8O(vt_, roff0); S.st_v1 = LD8O(vt_, roff1); S.st_k0 = LD8O(kt_, roff0); S.st_k1 = LD8O(kt_, roff1); } while (0)
#define SWRITE_HK(bf) do { *(LAS bf16x8*)(K_lds + (bf) * SHM_K + kws) = S.st_k0; *(LAS bf16x8*)(K_lds + (bf) * SHM_K + kws + 32 * 256) = S.st_k1; } while (0)
#define SWRITE_HV(bf) do { *(LAS bf16x8*)(V_lds + (bf) * SHM_V + vst0) = S.st_v0; *(LAS bf16x8*)(V_lds + (bf) * SHM_V + vst1) = S.st_v1; } while (0)
#define SWRITE_H(bf) do { SWRITE_HV(bf); SWRITE_HK(bf); } while (0)

__device__ __forceinline__ void prime(const Unit& cur, LAS char* lds, Seam& S, int tid_) {
    int tid = tid_; asm volatile("" : "+v"(tid));
    const int wid = __builtin_amdgcn_readfirstlane(tid >> 6), lane = tid & 63, r32 = lane & 31, hi = lane >> 5;
    const int sr = tid >> 4, sc = (tid & 15) * 8, kws = KSWZ(sr, sc * 2); LAS char* K_lds = lds + OFF_K;
    const unsigned roff0 = (unsigned)(sr * PITCH + sc) * 2u, roff1 = roff0 + 32u * PITCH * 2u, qoff = (unsigned)(r32 * PITCH + hi * 8) * 2u;
    { const char* qb_ = (const char*)(cur.Q + (size_t)(wid * QBLK) * PITCH);
#pragma unroll
    for (int d0 = 0; d0 < 8; ++d0) S.qr[d0] = LD8O(qb_, qoff + d0 * 32); }
    SLOAD_H(cur.K, cur.V, 0); VMW(); SWRITE_HK(0);
    __syncthreads();
}
__device__ __forceinline__ void block(const Unit& cur, const Unit& nxt, float slope2, float M2, LAS char* lds, Seam& S, int tid_) {
    int tid = tid_; asm volatile("" : "+v"(tid));
    const int wid = __builtin_amdgcn_readfirstlane(tid >> 6), lane = tid & 63, r32 = lane & 31, hi = lane >> 5;
    const unsigned roff0 = (unsigned)((tid >> 4) * PITCH + (tid & 15) * 8) * 2u, roff1 = roff0 + 32u * PITCH * 2u, qoff = (unsigned)(r32 * PITCH + hi * 8) * 2u;
    const int NT = 4 * (cur.qb + 1);
    LAS char* V_lds = lds + OFF_V; LAS char* K_lds = lds + OFF_K;
    LAS float* li_l = (LAS float*)(lds + OFF_WS) + wid * 64;
    float l_reg = 0; f32x16 o[4] = {};
    const int sr = tid >> 4, sc = (tid & 15) * 8, vst0 = v_st(sr, sc), vst1 = v_st(32 + sr, sc), kws = KSWZ(sr, sc * 2);
    const int vb0 = (int)(unsigned)(size_t)V_lds + v_rd_base(lane);
    const bf16* Kh = cur.K; const bf16* Vh = cur.V;
    const int tq = cur.qb * QB + wid * QBLK + r32;
    {
        const int n = sr & 15; const float* kp = cur.KM + n * HD + sc;
        const f32x4 a = *(const f32x4*)kp, b = *(const f32x4*)(kp + 4);
        float v[8] = {a.x, a.y, a.z, a.w, b.x, b.y, b.z, b.w}; unsigned w[4];
#pragma unroll
        for (int e = 0; e < 4; ++e) { const unsigned h0 = f2bf(v[2 * e]), h1 = f2bf(v[2 * e + 1]);
            if (sr < 16) w[e] = h0 | (h1 << 16); else w[e] = pk2(v[2 * e] - bflo(h0), v[2 * e + 1] - bflo(h1)); }
        *(LAS u32x4*)(lds + OFF_KM + KSWZ(sr, sc * 2)) = (u32x4){w[0], w[1], w[2], w[3]};
    }
    __syncthreads();
    unsigned selmask = 0;
    {
        f32x16 pg = f32x16{};
#pragma unroll
        for (int d0 = 0; d0 < 8; ++d0) { const bf16x8 a = *reinterpret_cast<const LAS bf16x8*>(lds + OFF_KM + KSWZ(r32, (d0 * 16 + hi * 8) * 2));
            pg = __builtin_amdgcn_mfma_f32_32x32x16_bf16(a, S.qr[d0], pg, 0, 0, 0); }
        float g[16];
#pragma unroll
        for (int j = 0; j < 8; ++j) { const float mine = pg[j] + pg[j + 8], oth = __shfl_xor(mine, 32); const int n0 = (j & 3) + 8 * (j >> 2);
            g[n0] = hi ? oth : mine; g[n0 + 4] = hi ? mine : oth; }
        float v0 = -__builtin_inff(), v1 = v0, v2 = v0; int i0 = 0, i1 = 0, i2 = 0;
#pragma unroll
        for (int n = 0; n < 16; ++n) { const float gt = n < cur.qb ? g[n] : -__builtin_inff();
            if (gt > v0) { v2 = v1; i2 = i1; v1 = v0; i1 = i0; v0 = gt; i0 = n; }
            else if (gt > v1) { v2 = v1; i2 = i1; v1 = gt; i1 = n; }
            else if (gt > v2) { v2 = gt; i2 = n; } }
        if (v0 > -__builtin_inff()) selmask |= 1u << i0;
        if (v1 > -__builtin_inff()) selmask |= 1u << i1;
        if (v2 > -__builtin_inff()) selmask |= 1u << i2;
    }
    const float basec = -M2 + slope2 * (float)(4 * hi - tq);
    const int ownt = 4 * cur.qb;
#define KBASE(t) ((t) * KVBLK)
#define TBASE(t) (((t) >= ownt || ((selmask >> ((t) >> 2)) & 1u)) ? fmaf(slope2, (float)KBASE(t), basec) : -__builtin_inff())
#define MASKT(P0_, P1_, t) do { if ((t) >= ownt && KBASE(t) + KVBLK - 1 > cur.qb * QB + wid * QBLK) mask_tile(P0_, P1_, tq - 4 * hi - KBASE(t)); } while (0)
    f32x16 pA0, pA1, pB0, pB1; bf16x8 pa0, pa1, pa2, pa3;
    SWRITE_HV(0); SBAR();
    SLOAD_H(Kh, Vh, KBASE(1));
    SBAR(); qkt<0>(pA0, pA1, K_lds, r32, hi, S.qr);
    MASKT(pA0, pA1, 0); partialSM(pA0, pA1, TBASE(0), slope2);
    VMW(); SWRITE_H(1);
    __syncthreads();
#define HALF_STEP(PX0, PX1, PY0, PY1, t, KB, VB, SB) do { \
        SBAR(); qkt<KB>(PX0, PX1, K_lds, r32, hi, S.qr); \
        finishSM(PY0, PY1, l_reg, pa0, pa1, pa2, pa3); SBAR(); \
        if ((t) + 1 < NT) { SLOAD_H(Kh, Vh, KBASE((t) + 1)); SBAR(); } \
        pv_tile<VB>(o, vb0, pa0, pa1, pa2, pa3); MASKT(PX0, PX1, (t)); partialSM(PX0, PX1, TBASE(t), slope2); \
        __syncthreads(); \
        if ((t) + 1 < NT) { VMW(); SWRITE_H(SB); } \
        __syncthreads(); } while (0)
    for (int t = 1; t + 1 < NT; t += 2) {
        HALF_STEP(pB0, pB1, pA0, pA1, t, 1, 0, 0);
        HALF_STEP(pA0, pA1, pB0, pB1, t + 1, 0, 1, 1);
    }
    SBAR(); qkt<1>(pB0, pB1, K_lds, r32, hi, S.qr); SBAR();
    SLOAD_H(nxt.K, nxt.V, 0); SBAR();
    { const char* qb_ = (const char*)(nxt.Q + (size_t)(wid * QBLK) * PITCH);
#pragma unroll
    for (int d0 = 0; d0 < 8; ++d0) S.qr[d0] = LD8O(qb_, qoff + d0 * 32); }
    SBAR();
    finishSM(pA0, pA1, l_reg, pa0, pa1, pa2, pa3); SBAR();
    pv_tile<0>(o, vb0, pa0, pa1, pa2, pa3);
    MASKT(pB0, pB1, NT - 1); partialSM(pB0, pB1, TBASE(NT - 1), slope2); __syncthreads();
    finishSM(pB0, pB1, l_reg, pa0, pa1, pa2, pa3); SBAR(); pv_tile<1>(o, vb0, pa0, pa1, pa2, pa3);
    SBAR(); VMWN(8); SWRITE_HK(0); SBAR();
    if (hi == 0) li_l[r32] = l_reg; asm volatile("s_waitcnt lgkmcnt(0)" ::: "memory");
    char* Ow = (char*)(const_cast<bf16*>(cur.Q) + (size_t)(wid * QBLK) * PITCH);
    const char* Gw = Ow + (C_G - C_Q) * 2;
    const unsigned eoff = (unsigned)(4 * hi * PITCH + r32) * 2u;
#pragma unroll
    for (int r = 0; r < 16; ++r) { const int orow = crow(r, hi); const float rl = __builtin_amdgcn_rcpf(li_l[orow]);
        const unsigned ro = eoff + (unsigned)(((r & 3) + 8 * (r >> 2)) * PITCH) * 2u;
#pragma unroll
        for (int d0 = 0; d0 < 4; ++d0) { const float gg = bflo((unsigned)*(const bf16*)(Gw + ro + d0 * 64));
            const float v = o[d0][r] * rl * silu_f(gg);
            const float vn = __shfl_xor(v, 1);
            if ((r32 & 1) == 0) *(unsigned*)(Ow + ro + d0 * 64) = cvtpk(v, vn); } }
    __syncthreads();
#undef KBASE
#undef TBASE
#undef MASKT
#undef HALF_STEP
}
#undef TILEP
#undef LD8O
#undef VMW
#undef VMWN
#undef LD8
#undef SLOAD_H
#undef SWRITE_HK
#undef SWRITE_HV
#undef SWRITE_H
#undef KSWZ
#undef SBAR
}

__device__ __forceinline__ bool attn_unit_of(int k, int v, int G, bf16* PROJ, const float* KM, moba::Unit& u) {
    const int item = v + (k >> 1) * G; if (item >= BATCH * NH * 8) return false;
    const int bh = item >> 3, s = item & 7, b = bh >> 3, h = bh & 7, qb = (k & 1) ? s : 15 - s;
    const bf16* base = PROJ + (size_t)b * SEQ * PITCH + h * HD;
    u.Q = base + (size_t)qb * MOBA * PITCH + C_Q; u.K = base + C_K; u.V = base + C_V; u.KM = KM + (size_t)bh * NBLK * HD; u.qb = qb; u.h = h;
    return true;
}
__device__ __forceinline__ void attn_phase(Frame& F, int layer) {
    bf16* const PROJ = WSP(bf16, WS_PROJ); const float* const KM = WSP(float, WS_KM);
    const float* qw = in_ptr(3) + layer * HD; const float* kw = in_ptr(4) + layer * HD;
    const float mq = wave_max(fmaxf(fabsf(qw[2 * F.lane]), fabsf(qw[2 * F.lane + 1]))), mk = wave_max(fmaxf(fabsf(kw[2 * F.lane]), fabsf(kw[2 * F.lane + 1])));
    const float M2 = 11.313708499f * mq * mk * 1.02f * moba::LOG2E;
    LAS char* lds = (LAS char*)(F.lds + RING_OFF);
    moba::Unit cur, nxt; moba::Seam S;
    if (!attn_unit_of(0, F.vcu, F.G, PROJ, KM, cur)) return;
    moba::prime(cur, lds, S, F.tid);
    for (int k = 0;; ++k) {
        const bool more = attn_unit_of(k + 1, F.vcu, F.G, PROJ, KM, nxt);
        if (!more) nxt = cur;
        const float slope2 = exp2f(-(float)(cur.h + 1)) * moba::LOG2E;
        moba::block(cur, nxt, slope2, M2, lds, S, F.tid);
        if (!more) break;
        cur = nxt;
    }
}

__device__ __forceinline__ void phase_e(Frame& F, int layer) {
    bf16* const PROJ = WSP(bf16, WS_PROJ); const float* const SSQ = WSP(float, WS_SSQ);
    const int gw = F.vcu * NWAVES + F.wave, NGW = F.G * NWAVES;
    const float* w = in_ptr(10) + (size_t)layer * 1024 + 16 * F.lane;
    float wv[16];
#pragma unroll
    for (int e = 0; e < 16; ++e) wv[e] = w[e];
    const int g = F.lane >> 5;
    for (int m = gw; m < M; m += NGW) {
        const f32x4* sp = (const f32x4*)(SSQ + (size_t)m * 64 + g * 32);
        float ssq = 0.f;
#pragma unroll
        for (int i = 0; i < 8; ++i) { const f32x4 v = sp[i]; ssq += (v.x + v.y) + (v.z + v.w); }
        const float r = 1.f / sqrtf(ssq * (1.f / 512.f) + EPS);
        v4u* yp = (v4u*)(PROJ + (size_t)m * PITCH + C_Z + 16 * F.lane);
        v4u a = yp[0], c = yp[1];
        a.x = pk2(bflo(a.x) * r * wv[0], bfhi(a.x) * r * wv[1]); a.y = pk2(bflo(a.y) * r * wv[2], bfhi(a.y) * r * wv[3]);
        a.z = pk2(bflo(a.z) * r * wv[4], bfhi(a.z) * r * wv[5]); a.w = pk2(bflo(a.w) * r * wv[6], bfhi(a.w) * r * wv[7]);
        c.x = pk2(bflo(c.x) * r * wv[8], bfhi(c.x) * r * wv[9]); c.y = pk2(bflo(c.y) * r * wv[10], bfhi(c.y) * r * wv[11]);
        c.z = pk2(bflo(c.z) * r * wv[12], bfhi(c.z) * r * wv[13]); c.w = pk2(bflo(c.w) * r * wv[14], bfhi(c.w) * r * wv[15]);
        yp[0] = a; yp[1] = c;
    }
}

__global__ void __launch_bounds__(NWAVES * 64, 2) mk_fwd(Args args) {
    extern __shared__ __attribute__((aligned(16))) unsigned char lds[];
    Frame F;
    F.lds = (LAS unsigned char*)lds;
    F.MISC = (volatile LAS unsigned*)(F.lds + MISC_OFF);
    F.tid = threadIdx.x; F.lane = F.tid & 63; F.wave = __builtin_amdgcn_readfirstlane(F.tid >> 6);
    F.G = gridDim.x; { const int bx = blockIdx.x; F.vcu = (F.G % 8 == 0) ? (bx % 8) * (F.G / 8) + bx / 8 : bx; }
    for (int u = F.tid; u < (LDS_BYTES - LDSCTL_OFF) / 4; u += NWAVES * 64) ((LAS unsigned*)(F.lds + LDSCTL_OFF))[u] = 0u;
    __syncthreads();
    XcdBarrier bar; bar.bar = nullptr; bar.x = 0; bar.st = nullptr;
    if (N_LAUNCHES == 1) bar = xcd_barrier_post(WSP(unsigned, WS_CTL) + CW_BAR, F.MISC + 8);
    const int lo = args.ph_lo, hi = args.ph_hi;
#define IN(k) (lo <= (k) && (k) < hi)
#define REFRESH() do { asm volatile("" : "+v"(F.tid)); F.lane = F.tid & 63; F.wave = __builtin_amdgcn_readfirstlane(F.tid >> 6); asm volatile("" : "+s"(F.vcu), "+s"(F.G)); } while (0)
#define SEAM(k) do { if (IN(k) && IN((k) + 1)) { bar.bar = WSP(unsigned, WS_CTL) + CW_BAR; xcd_barrier(bar); } } while (0)

#pragma unroll 1
    for (int layer = 0; layer < DEPTH; ++layer) {
        const int pb = layer * 6;
        if (IN(pb + 0) && (DBG_MASK & 1)) { REFRESH(); phase_a(F, layer); } SEAM(pb + 0);
        if (IN(pb + 1) && (DBG_MASK & 2)) {
            REFRESH();
            pg8::Gemm g{WSP(bf16, WS_A), WSP(bf16, WS_WIN), M, PITCH, DM, DM}; pg8::StaticOrder S; S.init(M, PITCH, F.G, (int)blockIdx.x);
            pg8::EpiBf16<0> E{WSP(bf16, WS_PROJ), PITCH, nullptr, 0, 0, 1.f};
            pg8::gemm_phase<pg8::EpiBf16<0>, pg8::StaticOrder, true, true>(F.lds + RING_OFF, g, S, E);
        } SEAM(pb + 1);
        if (IN(pb + 2) && (DBG_MASK & 4)) { REFRESH(); phase_c(F, layer); } SEAM(pb + 2);
        if (IN(pb + 3)) { if (DBG_MASK & 8) { REFRESH(); if (USE_FAST_SSD) ssd_phase(F, layer); else ssd_simple(F, layer); __syncthreads(); }     if (DBG_MASK & 16) { REFRESH(); if (USE_FAST_ATTN) attn_phase(F, layer); else attn_simple(F, layer); } } SEAM(pb + 3);
        if (IN(pb + 4) && (DBG_MASK & 32)) { REFRESH(); phase_e(F, layer); } SEAM(pb + 4);
        if (IN(pb + 5) && (DBG_MASK & 64)) {
            REFRESH();
            float* const OUTP = out_ptr(); const float* base = layer == 0 ? in_ptr(0) : OUTP;
            pg8::Gemm g{WSP(bf16, WS_PROJ), WSP(bf16, WS_WOUT), M, DM, 2048, PITCH}; pg8::StaticOrder S; S.init(M, DM, F.G, (int)blockIdx.x);
            pg8::EpiResF32 E{base, OUTP, DM};
            pg8::gemm_phase<pg8::EpiResF32, pg8::StaticOrder, true, true>(F.lds + RING_OFF, g, S, E);
        } SEAM(pb + 5);
    }
#undef IN
#undef SEAM
}

extern "C" void kernel_launch(void* const* d_in, const int* in_sizes, int n_in, void* d_out, int out_size, void* d_ws, size_t ws_size, hipStream_t stream) {
    static int grid = 0;
    if (grid == 0) {
        if (n_in != 12 || in_sizes[0] != M * DM || out_size != M * DM || ws_size < WS_END) {
            fprintf(stderr, "kernel_launch: unexpected shapes (n_in %d, in0 %d, out %d, ws %zu); nothing launched\n", n_in, n_in > 0 ? in_sizes[0] : -1, out_size, ws_size); grid = -1; return; }
        int dev = 0, cus = 0, per_cu = 0;
        if (hipGetDevice(&dev) != hipSuccess || hipDeviceGetAttribute(&cus, hipDeviceAttributeMultiprocessorCount, dev) != hipSuccess) { grid = -1; return; }
        if (hipFuncSetAttribute((const void*)mk_fwd, hipFuncAttributeMaxDynamicSharedMemorySize, LDS_BYTES) != hipSuccess) { fprintf(stderr, "kernel_launch: hipFuncSetAttribute failed\n"); grid = -1; return; }
        if (hipOccupancyMaxActiveBlocksPerMultiprocessor(&per_cu, (const void*)mk_fwd, NWAVES * 64, LDS_BYTES) != hipSuccess || per_cu < 1) {
            fprintf(stderr, "kernel_launch: occupancy query reports %d workgroups per CU; nothing launched\n", per_cu); (void)hipGetLastError(); grid = -1; return; }
        grid = cus;
    }
    if (grid < 0) return;
    if (hipMemsetAsync((char*)d_ws + WS_CTL, 0, CTL_ZERO_BYTES, stream) != hipSuccess) { fprintf(stderr, "kernel_launch: hipMemsetAsync failed\n"); return; }
    Args a{};
    for (int i = 0; i < 12; ++i) a.in[i] = (const float*)d_in[i];
    a.out = (float*)d_out; a.ws = (unsigned char*)d_ws;
    for (int li = 0; li < N_LAUNCHES; ++li) {
        a.ph_lo = (N_LAUNCHES == 1) ? 0 : li; a.ph_hi = (N_LAUNCHES == 1) ? N_PHASES : li + 1; a.li = li;
        hipLaunchKernelGGL(mk_fwd, dim3(grid), dim3(NWAVES * 64), LDS_BYTES, stream, a);
        const hipError_t le = hipPeekAtLastError();
        if (le != hipSuccess) { fprintf(stderr, "kernel_launch: launch %d failed: %s\n", li, hipGetErrorName(le)); break; }
    }
}
```

```cpp
#include <hip/hip_runtime.h>
#include <cstdio>
#include <cstdint>
namespace pg8 {
#define PG8_LAS __attribute__((address_space(3)))
typedef unsigned short bf16_t;
typedef short bf16x8 __attribute__((ext_vector_type(8)));
typedef float f32x4 __attribute__((ext_vector_type(4)));
typedef unsigned u32x4 __attribute__((ext_vector_type(4)));
constexpr int BM = 256, BK = 64, HALF = 128, HTB = HALF * BK * 2  , STAGE_BYTES = 8 * HTB, NXCD = 8, WGM = 8;

__host__ __device__ __forceinline__ int lds_byte(int r, int c) { const int st = (r >> 4) * 2 + (c >> 5), rr = r & 15, cc = c & 31, ob = rr * 64 + cc * 2; return st * 1024 + (ob ^ (((ob >> 9) & 1) << 5)); }
__host__ __device__ __forceinline__ void stage_rc(int b, int& R, int& C) { const int st = b / 1024, sb = b % 1024, swz = sb ^ (((sb >> 9) & 1) << 5); R = (st >> 1) * 16 + swz / 64; C = (st & 1) * 32 + (swz % 64) / 2; }
__host__ __device__ __forceinline__ int perm32(int rho) { const int n = rho >> 4, i = rho & 15; return 8 * (i >> 2) + 4 * n + (i & 3); }

struct Unit { int pm, pn; };
struct Gemm { const bf16_t* A; const bf16_t* Bt; int M, N, K, lda; };

struct StaticOrder {
    int nM, nN, nwg, G, c;
    __host__ __device__ void init(int M, int N, int G_, int c_) { nM = M / BM; nN = N / BM; nwg = nM * nN; G = G_; c = c_; }
    __host__ __device__ bool next(int i, Unit& u) const {
        const long L = (long)i * G + c; if (L >= nwg) return false;
        int wgid = (int)L; { const int q = nwg / NXCD, r = nwg % NXCD, xcd = wgid % NXCD, off = wgid / NXCD; wgid = (xcd < r ? xcd * (q + 1) : r * (q + 1) + (xcd - r) * q) + off; }
        const int nig = WGM * nN, gid = wgid / nig, fm = gid * WGM, gsz = (nM - fm) < WGM ? (nM - fm) : WGM;
        u.pm = fm + ((wgid % nig) % gsz); u.pn = (wgid % nig) / gsz; return true;
    }
    __device__ __forceinline__ void a_ready(const Unit&) const {}
    __device__ __forceinline__ void done(const Unit&) const {}
};

__device__ __forceinline__ unsigned cvt_pk_bf16(float lo, float hi) { unsigned r; asm volatile("v_cvt_pk_bf16_f32 %0, %1, %2" : "=v"(r) : "v"(lo), "v"(hi)); return r; }
typedef float f32x2 __attribute__((ext_vector_type(2)));
__device__ __forceinline__ f32x2 gelu_pk(f32x2 v) {
    const f32x2 av = __builtin_elementwise_abs(v), d = av * 0.2316418882f + 1.0f;
    f32x2 t; t.x = __builtin_amdgcn_rcpf(d.x); t.y = __builtin_amdgcn_rcpf(d.y);
    f32x2 q = t * 0.5307027145f + (-0.7265760135f); q = q * t + 0.7107068705f; q = q * t + (-0.142248368f); q = q * t + 0.127414796f; q = q * t;
    const f32x2 s = (v * v) * (-0.72134752044f);
    f32x2 e; e.x = __builtin_amdgcn_exp2f(s.x); e.y = __builtin_amdgcn_exp2f(s.y);
    const f32x2 m = v * (q * e), r = v - m;
    f32x2 o; o.x = v.x < 0.f ? m.x : r.x; o.y = v.y < 0.f ? m.y : r.y; return o;
}

template <int ACT  > struct EpiBf16 {
    static constexpr bool PERM = true, AFTER_DRAIN = false; static_assert(ACT == 0 || ACT == 1, "EpiBf16: ACT is 0 (none) or 1 (gelu_pk)");
    bf16_t* O; int ldc; const float* bias; int split_cols; size_t split_stride; float scale0;
    __device__ __forceinline__ void operator()(const f32x4 (&acc)[2][2][4][2], const Unit& u, int wr, int wc, int fr, int fq) const {
        const int row0 = u.pm * BM + wr * 64 + fr; int colt = u.pn * BM; bf16_t* base = O;
        float sc = 1.f; if (split_cols) { const int t = colt / split_cols; base += (size_t)t * split_stride; colt -= t * split_cols; if (t == 0) sc = scale0; }
        const int col0 = colt + wc * 32 + 8 * fq, bcol0 = u.pn * BM + wc * 32 + 8 * fq;
        f32x4 bv[2][2];
#pragma unroll
        for (int bj = 0; bj < 2; ++bj)
#pragma unroll
            for (int n = 0; n < 2; ++n) bv[bj][n] = bias ? *(const f32x4*)(bias + bcol0 + bj * HALF + 4 * n) : (f32x4){0.f, 0.f, 0.f, 0.f};
#pragma unroll
        for (int ai = 0; ai < 2; ++ai)
#pragma unroll
            for (int m = 0; m < 4; ++m) { bf16_t* rowp = base + (size_t)(row0 + ai * HALF + m * 16) * ldc + col0;
#pragma unroll
                for (int bj = 0; bj < 2; ++bj) { f32x4 v0 = acc[ai][bj][m][0] + bv[bj][0], v1 = acc[ai][bj][m][1] + bv[bj][1];
                    if (ACT == 1) { f32x2 a = gelu_pk((f32x2){v0[0], v0[1]}), b = gelu_pk((f32x2){v0[2], v0[3]}), c = gelu_pk((f32x2){v1[0], v1[1]}), d = gelu_pk((f32x2){v1[2], v1[3]});
                        v0 = (f32x4){a.x, a.y, b.x, b.y}; v1 = (f32x4){c.x, c.y, d.x, d.y}; }
                    v0 = v0 * sc; v1 = v1 * sc; u32x4 w; w.x = cvt_pk_bf16(v0[0], v0[1]); w.y = cvt_pk_bf16(v0[2], v0[3]); w.z = cvt_pk_bf16(v1[0], v1[1]); w.w = cvt_pk_bf16(v1[2], v1[3]);
                    *(u32x4*)(rowp + bj * HALF) = w; } }
    }
};
template <class Epi, class Sched, bool ALIGN_EPI = false, bool SP2 = false>
__device__ __forceinline__ void gemm_phase(PG8_LAS unsigned char* lds, const Gemm g, const Sched& S, const Epi& E, int ptid_) {
    int tid_ = ptid_; asm volatile("" : "+v"(tid_));
    const int tid = tid_, wid = __builtin_amdgcn_readfirstlane(tid >> 6), lane = tid & 63, wr = wid >> 2, wc = wid & 3, fr = lane & 15, fq = lane >> 4;
    const int K = g.K, nt = K / BK;
    unsigned voffA[2], voffB[2];
#pragma unroll
    for (int i = 0; i < 2; ++i) { int R, C; stage_rc(tid * 16 + i * 8192, R, C); const int Rb = Epi::PERM ? ((R & ~31) + perm32(R & 31)) : R;
        voffA[i] = (unsigned)(R * g.lda + C) * 2u; voffB[i] = (unsigned)(Rb * K + C) * 2u; }
    const size_t kstep = (size_t)(BK * 2);
    const size_t hstep = (size_t)HALF * K * 2;
    const size_t tstep = 2 * hstep; const size_t hstepA = (size_t)HALF * g.lda * 2, tstepA = 2 * hstepA;
    const unsigned ldsw = (unsigned)wid * 1024u;
    const int aoff = lds_byte(wr * 64 + fr, fq * 8), boff = lds_byte(wc * 32 + fr, fq * 8);
#define PG8_SA(b, h) (((b) * 2 + (h)) * HTB)
#define PG8_SB(b, h) ((4 + (b) * 2 + (h)) * HTB)
#define PG8_STAGE(bufoff, gbase, voff) do { _Pragma("unroll") for (int _i = 0; _i < 2; ++_i) \
        __builtin_amdgcn_global_load_lds((const unsigned*)((const char*)(gbase) + (voff)[_i]), (PG8_LAS unsigned*)(lds + (bufoff) + ldsw + _i * 8192), 16, 0, 0); } while (0)
#define PG8_LDA(dst, b, h) do { _Pragma("unroll") for (int m = 0; m < 4; ++m) _Pragma("unroll") for (int k = 0; k < 2; ++k) dst[m][k] = *(const PG8_LAS bf16x8*)(lds + PG8_SA(b, h) + aoff + m * 2048 + k * 1024); } while (0)
#define PG8_LDB(dst, b, h) do { _Pragma("unroll") for (int n = 0; n < 2; ++n) _Pragma("unroll") for (int k = 0; k < 2; ++k) dst[n][k] = *(const PG8_LAS bf16x8*)(lds + PG8_SB(b, h) + boff + n * 2048 + k * 1024); } while (0)
#define PG8_MMA(ai, bj, At, Bt) do { __builtin_amdgcn_s_setprio(1); _Pragma("unroll") for (int m = 0; m < 4; ++m) _Pragma("unroll") for (int n = 0; n < 2; ++n) _Pragma("unroll") for (int k = 0; k < 2; ++k) \
        acc[ai][bj][m][n] = __builtin_amdgcn_mfma_f32_16x16x32_bf16(Bt[n][k], At[m][k], acc[ai][bj][m][n], 0, 0, 0); __builtin_amdgcn_s_setprio(0); } while (0)
#define PG8_WAIT_V(n) asm volatile("s_waitcnt vmcnt(" #n ")" ::: "memory")
#define PG8_WAIT_L(n) asm volatile("s_waitcnt lgkmcnt(" #n ")" ::: "memory")
#define PG8_BAR __builtin_amdgcn_s_barrier()
#define PG8_SCHED __builtin_amdgcn_sched_barrier(0)
    Unit cur, nxt; int ui = 0;
    if (!S.next(0, cur)) return;
    f32x4 acc[2][2][4][2];
#pragma unroll
    for (int a = 0; a < 2; ++a)
#pragma unroll
        for (int b = 0; b < 2; ++b)
#pragma unroll
            for (int m = 0; m < 4; ++m)
#pragma unroll
                for (int n = 0; n < 2; ++n) acc[a][b][m][n] = (f32x4){0.f, 0.f, 0.f, 0.f};
    bf16x8 At[4][2], B0[2][2], B1[2][2];
    const char* cA = (const char*)g.A + (size_t)cur.pm * tstepA; const char* cB = (const char*)g.Bt + (size_t)cur.pn * tstep;
    S.a_ready(cur);
    if constexpr (Epi::KHOOK) E.unit_begin(cur, ui, tid);
    if constexpr (SP2) {
        PG8_STAGE(PG8_SB(0, 0), cB, voffB); PG8_STAGE(PG8_SB(0, 1), cB + hstep, voffB); PG8_STAGE(PG8_SA(0, 0), cA, voffA); PG8_STAGE(PG8_SA(0, 1), cA + hstepA, voffA);
        if (wr == 1) PG8_BAR;
        PG8_WAIT_V(2); PG8_BAR;
        PG8_STAGE(PG8_SB(1, 0), cB + kstep, voffB); PG8_STAGE(PG8_SA(1, 0), cA + kstep, voffA); PG8_STAGE(PG8_SB(1, 1), cB + hstep + kstep, voffB);
        PG8_WAIT_V(6); PG8_BAR;
    } else {
        PG8_STAGE(PG8_SB(0, 0), cB, voffB); PG8_STAGE(PG8_SA(0, 0), cA, voffA); PG8_STAGE(PG8_SB(0, 1), cB + hstep, voffB); PG8_STAGE(PG8_SA(0, 1), cA + hstepA, voffA);
        if (wr == 1) PG8_BAR;
        PG8_WAIT_V(4); PG8_BAR;
        PG8_STAGE(PG8_SB(1, 0), cB + kstep, voffB); PG8_STAGE(PG8_SA(1, 0), cA + kstep, voffA); PG8_STAGE(PG8_SB(1, 1), cB + hstep + kstep, voffB);
        PG8_WAIT_V(6); PG8_BAR;
    }
    for (;;) {
        const bool has_next = S.next(ui + 1, nxt);
        const char* nA = has_next ? (const char*)g.A + (size_t)nxt.pm * tstepA : cA; const char* nB = has_next ? (const char*)g.Bt + (size_t)nxt.pn * tstep : cB;
        for (int t = 0; t < nt; t += 2) {
            if constexpr (Epi::KHOOK) { if (t == Epi::KH0 || t == Epi::KH1) E.khook(acc, t, ui, wr, fr); }
            const bool last = (t == nt - 2);
            const char* a1 = cA + (size_t)(t + 1) * kstep;
            const char* a2 = last ? nA : cA + (size_t)(t + 2) * kstep; const char* b2 = last ? nB : cB + (size_t)(t + 2) * kstep;
            const char* a3 = a2 + kstep; const char* b3 = b2 + kstep;
            if (last && has_next) S.a_ready(nxt);
            if constexpr (SP2) {
            PG8_LDB(B0, 0, 0); PG8_LDB(B1, 0, 1); PG8_SCHED; PG8_LDA(At, 0, 0); PG8_STAGE(PG8_SA(1, 1), a1 + hstepA, voffA);
            PG8_WAIT_V(8); PG8_WAIT_L(0); PG8_BAR; PG8_MMA(0, 0, At, B0); PG8_MMA(0, 1, At, B1); PG8_BAR; PG8_SCHED;
            PG8_LDA(At, 0, 1); PG8_STAGE(PG8_SB(0, 0), b2, voffB); PG8_STAGE(PG8_SB(0, 1), b2 + hstep, voffB); PG8_STAGE(PG8_SA(0, 0), a2, voffA);
            PG8_WAIT_V(8); PG8_WAIT_L(0); PG8_BAR; PG8_MMA(1, 0, At, B0); PG8_MMA(1, 1, At, B1); PG8_BAR; PG8_SCHED;
            PG8_LDB(B0, 1, 0); PG8_LDB(B1, 1, 1); PG8_SCHED; PG8_LDA(At, 1, 0); PG8_STAGE(PG8_SA(0, 1), a2 + hstepA, voffA);
            PG8_WAIT_V(8); PG8_WAIT_L(0); PG8_BAR; PG8_MMA(0, 0, At, B0); PG8_MMA(0, 1, At, B1); PG8_BAR; PG8_SCHED;
            PG8_LDA(At, 1, 1); PG8_STAGE(PG8_SB(1, 0), b3, voffB); PG8_STAGE(PG8_SB(1, 1), b3 + hstep, voffB); PG8_STAGE(PG8_SA(1, 0), a3, voffA);
            PG8_WAIT_V(8); PG8_WAIT_L(0); PG8_BAR; PG8_MMA(1, 0, At, B0); PG8_MMA(1, 1, At, B1); PG8_BAR; PG8_SCHED;
            } else {
            PG8_LDB(B0, 0, 0); PG8_SCHED; PG8_LDA(At, 0, 0); PG8_STAGE(PG8_SA(1, 1), a1 + hstepA, voffA);
            PG8_WAIT_L(8); PG8_BAR; PG8_WAIT_L(0); PG8_MMA(0, 0, At, B0); PG8_BAR; PG8_SCHED;
            PG8_LDB(B1, 0, 1); PG8_STAGE(PG8_SB(0, 0), b2, voffB);
            PG8_BAR; PG8_WAIT_L(0); PG8_MMA(0, 1, At, B1); PG8_BAR;
            PG8_LDA(At, 0, 1); PG8_STAGE(PG8_SA(0, 0), a2, voffA);
            PG8_BAR; PG8_WAIT_L(0); PG8_MMA(1, 0, At, B0); PG8_BAR; PG8_SCHED;
            PG8_STAGE(PG8_SB(0, 1), b2 + hstep, voffB);
            PG8_WAIT_V(6); PG8_BAR; PG8_MMA(1, 1, At, B1); PG8_BAR;
            PG8_LDB(B0, 1, 0); PG8_SCHED; PG8_LDA(At, 1, 0); PG8_STAGE(PG8_SA(0, 1), a2 + hstepA, voffA);
            PG8_WAIT_L(8); PG8_BAR; PG8_WAIT_L(0); PG8_MMA(0, 0, At, B0); PG8_BAR; PG8_SCHED;
            PG8_LDB(B1, 1, 1); PG8_STAGE(PG8_SB(1, 0), b3, voffB);
            PG8_BAR; PG8_WAIT_L(0); PG8_MMA(0, 1, At, B1); PG8_BAR;
            PG8_LDA(At, 1, 1); PG8_STAGE(PG8_SA(1, 0), a3, voffA);
            PG8_BAR; PG8_WAIT_L(0); PG8_MMA(1, 0, At, B0); PG8_BAR; PG8_SCHED;
            PG8_STAGE(PG8_SB(1, 1), b3 + hstep, voffB);
            PG8_WAIT_V(6); PG8_BAR; PG8_MMA(1, 1, At, B1); PG8_BAR;
            }
        }
        if constexpr (ALIGN_EPI) { if (wr == 0) PG8_BAR; }
        if constexpr (Epi::KHOOK) { E.epi(acc, cur, ui, wr, wc, fr, fq); S.done(cur); } else if constexpr (!Epi::AFTER_DRAIN) { E(acc, cur, wr, wc, fr, fq); S.done(cur); }
        if (!has_next) break;
#pragma unroll
        for (int a = 0; a < 2; ++a)
#pragma unroll
            for (int b = 0; b < 2; ++b)
#pragma unroll
                for (int m = 0; m < 4; ++m)
#pragma unroll
                    for (int n = 0; n < 2; ++n) acc[a][b][m][n] = (f32x4){0.f, 0.f, 0.f, 0.f};
        cur = nxt; cA = nA; cB = nB; ++ui;
        if constexpr (Epi::KHOOK) E.unit_begin(cur, ui, tid);
        if constexpr (ALIGN_EPI) { if (wr == 1) PG8_BAR; }
    }
    PG8_WAIT_V(0);
    if constexpr (!ALIGN_EPI) { if (wr == 0) PG8_BAR; }
    PG8_BAR;
    if constexpr (Epi::AFTER_DRAIN) { E.fused(acc, cur, wr, wc, fr, fq, lds, wid, lane); S.done(cur); }
#undef PG8_SA
#undef PG8_SB
#undef PG8_STAGE
#undef PG8_LDA
#undef PG8_LDB
#undef PG8_MMA
#undef PG8_WAIT_V
#undef PG8_WAIT_L
#undef PG8_BAR
#undef PG8_SCHED
}
}

namespace pg8 {
struct EpiResF32 {
    static constexpr bool PERM = false, AFTER_DRAIN = false, KHOOK = false;
    const float* base; float* out; int ldc;
    __device__ __forceinline__ void operator()(const f32x4 (&acc)[2][2][4][2], const Unit& u, int wr, int wc, int fr, int fq) const {
        const int col0 = u.pn * BM + wc * 32 + 4 * fq;
#pragma unroll
        for (int ai = 0; ai < 2; ++ai)
#pragma unroll
            for (int m = 0; m < 4; ++m) { const size_t off = (size_t)(u.pm * BM + ai * HALF + wr * 64 + m * 16 + fr) * ldc + col0;
#pragma unroll
                for (int bj = 0; bj < 2; ++bj)
#pragma unroll
                    for (int n = 0; n < 2; ++n) { const f32x4 bs = *(const f32x4*)(base + off + bj * HALF + n * 16); *(f32x4*)(out + off + bj * HALF + n * 16) = bs + acc[ai][bj][m][n]; } }
    }
};

struct EpiProj {
    static constexpr bool PERM = true, AFTER_DRAIN = false, KHOOK = true; static constexpr int KH0 = -1, KH1 = -1;
    bf16_t* O; int ldc; const float* qw; const float* kw; float* KM; PG8_LAS unsigned char* xlds; float eps; const float* RSTD;
    __device__ __forceinline__ PG8_LAS float* rtab(int ui) const { return (PG8_LAS float*)(xlds + 11264) + (ui & 1) * 256; }
    __device__ __forceinline__ void unit_begin(const Unit& u, int ui, int tid) const { if (tid < 256) rtab(ui)[tid] = RSTD[u.pm * BM + tid]; }
    __device__ __forceinline__ void khook(f32x4 (&)[2][2][4][2], int, int, int, int) const {}
    __device__ __forceinline__ void bar() const { asm volatile("s_waitcnt lgkmcnt(0)" ::: "memory"); __builtin_amdgcn_s_barrier(); asm volatile("" ::: "memory"); }
    __device__ __forceinline__ void epi(const f32x4 (&acc)[2][2][4][2], const Unit& u, int ui, int wr, int wc, int fr, int fq) const {
        const int row0 = u.pm * BM + wr * 64 + fr, colt = u.pn * BM, col0 = colt + wc * 32 + 8 * fq;
        const PG8_LAS float* RT = rtab(ui) + wr * 64 + fr;
        const int kind = colt < 1024 ? 1 : ((colt >= 2048 && colt < 3072) ? 2 : 0);
        const bool gate = (colt >= 1024 && colt < 2048) || (colt >= 4096 && colt < 5120);
        if (kind == 0) {
#pragma unroll
            for (int ai = 0; ai < 2; ++ai)
#pragma unroll
                for (int m = 0; m < 4; ++m) { bf16_t* rowp = O + (size_t)(row0 + ai * HALF + m * 16) * ldc + col0; const float rr = RT[ai * HALF + m * 16];
#pragma unroll
                    for (int bj = 0; bj < 2; ++bj) { f32x4 v0 = acc[ai][bj][m][0] * rr, v1 = acc[ai][bj][m][1] * rr;
                        if (gate) {
#pragma unroll
                            for (int e = 0; e < 4; ++e) { v0[e] = v0[e] * __builtin_amdgcn_rcpf(1.0f + __expf(-v0[e])); v1[e] = v1[e] * __builtin_amdgcn_rcpf(1.0f + __expf(-v1[e])); } }
                        u32x4 w; w.x = cvt_pk_bf16(v0[0], v0[1]); w.y = cvt_pk_bf16(v0[2], v0[3]); w.z = cvt_pk_bf16(v1[0], v1[1]); w.w = cvt_pk_bf16(v1[2], v1[3]);
                        *(u32x4*)(rowp + bj * HALF) = w; } }
            return;
        }
        PG8_LAS float* P = (PG8_LAS float*)xlds;
        PG8_LAS float* KS = (PG8_LAS float*)(xlds + 8192);
#pragma unroll
        for (int ai = 0; ai < 2; ++ai)
#pragma unroll
            for (int m = 0; m < 4; ++m)
#pragma unroll
                for (int bj = 0; bj < 2; ++bj) { const float rr = RT[ai * HALF + m * 16]; const f32x4 a = acc[ai][bj][m][0] * rr, b = acc[ai][bj][m][1] * rr;
                    float s = ((a[0] * a[0] + a[1] * a[1]) + (a[2] * a[2] + a[3] * a[3])) + ((b[0] * b[0] + b[1] * b[1]) + (b[2] * b[2] + b[3] * b[3]));
                    s += __shfl_xor(s, 16); s += __shfl_xor(s, 32);
                    if (fq == 0) P[((ai * HALF + wr * 64 + m * 16 + fr) * 2 + bj) * 4 + wc] = s;
                    if (bj) asm volatile("" ::: "memory"); }
        bar();
        const PG8_LAS float* wp = (const PG8_LAS float*)(xlds + 10240) + (kind == 1 ? 0 : 128) + wc * 32 + 8 * fq;
        const f32x4 w0 = *(const PG8_LAS f32x4*)wp, w1 = *(const PG8_LAS f32x4*)(wp + 4);
        f32x4 ks[2][2] = {};
#pragma unroll
        for (int ai = 0; ai < 2; ++ai)
#pragma unroll
            for (int m = 0; m < 4; ++m) { bf16_t* rowp = O + (size_t)(row0 + ai * HALF + m * 16) * ldc + col0;
#pragma unroll
                for (int bj = 0; bj < 2; ++bj) { const f32x4 p = *(const PG8_LAS f32x4*)(P + ((ai * HALF + wr * 64 + m * 16 + fr) * 2 + bj) * 4);
                    const float rs = RT[ai * HALF + m * 16] / sqrtf(((p[0] + p[1]) + (p[2] + p[3])) * (1.0f / 128.0f) + eps);
                    const f32x4 v0 = acc[ai][bj][m][0] * rs * w0, v1 = acc[ai][bj][m][1] * rs * w1;
                    ks[bj][0] += v0; ks[bj][1] += v1;
                    u32x4 w; w.x = cvt_pk_bf16(v0[0], v0[1]); w.y = cvt_pk_bf16(v0[2], v0[3]); w.z = cvt_pk_bf16(v1[0], v1[1]); w.w = cvt_pk_bf16(v1[2], v1[3]);
                    *(u32x4*)(rowp + bj * HALF) = w; }
                asm volatile("" : "+v"(ks[0][0]), "+v"(ks[0][1]), "+v"(ks[1][0]), "+v"(ks[1][1]) :: "memory"); }
        if (kind == 2) {
            float v[16];
#pragma unroll
            for (int bj = 0; bj < 2; ++bj)
#pragma unroll
                for (int n = 0; n < 2; ++n)
#pragma unroll
                    for (int j = 0; j < 4; ++j) v[bj * 8 + n * 4 + j] = ks[bj][n][j];
            { const bool up = (fr & 8) != 0;
#pragma unroll
              for (int c = 0; c < 8; ++c) { const float snd = up ? v[c] : v[c + 8], keep = up ? v[c + 8] : v[c]; v[c] = keep + __shfl_xor(snd, 8); } }
            { const bool up = (fr & 4) != 0;
#pragma unroll
              for (int c = 0; c < 4; ++c) { const float snd = up ? v[c] : v[c + 4], keep = up ? v[c + 4] : v[c]; v[c] = keep + __shfl_xor(snd, 4); } }
            { const bool up = (fr & 2) != 0;
#pragma unroll
              for (int c = 0; c < 2; ++c) { const float snd = up ? v[c] : v[c + 2], keep = up ? v[c + 2] : v[c]; v[c] = keep + __shfl_xor(snd, 2); } }
            { const bool up = (fr & 1) != 0; const float snd = up ? v[0] : v[1], keep = up ? v[1] : v[0]; v[0] = keep + __shfl_xor(snd, 1); }
            KS[wr * 256 + 128 * (fr >> 3) + 32 * wc + 8 * fq + (fr & 7)] = v[0];
            bar();
            const int t = (wr * 4 + wc) * 64 + fq * 16 + fr;
            if (t < 256) { const int b = u.pm >> 4, nb = u.pm & 15, head = 2 * (u.pn & 3) + (t >> 7);
                KM[(((size_t)b * 8 + head) * 16 + nb) * 128 + (t & 127)] = (KS[t] + KS[256 + t]) * (1.0f / 256.0f); }
        }
    }
};

struct EpiResScale {
    static constexpr bool PERM = false, AFTER_DRAIN = false, KHOOK = true; static constexpr int KH0 = 16, KH1 = 24;
    const float* base; float* out; int ldc; const float* SSQ; PG8_LAS unsigned char* xlds; float eps; bool last;
    __device__ __forceinline__ PG8_LAS float* tab(int ui) const { return (PG8_LAS float*)xlds + (ui & 1) * 768; }
    __device__ __forceinline__ void unit_begin(const Unit& u, int ui, int tid) const {
        if (tid < 256) { const f32x4* sp = (const f32x4*)(SSQ + (size_t)(u.pm * BM + tid) * 64); float s0 = 0.f, s1 = 0.f;
#pragma unroll
            for (int i = 0; i < 8; ++i) { const f32x4 a = sp[i], b = sp[8 + i]; s0 += (a[0] + a[1]) + (a[2] + a[3]); s1 += (b[0] + b[1]) + (b[2] + b[3]); }
            const float m0 = s0 * (1.0f / 512.0f) + eps, m1 = s1 * (1.0f / 512.0f) + eps; PG8_LAS float* T = tab(ui);
            T[tid] = sqrtf(m0); T[256 + tid] = sqrtf(m1 / m0); T[512 + tid] = 1.0f / sqrtf(m1); }
    }
    __device__ __forceinline__ void khook(f32x4 (&acc)[2][2][4][2], int t, int ui, int wr, int fr) const {
        const PG8_LAS float* T = tab(ui) + (t == KH0 ? 0 : 256) + wr * 64 + fr;
#pragma unroll
        for (int ai = 0; ai < 2; ++ai)
#pragma unroll
            for (int m = 0; m < 4; ++m) { const float f = T[ai * HALF + m * 16];
#pragma unroll
                for (int bj = 0; bj < 2; ++bj)
#pragma unroll
                    for (int n = 0; n < 2; ++n) acc[ai][bj][m][n] = acc[ai][bj][m][n] * f; }
    }
    __device__ __forceinline__ void epi(const f32x4 (&acc)[2][2][4][2], const Unit& u, int ui, int wr, int wc, int fr, int fq) const {
        const int col0 = u.pn * BM + wc * 32 + 4 * fq; const PG8_LAS float* T = tab(ui) + 512 + wr * 64 + fr;
#pragma unroll
        for (int ai = 0; ai < 2; ++ai)
#pragma unroll
            for (int m = 0; m < 4; ++m) { const size_t off = (size_t)(u.pm * BM + ai * HALF + wr * 64 + m * 16 + fr) * ldc + col0; const float f = T[ai * HALF + m * 16];
#pragma unroll
                for (int bj = 0; bj < 2; ++bj)
#pragma unroll
                    for (int n = 0; n < 2; ++n) { const f32x4* bp = (const f32x4*)(base + off + bj * HALF + n * 16); f32x4* op = (f32x4*)(out + off + bj * HALF + n * 16);
                        if (last) { const f32x4 bs = __builtin_nontemporal_load(bp); __builtin_nontemporal_store(bs + acc[ai][bj][m][n] * f, op); }
                        else { const f32x4 bs = *bp; *op = bs + acc[ai][bj][m][n] * f; } } }
    }
};
}

#ifndef GEMM1_ALIGN
#define GEMM1_ALIGN true
#endif
#ifndef GEMM1_SP2
#define GEMM1_SP2 true
#endif
#ifndef GEMM2_ALIGN
#define GEMM2_ALIGN true
#endif
#ifndef GEMM2_SP2
#define GEMM2_SP2 true
#endif
#ifndef PROBE_PH
#define PROBE_PH -1
#endif
constexpr int NWAVES = 8;
#ifndef MK_N_LAUNCHES
#define MK_N_LAUNCHES 1
#endif
constexpr int N_PHASES = 12;
constexpr int N_LAUNCHES = MK_N_LAUNCHES;

constexpr int BATCH = 8, SEQ = 4096, DM = 1024, DEPTH = 2;
constexpr int M = BATCH * SEQ;
constexpr int NH = 8, HD = 128;
constexpr int NSH = 16, SHD = 64, NST = 128;
constexpr int NIN = 6672;
constexpr int PITCH = 6656;
constexpr int C_Q = 0, C_Z = 1024, C_K = 2048, C_V = 3072, C_G = 4096, C_X = 5120, C_B = 6144, C_C = 6400;
constexpr int MOBA = 256, NBLK = SEQ / MOBA;
constexpr float EPS = 1e-6f;

constexpr size_t MiB = 1u << 20;
constexpr size_t WS_CTL = 0, CTL_ZERO_BYTES = 64 * 1024;
constexpr size_t WS_WIN = 1 * MiB;
constexpr size_t WS_WOUT = 14 * MiB;
constexpr size_t WS_KM = 18 * MiB;
constexpr size_t WS_DT = 19 * MiB;
constexpr size_t WS_SSQ = 21 * MiB;
constexpr size_t WS_RSTD = 31 * MiB;
constexpr size_t WS_ACS = 29 * MiB;
constexpr size_t WS_A = 32 * MiB;
constexpr size_t WS_PROJ = 96 * MiB;
constexpr size_t WS_END = 512 * MiB;
static_assert(WS_PROJ + (size_t)M * PITCH * 2 <= WS_END, "d_ws map");
constexpr int CW_TMO = 0;
constexpr int CW_BAR = 4096;
constexpr int CW_AQ = 8192;   static_assert((CW_AQ + 128) * 4 <= (int)CTL_ZERO_BYTES && (CW_BAR + 3456) <= CW_AQ, "control words inside the zeroed region");
constexpr int CW_AQ_ = 0;

constexpr int RING_OFF = 0, RING_BYTES = 131072;
constexpr int LDSCTL_OFF = 146944, MISC_OFF = LDSCTL_OFF + 320;
constexpr int LDS_BYTES = 147456;
static_assert(MISC_OFF + 128 <= LDS_BYTES && RING_BYTES <= LDSCTL_OFF, "LDS map");

#define GAS __attribute__((address_space(1)))
#define LAS __attribute__((address_space(3)))
typedef unsigned short bf16;
typedef unsigned v4u __attribute__((ext_vector_type(4)));
typedef unsigned v2u __attribute__((ext_vector_type(2)));
typedef float f32x4 __attribute__((ext_vector_type(4)));
typedef short bf16x8 __attribute__((ext_vector_type(8)));
typedef GAS unsigned gu32;
#define RLX_AGENT __ATOMIC_RELAXED, __HIP_MEMORY_SCOPE_AGENT
#define LDS_WAIT() asm volatile("s_waitcnt lgkmcnt(0)" ::: "memory")
#define VM_WAIT() asm volatile("s_waitcnt vmcnt(0)" ::: "memory")
__device__ __forceinline__ unsigned f2bf(float f) { unsigned u = __builtin_bit_cast(unsigned, f); return (u + 0x7fffu + ((u >> 16) & 1u)) >> 16; }
typedef __bf16 bf16x2_n __attribute__((ext_vector_type(2)));
__device__ __forceinline__ unsigned pk2(float lo, float hi) { bf16x2_n v = {(__bf16)lo, (__bf16)hi}; return __builtin_bit_cast(unsigned, v); }
__device__ __forceinline__ float bflo(unsigned u) { return __builtin_bit_cast(float, u << 16); }
__device__ __forceinline__ float bfhi(unsigned u) { return __builtin_bit_cast(float, u & 0xffff0000u); }
__device__ __forceinline__ float silu_f(float v) { return v * __builtin_amdgcn_rcpf(1.f + __expf(-v)); }
__device__ __forceinline__ float wave_sum(float v) {
#pragma unroll
    for (int o = 1; o < 64; o <<= 1) v += __shfl_xor(v, o);
    return v;
}
__device__ __forceinline__ float wave_max(float v) {
#pragma unroll
    for (int o = 1; o < 64; o <<= 1) v = fmaxf(v, __shfl_xor(v, o));
    return v;
}

#define XB_TMO      128
#define XB_XCNT(j)  (256  + 64 * (j))
#define XB_XSUB(j)  (1280 + 64 * (j))
#define XB_XGEN(j)  (2304 + 64 * (j))
#define XB_TOP      3328
#define XB_TOPGEN   3392
#define XCD_BAR_WORDS 3456
#define XB_SPIN_CAP (1u << 22)

__device__ __forceinline__ unsigned xb_ld(unsigned* p)              { return __hip_atomic_load(p, __ATOMIC_RELAXED, __HIP_MEMORY_SCOPE_AGENT); }
__device__ __forceinline__ unsigned xb_add(unsigned* p, unsigned v) { return __hip_atomic_fetch_add(p, v, __ATOMIC_RELAXED, __HIP_MEMORY_SCOPE_AGENT); }
__device__ __forceinline__ unsigned xb_xcc_id() { return (unsigned)__builtin_amdgcn_s_getreg((3 << 11) | 20) & 0xFu; }
#define XB_SPIN(cond, bar) do { unsigned _sp = 0; while (cond) { __builtin_amdgcn_s_sleep(1); \
    if ((++_sp & 255u) == 0u) { if (xb_ld(&(bar)[XB_TMO])) break; if (_sp > XB_SPIN_CAP) { atomicAdd(&(bar)[XB_TMO], 1u); break; } } } } while (0)

struct XcdBarrier { unsigned* bar; unsigned x; volatile LAS unsigned* st; };

__device__ __forceinline__ XcdBarrier xcd_barrier_post(unsigned* bar, volatile LAS unsigned* st) {
    XcdBarrier b; b.bar = bar; b.x = xb_xcc_id(); b.st = st;
    if (threadIdx.x == 0) (void)xb_add(&bar[XB_XCNT(b.x)], 1u);
    return b;
}
__device__ __forceinline__ void xcd_barrier_complete(unsigned* bar, unsigned x, unsigned& nloc, unsigned& nx) {
    const unsigned G = gridDim.x * gridDim.y * gridDim.z;
    unsigned sum, cnt, mine, sp = 0u;
    for (;;) {
        sum = 0u; cnt = 0u; mine = 0u;
#pragma unroll
        for (unsigned j = 0; j < 16; ++j) { const unsigned c = xb_ld(&bar[XB_XCNT(j)]); sum += c; cnt += (c > 0u) ? 1u : 0u; mine = (j == x) ? c : mine; }
        if (sum == G) break;
        __builtin_amdgcn_s_sleep(1);
        if ((++sp & 255u) == 0u) { if (xb_ld(&bar[XB_TMO])) break; if (sp > XB_SPIN_CAP) { atomicAdd(&bar[XB_TMO], 1u); break; } }
    }
    nloc = mine > 0u ? mine : 1u; nx = cnt > 0u ? cnt : 1u;
}
__device__ __forceinline__ void xcd_barrier(const XcdBarrier& b, int wave) {
    asm volatile("s_waitcnt vmcnt(0)" ::: "memory");
    __syncthreads();
    int z_ = 0; asm volatile("" : "+v"(z_));
    if (wave == 0 && __builtin_amdgcn_mbcnt_hi(~0u, __builtin_amdgcn_mbcnt_lo(~0u, (unsigned)z_)) == 0u) {
        unsigned* bar = b.bar;
        __builtin_amdgcn_s_waitcnt(0);
        unsigned nloc = b.st[0], nx = b.st[1];
        if (nloc == 0u) { xcd_barrier_complete(bar, b.x, nloc, nx); b.st[0] = nloc; b.st[1] = nx; }
        const unsigned old = xb_add(&bar[XB_XSUB(b.x)], 1u);
        const unsigned gen = old / nloc;
        if (old + 1u == (gen + 1u) * nloc) {
            __builtin_amdgcn_fence(__ATOMIC_RELEASE, "agent");
            asm volatile("s_waitcnt vmcnt(0)" ::: "memory");
            const unsigned og = xb_add(&bar[XB_TOP], 1u);
            const unsigned tg = og / nx;
            if (og + 1u == (tg + 1u) * nx) xb_add(&bar[XB_TOPGEN], 1u);
            else XB_SPIN(xb_ld(&bar[XB_TOPGEN]) == tg, bar);
            __builtin_amdgcn_fence(__ATOMIC_ACQUIRE, "agent");
            xb_add(&bar[XB_XGEN(b.x)], 1u);
            asm volatile("s_waitcnt vmcnt(0)" ::: "memory");
        } else {
            XB_SPIN(xb_ld(&bar[XB_XGEN(b.x)]) == gen, bar);
            __builtin_amdgcn_fence(__ATOMIC_ACQUIRE, "agent");
            asm volatile("s_waitcnt vmcnt(0)" ::: "memory");
        }
    }
    __syncthreads();
}

struct Frame {
    LAS unsigned char* lds;
    volatile LAS unsigned* MISC;
    int tid, lane, wave;
    int vcu, G;
};
struct Args { const float* in[12]; float* out; unsigned char* ws; int ph_lo, ph_hi, li, pad; };
template <class T> __device__ __forceinline__ T* karg_ptr(int byte_off) {
    const char __attribute__((address_space(4)))* p = (const char __attribute__((address_space(4)))*)__builtin_amdgcn_kernarg_segment_ptr();
    int o = byte_off; asm volatile("" : "+s"(o));
    return *(T* const __attribute__((address_space(4)))*)(p + o);
}
__device__ __forceinline__ const float* in_ptr(int i) { return karg_ptr<const float>(8 * i); }
__device__ __forceinline__ float* out_ptr() { return karg_ptr<float>(96); }
__device__ __forceinline__ unsigned char* ws_ptr() { return karg_ptr<unsigned char>(104); }
#define WSP(T, off) ((T*)(ws_ptr() + (off)))

__device__ __forceinline__ void transpose_item(const float* Wsrc, int ldw, int K, int ncols, bf16* WT, int row_off, LAS float* scr, int item, int lane, const float* kscale = nullptr, int kmin = 0) {
    const int nblk = ncols / 32, kb = item / nblk, nb = item % nblk, k0 = 64 * kb, n0 = 32 * nb;
#pragma unroll
    for (int i = 0; i < 8; ++i) { const int kk = (lane >> 3) + 8 * i, c4 = lane & 7;
        f32x4 v = *(const f32x4*)(Wsrc + (size_t)(k0 + kk) * ldw + n0 + 4 * c4);
        if (kscale && k0 + kk >= kmin) v = v * kscale[k0 + kk - kmin];
        LAS float* d = scr + kk * 33 + 4 * c4; d[0] = v.x; d[1] = v.y; d[2] = v.z; d[3] = v.w; }
    LDS_WAIT(); asm volatile("" ::: "memory");
    const int c = lane & 7;
#pragma unroll
    for (int j = 0; j < 4; ++j) { const int n = (lane >> 3) + 8 * j; const LAS float* s = scr + (8 * c) * 33 + n;
        v4u o; o.x = pk2(s[0 * 33], s[1 * 33]); o.y = pk2(s[2 * 33], s[3 * 33]); o.z = pk2(s[4 * 33], s[5 * 33]); o.w = pk2(s[6 * 33], s[7 * 33]);
        *(v4u*)(WT + (size_t)(row_off + n0 + n) * K + k0 + 8 * c) = o; }
    LDS_WAIT(); asm volatile("" ::: "memory");
}

__device__ __forceinline__ void phase_a(Frame& F, int layer) {
    bf16* const WinT = WSP(bf16, WS_WIN); bf16* const WoutT = WSP(bf16, WS_WOUT); bf16* const XN = WSP(bf16, WS_A); float* const DT = WSP(float, WS_DT); const float* const OUTP = out_ptr();
    const int gw = F.vcu * NWAVES + F.wave, NGW = F.G * NWAVES;
    {
        LAS float* scr = (LAS float*)(F.lds + RING_OFF + F.wave * 16384);
        const float* win = in_ptr(2) + (size_t)layer * DM * NIN;
        const float* wout = in_ptr(11) + (size_t)layer * 2048 * DM;
        constexpr int KB_IN = DM / 64;
        constexpr int I_1K = KB_IN * (1024 / 32), I_X = KB_IN * (1536 / 32), I_OUT = (2048 / 64) * (1024 / 32);
        constexpr int NITEMS = 5 * I_1K + I_X + I_OUT;
        for (int it = gw; it < NITEMS; it += NGW) {
            int r = it;
            if (r < I_1K) { transpose_item(win + 0,    NIN, DM, 1024, WinT, C_Q, scr, r, F.lane); continue; } r -= I_1K;
            if (r < I_1K) { transpose_item(win + 4096, NIN, DM, 1024, WinT, C_Z, scr, r, F.lane); continue; } r -= I_1K;
            if (r < I_1K) { transpose_item(win + 1024, NIN, DM, 1024, WinT, C_K, scr, r, F.lane); continue; } r -= I_1K;
            if (r < I_1K) { transpose_item(win + 2048, NIN, DM, 1024, WinT, C_V, scr, r, F.lane); continue; } r -= I_1K;
            if (r < I_1K) { transpose_item(win + 3072, NIN, DM, 1024, WinT, C_G, scr, r, F.lane); continue; } r -= I_1K;
            if (r < I_X)  { transpose_item(win + 5120, NIN, DM, 1536, WinT, C_X, scr, r, F.lane); continue; } r -= I_X;
            transpose_item(wout, DM, 2048, 1024, WoutT, 0, scr, r, F.lane, in_ptr(10) + (size_t)layer * 1024, 1024);
        }
    }
    __syncthreads();
    LAS unsigned short* wdb = (LAS unsigned short*)(F.lds + RING_OFF); LAS float* lnl = (LAS float*)(F.lds + RING_OFF + 32768);
    {
        const float* win = in_ptr(2) + (size_t)layer * DM * NIN + 6656; const float* lnw = in_ptr(1) + layer * DM;
        for (int i = F.tid; i < 16 * 1024; i += NWAVES * 64) { const int k = i >> 4, c = i & 15; wdb[c * 1024 + k] = (unsigned short)f2bf(win[(size_t)k * NIN + c]); }
        for (int i = F.tid; i < 1024; i += NWAVES * 64) lnl[i] = lnw[i];
    }
    __syncthreads();
    const float* xin = layer == 0 ? in_ptr(0) : OUTP;
    const float* dtb = in_ptr(7) + layer * NSH;
    float* const RSTD = WSP(float, WS_RSTD);
    const int r = F.lane & 15, g4 = F.lane >> 4;
    for (int grp = gw; grp < M / 16; grp += NGW) {
        asm volatile("" ::: "memory");
        const size_t m0 = (size_t)grp * 16;
        const char* xb = (const char*)(xin + (m0 + r) * DM + 8 * g4); char* ob = (char*)(XN + (m0 + r) * DM + 8 * g4);
        f32x4 acc = {0.f, 0.f, 0.f, 0.f}; float ssq = 0.f;
#pragma unroll 8
        for (int kk = 0; kk < 32; ++kk) {
            const f32x4 a = __builtin_nontemporal_load((const f32x4*)(xb + kk * 128)), b = __builtin_nontemporal_load((const f32x4*)(xb + kk * 128 + 16));
            const f32x4 la = *(const LAS f32x4*)(lnl + 32 * kk + 8 * g4), lb = *(const LAS f32x4*)(lnl + 32 * kk + 8 * g4 + 4);
            ssq += ((a.x * a.x + a.y * a.y) + (a.z * a.z + a.w * a.w)) + ((b.x * b.x + b.y * b.y) + (b.z * b.z + b.w * b.w));
            const f32x4 ha = a * la, hb = b * lb;
            v4u pk; pk.x = pk2(ha.x, ha.y); pk.y = pk2(ha.z, ha.w); pk.z = pk2(hb.x, hb.y); pk.w = pk2(hb.z, hb.w);
            *(v4u*)(ob + kk * 64) = pk;
            const bf16x8 wf = *(const LAS bf16x8*)(wdb + r * 1024 + 32 * kk + 8 * g4);
            acc = __builtin_amdgcn_mfma_f32_16x16x32_bf16(wf, __builtin_bit_cast(bf16x8, pk), acc, 0, 0, 0);
        }
        ssq += __shfl_xor(ssq, 16); ssq += __shfl_xor(ssq, 32);
        const float rstd = 1.f / sqrtf(ssq * (1.f / DM) + EPS);
        if (g4 == 0) RSTD[m0 + r] = rstd;
        f32x4 o;
#pragma unroll
        for (int i = 0; i < 4; ++i) { const float a = acc[i] * rstd + dtb[4 * g4 + i], u = __expf(-fabsf(a));
            o[i] = fmaxf(a, 0.f) + (u < 1e-3f ? u * (1.f - u * (0.5f - 0.33333334f * u)) : __logf(1.f + u)); }
        *(f32x4*)(DT + (m0 + r) * 16 + 4 * g4) = o;
    }
}

__device__ __forceinline__ void phase_c(Frame& F, int layer) {
    bf16* const PROJ = WSP(bf16, WS_PROJ); bf16* const BCc = WSP(bf16, WS_A); float* const KM = WSP(float, WS_KM);
    {
        const float* const DT = WSP(float, WS_DT); float* const ACS = WSP(float, WS_ACS); const float* alog = in_ptr(8) + layer * NSH;
        const int gw = F.vcu * NWAVES + F.wave, NGW = F.G * NWAVES;
        for (int i = gw; i < (M / 64) * NSH; i += NGW) {
            const int h = i & 15; const size_t idx = ((size_t)(i >> 4) * 64 + F.lane) * 16 + h;
            float a = DT[idx] * -__expf(alog[h]);
#pragma unroll
            for (int o = 1; o < 64; o <<= 1) { const float t = __shfl_up(a, o); if (F.lane >= o) a += t; }
            ACS[idx] = a;
        }
    }
    const float* cw = in_ptr(5) + (size_t)layer * 4 * 1536 + 1024;
    const float* cb = in_ptr(6) + (size_t)layer * 1536 + 1024;
    const int gt = F.vcu * (NWAVES * 64) + F.tid, NGT = F.G * NWAVES * 64;
    for (int i = gt; i < M * 64; i += NGT) {
        const int m = i >> 6, c8 = (i & 63) * 8, t = m & (SEQ - 1);
        float acc[8];
#pragma unroll
        for (int e = 0; e < 8; ++e) acc[e] = cb[c8 + e];
#pragma unroll
        for (int k = 0; k < 4; ++k) {
            if (t - 3 + k >= 0) {
                const v4u u = *(const v4u*)(PROJ + (size_t)(m - 3 + k) * PITCH + C_B + c8);
                const float* w = cw + k * 1536 + c8;
                acc[0] += w[0] * bflo(u.x); acc[1] += w[1] * bfhi(u.x); acc[2] += w[2] * bflo(u.y); acc[3] += w[3] * bfhi(u.y);
                acc[4] += w[4] * bflo(u.z); acc[5] += w[5] * bfhi(u.z); acc[6] += w[6] * bflo(u.w); acc[7] += w[7] * bfhi(u.w);
            }
        }
        v4u o; o.x = pk2(silu_f(acc[0]), silu_f(acc[1])); o.y = pk2(silu_f(acc[2]), silu_f(acc[3])); o.z = pk2(silu_f(acc[4]), silu_f(acc[5])); o.w = pk2(silu_f(acc[6]), silu_f(acc[7]));
        *(v4u*)(BCc + (size_t)m * 512 + c8) = o;
    }
}


namespace ssd {
typedef float f32x4v __attribute__((ext_vector_type(4)));
typedef short s16x4v __attribute__((ext_vector_type(4)));
constexpr int L = 64, S256 = 272, S64 = 144, S32 = 144;
constexpr int O_BS = 0, O_CS = O_BS + 64 * S256, O_XB = O_CS + 64 * S256, O_XW = O_XB + 64 * S32, O_MT = O_XW + 64 * S32, O_ST = O_MT + 64 * S64,
              O_TB = O_ST + 2 * 64 * S256, O_CS2 = O_TB + NWAVES * 1024, O_XB2 = O_CS2 + 64 * S256, O_END = O_XB2 + 64 * S32;
static_assert(O_END <= LDSCTL_OFF, "SSD LDS map");
#define LD128(off) (*(const LAS bf16x8*)(lds + (off)))
#define MFMA16(a, b, c) __builtin_amdgcn_mfma_f32_16x16x32_bf16(a, b, c, 0, 0, 0)
#define TRRD(dst, addr, off) asm volatile("ds_read_b64_tr_b16 %0, %1 offset:%2" : "=&v"(dst) : "v"(addr), "i"(off) : "memory")
#define TRWAIT() do { asm volatile("s_waitcnt lgkmcnt(0)" ::: "memory"); __builtin_amdgcn_sched_barrier(0); } while (0)
#define CAT8(lo, hi) ((bf16x8){lo[0], lo[1], lo[2], lo[3], hi[0], hi[1], hi[2], hi[3]})
typedef __bf16 bf16x2n __attribute__((ext_vector_type(2)));
__device__ __forceinline__ unsigned cvtpk(float lo, float hi) { bf16x2n v = {(__bf16)lo, (__bf16)hi}; return __builtin_bit_cast(unsigned, v); }
__device__ __forceinline__ float silu_fast(float v) { return v * __builtin_amdgcn_rcpf(1.f + __expf(-v)); }

__device__ __forceinline__ void item(LAS unsigned char* lds, int wave_, int layer, int b, int h) {
    int z_ = 0; asm volatile("" : "+v"(z_));
    const int wid = wave_, lane = (int)__builtin_amdgcn_mbcnt_hi(~0u, __builtin_amdgcn_mbcnt_lo(~0u, (unsigned)z_)), tid = wid * 64 + lane, fr = lane & 15, fq = lane >> 4;
    const int g = h >> 3;
    const float Dh = in_ptr(9)[layer * NSH + h];
    const int brow = tid >> 4, bch = tid & 15;
    const int xl = tid >> 3, xpg = tid & 7;
    const int xcol = h * SHD + 4 * xpg;
    float cw[2][4][4], cbv[2][4];
    { const float* cwp = in_ptr(5) + (size_t)layer * 4 * 1536 + xcol; const float* cbp = in_ptr(6) + (size_t)layer * 1536 + xcol;
#pragma unroll
      for (int j = 0; j < 2; ++j) {
#pragma unroll
      for (int k = 0; k < 4; ++k)
#pragma unroll
          for (int e = 0; e < 4; ++e) cw[j][k][e] = cwp[k * 1536 + 32 * j + e];
#pragma unroll
      for (int e = 0; e < 4; ++e) cbv[j][e] = cbp[32 * j + e]; } }
    const char* pBC = (const char*)(WSP(bf16, WS_A) + (size_t)b * SEQ * 512 + g * 128);
    const char* pX = (const char*)(WSP(bf16, WS_PROJ) + (size_t)b * SEQ * PITCH + C_X);
    char* pZ = (char*)(WSP(bf16, WS_PROJ) + (size_t)b * SEQ * PITCH + C_Z + h * SHD);
    const char* pDT = (const char*)(WSP(float, WS_DT) + (size_t)b * SEQ * 16 + h);
    const char* pAC = (const char*)(WSP(float, WS_ACS) + (size_t)b * SEQ * 16 + h);
    float* pSQ = WSP(float, WS_SSQ) + (size_t)b * SEQ * 64 + h * 4;
    const unsigned obc = (unsigned)(brow * 512 + bch * 8) * 2u;
    const int oxr = (xl - 3) * PITCH * 2 + xcol * 2;
    const unsigned odt = (unsigned)lane * 64u;
    const int tl = wid >> 1, ts0 = 2 * (wid & 1), tpC = wid & 1, tn = wid;
    const unsigned ozy = (unsigned)((16 * tl + fr) * PITCH + 32 * tpC + 4 * fq) * 2u;
    const int trq = fr >> 2, trp = fr & 3;
    const int aXB = (int)(unsigned)(size_t)(lds + O_XB) + (8 * fq + trq) * S32 + (4 * trp) * 2;
    const int aXBc = aXB + 64 * tpC;
    const int aXW = (int)(unsigned)(size_t)(lds + O_XW) + (8 * fq + trq) * S32 + (4 * trp) * 2;
    const int aBS = (int)(unsigned)(size_t)(lds + O_BS) + (8 * fq + trq) * S256 + (16 * tn + 4 * trp) * 2;
    f32x4v accS[4] = {};
    for (int i = tid; i < 64 * S256 / 4; i += NWAVES * 64) ((LAS unsigned*)(lds + O_ST))[i] = 0u;
    LAS float* const tb = (LAS float*)(lds + O_TB + wid * 1024);
    v4u bu0_0, bu1_0, cu0_0, cu1_0, bu0_1, bu1_1, cu0_1, cu1_1; v2u xr_0[2][4], xr_1[2][4], zr_0[2], zr_1[2]; float dtn_0, dtn_1, acn_0, acn_1;
#define SSD_LOAD(c, S_) do { const char* bc_ = pBC + (size_t)(c) * (L * 512 * 2); const char* px_ = pX + (size_t)(c) * (L * PITCH * 2); \
        bu0_##S_ = *(const v4u*)(bc_ + obc); bu1_##S_ = *(const v4u*)(bc_ + obc + 32 * 512 * 2); cu0_##S_ = *(const v4u*)(bc_ + obc + 512); cu1_##S_ = *(const v4u*)(bc_ + obc + 32 * 512 * 2 + 512); \
        _Pragma("unroll") for (int j = 0; j < 2; ++j) _Pragma("unroll") for (int k = 0; k < 4; ++k) xr_##S_[j][k] = ((c) * L + xl - 3 + k >= 0) ? *(const v2u*)(px_ + (oxr + k * PITCH * 2 + 64 * j)) : (v2u){0u, 0u}; \
        dtn_##S_ = *(const float*)(pDT + (size_t)(c) * (L * 64) + odt); acn_##S_ = *(const float*)(pAC + (size_t)(c) * (L * 64) + odt); \
        zr_##S_[0] = *(const v2u*)(pZ + (size_t)(c) * (L * PITCH * 2) + ozy); zr_##S_[1] = *(const v2u*)(pZ + (size_t)(c) * (L * PITCH * 2) + ozy + 32); } while (0)
#define SSD_STEP(c, S_) do { \
        constexpr int OCS = (S_) ? O_CS2 : O_CS, OXB = (S_) ? O_XB2 : O_XB;     \
        const int aXBs = aXBc + (OXB - O_XB); \
          \
        const float dtv = dtn_##S_, acs = acn_##S_; \
        const float tot = __builtin_bit_cast(float, __builtin_amdgcn_readlane(__builtin_bit_cast(int, acs), 63)); \
        const float ea = __expf(acs); \
        tb[lane] = acs; tb[64 + lane] = dtv; tb[128 + lane] = __expf(tot - acs) * dtv; tb[192 + lane] = ea; \
        const v2u zq0 = zr_##S_[0], zq1 = zr_##S_[1]; \
          \
        { \
            *(LAS v4u*)(lds + O_BS + brow * S256 + bch * 16) = bu0_##S_; *(LAS v4u*)(lds + O_BS + (32 + brow) * S256 + bch * 16) = bu1_##S_; \
            *(LAS v4u*)(lds + OCS + brow * S256 + bch * 16) = cu0_##S_; *(LAS v4u*)(lds + OCS + (32 + brow) * S256 + bch * 16) = cu1_##S_; \
            asm volatile("s_waitcnt lgkmcnt(0)" ::: "memory"); \
            const float wl = tb[128 + xl]; \
            _Pragma("unroll") for (int j = 0; j < 2; ++j) { \
                float xv[4]; \
                _Pragma("unroll") for (int e = 0; e < 4; ++e) xv[e] = cbv[j][e]; \
                _Pragma("unroll") for (int k = 0; k < 4; ++k) { xv[0] += cw[j][k][0] * bflo(xr_##S_[j][k].x); xv[1] += cw[j][k][1] * bfhi(xr_##S_[j][k].x); xv[2] += cw[j][k][2] * bflo(xr_##S_[j][k].y); xv[3] += cw[j][k][3] * bfhi(xr_##S_[j][k].y); } \
                _Pragma("unroll") for (int e = 0; e < 4; ++e) xv[e] = silu_fast(xv[e]); \
                *(LAS v2u*)(lds + OXB + xl * S32 + xpg * 8 + 64 * j) = (v2u){cvtpk(xv[0], xv[1]), cvtpk(xv[2], xv[3])}; \
                *(LAS v2u*)(lds + O_XW + xl * S32 + xpg * 8 + 64 * j) = (v2u){cvtpk(xv[0] * wl, xv[1] * wl), cvtpk(xv[2] * wl, xv[3] * wl)}; } \
        } \
        __syncthreads(); \
        if ((c) + 2 < SEQ / L) SSD_LOAD((c) + 2, S_);                          \
          \
        { \
            bf16x8 cf[4]; \
            _Pragma("unroll") for (int kk = 0; kk < 4; ++kk) cf[kk] = LD128(OCS + (16 * tl + fr) * S256 + (32 * kk + 8 * fq) * 2); \
            const float al = tb[16 * tl + fr];                                 \
            const int l = 16 * tl + fr; \
            _Pragma("unroll") for (int j = 0; j < 2; ++j) { \
                const int ts = ts0 + j; \
                if (ts <= tl) { \
                    f32x4v gacc = {}; \
                    _Pragma("unroll") for (int kk = 0; kk < 4; ++kk) gacc = MFMA16(LD128(O_BS + (16 * ts + fr) * S256 + (32 * kk + 8 * fq) * 2), cf[kk], gacc);     \
                    const f32x4v as4 = *(const LAS f32x4v*)(tb + 16 * ts + 4 * fq), ds4 = *(const LAS f32x4v*)(tb + 64 + 16 * ts + 4 * fq); \
                    float mv[4]; \
                    _Pragma("unroll") for (int r = 0; r < 4; ++r) mv[r] = (16 * ts + 4 * fq + r <= l) ? gacc[r] * __expf(al - as4[r]) * ds4[r] : 0.f; \
                    *(LAS v2u*)(lds + O_MT + l * S64 + (16 * ts + 4 * fq) * 2) = (v2u){cvtpk(mv[0], mv[1]), cvtpk(mv[2], mv[3])}; \
                } else { \
                    *(LAS v2u*)(lds + O_MT + l * S64 + (16 * ts + 4 * fq) * 2) = (v2u){0u, 0u}; \
                } \
            } \
            const float dec = __expf(tot); \
            s16x4v b0, b1, b2, b3; \
            TRRD(b0, aBS, 0); TRRD(b1, aBS, 4 * S256); TRRD(b2, aBS, 32 * S256); TRRD(b3, aBS, 36 * S256); \
            _Pragma("unroll") for (int tp = 0; tp < 4; ++tp) { s16x4v x0, x1, x2, x3; \
                TRRD(x0, aXW, 32 * tp); TRRD(x1, aXW, 4 * S32 + 32 * tp); TRRD(x2, aXW, 32 * S32 + 32 * tp); TRRD(x3, aXW, 36 * S32 + 32 * tp); \
                TRWAIT(); \
                accS[tp] = accS[tp] * dec; \
                accS[tp] = MFMA16(CAT8(b0, b1), CAT8(x0, x1), accS[tp]); accS[tp] = MFMA16(CAT8(b2, b3), CAT8(x2, x3), accS[tp]);     \
            } \
            _Pragma("unroll") for (int tp = 0; tp < 4; ++tp) \
                *(LAS v2u*)(lds + O_ST + (cur ^ 1) * 64 * S256 + (16 * tp + fr) * S256 + (16 * tn + 4 * fq) * 2) = (v2u){cvtpk(accS[tp][0], accS[tp][1]), cvtpk(accS[tp][2], accS[tp][3])}; \
        } \
        __syncthreads(); \
          \
        { \
            const bf16x8 m0f = LD128(O_MT + (16 * tl + fr) * S64 + (8 * fq) * 2), m1f = LD128(O_MT + (16 * tl + fr) * S64 + (32 + 8 * fq) * 2); \
            bf16x8 cfr[4]; \
            _Pragma("unroll") for (int kk = 0; kk < 4; ++kk) cfr[kk] = LD128(OCS + (16 * tl + fr) * S256 + (32 * kk + 8 * fq) * 2); \
            const float eal = tb[192 + 16 * tl + fr]; \
            _Pragma("unroll") for (int j = 0; j < 2; ++j) { \
                s16x4v x0, x1, x2, x3; \
                TRRD(x0, aXBs, 32 * j); TRRD(x1, aXBs, 4 * S32 + 32 * j); TRRD(x2, aXBs, 32 * S32 + 32 * j); TRRD(x3, aXBs, 36 * S32 + 32 * j); \
                TRWAIT(); \
                f32x4v yd = {}, yo = {}; \
                yd = MFMA16(CAT8(x0, x1), m0f, yd); yd = MFMA16(CAT8(x2, x3), m1f, yd); \
                _Pragma("unroll") for (int kk = 0; kk < 4; ++kk) yo = MFMA16(LD128(O_ST + cur * 64 * S256 + (32 * tpC + 16 * j + fr) * S256 + (32 * kk + 8 * fq) * 2), cfr[kk], yo); \
                const v2u xb = *(const LAS v2u*)(lds + OXB + (16 * tl + fr) * S32 + (32 * tpC + 16 * j + 4 * fq) * 2); \
                const v2u zr = j ? zq1 : zq0;                                 \
                float yz[4]; \
                yz[0] = (yd[0] + eal * yo[0] + Dh * bflo(xb.x)) * bflo(zr.x); yz[1] = (yd[1] + eal * yo[1] + Dh * bfhi(xb.x)) * bfhi(zr.x); \
                yz[2] = (yd[2] + eal * yo[2] + Dh * bflo(xb.y)) * bflo(zr.y); yz[3] = (yd[3] + eal * yo[3] + Dh * bfhi(xb.y)) * bfhi(zr.y); \
                *(v2u*)(pZ + (size_t)(c) * (L * PITCH * 2) + ozy + 32 * j) = (v2u){cvtpk(yz[0], yz[1]), cvtpk(yz[2], yz[3])}; \
                float q = (yz[0] * yz[0] + yz[1] * yz[1]) + (yz[2] * yz[2] + yz[3] * yz[3]); \
                q += __shfl_xor(q, 16); q += __shfl_xor(q, 32); \
                if (fq == 0) pSQ[((size_t)(c) * L + 16 * tl + fr) * 64 + 2 * tpC + j] = q; } \
        } \
          \
        cur ^= 1; } while (0)
    SSD_LOAD(0, 0); SSD_LOAD(1, 1);
    int cur = 0;
#pragma unroll 1
    for (int c = 0; c < SEQ / L; c += 2) { SSD_STEP(c, 0); SSD_STEP(c + 1, 1); }
    __syncthreads();
#undef SSD_STEP
#undef SSD_LOAD
}
#undef LD128
#undef MFMA16
#undef TRRD
#undef TRWAIT
#undef CAT8
}


__device__ __forceinline__ void ssd_phase(Frame& F, int layer) {
    if ((F.vcu & 1) == 0) for (int it = F.vcu >> 1; it < BATCH * NSH; it += (F.G + 1) >> 1) ssd::item(F.lds + RING_OFF, F.wave, layer, it >> 4, it & 15);
}


namespace moba {
typedef float f32x16 __attribute__((ext_vector_type(16)));
typedef short s16x4 __attribute__((ext_vector_type(4)));
typedef unsigned u32x4 __attribute__((ext_vector_type(4)));
constexpr int NW = 8, QBLK = 32, KVBLK = 64, QB = NW * QBLK;
constexpr int SHM_V = KVBLK * HD * 2, SHM_K = KVBLK * HD * 2;
constexpr int OFF_V = 0, OFF_K = 3 * SHM_V, OFF_WS = 3 * SHM_V + 3 * SHM_K, OFF_KM = OFF_WS + NW * 64 * 4;
constexpr int ATTN_LDS = OFF_KM + 32 * 256;
constexpr float SCALE = 0.08838834764831845f, LOG2E = 1.4426950408889634f;

#define KSWZ(row, colB) ((row) * 256 + ((colB) ^ (((row) & 7) << 4)))
#define SBAR() __builtin_amdgcn_sched_barrier(0)
__device__ __forceinline__ int v_st(int k, int c) { const int kk = (k & ~0xC) | ((k & 4) << 1) | ((k & 8) >> 1); return ((kk >> 3) * 4 + (c >> 5)) * 512 + ((kk & 7) * 32 + (c & 31)) * 2; }
__device__ __forceinline__ int v_rd_base(int lane) { return ((lane & 3) << 3) | (((lane >> 2) & 3) << 6) | (((lane >> 4) & 1) << 5) | (((lane >> 5) & 1) << 8); }
constexpr int v_rd_off(int d0, int ks, int half) { return d0 * 512 + ks * 4096 + half * 2048; }
__device__ __forceinline__ int crow(int r, int hi) { return (r & 3) + 8 * (r >> 2) + 4 * hi; }
typedef __bf16 bf16x2n __attribute__((ext_vector_type(2)));
__device__ __forceinline__ unsigned cvtpk(float lo, float hi) { bf16x2n v = {(__bf16)lo, (__bf16)hi}; return __builtin_bit_cast(unsigned, v); }

struct Unit { const bf16* Q; const bf16* K; const bf16* V; const float* KM; int qb, h, jlo; };
struct Seam { bf16x8 qr[8]; bf16x8 st_v0, st_v1, st_k0, st_k1; };
constexpr int OFF_ORD = 108 * 1024, OFF_TK = OFF_ORD + 2048, OFF_WT = OFF_TK + 16;
struct Queue { unsigned* ctr; bf16* PROJ; const float* KM; };
__device__ __forceinline__ bool unit_from_ticket(unsigned t, const Queue& q, const LAS char* lds, Unit& u) {
    if (t >= (unsigned)(BATCH * NH * NBLK)) return false;
    const int id = __builtin_amdgcn_readfirstlane((int)((const LAS unsigned short*)(lds + OFF_ORD))[t]), b = id >> 7, h = (id >> 4) & 7, qb = id & 15;
    const int w = __builtin_amdgcn_readfirstlane(((const LAS int*)(lds + OFF_WT))[h]);
    const bf16* base = q.PROJ + (size_t)b * SEQ * PITCH + h * HD;
    u.Q = base + (size_t)qb * MOBA * PITCH + C_Q; u.K = base + C_K; u.V = base + C_V; u.KM = q.KM + (size_t)(b * NH + h) * NBLK * HD; u.qb = qb; u.h = h;
    u.jlo = qb > w ? 4 * (qb - w) : 0;
    return true;
}

__device__ __forceinline__ void mask_tile(f32x16& p0, f32x16& p1, int dq) {
    const float NEG = -__builtin_inff();
#pragma unroll
    for (int r = 0; r < 16; ++r) { const int c = (r & 3) + 8 * (r >> 2); if (dq - c < 0) p0[r] = NEG; if (dq - c - 32 < 0) p1[r] = NEG; }
}
__device__ __forceinline__ void partialSM(f32x16& p0, f32x16& p1, float base, float slope2) {
    constexpr float C2 = LOG2E * SCALE;
#pragma unroll
    for (int r = 0; r < 16; ++r) { const float c = (float)((r & 3) + 8 * (r >> 2)); p0[r] = fmaf(p0[r], C2, fmaf(slope2, c, base)); p1[r] = fmaf(p1[r], C2, fmaf(slope2, c + 32.f, base)); }
#pragma unroll
    for (int r = 0; r < 16; ++r) p0[r] = __builtin_amdgcn_exp2f(p0[r]);
}
__device__ __forceinline__ void finishSM(f32x16& p0, f32x16& p1, float& l_reg, bf16x8& pa0, bf16x8& pa1, bf16x8& pa2, bf16x8& pa3) {
#pragma unroll
    for (int r = 0; r < 16; ++r) p1[r] = __builtin_amdgcn_exp2f(p1[r]);
    float ps = 0;
#pragma unroll
    for (int r = 0; r < 16; ++r) ps += p0[r];
#pragma unroll
    for (int r = 0; r < 16; ++r) ps += p1[r];
    { auto rr = __builtin_amdgcn_permlane32_swap(__float_as_uint(ps), __float_as_uint(ps), false, false); ps = __uint_as_float(rr[0]) + __uint_as_float(rr[1]); }
    l_reg += ps;
#define PK4(P, B_, OUT) do { unsigned a0 = cvtpk(P[B_+0], P[B_+1]), a1 = cvtpk(P[B_+2], P[B_+3]); unsigned b0 = cvtpk(P[B_+4], P[B_+5]), b1 = cvtpk(P[B_+6], P[B_+7]); \
        auto r0 = __builtin_amdgcn_permlane32_swap(a0, b0, false, false); auto r1 = __builtin_amdgcn_permlane32_swap(a1, b1, false, false); \
        u32x4 w = {r0[0], r1[0], r0[1], r1[1]}; OUT = *reinterpret_cast<bf16x8*>(&w); } while (0)
    PK4(p0, 0, pa0); PK4(p0, 8, pa1); PK4(p1, 0, pa2); PK4(p1, 8, pa3);
#undef PK4
}
__device__ __forceinline__ void qkt(f32x16& p0, f32x16& p1, const LAS char* const (&kbase)[4], int kslot, const bf16x8* qr) {
    p0 = f32x16{}; p1 = f32x16{};
#pragma unroll
    for (int d0 = 0; d0 < 8; ++d0) { const LAS char* a = kbase[d0 & 3] + kslot + (d0 >> 2) * 128;
        bf16x8 b0 = *reinterpret_cast<const LAS bf16x8*>(a);
        bf16x8 b1 = *reinterpret_cast<const LAS bf16x8*>(a + 32 * 256);
        p0 = __builtin_amdgcn_mfma_f32_32x32x16_bf16(b0, qr[d0], p0, 0, 0, 0);
        p1 = __builtin_amdgcn_mfma_f32_32x32x16_bf16(b1, qr[d0], p1, 0, 0, 0); }
}
__device__ __forceinline__ void pv_tile(f32x16* o, int vb0, bf16x8 pa0, bf16x8 pa1, bf16x8 pa2, bf16x8 pa3) {
#define TRRD(dst, off) asm volatile("ds_read_b64_tr_b16 %0, %1 offset:%2" : "=&v"(dst) : "v"(vb0), "i"(off) : "memory")
#define PV_D0(d0) do { s16x4 l0, l1, l2, l3, h0, h1, h2, h3; constexpr int b_ = v_rd_off(d0, 0, 0); \
        TRRD(l0, b_); TRRD(h0, b_ + 2048); TRRD(l1, b_ + 4096); TRRD(h1, b_ + 6144); TRRD(l2, b_ + 8192); TRRD(h2, b_ + 10240); TRRD(l3, b_ + 12288); TRRD(h3, b_ + 14336); \
        asm volatile("s_waitcnt lgkmcnt(0)" ::: "memory"); SBAR(); \
        o[d0] = __builtin_amdgcn_mfma_f32_32x32x16_bf16(pa0, (bf16x8){l0[0], l0[1], l0[2], l0[3], h0[0], h0[1], h0[2], h0[3]}, o[d0], 0, 0, 0); \
        o[d0] = __builtin_amdgcn_mfma_f32_32x32x16_bf16(pa1, (bf16x8){l1[0], l1[1], l1[2], l1[3], h1[0], h1[1], h1[2], h1[3]}, o[d0], 0, 0, 0); \
        o[d0] = __builtin_amdgcn_mfma_f32_32x32x16_bf16(pa2, (bf16x8){l2[0], l2[1], l2[2], l2[3], h2[0], h2[1], h2[2], h2[3]}, o[d0], 0, 0, 0); \
        o[d0] = __builtin_amdgcn_mfma_f32_32x32x16_bf16(pa3, (bf16x8){l3[0], l3[1], l3[2], l3[3], h3[0], h3[1], h3[2], h3[3]}, o[d0], 0, 0, 0); } while (0)
    PV_D0(0); PV_D0(1); PV_D0(2); PV_D0(3);
#undef PV_D0
#undef TRRD
}

#define TILEP(p, k0) ((const char*)((p) + (size_t)(k0) * PITCH))
#define VMW() asm volatile("s_waitcnt vmcnt(0)" ::: "memory")
#define VMWN(n) asm volatile("s_waitcnt vmcnt(%0)" :: "i"(n) : "memory")
#define LD8(p) (*reinterpret_cast<const bf16x8*>(p))
#define LD8O(base, off) (*reinterpret_cast<const bf16x8*>((base) + (off)))
#define SLOAD_H(Kp, Vp, k0) do { const char* vt_ = TILEP(Vp, k0); const char* kt_ = TILEP(Kp, k0); S.st_v0 = LD8O(vt_, roff0); S.st_v1 = LD8O(vt_, roff1); S.st_k0 = LD8O(kt_, roff0); S.st_k1 = LD8O(kt_, roff1); } while (0)
#define SWRITE_HK(so) do { *(LAS bf16x8*)(K_lds + (so) + kws) = S.st_k0; *(LAS bf16x8*)(K_lds + (so) + kws + 32 * 256) = S.st_k1; } while (0)
#define SWRITE_HV(so) do { *(LAS bf16x8*)(V_lds + (so) + vst0) = S.st_v0; *(LAS bf16x8*)(V_lds + (so) + vst1) = S.st_v1; } while (0)
#define SWRITE_H(so) do { SWRITE_HV(so); SWRITE_HK(so); } while (0)

__device__ __forceinline__ void prime(const Unit& cur, LAS char* lds, Seam& S, int tid_) {
    int tid = tid_; asm volatile("" : "+v"(tid));
    const int wid = __builtin_amdgcn_readfirstlane(tid >> 6), lane = tid & 63, r32 = lane & 31, hi = lane >> 5;
    const int sr = tid >> 4, sc = (tid & 15) * 8, kws = KSWZ(sr, sc * 2); LAS char* K_lds = lds + OFF_K;
    const unsigned roff0 = (unsigned)(sr * PITCH + sc) * 2u, roff1 = roff0 + 32u * PITCH * 2u, qoff = (unsigned)(r32 * PITCH + hi * 8) * 2u;
    { const char* qb_ = (const char*)(cur.Q + (size_t)(wid * QBLK) * PITCH);
#pragma unroll
    for (int d0 = 0; d0 < 8; ++d0) S.qr[d0] = LD8O(qb_, qoff + d0 * 32); }
    SLOAD_H(cur.K, cur.V, cur.jlo * KVBLK); VMW(); SWRITE_HK(0);
    __syncthreads();
}
__device__ __forceinline__ void block(const Unit& cur, Unit& nxt, bool& more, const Queue& Qd, float slope2, float M2, LAS char* lds, Seam& S, int tid_) {
    int tid = tid_; asm volatile("" : "+v"(tid));
    const int wid = __builtin_amdgcn_readfirstlane(tid >> 6), lane = tid & 63, r32 = lane & 31, hi = lane >> 5;
    const unsigned roff0 = (unsigned)((tid >> 4) * PITCH + (tid & 15) * 8) * 2u, roff1 = roff0 + 32u * PITCH * 2u, qoff = (unsigned)(r32 * PITCH + hi * 8) * 2u;
    const int jlo = cur.jlo, NT = 4 * (cur.qb + 1) - jlo;
    LAS char* V_lds = lds + OFF_V; LAS char* K_lds = lds + OFF_K;
    LAS float* li_l = (LAS float*)(lds + OFF_WS) + wid * 64;
    float l_reg = 0; f32x16 o[4] = {};
    const int sr = tid >> 4, sc = (tid & 15) * 8, vst0 = v_st(sr, sc), vst1 = v_st(32 + sr, sc), kws = KSWZ(sr, sc * 2);
    const int vb0 = (int)(unsigned)(size_t)V_lds + v_rd_base(lane);
    const bf16* Kh = cur.K; const bf16* Vh = cur.V;
    const int tq = cur.qb * QB + wid * QBLK + r32;
    {
        const int n = sr & 15; const float* kp = cur.KM + n * HD + sc;
        const f32x4 a = *(const f32x4*)kp, b = *(const f32x4*)(kp + 4);
        float v[8] = {a.x, a.y, a.z, a.w, b.x, b.y, b.z, b.w}; unsigned w[4];
#pragma unroll
        for (int e = 0; e < 4; ++e) { const unsigned h0 = f2bf(v[2 * e]), h1 = f2bf(v[2 * e + 1]);
            if (sr < 16) w[e] = h0 | (h1 << 16); else w[e] = pk2(v[2 * e] - bflo(h0), v[2 * e + 1] - bflo(h1)); }
        *(LAS u32x4*)(lds + OFF_KM + KSWZ(sr, sc * 2)) = (u32x4){w[0], w[1], w[2], w[3]};
    }
    if (tid == 0) *(LAS unsigned*)(lds + OFF_TK) = __hip_atomic_fetch_add(Qd.ctr, 1u, __ATOMIC_RELAXED, __HIP_MEMORY_SCOPE_AGENT);
    __syncthreads();
    { const unsigned tnext = (unsigned)__builtin_amdgcn_readfirstlane((int)*(const LAS unsigned*)(lds + OFF_TK));
      more = unit_from_ticket(tnext, Qd, lds, nxt); if (!more) nxt = cur; }
    unsigned selmask = 0;
    {
        f32x16 pg = f32x16{};
#pragma unroll
        for (int d0 = 0; d0 < 8; ++d0) { const bf16x8 a = *reinterpret_cast<const LAS bf16x8*>(lds + OFF_KM + KSWZ(r32, (d0 * 16 + hi * 8) * 2));
            pg = __builtin_amdgcn_mfma_f32_32x32x16_bf16(a, S.qr[d0], pg, 0, 0, 0); }
        float g[16];
#pragma unroll
        for (int j = 0; j < 8; ++j) { const float mine = pg[j] + pg[j + 8], oth = __shfl_xor(mine, 32); const int n0 = (j & 3) + 8 * (j >> 2);
            g[n0] = hi ? oth : mine; g[n0 + 4] = hi ? mine : oth; }
        float v0 = -__builtin_inff(), v1 = v0, v2 = v0; int i0 = 0, i1 = 0, i2 = 0;
#pragma unroll
        for (int n = 0; n < 16; ++n) { const float gt = n < cur.qb ? g[n] : -__builtin_inff();
            if (gt > v0) { v2 = v1; i2 = i1; v1 = v0; i1 = i0; v0 = gt; i0 = n; }
            else if (gt > v1) { v2 = v1; i2 = i1; v1 = gt; i1 = n; }
            else if (gt > v2) { v2 = gt; i2 = n; } }
        if (v0 > -__builtin_inff()) selmask |= 1u << i0;
        if (v1 > -__builtin_inff()) selmask |= 1u << i1;
        if (v2 > -__builtin_inff()) selmask |= 1u << i2;
    }
    const float basec = -M2 + slope2 * (float)(4 * hi - tq);
    const int ownt = 4 * cur.qb - jlo;
#define KBASE(t) ((jlo + (t)) * KVBLK)
#define TBASE(t) (((t) >= ownt || ((selmask >> ((jlo + (t)) >> 2)) & 1u)) ? fmaf(slope2, (float)KBASE(t), basec) : -__builtin_inff())
#define MASKT(P0_, P1_, t) do { if ((t) >= ownt && KBASE(t) + KVBLK - 1 > cur.qb * QB + wid * QBLK) mask_tile(P0_, P1_, tq - 4 * hi - KBASE(t)); } while (0)
    f32x16 pA0, pA1, pB0, pB1; bf16x8 pa0, pa1, pa2, pa3;
    const LAS char* kbase[4];
#pragma unroll
    for (int dd = 0; dd < 4; ++dd) kbase[dd] = K_lds + KSWZ(r32, (dd * 16 + hi * 8) * 2);
    SWRITE_HV(0); SBAR();
    SLOAD_H(Kh, Vh, KBASE(1));
    SBAR(); qkt(pA0, pA1, kbase, 0, S.qr);
    MASKT(pA0, pA1, 0); partialSM(pA0, pA1, TBASE(0), slope2);
    VMW(); SWRITE_H(SHM_K); SBAR(); SLOAD_H(Kh, Vh, KBASE(2));
    __syncthreads();
    int sp = 0, scur = SHM_K, sn = 2 * SHM_K;
#define STEP(PX0, PX1, PY0, PY1, t, LAST) do { \
        if (!(LAST)) { VMW(); SWRITE_H(sn); SBAR(); if ((t) + 2 < NT) SLOAD_H(Kh, Vh, KBASE((t) + 2)); } \
        else { SLOAD_H(nxt.K, nxt.V, nxt.jlo * KVBLK); }                        \
        SBAR(); qkt(PX0, PX1, kbase, scur, S.qr); \
        if (LAST) { SBAR(); const char* nq_ = (const char*)(nxt.Q + (size_t)(wid * QBLK) * PITCH); \
            _Pragma("unroll") for (int d0 = 0; d0 < 8; ++d0) S.qr[d0] = LD8O(nq_, qoff + d0 * 32); SBAR(); }     \
        finishSM(PY0, PY1, l_reg, pa0, pa1, pa2, pa3); SBAR(); \
        pv_tile(o, vb0 + sp, pa0, pa1, pa2, pa3); MASKT(PX0, PX1, (t)); partialSM(PX0, PX1, TBASE(t), slope2); \
        __syncthreads(); \
        { const int r_ = sp; sp = scur; scur = sn; sn = r_; } } while (0)
    int t = 1;
    for (; t + 1 < NT; t += 2) { STEP(pB0, pB1, pA0, pA1, t, false); STEP(pA0, pA1, pB0, pB1, t + 1, false); }
    STEP(pB0, pB1, pA0, pA1, t, true);
#undef STEP
    finishSM(pB0, pB1, l_reg, pa0, pa1, pa2, pa3); SBAR();
    pv_tile(o, vb0 + sp, pa0, pa1, pa2, pa3);
    SBAR(); VMWN(8); SWRITE_HK(0); SBAR();
    if (hi == 0) li_l[r32] = l_reg; asm volatile("s_waitcnt lgkmcnt(0)" ::: "memory");
    char* Ow = (char*)(const_cast<bf16*>(cur.Q) + (size_t)(wid * QBLK) * PITCH);
    const char* Gw = Ow + (C_G - C_Q) * 2;
    const unsigned eoff = (unsigned)(4 * hi * PITCH + r32) * 2u;
#pragma unroll
    for (int r = 0; r < 16; ++r) { const int orow = crow(r, hi); const float rl = __builtin_amdgcn_rcpf(li_l[orow]);
        const unsigned ro = eoff + (unsigned)(((r & 3) + 8 * (r >> 2)) * PITCH) * 2u;
#pragma unroll
        for (int d0 = 0; d0 < 4; ++d0) { const float gg = bflo((unsigned)*(const bf16*)(Gw + ro + d0 * 64));
            const float v = o[d0][r] * rl * gg;
            const float vn = __shfl_xor(v, 1);
            if ((r32 & 1) == 0) *(unsigned*)(Ow + ro + d0 * 64) = cvtpk(v, vn); } }
    __syncthreads();
#undef KBASE
#undef TBASE
#undef MASKT
#undef HALF_STEP
}
#undef TILEP
#undef LD8O
#undef VMW
#undef VMWN
#undef LD8
#undef SLOAD_H
#undef SWRITE_HK
#undef SWRITE_HV
#undef SWRITE_H
#undef KSWZ
#undef SBAR
}

__device__ __forceinline__ int attn_window(float slope2, float M2) {
    int w = 0;
#pragma unroll 1
    for (int j = 0; j < 15; ++j) if (slope2 * (float)(256 * j + 1) < 2.f * M2 + 48.f) w = j + 1;
    return w;
}
__device__ __forceinline__ void attn_phase(Frame& F, int layer) {
    bf16* const PROJ = WSP(bf16, WS_PROJ); const float* const KM = WSP(float, WS_KM);
    const float* qw = in_ptr(3) + layer * HD; const float* kw = in_ptr(4) + layer * HD;
    const float mq = wave_max(fmaxf(fabsf(qw[2 * F.lane]), fabsf(qw[2 * F.lane + 1]))), mk = wave_max(fmaxf(fabsf(kw[2 * F.lane]), fabsf(kw[2 * F.lane + 1])));
    const float M2 = 11.313708499f * mq * mk * 1.02f * moba::LOG2E;
    LAS char* lds = (LAS char*)(F.lds + RING_OFF);
    {
        int W[8];
#pragma unroll
        for (int h = 0; h < 8; ++h) W[h] = attn_window(exp2f(-(float)(h + 1)) * moba::LOG2E, M2);
        if (F.tid < 8) { int w = 0;
#pragma unroll
            for (int h = 0; h < 8; ++h) w = (F.tid == h) ? W[h] : w;
            ((LAS int*)(lds + moba::OFF_WT))[F.tid] = w; }
#define NCOST(c, hh) (((c) - 1 < W[hh]) ? 1 : (((c) - 1 == W[hh]) ? 16 - W[hh] : 0))
#pragma unroll 1
        for (int u = F.tid; u < BATCH * NH * NBLK; u += NWAVES * 64) {
            const int b = u >> 7, h = (u >> 4) & 7, qb = u & 15;
            int wh = 0;
#pragma unroll
            for (int hh = 0; hh < 8; ++hh) wh = (h == hh) ? W[hh] : wh;
            const int c = (qb < wh ? qb : wh) + 1;
            int pos = 0;
#pragma unroll 1
            for (int cc = c + 1; cc <= 16; ++cc) { int n = 0;
#pragma unroll
                for (int hh = 0; hh < 8; ++hh) n += NCOST(cc, hh);
                pos += BATCH * n; }
            int nall = 0, nbefore = 0;
#pragma unroll
            for (int hh = 0; hh < 8; ++hh) { const int n = NCOST(c, hh); nall += n; nbefore += (hh < h) ? n : 0; }
            pos += b * nall + nbefore + ((c - 1 == wh) ? qb - wh : 0);
            ((LAS unsigned short*)(lds + moba::OFF_ORD))[pos] = (unsigned short)u;
        }
#undef NCOST
    }
    moba::Queue Qd{WSP(unsigned, WS_CTL) + CW_AQ + 64 * layer, PROJ, KM};
    if (F.tid == 0) *(LAS unsigned*)(lds + moba::OFF_TK) = __hip_atomic_fetch_add(Qd.ctr, 1u, __ATOMIC_RELAXED, __HIP_MEMORY_SCOPE_AGENT);
    __syncthreads();
    moba::Unit cur, nxt; moba::Seam S;
    { const unsigned t0 = (unsigned)__builtin_amdgcn_readfirstlane((int)*(const LAS unsigned*)(lds + moba::OFF_TK));
      if (!moba::unit_from_ticket(t0, Qd, lds, cur)) return; }
    __syncthreads();
    moba::prime(cur, lds, S, F.tid);
    for (;;) {
        bool more;
        const float slope2 = exp2f(-(float)(cur.h + 1)) * moba::LOG2E;
        moba::block(cur, nxt, more, Qd, slope2, M2, lds, S, F.tid);
        if (!more) break;
        cur = nxt;
    }
}

__global__ void __launch_bounds__(NWAVES * 64, 2) mk_fwd(Args args) {
    extern __shared__ __attribute__((aligned(16))) unsigned char lds[];
    Frame F;
    F.lds = (LAS unsigned char*)lds;
    F.MISC = (volatile LAS unsigned*)(F.lds + MISC_OFF);
    F.tid = threadIdx.x; F.lane = F.tid & 63; F.wave = __builtin_amdgcn_readfirstlane(F.tid >> 6);
    F.G = gridDim.x; { const int bx = blockIdx.x; F.vcu = (F.G % 8 == 0) ? (bx % 8) * (F.G / 8) + bx / 8 : bx; }
    for (int u = F.tid; u < (LDS_BYTES - LDSCTL_OFF) / 4; u += NWAVES * 64) ((LAS unsigned*)(F.lds + LDSCTL_OFF))[u] = 0u;
    __syncthreads();
    XcdBarrier bar; bar.bar = nullptr; bar.x = 0; bar.st = nullptr;
    if (N_LAUNCHES == 1) bar = xcd_barrier_post(WSP(unsigned, WS_CTL) + CW_BAR, F.MISC + 8);
    const int lo = args.ph_lo, hi = args.ph_hi;
#define IN(k) (lo <= (k) && (k) < hi)
#define REFRESH() do { int z_ = 0; asm volatile("" : "+v"(z_)); asm volatile("" : "+s"(F.wave), "+s"(F.vcu), "+s"(F.G)); \
        F.lane = (int)__builtin_amdgcn_mbcnt_hi(~0u, __builtin_amdgcn_mbcnt_lo(~0u, (unsigned)z_)); F.tid = F.wave * 64 + F.lane; } while (0)
#define SEAM(k) do { if (IN(k) && IN((k) + 1)) { bar.bar = WSP(unsigned, WS_CTL) + CW_BAR; xcd_barrier(bar, F.wave); } } while (0)
#define PROBE_T0(ph) unsigned long long pt0_ = 0; if (PROBE_PH == (ph)) pt0_ = __builtin_amdgcn_s_memrealtime()
#define PROBE_T1(ph) do { if (PROBE_PH == (ph)) { const unsigned long long pt1_ = __builtin_amdgcn_s_memrealtime(); while (__builtin_amdgcn_s_memrealtime() - pt1_ < pt1_ - pt0_) __builtin_amdgcn_s_sleep(8); } } while (0)

#pragma unroll 1
    for (int layer = 0; layer < DEPTH; ++layer) {
        const int pb = layer * 6;
        { PROBE_T0(0); if (IN(pb + 0)) { REFRESH(); phase_a(F, layer); } SEAM(pb + 0); PROBE_T1(0); }
        { PROBE_T0(1); if (IN(pb + 1)) {
            REFRESH();
            pg8::Gemm g{WSP(bf16, WS_A), WSP(bf16, WS_WIN), M, PITCH, DM, DM}; pg8::StaticOrder S; S.init(M, PITCH, F.G, (int)blockIdx.x);
            if (F.tid < 256) ((LAS float*)(F.lds + RING_BYTES + 10240))[F.tid] = (F.tid < 128 ? in_ptr(3) + layer * HD : in_ptr(4) + layer * HD - 128)[F.tid];
            __syncthreads();
            pg8::EpiProj E{WSP(bf16, WS_PROJ), PITCH, in_ptr(3) + layer * HD, in_ptr(4) + layer * HD, WSP(float, WS_KM), F.lds + RING_BYTES, EPS, WSP(float, WS_RSTD)};
            static_assert(GEMM1_ALIGN, "EpiProj's in-epilogue barriers need both half-workgroups in the epilogue together");
            pg8::gemm_phase<pg8::EpiProj, pg8::StaticOrder, GEMM1_ALIGN, GEMM1_SP2>(F.lds + RING_OFF, g, S, E, F.tid);
        } SEAM(pb + 1); PROBE_T1(1); }
        { PROBE_T0(2); if (IN(pb + 2)) { REFRESH(); phase_c(F, layer); } SEAM(pb + 2); PROBE_T1(2); }
        { PROBE_T0(3); if (IN(pb + 3)) {
            { PROBE_T0(6); REFRESH(); ssd_phase(F, layer); __syncthreads(); PROBE_T1(6); }
            { PROBE_T0(7); REFRESH(); attn_phase(F, layer); PROBE_T1(7); }
        } if (IN(pb + 3) && IN(pb + 5)) { bar.bar = WSP(unsigned, WS_CTL) + CW_BAR; xcd_barrier(bar, F.wave); } PROBE_T1(3); }
        { PROBE_T0(5); if (IN(pb + 5)) {
            REFRESH();
            float* const OUTP = out_ptr(); const float* base = layer == 0 ? in_ptr(0) : OUTP;
            pg8::Gemm g{WSP(bf16, WS_PROJ), WSP(bf16, WS_WOUT), M, DM, 2048, PITCH}; pg8::StaticOrder S; S.init(M, DM, F.G, (int)blockIdx.x);
            pg8::EpiResScale E{base, OUTP, DM, WSP(float, WS_SSQ), F.lds + RING_BYTES, EPS, layer == DEPTH - 1};
            pg8::gemm_phase<pg8::EpiResScale, pg8::StaticOrder, GEMM2_ALIGN, GEMM2_SP2>(F.lds + RING_OFF, g, S, E, F.tid);
        } SEAM(pb + 5); PROBE_T1(5); }
    }
#undef IN
#undef SEAM
}

extern "C" void kernel_launch(void* const* d_in, const int* in_sizes, int n_in, void* d_out, int out_size, void* d_ws, size_t ws_size, hipStream_t stream) {
    static int grid = 0;
    if (grid == 0) {
        if (n_in != 12 || in_sizes[0] != M * DM || out_size != M * DM || ws_size < WS_END) {
            fprintf(stderr, "kernel_launch: unexpected shapes (n_in %d, in0 %d, out %d, ws %zu); nothing launched\n", n_in, n_in > 0 ? in_sizes[0] : -1, out_size, ws_size); grid = -1; return; }
        int dev = 0, cus = 0, per_cu = 0;
        if (hipGetDevice(&dev) != hipSuccess || hipDeviceGetAttribute(&cus, hipDeviceAttributeMultiprocessorCount, dev) != hipSuccess) { grid = -1; return; }
        if (hipFuncSetAttribute((const void*)mk_fwd, hipFuncAttributeMaxDynamicSharedMemorySize, LDS_BYTES) != hipSuccess) { fprintf(stderr, "kernel_launch: hipFuncSetAttribute failed\n"); grid = -1; return; }
        if (hipOccupancyMaxActiveBlocksPerMultiprocessor(&per_cu, (const void*)mk_fwd, NWAVES * 64, LDS_BYTES) != hipSuccess || per_cu < 1) {
            fprintf(stderr, "kernel_launch: occupancy query reports %d workgroups per CU; nothing launched\n", per_cu); (void)hipGetLastError(); grid = -1; return; }
        grid = cus;
    }
    if (grid < 0) return;
    if (hipMemsetAsync((char*)d_ws + WS_CTL, 0, CTL_ZERO_BYTES, stream) != hipSuccess) { fprintf(stderr, "kernel_launch: hipMemsetAsync failed\n"); return; }
    Args a{};
    for (int i = 0; i < 12; ++i) a.in[i] = (const float*)d_in[i];
    a.out = (float*)d_out; a.ws = (unsigned char*)d_ws;
    for (int li = 0; li < N_LAUNCHES; ++li) {
        a.ph_lo = (N_LAUNCHES == 1) ? 0 : li; a.ph_hi = (N_LAUNCHES == 1) ? N_PHASES : li + 1; a.li = li;
        hipLaunchKernelGGL(mk_fwd, dim3(grid), dim3(NWAVES * 64), LDS_BYTES, stream, a);
        const hipError_t le = hipPeekAtLastError();
        if (le != hipSuccess) { fprintf(stderr, "kernel_launch: launch %d failed: %s\n", li, hipGetErrorName(le)); break; }
    }
}
```

```cpp
#include <hip/hip_runtime.h>
#include <cstdio>
#include <cstdint>
namespace pg8 {
#define PG8_LAS __attribute__((address_space(3)))
typedef unsigned short bf16_t;
typedef short bf16x8 __attribute__((ext_vector_type(8)));
typedef float f32x4 __attribute__((ext_vector_type(4)));
typedef unsigned u32x4 __attribute__((ext_vector_type(4)));
constexpr int BM = 256, BK = 64, HALF = 128, HTB = HALF * BK * 2  , STAGE_BYTES = 8 * HTB, NXCD = 8, WGM = 8;

__host__ __device__ __forceinline__ int lds_byte(int r, int c) { const int st = (r >> 4) * 2 + (c >> 5), rr = r & 15, cc = c & 31, ob = rr * 64 + cc * 2; return st * 1024 + (ob ^ (((ob >> 9) & 1) << 5)); }
__host__ __device__ __forceinline__ void stage_rc(int b, int& R, int& C) { const int st = b / 1024, sb = b % 1024, swz = sb ^ (((sb >> 9) & 1) << 5); R = (st >> 1) * 16 + swz / 64; C = (st & 1) * 32 + (swz % 64) / 2; }
__host__ __device__ __forceinline__ int perm32(int rho) { const int n = rho >> 4, i = rho & 15; return 8 * (i >> 2) + 4 * n + (i & 3); }

struct Unit { int pm, pn; };
struct Gemm { const bf16_t* A; const bf16_t* Bt; int M, N, K, lda; };

struct StaticOrder {
    int nM, nN, nwg, G, c;
    __host__ __device__ void init(int M, int N, int G_, int c_) { nM = M / BM; nN = N / BM; nwg = nM * nN; G = G_; c = c_; }
    __host__ __device__ bool next(int i, Unit& u) const {
        const long L = (long)i * G + c; if (L >= nwg) return false;
        int wgid = (int)L; { const int q = nwg / NXCD, r = nwg % NXCD, xcd = wgid % NXCD, off = wgid / NXCD; wgid = (xcd < r ? xcd * (q + 1) : r * (q + 1) + (xcd - r) * q) + off; }
        const int nig = WGM * nN, gid = wgid / nig, fm = gid * WGM, gsz = (nM - fm) < WGM ? (nM - fm) : WGM;
        u.pm = fm + ((wgid % nig) % gsz); u.pn = (wgid % nig) / gsz; return true;
    }
    __device__ __forceinline__ void a_ready(const Unit&) const {}
    __device__ __forceinline__ void done(const Unit&) const {}
};

__device__ __forceinline__ unsigned cvt_pk_bf16(float lo, float hi) { unsigned r; asm volatile("v_cvt_pk_bf16_f32 %0, %1, %2" : "=v"(r) : "v"(lo), "v"(hi)); return r; }
typedef float f32x2 __attribute__((ext_vector_type(2)));
__device__ __forceinline__ f32x2 gelu_pk(f32x2 v) {
    const f32x2 av = __builtin_elementwise_abs(v), d = av * 0.2316418882f + 1.0f;
    f32x2 t; t.x = __builtin_amdgcn_rcpf(d.x); t.y = __builtin_amdgcn_rcpf(d.y);
    f32x2 q = t * 0.5307027145f + (-0.7265760135f); q = q * t + 0.7107068705f; q = q * t + (-0.142248368f); q = q * t + 0.127414796f; q = q * t;
    const f32x2 s = (v * v) * (-0.72134752044f);
    f32x2 e; e.x = __builtin_amdgcn_exp2f(s.x); e.y = __builtin_amdgcn_exp2f(s.y);
    const f32x2 m = v * (q * e), r = v - m;
    f32x2 o; o.x = v.x < 0.f ? m.x : r.x; o.y = v.y < 0.f ? m.y : r.y; return o;
}

template <int ACT  > struct EpiBf16 {
    static constexpr bool PERM = true, AFTER_DRAIN = false; static_assert(ACT == 0 || ACT == 1, "EpiBf16: ACT is 0 (none) or 1 (gelu_pk)");
    bf16_t* O; int ldc; const float* bias; int split_cols; size_t split_stride; float scale0;
    __device__ __forceinline__ void operator()(const f32x4 (&acc)[2][2][4][2], const Unit& u, int wr, int wc, int fr, int fq) const {
        const int row0 = u.pm * BM + wr * 64 + fr; int colt = u.pn * BM; bf16_t* base = O;
        float sc = 1.f; if (split_cols) { const int t = colt / split_cols; base += (size_t)t * split_stride; colt -= t * split_cols; if (t == 0) sc = scale0; }
        const int col0 = colt + wc * 32 + 8 * fq, bcol0 = u.pn * BM + wc * 32 + 8 * fq;
        f32x4 bv[2][2];
#pragma unroll
        for (int bj = 0; bj < 2; ++bj)
#pragma unroll
            for (int n = 0; n < 2; ++n) bv[bj][n] = bias ? *(const f32x4*)(bias + bcol0 + bj * HALF + 4 * n) : (f32x4){0.f, 0.f, 0.f, 0.f};
#pragma unroll
        for (int ai = 0; ai < 2; ++ai)
#pragma unroll
            for (int m = 0; m < 4; ++m) { bf16_t* rowp = base + (size_t)(row0 + ai * HALF + m * 16) * ldc + col0;
#pragma unroll
                for (int bj = 0; bj < 2; ++bj) { f32x4 v0 = acc[ai][bj][m][0] + bv[bj][0], v1 = acc[ai][bj][m][1] + bv[bj][1];
                    if (ACT == 1) { f32x2 a = gelu_pk((f32x2){v0[0], v0[1]}), b = gelu_pk((f32x2){v0[2], v0[3]}), c = gelu_pk((f32x2){v1[0], v1[1]}), d = gelu_pk((f32x2){v1[2], v1[3]});
                        v0 = (f32x4){a.x, a.y, b.x, b.y}; v1 = (f32x4){c.x, c.y, d.x, d.y}; }
                    v0 = v0 * sc; v1 = v1 * sc; u32x4 w; w.x = cvt_pk_bf16(v0[0], v0[1]); w.y = cvt_pk_bf16(v0[2], v0[3]); w.z = cvt_pk_bf16(v1[0], v1[1]); w.w = cvt_pk_bf16(v1[2], v1[3]);
                    *(u32x4*)(rowp + bj * HALF) = w; } }
    }
};
template <class Epi, class Sched, bool ALIGN_EPI = false, bool SP2 = false>
__device__ __forceinline__ void gemm_phase(PG8_LAS unsigned char* lds, const Gemm g, const Sched& S, const Epi& E, int ptid_) {
    int tid_ = ptid_; asm volatile("" : "+v"(tid_));
    const int tid = tid_, wid = __builtin_amdgcn_readfirstlane(tid >> 6), lane = tid & 63, wr = wid >> 2, wc = wid & 3, fr = lane & 15, fq = lane >> 4;
    const int K = g.K, nt = K / BK;
    unsigned voffA[2], voffB[2];
#pragma unroll
    for (int i = 0; i < 2; ++i) { int R, C; stage_rc(tid * 16 + i * 8192, R, C); const int Rb = Epi::PERM ? ((R & ~31) + perm32(R & 31)) : R;
        voffA[i] = (unsigned)(R * g.lda + C) * 2u; voffB[i] = (unsigned)(Rb * K + C) * 2u; }
    const size_t kstep = (size_t)(BK * 2);
    const size_t hstep = (size_t)HALF * K * 2;
    const size_t tstep = 2 * hstep; const size_t hstepA = (size_t)HALF * g.lda * 2, tstepA = 2 * hstepA;
    const unsigned ldsw = (unsigned)wid * 1024u;
    const int aoff = lds_byte(wr * 64 + fr, fq * 8), boff = lds_byte(wc * 32 + fr, fq * 8);
#define PG8_SA(b, h) (((b) * 2 + (h)) * HTB)
#define PG8_SB(b, h) ((4 + (b) * 2 + (h)) * HTB)
#define PG8_STAGE(bufoff, gbase, voff) do { _Pragma("unroll") for (int _i = 0; _i < 2; ++_i) \
        __builtin_amdgcn_global_load_lds((const unsigned*)((const char*)(gbase) + (voff)[_i]), (PG8_LAS unsigned*)(lds + (bufoff) + ldsw + _i * 8192), 16, 0, 0); } while (0)
#define PG8_LDA(dst, b, h) do { _Pragma("unroll") for (int m = 0; m < 4; ++m) _Pragma("unroll") for (int k = 0; k < 2; ++k) dst[m][k] = *(const PG8_LAS bf16x8*)(lds + PG8_SA(b, h) + aoff + m * 2048 + k * 1024); } while (0)
#define PG8_LDB(dst, b, h) do { _Pragma("unroll") for (int n = 0; n < 2; ++n) _Pragma("unroll") for (int k = 0; k < 2; ++k) dst[n][k] = *(const PG8_LAS bf16x8*)(lds + PG8_SB(b, h) + boff + n * 2048 + k * 1024); } while (0)
#define PG8_MMA(ai, bj, At, Bt) do { __builtin_amdgcn_s_setprio(1); _Pragma("unroll") for (int m = 0; m < 4; ++m) _Pragma("unroll") for (int n = 0; n < 2; ++n) _Pragma("unroll") for (int k = 0; k < 2; ++k) \
        acc[ai][bj][m][n] = __builtin_amdgcn_mfma_f32_16x16x32_bf16(Bt[n][k], At[m][k], acc[ai][bj][m][n], 0, 0, 0); __builtin_amdgcn_s_setprio(0); } while (0)
#define PG8_WAIT_V(n) asm volatile("s_waitcnt vmcnt(" #n ")" ::: "memory")
#define PG8_WAIT_L(n) asm volatile("s_waitcnt lgkmcnt(" #n ")" ::: "memory")
#define PG8_BAR __builtin_amdgcn_s_barrier()
#define PG8_SCHED __builtin_amdgcn_sched_barrier(0)
    Unit cur, nxt; int ui = 0;
    if (!S.next(0, cur)) return;
    f32x4 acc[2][2][4][2];
#pragma unroll
    for (int a = 0; a < 2; ++a)
#pragma unroll
        for (int b = 0; b < 2; ++b)
#pragma unroll
            for (int m = 0; m < 4; ++m)
#pragma unroll
                for (int n = 0; n < 2; ++n) acc[a][b][m][n] = (f32x4){0.f, 0.f, 0.f, 0.f};
    bf16x8 At[4][2], B0[2][2], B1[2][2];
    const char* cA = (const char*)g.A + (size_t)cur.pm * tstepA; const char* cB = (const char*)g.Bt + (size_t)cur.pn * tstep;
    S.a_ready(cur);
    if constexpr (Epi::KHOOK) E.unit_begin(cur, ui, tid);
    if constexpr (SP2) {
        PG8_STAGE(PG8_SB(0, 0), cB, voffB); PG8_STAGE(PG8_SB(0, 1), cB + hstep, voffB); PG8_STAGE(PG8_SA(0, 0), cA, voffA); PG8_STAGE(PG8_SA(0, 1), cA + hstepA, voffA);
        if (wr == 1) PG8_BAR;
        PG8_WAIT_V(2); PG8_BAR;
        PG8_STAGE(PG8_SB(1, 0), cB + kstep, voffB); PG8_STAGE(PG8_SA(1, 0), cA + kstep, voffA); PG8_STAGE(PG8_SB(1, 1), cB + hstep + kstep, voffB);
        PG8_WAIT_V(6); PG8_BAR;
    } else {
        PG8_STAGE(PG8_SB(0, 0), cB, voffB); PG8_STAGE(PG8_SA(0, 0), cA, voffA); PG8_STAGE(PG8_SB(0, 1), cB + hstep, voffB); PG8_STAGE(PG8_SA(0, 1), cA + hstepA, voffA);
        if (wr == 1) PG8_BAR;
        PG8_WAIT_V(4); PG8_BAR;
        PG8_STAGE(PG8_SB(1, 0), cB + kstep, voffB); PG8_STAGE(PG8_SA(1, 0), cA + kstep, voffA); PG8_STAGE(PG8_SB(1, 1), cB + hstep + kstep, voffB);
        PG8_WAIT_V(6); PG8_BAR;
    }
    for (;;) {
        const bool has_next = S.next(ui + 1, nxt);
        const char* nA = has_next ? (const char*)g.A + (size_t)nxt.pm * tstepA : cA; const char* nB = has_next ? (const char*)g.Bt + (size_t)nxt.pn * tstep : cB;
        for (int t = 0; t < nt; t += 2) {
            if constexpr (Epi::KHOOK) { if (t == Epi::KH0 || t == Epi::KH1) E.khook(acc, t, ui, wr, fr); }
            const bool last = (t == nt - 2);
            const char* a1 = cA + (size_t)(t + 1) * kstep;
            const char* a2 = last ? nA : cA + (size_t)(t + 2) * kstep; const char* b2 = last ? nB : cB + (size_t)(t + 2) * kstep;
            const char* a3 = a2 + kstep; const char* b3 = b2 + kstep;
            if (last && has_next) S.a_ready(nxt);
            if constexpr (SP2) {
            PG8_LDB(B0, 0, 0); PG8_LDB(B1, 0, 1); PG8_SCHED; PG8_LDA(At, 0, 0); PG8_STAGE(PG8_SA(1, 1), a1 + hstepA, voffA);
            PG8_WAIT_V(8); PG8_WAIT_L(0); PG8_BAR; PG8_MMA(0, 0, At, B0); PG8_MMA(0, 1, At, B1); PG8_BAR; PG8_SCHED;
            PG8_LDA(At, 0, 1); PG8_STAGE(PG8_SB(0, 0), b2, voffB); PG8_STAGE(PG8_SB(0, 1), b2 + hstep, voffB); PG8_STAGE(PG8_SA(0, 0), a2, voffA);
            PG8_WAIT_V(8); PG8_WAIT_L(0); PG8_BAR; PG8_MMA(1, 0, At, B0); PG8_MMA(1, 1, At, B1); PG8_BAR; PG8_SCHED;
            PG8_LDB(B0, 1, 0); PG8_LDB(B1, 1, 1); PG8_SCHED; PG8_LDA(At, 1, 0); PG8_STAGE(PG8_SA(0, 1), a2 + hstepA, voffA);
            PG8_WAIT_V(8); PG8_WAIT_L(0); PG8_BAR; PG8_MMA(0, 0, At, B0); PG8_MMA(0, 1, At, B1); PG8_BAR; PG8_SCHED;
            PG8_LDA(At, 1, 1); PG8_STAGE(PG8_SB(1, 0), b3, voffB); PG8_STAGE(PG8_SB(1, 1), b3 + hstep, voffB); PG8_STAGE(PG8_SA(1, 0), a3, voffA);
            PG8_WAIT_V(8); PG8_WAIT_L(0); PG8_BAR; PG8_MMA(1, 0, At, B0); PG8_MMA(1, 1, At, B1); PG8_BAR; PG8_SCHED;
            } else {
            PG8_LDB(B0, 0, 0); PG8_SCHED; PG8_LDA(At, 0, 0); PG8_STAGE(PG8_SA(1, 1), a1 + hstepA, voffA);
            PG8_WAIT_L(8); PG8_BAR; PG8_WAIT_L(0); PG8_MMA(0, 0, At, B0); PG8_BAR; PG8_SCHED;
            PG8_LDB(B1, 0, 1); PG8_STAGE(PG8_SB(0, 0), b2, voffB);
            PG8_BAR; PG8_WAIT_L(0); PG8_MMA(0, 1, At, B1); PG8_BAR;
            PG8_LDA(At, 0, 1); PG8_STAGE(PG8_SA(0, 0), a2, voffA);
            PG8_BAR; PG8_WAIT_L(0); PG8_MMA(1, 0, At, B0); PG8_BAR; PG8_SCHED;
            PG8_STAGE(PG8_SB(0, 1), b2 + hstep, voffB);
            PG8_WAIT_V(6); PG8_BAR; PG8_MMA(1, 1, At, B1); PG8_BAR;
            PG8_LDB(B0, 1, 0); PG8_SCHED; PG8_LDA(At, 1, 0); PG8_STAGE(PG8_SA(0, 1), a2 + hstepA, voffA);
            PG8_WAIT_L(8); PG8_BAR; PG8_WAIT_L(0); PG8_MMA(0, 0, At, B0); PG8_BAR; PG8_SCHED;
            PG8_LDB(B1, 1, 1); PG8_STAGE(PG8_SB(1, 0), b3, voffB);
            PG8_BAR; PG8_WAIT_L(0); PG8_MMA(0, 1, At, B1); PG8_BAR;
            PG8_LDA(At, 1, 1); PG8_STAGE(PG8_SA(1, 0), a3, voffA);
            PG8_BAR; PG8_WAIT_L(0); PG8_MMA(1, 0, At, B0); PG8_BAR; PG8_SCHED;
            PG8_STAGE(PG8_SB(1, 1), b3 + hstep, voffB);
            PG8_WAIT_V(6); PG8_BAR; PG8_MMA(1, 1, At, B1); PG8_BAR;
            }
        }
        if constexpr (ALIGN_EPI) { if (wr == 0) PG8_BAR; }
        if constexpr (Epi::KHOOK) { E.epi(acc, cur, ui, wr, wc, fr, fq); S.done(cur); } else if constexpr (!Epi::AFTER_DRAIN) { E(acc, cur, wr, wc, fr, fq); S.done(cur); }
        if (!has_next) break;
#pragma unroll
        for (int a = 0; a < 2; ++a)
#pragma unroll
            for (int b = 0; b < 2; ++b)
#pragma unroll
                for (int m = 0; m < 4; ++m)
#pragma unroll
                    for (int n = 0; n < 2; ++n) acc[a][b][m][n] = (f32x4){0.f, 0.f, 0.f, 0.f};
        cur = nxt; cA = nA; cB = nB; ++ui;
        if constexpr (Epi::KHOOK) E.unit_begin(cur, ui, tid);
        if constexpr (ALIGN_EPI) { if (wr == 1) PG8_BAR; }
    }
    PG8_WAIT_V(0);
    if constexpr (!ALIGN_EPI) { if (wr == 0) PG8_BAR; }
    PG8_BAR;
    if constexpr (Epi::AFTER_DRAIN) { E.fused(acc, cur, wr, wc, fr, fq, lds, wid, lane); S.done(cur); }
#undef PG8_SA
#undef PG8_SB
#undef PG8_STAGE
#undef PG8_LDA
#undef PG8_LDB
#undef PG8_MMA
#undef PG8_WAIT_V
#undef PG8_WAIT_L
#undef PG8_BAR
#undef PG8_SCHED
}
}

namespace pg8 {
struct EpiResF32 {
    static constexpr bool PERM = false, AFTER_DRAIN = false, KHOOK = false;
    const float* base; float* out; int ldc;
    __device__ __forceinline__ void operator()(const f32x4 (&acc)[2][2][4][2], const Unit& u, int wr, int wc, int fr, int fq) const {
        const int col0 = u.pn * BM + wc * 32 + 4 * fq;
#pragma unroll
        for (int ai = 0; ai < 2; ++ai)
#pragma unroll
            for (int m = 0; m < 4; ++m) { const size_t off = (size_t)(u.pm * BM + ai * HALF + wr * 64 + m * 16 + fr) * ldc + col0;
#pragma unroll
                for (int bj = 0; bj < 2; ++bj)
#pragma unroll
                    for (int n = 0; n < 2; ++n) { const f32x4 bs = *(const f32x4*)(base + off + bj * HALF + n * 16); *(f32x4*)(out + off + bj * HALF + n * 16) = bs + acc[ai][bj][m][n]; } }
    }
};

struct EpiProj {
    static constexpr bool PERM = true, AFTER_DRAIN = false, KHOOK = true; static constexpr int KH0 = -1, KH1 = -1;
    bf16_t* O; int ldc; const float* qw; const float* kw; float* KM; PG8_LAS unsigned char* xlds; float eps; const float* RSTD;
    __device__ __forceinline__ PG8_LAS float* rtab(int ui) const { return (PG8_LAS float*)(xlds + 11264) + (ui & 1) * 256; }
    __device__ __forceinline__ void unit_begin(const Unit& u, int ui, int tid) const { if (tid < 256) rtab(ui)[tid] = RSTD[u.pm * BM + tid]; }
    __device__ __forceinline__ void khook(f32x4 (&)[2][2][4][2], int, int, int, int) const {}
    __device__ __forceinline__ void bar() const { asm volatile("s_waitcnt lgkmcnt(0)" ::: "memory"); __builtin_amdgcn_s_barrier(); asm volatile("" ::: "memory"); }
    __device__ __forceinline__ void epi(const f32x4 (&acc)[2][2][4][2], const Unit& u, int ui, int wr, int wc, int fr, int fq) const {
        const int row0 = u.pm * BM + wr * 64 + fr, colt = u.pn * BM, col0 = colt + wc * 32 + 8 * fq;
        const PG8_LAS float* RT = rtab(ui) + wr * 64 + fr;
        const int kind = colt < 1024 ? 1 : ((colt >= 2048 && colt < 3072) ? 2 : 0);
        const bool gate = (colt >= 1024 && colt < 2048) || (colt >= 4096 && colt < 5120);
        if (kind == 0) {
#pragma unroll
            for (int ai = 0; ai < 2; ++ai)
#pragma unroll
                for (int m = 0; m < 4; ++m) { bf16_t* rowp = O + (size_t)(row0 + ai * HALF + m * 16) * ldc + col0; const float rr = RT[ai * HALF + m * 16];
#pragma unroll
                    for (int bj = 0; bj < 2; ++bj) { f32x4 v0 = acc[ai][bj][m][0] * rr, v1 = acc[ai][bj][m][1] * rr;
                        if (gate) {
#pragma unroll
                            for (int e = 0; e < 4; ++e) { v0[e] = v0[e] * __builtin_amdgcn_rcpf(1.0f + __expf(-v0[e])); v1[e] = v1[e] * __builtin_amdgcn_rcpf(1.0f + __expf(-v1[e])); } }
                        u32x4 w; w.x = cvt_pk_bf16(v0[0], v0[1]); w.y = cvt_pk_bf16(v0[2], v0[3]); w.z = cvt_pk_bf16(v1[0], v1[1]); w.w = cvt_pk_bf16(v1[2], v1[3]);
                        *(u32x4*)(rowp + bj * HALF) = w; } }
            return;
        }
        PG8_LAS float* P = (PG8_LAS float*)xlds;
        PG8_LAS float* KS = (PG8_LAS float*)(xlds + 8192);
#pragma unroll
        for (int ai = 0; ai < 2; ++ai)
#pragma unroll
            for (int m = 0; m < 4; ++m)
#pragma unroll
                for (int bj = 0; bj < 2; ++bj) { const float rr = RT[ai * HALF + m * 16]; const f32x4 a = acc[ai][bj][m][0] * rr, b = acc[ai][bj][m][1] * rr;
                    float s = ((a[0] * a[0] + a[1] * a[1]) + (a[2] * a[2] + a[3] * a[3])) + ((b[0] * b[0] + b[1] * b[1]) + (b[2] * b[2] + b[3] * b[3]));
                    s += __shfl_xor(s, 16); s += __shfl_xor(s, 32);
                    if (fq == 0) P[((ai * HALF + wr * 64 + m * 16 + fr) * 2 + bj) * 4 + wc] = s;
                    if (bj) asm volatile("" ::: "memory"); }
        bar();
        const PG8_LAS float* wp = (const PG8_LAS float*)(xlds + 10240) + (kind == 1 ? 0 : 128) + wc * 32 + 8 * fq;
        const f32x4 w0 = *(const PG8_LAS f32x4*)wp, w1 = *(const PG8_LAS f32x4*)(wp + 4);
        f32x4 ks[2][2] = {};
#pragma unroll
        for (int ai = 0; ai < 2; ++ai)
#pragma unroll
            for (int m = 0; m < 4; ++m) { bf16_t* rowp = O + (size_t)(row0 + ai * HALF + m * 16) * ldc + col0;
#pragma unroll
                for (int bj = 0; bj < 2; ++bj) { const f32x4 p = *(const PG8_LAS f32x4*)(P + ((ai * HALF + wr * 64 + m * 16 + fr) * 2 + bj) * 4);
                    const float rs = RT[ai * HALF + m * 16] / sqrtf(((p[0] + p[1]) + (p[2] + p[3])) * (1.0f / 128.0f) + eps);
                    const f32x4 v0 = acc[ai][bj][m][0] * rs * w0, v1 = acc[ai][bj][m][1] * rs * w1;
                    ks[bj][0] += v0; ks[bj][1] += v1;
                    u32x4 w; w.x = cvt_pk_bf16(v0[0], v0[1]); w.y = cvt_pk_bf16(v0[2], v0[3]); w.z = cvt_pk_bf16(v1[0], v1[1]); w.w = cvt_pk_bf16(v1[2], v1[3]);
                    *(u32x4*)(rowp + bj * HALF) = w; }
                asm volatile("" : "+v"(ks[0][0]), "+v"(ks[0][1]), "+v"(ks[1][0]), "+v"(ks[1][1]) :: "memory"); }
        if (kind == 2) {
            float v[16];
#pragma unroll
            for (int bj = 0; bj < 2; ++bj)
#pragma unroll
                for (int n = 0; n < 2; ++n)
#pragma unroll
                    for (int j = 0; j < 4; ++j) v[bj * 8 + n * 4 + j] = ks[bj][n][j];
            { const bool up = (fr & 8) != 0;
#pragma unroll
              for (int c = 0; c < 8; ++c) { const float snd = up ? v[c] : v[c + 8], keep = up ? v[c + 8] : v[c]; v[c] = keep + __shfl_xor(snd, 8); } }
            { const bool up = (fr & 4) != 0;
#pragma unroll
              for (int c = 0; c < 4; ++c) { const float snd = up ? v[c] : v[c + 4], keep = up ? v[c + 4] : v[c]; v[c] = keep + __shfl_xor(snd, 4); } }
            { const bool up = (fr & 2) != 0;
#pragma unroll
              for (int c = 0; c < 2; ++c) { const float snd = up ? v[c] : v[c + 2], keep = up ? v[c + 2] : v[c]; v[c] = keep + __shfl_xor(snd, 2); } }
            { const bool up = (fr & 1) != 0; const float snd = up ? v[0] : v[1], keep = up ? v[1] : v[0]; v[0] = keep + __shfl_xor(snd, 1); }
            KS[wr * 256 + 128 * (fr >> 3) + 32 * wc + 8 * fq + (fr & 7)] = v[0];
            bar();
            const int t = (wr * 4 + wc) * 64 + fq * 16 + fr;
            if (t < 256) { const int b = u.pm >> 4, nb = u.pm & 15, head = 2 * (u.pn & 3) + (t >> 7);
                KM[(((size_t)b * 8 + head) * 16 + nb) * 128 + (t & 127)] = (KS[t] + KS[256 + t]) * (1.0f / 256.0f); }
        }
    }
};

struct EpiResScale {
    static constexpr bool PERM = false, AFTER_DRAIN = false, KHOOK = true; static constexpr int KH0 = 16, KH1 = 24;
    const float* base; float* out; int ldc; const float* SSQ; PG8_LAS unsigned char* xlds; float eps; bool last;
    __device__ __forceinline__ PG8_LAS float* tab(int ui) const { return (PG8_LAS float*)xlds + (ui & 1) * 768; }
    __device__ __forceinline__ void unit_begin(const Unit& u, int ui, int tid) const {
        if (tid < 256) { const f32x4* sp = (const f32x4*)(SSQ + (size_t)(u.pm * BM + tid) * 64); float s0 = 0.f, s1 = 0.f;
#pragma unroll
            for (int i = 0; i < 8; ++i) { const f32x4 a = sp[i], b = sp[8 + i]; s0 += (a[0] + a[1]) + (a[2] + a[3]); s1 += (b[0] + b[1]) + (b[2] + b[3]); }
            const float m0 = s0 * (1.0f / 512.0f) + eps, m1 = s1 * (1.0f / 512.0f) + eps; PG8_LAS float* T = tab(ui);
            T[tid] = sqrtf(m0); T[256 + tid] = sqrtf(m1 / m0); T[512 + tid] = 1.0f / sqrtf(m1); }
    }
    __device__ __forceinline__ void khook(f32x4 (&acc)[2][2][4][2], int t, int ui, int wr, int fr) const {
        const PG8_LAS float* T = tab(ui) + (t == KH0 ? 0 : 256) + wr * 64 + fr;
#pragma unroll
        for (int ai = 0; ai < 2; ++ai)
#pragma unroll
            for (int m = 0; m < 4; ++m) { const float f = T[ai * HALF + m * 16];
#pragma unroll
                for (int bj = 0; bj < 2; ++bj)
#pragma unroll
                    for (int n = 0; n < 2; ++n) acc[ai][bj][m][n] = acc[ai][bj][m][n] * f; }
    }
    __device__ __forceinline__ void epi(const f32x4 (&acc)[2][2][4][2], const Unit& u, int ui, int wr, int wc, int fr, int fq) const {
        const int col0 = u.pn * BM + wc * 32 + 4 * fq; const PG8_LAS float* T = tab(ui) + 512 + wr * 64 + fr;
#pragma unroll
        for (int ai = 0; ai < 2; ++ai)
#pragma unroll
            for (int m = 0; m < 4; ++m) { const size_t off = (size_t)(u.pm * BM + ai * HALF + wr * 64 + m * 16 + fr) * ldc + col0; const float f = T[ai * HALF + m * 16];
#pragma unroll
                for (int bj = 0; bj < 2; ++bj)
#pragma unroll
                    for (int n = 0; n < 2; ++n) { const f32x4* bp = (const f32x4*)(base + off + bj * HALF + n * 16); f32x4* op = (f32x4*)(out + off + bj * HALF + n * 16);
                        if (last) { const f32x4 bs = __builtin_nontemporal_load(bp); __builtin_nontemporal_store(bs + acc[ai][bj][m][n] * f, op); }
                        else { const f32x4 bs = *bp; *op = bs + acc[ai][bj][m][n] * f; } } }
    }
};
}

#ifndef GEMM1_ALIGN
#define GEMM1_ALIGN true
#endif
#ifndef GEMM1_SP2
#define GEMM1_SP2 true
#endif
#ifndef GEMM2_ALIGN
#define GEMM2_ALIGN true
#endif
#ifndef GEMM2_SP2
#define GEMM2_SP2 true
#endif
#ifndef PFD
#define PFD 2
#endif
#ifndef PROBE_SEC
#define PROBE_SEC -1
#endif
#ifndef PROBE_MEM2
#define PROBE_MEM2 0
#endif
#ifndef PROBE_PH
#define PROBE_PH -1
#endif
constexpr int NWAVES = 8;
#ifndef MK_N_LAUNCHES
#define MK_N_LAUNCHES 1
#endif
constexpr int N_PHASES = 12;
constexpr int N_LAUNCHES = MK_N_LAUNCHES;

constexpr int BATCH = 8, SEQ = 4096, DM = 1024, DEPTH = 2;
constexpr int M = BATCH * SEQ;
constexpr int NH = 8, HD = 128;
constexpr int NSH = 16, SHD = 64, NST = 128;
constexpr int NIN = 6672;
constexpr int PITCH = 6656;
constexpr int C_Q = 0, C_Z = 1024, C_K = 2048, C_V = 3072, C_G = 4096, C_X = 5120, C_B = 6144, C_C = 6400;
constexpr int MOBA = 256, NBLK = SEQ / MOBA;
constexpr float EPS = 1e-6f;

constexpr size_t MiB = 1u << 20;
constexpr size_t WS_CTL = 0, CTL_ZERO_BYTES = 64 * 1024;
constexpr size_t WS_WIN = 1 * MiB;
constexpr size_t WS_WOUT = 14 * MiB;
constexpr size_t WS_KM = 18 * MiB;
constexpr size_t WS_DT = 19 * MiB;
constexpr size_t WS_SSQ = 21 * MiB;
constexpr size_t WS_RSTD = 31 * MiB;
constexpr size_t WS_ACS = 29 * MiB;
constexpr size_t WS_A = 32 * MiB;
constexpr size_t WS_PROJ = 96 * MiB;
constexpr size_t WS_END = 512 * MiB;
static_assert(WS_PROJ + (size_t)M * PITCH * 2 <= WS_END, "d_ws map");
constexpr int CW_TMO = 0;
constexpr int CW_BAR = 4096;
constexpr int CW_AQ = 8192;   static_assert((CW_AQ + 128) * 4 <= (int)CTL_ZERO_BYTES && (CW_BAR + 3456) <= CW_AQ, "control words inside the zeroed region");
constexpr int CW_AQ_ = 0;

constexpr int RING_OFF = 0, RING_BYTES = 131072;
constexpr int LDSCTL_OFF = 146944, MISC_OFF = LDSCTL_OFF + 320;
constexpr int LDS_BYTES = 147456;
static_assert(MISC_OFF + 128 <= LDS_BYTES && RING_BYTES <= LDSCTL_OFF, "LDS map");

#define GAS __attribute__((address_space(1)))
#define LAS __attribute__((address_space(3)))
typedef unsigned short bf16;
typedef unsigned v4u __attribute__((ext_vector_type(4)));
typedef unsigned v2u __attribute__((ext_vector_type(2)));
typedef float f32x4 __attribute__((ext_vector_type(4)));
typedef short bf16x8 __attribute__((ext_vector_type(8)));
typedef GAS unsigned gu32;
#define RLX_AGENT __ATOMIC_RELAXED, __HIP_MEMORY_SCOPE_AGENT
#define LDS_WAIT() asm volatile("s_waitcnt lgkmcnt(0)" ::: "memory")
#define VM_WAIT() asm volatile("s_waitcnt vmcnt(0)" ::: "memory")
__device__ __forceinline__ unsigned f2bf(float f) { unsigned u = __builtin_bit_cast(unsigned, f); return (u + 0x7fffu + ((u >> 16) & 1u)) >> 16; }
typedef __bf16 bf16x2_n __attribute__((ext_vector_type(2)));
__device__ __forceinline__ unsigned pk2(float lo, float hi) { bf16x2_n v = {(__bf16)lo, (__bf16)hi}; return __builtin_bit_cast(unsigned, v); }
__device__ __forceinline__ float bflo(unsigned u) { return __builtin_bit_cast(float, u << 16); }
__device__ __forceinline__ float bfhi(unsigned u) { return __builtin_bit_cast(float, u & 0xffff0000u); }
__device__ __forceinline__ float silu_f(float v) { return v * __builtin_amdgcn_rcpf(1.f + __expf(-v)); }
__device__ __forceinline__ float wave_sum(float v) {
#pragma unroll
    for (int o = 1; o < 64; o <<= 1) v += __shfl_xor(v, o);
    return v;
}
__device__ __forceinline__ float wave_max(float v) {
#pragma unroll
    for (int o = 1; o < 64; o <<= 1) v = fmaxf(v, __shfl_xor(v, o));
    return v;
}

#define XB_TMO      128
#define XB_XCNT(j)  (256  + 64 * (j))
#define XB_XSUB(j)  (1280 + 64 * (j))
#define XB_XGEN(j)  (2304 + 64 * (j))
#define XB_TOP      3328
#define XB_TOPGEN   3392
#define XCD_BAR_WORDS 3456
#define XB_SPIN_CAP (1u << 22)

__device__ __forceinline__ unsigned xb_ld(unsigned* p)              { return __hip_atomic_load(p, __ATOMIC_RELAXED, __HIP_MEMORY_SCOPE_AGENT); }
__device__ __forceinline__ unsigned xb_add(unsigned* p, unsigned v) { return __hip_atomic_fetch_add(p, v, __ATOMIC_RELAXED, __HIP_MEMORY_SCOPE_AGENT); }
__device__ __forceinline__ unsigned xb_xcc_id() { return (unsigned)__builtin_amdgcn_s_getreg((3 << 11) | 20) & 0xFu; }
#define XB_SPIN(cond, bar) do { unsigned _sp = 0; while (cond) { __builtin_amdgcn_s_sleep(1); \
    if ((++_sp & 255u) == 0u) { if (xb_ld(&(bar)[XB_TMO])) break; if (_sp > XB_SPIN_CAP) { atomicAdd(&(bar)[XB_TMO], 1u); break; } } } } while (0)

struct XcdBarrier { unsigned* bar; unsigned x; volatile LAS unsigned* st; };

__device__ __forceinline__ XcdBarrier xcd_barrier_post(unsigned* bar, volatile LAS unsigned* st) {
    XcdBarrier b; b.bar = bar; b.x = xb_xcc_id(); b.st = st;
    if (threadIdx.x == 0) (void)xb_add(&bar[XB_XCNT(b.x)], 1u);
    return b;
}
__device__ __forceinline__ void xcd_barrier_complete(unsigned* bar, unsigned x, unsigned& nloc, unsigned& nx) {
    const unsigned G = gridDim.x * gridDim.y * gridDim.z;
    unsigned sum, cnt, mine, sp = 0u;
    for (;;) {
        sum = 0u; cnt = 0u; mine = 0u;
#pragma unroll
        for (unsigned j = 0; j < 16; ++j) { const unsigned c = xb_ld(&bar[XB_XCNT(j)]); sum += c; cnt += (c > 0u) ? 1u : 0u; mine = (j == x) ? c : mine; }
        if (sum == G) break;
        __builtin_amdgcn_s_sleep(1);
        if ((++sp & 255u) == 0u) { if (xb_ld(&bar[XB_TMO])) break; if (sp > XB_SPIN_CAP) { atomicAdd(&bar[XB_TMO], 1u); break; } }
    }
    nloc = mine > 0u ? mine : 1u; nx = cnt > 0u ? cnt : 1u;
}
__device__ __forceinline__ void xcd_barrier(const XcdBarrier& b, int wave) {
    asm volatile("s_waitcnt vmcnt(0)" ::: "memory");
    __syncthreads();
    int z_ = 0; asm volatile("" : "+v"(z_));
    if (wave == 0 && __builtin_amdgcn_mbcnt_hi(~0u, __builtin_amdgcn_mbcnt_lo(~0u, (unsigned)z_)) == 0u) {
        unsigned* bar = b.bar;
        __builtin_amdgcn_s_waitcnt(0);
        unsigned nloc = b.st[0], nx = b.st[1];
        if (nloc == 0u) { xcd_barrier_complete(bar, b.x, nloc, nx); b.st[0] = nloc; b.st[1] = nx; }
        const unsigned old = xb_add(&bar[XB_XSUB(b.x)], 1u);
        const unsigned gen = old / nloc;
        if (old + 1u == (gen + 1u) * nloc) {
            __builtin_amdgcn_fence(__ATOMIC_RELEASE, "agent");
            asm volatile("s_waitcnt vmcnt(0)" ::: "memory");
            const unsigned og = xb_add(&bar[XB_TOP], 1u);
            const unsigned tg = og / nx;
            if (og + 1u == (tg + 1u) * nx) xb_add(&bar[XB_TOPGEN], 1u);
            else XB_SPIN(xb_ld(&bar[XB_TOPGEN]) == tg, bar);
            __builtin_amdgcn_fence(__ATOMIC_ACQUIRE, "agent");
            xb_add(&bar[XB_XGEN(b.x)], 1u);
            asm volatile("s_waitcnt vmcnt(0)" ::: "memory");
        } else {
            XB_SPIN(xb_ld(&bar[XB_XGEN(b.x)]) == gen, bar);
            __builtin_amdgcn_fence(__ATOMIC_ACQUIRE, "agent");
            asm volatile("s_waitcnt vmcnt(0)" ::: "memory");
        }
    }
    __syncthreads();
}

struct Frame {
    LAS unsigned char* lds;
    volatile LAS unsigned* MISC;
    int tid, lane, wave;
    int vcu, G;
};
struct Args { const float* in[12]; float* out; unsigned char* ws; int ph_lo, ph_hi, li, pad; };
template <class T> __device__ __forceinline__ T* karg_ptr(int byte_off) {
    const char __attribute__((address_space(4)))* p = (const char __attribute__((address_space(4)))*)__builtin_amdgcn_kernarg_segment_ptr();
    int o = byte_off; asm volatile("" : "+s"(o));
    return *(T* const __attribute__((address_space(4)))*)(p + o);
}
__device__ __forceinline__ const float* in_ptr(int i) { return karg_ptr<const float>(8 * i); }
__device__ __forceinline__ float* out_ptr() { return karg_ptr<float>(96); }
__device__ __forceinline__ unsigned char* ws_ptr() { return karg_ptr<unsigned char>(104); }
#define WSP(T, off) ((T*)(ws_ptr() + (off)))

__device__ __forceinline__ void transpose_item(const float* Wsrc, int ldw, int K, int ncols, bf16* WT, int row_off, LAS float* scr, int item, int lane, const float* kscale = nullptr, int kmin = 0) {
    const int nblk = ncols / 32, kb = item / nblk, nb = item % nblk, k0 = 64 * kb, n0 = 32 * nb;
#pragma unroll
    for (int i = 0; i < 8; ++i) { const int kk = (lane >> 3) + 8 * i, c4 = lane & 7;
        f32x4 v = *(const f32x4*)(Wsrc + (size_t)(k0 + kk) * ldw + n0 + 4 * c4);
        if (kscale && k0 + kk >= kmin) v = v * kscale[k0 + kk - kmin];
        LAS float* d = scr + kk * 33 + 4 * c4; d[0] = v.x; d[1] = v.y; d[2] = v.z; d[3] = v.w; }
    LDS_WAIT(); asm volatile("" ::: "memory");
    const int c = lane & 7;
#pragma unroll
    for (int j = 0; j < 4; ++j) { const int n = (lane >> 3) + 8 * j; const LAS float* s = scr + (8 * c) * 33 + n;
        v4u o; o.x = pk2(s[0 * 33], s[1 * 33]); o.y = pk2(s[2 * 33], s[3 * 33]); o.z = pk2(s[4 * 33], s[5 * 33]); o.w = pk2(s[6 * 33], s[7 * 33]);
        *(v4u*)(WT + (size_t)(row_off + n0 + n) * K + k0 + 8 * c) = o; }
    LDS_WAIT(); asm volatile("" ::: "memory");
}

__device__ __forceinline__ void phase_a(Frame& F, int layer) {
    bf16* const WinT = WSP(bf16, WS_WIN); bf16* const WoutT = WSP(bf16, WS_WOUT); bf16* const XN = WSP(bf16, WS_A); float* const DT = WSP(float, WS_DT); const float* const OUTP = out_ptr();
    const int gw = F.vcu * NWAVES + F.wave, NGW = F.G * NWAVES;
    {
        LAS float* scr = (LAS float*)(F.lds + RING_OFF + F.wave * 16384);
        const float* win = in_ptr(2) + (size_t)layer * DM * NIN;
        const float* wout = in_ptr(11) + (size_t)layer * 2048 * DM;
        constexpr int KB_IN = DM / 64;
        constexpr int I_1K = KB_IN * (1024 / 32), I_X = KB_IN * (1536 / 32), I_OUT = (2048 / 64) * (1024 / 32);
        constexpr int NITEMS = 5 * I_1K + I_X + I_OUT;
        for (int it = gw; it < NITEMS; it += NGW) {
            int r = it;
            if (r < I_1K) { transpose_item(win + 0,    NIN, DM, 1024, WinT, C_Q, scr, r, F.lane); continue; } r -= I_1K;
            if (r < I_1K) { transpose_item(win + 4096, NIN, DM, 1024, WinT, C_Z, scr, r, F.lane); continue; } r -= I_1K;
            if (r < I_1K) { transpose_item(win + 1024, NIN, DM, 1024, WinT, C_K, scr, r, F.lane); continue; } r -= I_1K;
            if (r < I_1K) { transpose_item(win + 2048, NIN, DM, 1024, WinT, C_V, scr, r, F.lane); continue; } r -= I_1K;
            if (r < I_1K) { transpose_item(win + 3072, NIN, DM, 1024, WinT, C_G, scr, r, F.lane); continue; } r -= I_1K;
            if (r < I_X)  { transpose_item(win + 5120, NIN, DM, 1536, WinT, C_X, scr, r, F.lane); continue; } r -= I_X;
            transpose_item(wout, DM, 2048, 1024, WoutT, 0, scr, r, F.lane, in_ptr(10) + (size_t)layer * 1024, 1024);
        }
    }
    __syncthreads();
    LAS unsigned short* wdb = (LAS unsigned short*)(F.lds + RING_OFF); LAS float* lnl = (LAS float*)(F.lds + RING_OFF + 32768);
    {
        const float* win = in_ptr(2) + (size_t)layer * DM * NIN + 6656; const float* lnw = in_ptr(1) + layer * DM;
        for (int i = F.tid; i < 16 * 1024; i += NWAVES * 64) { const int k = i >> 4, c = i & 15; wdb[c * 1024 + k] = (unsigned short)f2bf(win[(size_t)k * NIN + c]); }
        for (int i = F.tid; i < 1024; i += NWAVES * 64) lnl[i] = lnw[i];
    }
    __syncthreads();
    const float* xin = layer == 0 ? in_ptr(0) : OUTP;
    const float* dtb = in_ptr(7) + layer * NSH;
    float* const RSTD = WSP(float, WS_RSTD);
    const int r = F.lane & 15, g4 = F.lane >> 4;
    for (int grp = gw; grp < M / 16; grp += NGW) {
        asm volatile("" ::: "memory");
        const size_t m0 = (size_t)grp * 16;
        const char* xb = (const char*)(xin + (m0 + r) * DM + 8 * g4); char* ob = (char*)(XN + (m0 + r) * DM + 8 * g4);
        f32x4 acc = {0.f, 0.f, 0.f, 0.f}; float ssq = 0.f;
#pragma unroll 8
        for (int kk = 0; kk < 32; ++kk) {
            const f32x4 a = __builtin_nontemporal_load((const f32x4*)(xb + kk * 128)), b = __builtin_nontemporal_load((const f32x4*)(xb + kk * 128 + 16));
            const f32x4 la = *(const LAS f32x4*)(lnl + 32 * kk + 8 * g4), lb = *(const LAS f32x4*)(lnl + 32 * kk + 8 * g4 + 4);
            ssq += ((a.x * a.x + a.y * a.y) + (a.z * a.z + a.w * a.w)) + ((b.x * b.x + b.y * b.y) + (b.z * b.z + b.w * b.w));
            const f32x4 ha = a * la, hb = b * lb;
            v4u pk; pk.x = pk2(ha.x, ha.y); pk.y = pk2(ha.z, ha.w); pk.z = pk2(hb.x, hb.y); pk.w = pk2(hb.z, hb.w);
            *(v4u*)(ob + kk * 64) = pk;
            const bf16x8 wf = *(const LAS bf16x8*)(wdb + r * 1024 + 32 * kk + 8 * g4);
            acc = __builtin_amdgcn_mfma_f32_16x16x32_bf16(wf, __builtin_bit_cast(bf16x8, pk), acc, 0, 0, 0);
        }
        ssq += __shfl_xor(ssq, 16); ssq += __shfl_xor(ssq, 32);
        const float rstd = 1.f / sqrtf(ssq * (1.f / DM) + EPS);
        if (g4 == 0) RSTD[m0 + r] = rstd;
        f32x4 o;
#pragma unroll
        for (int i = 0; i < 4; ++i) { const float a = acc[i] * rstd + dtb[4 * g4 + i], u = __expf(-fabsf(a));
            o[i] = fmaxf(a, 0.f) + (u < 1e-3f ? u * (1.f - u * (0.5f - 0.33333334f * u)) : __logf(1.f + u)); }
        *(f32x4*)(DT + (m0 + r) * 16 + 4 * g4) = o;
    }
}

__device__ __forceinline__ void phase_c(Frame& F, int layer) {
    bf16* const PROJ = WSP(bf16, WS_PROJ); bf16* const BCc = WSP(bf16, WS_A); float* const KM = WSP(float, WS_KM);
    {
        const float* const DT = WSP(float, WS_DT); float* const ACS = WSP(float, WS_ACS); const float* alog = in_ptr(8) + layer * NSH;
        const int gw = F.vcu * NWAVES + F.wave, NGW = F.G * NWAVES;
        for (int i = gw; i < (M / 64) * NSH; i += NGW) {
            const int h = i & 15; const size_t idx = ((size_t)(i >> 4) * 64 + F.lane) * 16 + h;
            float a = DT[idx] * -__expf(alog[h]);
#pragma unroll
            for (int o = 1; o < 64; o <<= 1) { const float t = __shfl_up(a, o); if (F.lane >= o) a += t; }
            ACS[idx] = a;
        }
    }
    const float* cw = in_ptr(5) + (size_t)layer * 4 * 1536 + 1024;
    const float* cb = in_ptr(6) + (size_t)layer * 1536 + 1024;
    const int gt = F.vcu * (NWAVES * 64) + F.tid, NGT = F.G * NWAVES * 64;
    for (int i = gt; i < M * 64; i += NGT) {
        const int m = i >> 6, c8 = (i & 63) * 8, t = m & (SEQ - 1);
        float acc[8];
#pragma unroll
        for (int e = 0; e < 8; ++e) acc[e] = cb[c8 + e];
#pragma unroll
        for (int k = 0; k < 4; ++k) {
            if (t - 3 + k >= 0) {
                const v4u u = *(const v4u*)(PROJ + (size_t)(m - 3 + k) * PITCH + C_B + c8);
                const float* w = cw + k * 1536 + c8;
                acc[0] += w[0] * bflo(u.x); acc[1] += w[1] * bfhi(u.x); acc[2] += w[2] * bflo(u.y); acc[3] += w[3] * bfhi(u.y);
                acc[4] += w[4] * bflo(u.z); acc[5] += w[5] * bfhi(u.z); acc[6] += w[6] * bflo(u.w); acc[7] += w[7] * bfhi(u.w);
            }
        }
        v4u o; o.x = pk2(silu_f(acc[0]), silu_f(acc[1])); o.y = pk2(silu_f(acc[2]), silu_f(acc[3])); o.z = pk2(silu_f(acc[4]), silu_f(acc[5])); o.w = pk2(silu_f(acc[6]), silu_f(acc[7]));
        *(v4u*)(BCc + (size_t)m * 512 + c8) = o;
    }
}


namespace ssd {
typedef float f32x4v __attribute__((ext_vector_type(4)));
typedef short s16x4v __attribute__((ext_vector_type(4)));
constexpr int L = 64, S256 = 272, S64 = 144, S32 = 144;
constexpr int O_BS = 0, O_CS = O_BS + 64 * S256, O_XB = O_CS + 64 * S256, O_XW = O_XB + 64 * S32, O_MT = O_XW + 64 * S32, O_ST = O_MT + 64 * S64,
              O_TB = O_ST + 2 * 64 * S256, O_CS2 = O_TB + NWAVES * 1024, O_XB2 = O_CS2 + 64 * S256, O_END = O_XB2 + 64 * S32;
static_assert(O_END <= LDSCTL_OFF, "SSD LDS map");
#define LD128(off) (*(const LAS bf16x8*)(lds + (off)))
#define MFMA16(a, b, c) __builtin_amdgcn_mfma_f32_16x16x32_bf16(a, b, c, 0, 0, 0)
#define TRRD(dst, addr, off) asm volatile("ds_read_b64_tr_b16 %0, %1 offset:%2" : "=&v"(dst) : "v"(addr), "i"(off) : "memory")
#define TRWAIT() do { asm volatile("s_waitcnt lgkmcnt(0)" ::: "memory"); __builtin_amdgcn_sched_barrier(0); } while (0)
#define CAT8(lo, hi) ((bf16x8){lo[0], lo[1], lo[2], lo[3], hi[0], hi[1], hi[2], hi[3]})
typedef __bf16 bf16x2n __attribute__((ext_vector_type(2)));
__device__ __forceinline__ unsigned cvtpk(float lo, float hi) { bf16x2n v = {(__bf16)lo, (__bf16)hi}; return __builtin_bit_cast(unsigned, v); }
__device__ __forceinline__ float silu_fast(float v) { return v * __builtin_amdgcn_rcpf(1.f + __expf(-v)); }

__device__ __forceinline__ void item(LAS unsigned char* lds, int wave_, int layer, int b, int h) {
    int z_ = 0; asm volatile("" : "+v"(z_));
    const int wid = wave_, lane = (int)__builtin_amdgcn_mbcnt_hi(~0u, __builtin_amdgcn_mbcnt_lo(~0u, (unsigned)z_)), tid = wid * 64 + lane, fr = lane & 15, fq = lane >> 4;
    const int g = h >> 3;
    const float Dh = in_ptr(9)[layer * NSH + h];
    const int brow = tid >> 4, bch = tid & 15;
    const int xl = tid >> 3, xpg = tid & 7;
    const int xcol = h * SHD + 4 * xpg;
    float cw[2][4][4], cbv[2][4];
    { const float* cwp = in_ptr(5) + (size_t)layer * 4 * 1536 + xcol; const float* cbp = in_ptr(6) + (size_t)layer * 1536 + xcol;
#pragma unroll
      for (int j = 0; j < 2; ++j) {
#pragma unroll
      for (int k = 0; k < 4; ++k)
#pragma unroll
          for (int e = 0; e < 4; ++e) cw[j][k][e] = cwp[k * 1536 + 32 * j + e];
#pragma unroll
      for (int e = 0; e < 4; ++e) cbv[j][e] = cbp[32 * j + e]; } }
    const char* pBC = (const char*)(WSP(bf16, WS_A) + (size_t)b * SEQ * 512 + g * 128);
    const char* pX = (const char*)(WSP(bf16, WS_PROJ) + (size_t)b * SEQ * PITCH + C_X);
    char* pZ = (char*)(WSP(bf16, WS_PROJ) + (size_t)b * SEQ * PITCH + C_Z + h * SHD);
    const char* pDT = (const char*)(WSP(float, WS_DT) + (size_t)b * SEQ * 16 + h);
    const char* pAC = (const char*)(WSP(float, WS_ACS) + (size_t)b * SEQ * 16 + h);
    float* pSQ = WSP(float, WS_SSQ) + (size_t)b * SEQ * 64 + h * 4;
    const unsigned obc = (unsigned)(brow * 512 + bch * 8) * 2u;
    const int oxr = (xl - 3) * PITCH * 2 + xcol * 2;
    const unsigned odt = (unsigned)lane * 64u;
    const int tl = wid >> 1, ts0 = 2 * (wid & 1), tpC = wid & 1, tn = wid;
    const unsigned ozy = (unsigned)((16 * tl + fr) * PITCH + 32 * tpC + 4 * fq) * 2u;
    const int trq = fr >> 2, trp = fr & 3;
    const int aXB = (int)(unsigned)(size_t)(lds + O_XB) + (8 * fq + trq) * S32 + (4 * trp) * 2;
    const int aXBc = aXB + 64 * tpC;
    const int aXW = (int)(unsigned)(size_t)(lds + O_XW) + (8 * fq + trq) * S32 + (4 * trp) * 2;
    const int aBS = (int)(unsigned)(size_t)(lds + O_BS) + (8 * fq + trq) * S256 + (16 * tn + 4 * trp) * 2;
    f32x4v accS[4] = {};
    for (int i = tid; i < 64 * S256 / 4; i += NWAVES * 64) ((LAS unsigned*)(lds + O_ST))[i] = 0u;
    LAS float* const tb = (LAS float*)(lds + O_TB + wid * 1024);
    v4u bu0_0, bu1_0, cu0_0, cu1_0, bu0_1, bu1_1, cu0_1, cu1_1; v2u xr_0[2][4], xr_1[2][4], zr_0[2], zr_1[2]; float dtn_0, dtn_1, acn_0, acn_1;
#define SSD_LOAD(c, S_) do { const char* bc_ = pBC + (size_t)(c) * (L * 512 * 2); const char* px_ = pX + (size_t)(c) * (L * PITCH * 2); \
        bu0_##S_ = *(const v4u*)(bc_ + obc); bu1_##S_ = *(const v4u*)(bc_ + obc + 32 * 512 * 2); cu0_##S_ = *(const v4u*)(bc_ + obc + 512); cu1_##S_ = *(const v4u*)(bc_ + obc + 32 * 512 * 2 + 512); \
        _Pragma("unroll") for (int j = 0; j < 2; ++j) _Pragma("unroll") for (int k = 0; k < 4; ++k) xr_##S_[j][k] = ((c) * L + xl - 3 + k >= 0) ? *(const v2u*)(px_ + (oxr + k * PITCH * 2 + 64 * j)) : (v2u){0u, 0u}; \
        dtn_##S_ = *(const float*)(pDT + (size_t)(c) * (L * 64) + odt); acn_##S_ = *(const float*)(pAC + (size_t)(c) * (L * 64) + odt); \
        zr_##S_[0] = *(const v2u*)(pZ + (size_t)(c) * (L * PITCH * 2) + ozy); zr_##S_[1] = *(const v2u*)(pZ + (size_t)(c) * (L * PITCH * 2) + ozy + 32); } while (0)
#define SSD_STEP(c, S_) do { \
        constexpr int OCS = (S_) ? O_CS2 : O_CS, OXB = (S_) ? O_XB2 : O_XB;     \
        const int aXBs = aXBc + (OXB - O_XB); \
          \
        const float dtv = dtn_##S_, acs = acn_##S_; \
        const float tot = __builtin_bit_cast(float, __builtin_amdgcn_readlane(__builtin_bit_cast(int, acs), 63)); \
        const float ea = __expf(acs); \
        tb[lane] = acs; tb[64 + lane] = dtv; tb[128 + lane] = __expf(tot - acs) * dtv; tb[192 + lane] = ea; \
        const v2u zq0 = zr_##S_[0], zq1 = zr_##S_[1]; \
          \
        { \
            *(LAS v4u*)(lds + O_BS + brow * S256 + bch * 16) = bu0_##S_; *(LAS v4u*)(lds + O_BS + (32 + brow) * S256 + bch * 16) = bu1_##S_; \
            *(LAS v4u*)(lds + OCS + brow * S256 + bch * 16) = cu0_##S_; *(LAS v4u*)(lds + OCS + (32 + brow) * S256 + bch * 16) = cu1_##S_; \
            asm volatile("s_waitcnt lgkmcnt(0)" ::: "memory"); \
            const float wl = tb[128 + xl]; \
            _Pragma("unroll") for (int j = 0; j < 2; ++j) { \
                float xv[4]; \
                _Pragma("unroll") for (int e = 0; e < 4; ++e) xv[e] = cbv[j][e]; \
                _Pragma("unroll") for (int k = 0; k < 4; ++k) { xv[0] += cw[j][k][0] * bflo(xr_##S_[j][k].x); xv[1] += cw[j][k][1] * bfhi(xr_##S_[j][k].x); xv[2] += cw[j][k][2] * bflo(xr_##S_[j][k].y); xv[3] += cw[j][k][3] * bfhi(xr_##S_[j][k].y); } \
                _Pragma("unroll") for (int e = 0; e < 4; ++e) xv[e] = silu_fast(xv[e]); \
                *(LAS v2u*)(lds + OXB + xl * S32 + xpg * 8 + 64 * j) = (v2u){cvtpk(xv[0], xv[1]), cvtpk(xv[2], xv[3])}; \
                *(LAS v2u*)(lds + O_XW + xl * S32 + xpg * 8 + 64 * j) = (v2u){cvtpk(xv[0] * wl, xv[1] * wl), cvtpk(xv[2] * wl, xv[3] * wl)}; } \
        } \
        __syncthreads(); \
        if ((c) + 2 < SEQ / L) SSD_LOAD((c) + 2, S_);                          \
          \
        { \
            bf16x8 cf[4]; \
            _Pragma("unroll") for (int kk = 0; kk < 4; ++kk) cf[kk] = LD128(OCS + (16 * tl + fr) * S256 + (32 * kk + 8 * fq) * 2); \
            const float al = tb[16 * tl + fr];                                 \
            const int l = 16 * tl + fr; \
            _Pragma("unroll") for (int j = 0; j < 2; ++j) { \
                const int ts = ts0 + j; \
                if (ts <= tl) { \
                    f32x4v gacc = {}; \
                    _Pragma("unroll") for (int kk = 0; kk < 4; ++kk) gacc = MFMA16(LD128(O_BS + (16 * ts + fr) * S256 + (32 * kk + 8 * fq) * 2), cf[kk], gacc);     \
                    const f32x4v as4 = *(const LAS f32x4v*)(tb + 16 * ts + 4 * fq), ds4 = *(const LAS f32x4v*)(tb + 64 + 16 * ts + 4 * fq); \
                    float mv[4]; \
                    _Pragma("unroll") for (int r = 0; r < 4; ++r) mv[r] = (16 * ts + 4 * fq + r <= l) ? gacc[r] * __expf(al - as4[r]) * ds4[r] : 0.f; \
                    *(LAS v2u*)(lds + O_MT + l * S64 + (16 * ts + 4 * fq) * 2) = (v2u){cvtpk(mv[0], mv[1]), cvtpk(mv[2], mv[3])}; \
                } else { \
                    *(LAS v2u*)(lds + O_MT + l * S64 + (16 * ts + 4 * fq) * 2) = (v2u){0u, 0u}; \
                } \
            } \
            const float dec = __expf(tot); \
            s16x4v b0, b1, b2, b3; \
            TRRD(b0, aBS, 0); TRRD(b1, aBS, 4 * S256); TRRD(b2, aBS, 32 * S256); TRRD(b3, aBS, 36 * S256); \
            _Pragma("unroll") for (int tp = 0; tp < 4; ++tp) { s16x4v x0, x1, x2, x3; \
                TRRD(x0, aXW, 32 * tp); TRRD(x1, aXW, 4 * S32 + 32 * tp); TRRD(x2, aXW, 32 * S32 + 32 * tp); TRRD(x3, aXW, 36 * S32 + 32 * tp); \
                TRWAIT(); \
                accS[tp] = accS[tp] * dec; \
                accS[tp] = MFMA16(CAT8(b0, b1), CAT8(x0, x1), accS[tp]); accS[tp] = MFMA16(CAT8(b2, b3), CAT8(x2, x3), accS[tp]);     \
            } \
            _Pragma("unroll") for (int tp = 0; tp < 4; ++tp) \
                *(LAS v2u*)(lds + O_ST + (cur ^ 1) * 64 * S256 + (16 * tp + fr) * S256 + (16 * tn + 4 * fq) * 2) = (v2u){cvtpk(accS[tp][0], accS[tp][1]), cvtpk(accS[tp][2], accS[tp][3])}; \
        } \
        __syncthreads(); \
          \
        { \
            const bf16x8 m0f = LD128(O_MT + (16 * tl + fr) * S64 + (8 * fq) * 2), m1f = LD128(O_MT + (16 * tl + fr) * S64 + (32 + 8 * fq) * 2); \
            bf16x8 cfr[4]; \
            _Pragma("unroll") for (int kk = 0; kk < 4; ++kk) cfr[kk] = LD128(OCS + (16 * tl + fr) * S256 + (32 * kk + 8 * fq) * 2); \
            const float eal = tb[192 + 16 * tl + fr]; \
            _Pragma("unroll") for (int j = 0; j < 2; ++j) { \
                s16x4v x0, x1, x2, x3; \
                TRRD(x0, aXBs, 32 * j); TRRD(x1, aXBs, 4 * S32 + 32 * j); TRRD(x2, aXBs, 32 * S32 + 32 * j); TRRD(x3, aXBs, 36 * S32 + 32 * j); \
                TRWAIT(); \
                f32x4v yd = {}, yo = {}; \
                yd = MFMA16(CAT8(x0, x1), m0f, yd); yd = MFMA16(CAT8(x2, x3), m1f, yd); \
                _Pragma("unroll") for (int kk = 0; kk < 4; ++kk) yo = MFMA16(LD128(O_ST + cur * 64 * S256 + (32 * tpC + 16 * j + fr) * S256 + (32 * kk + 8 * fq) * 2), cfr[kk], yo); \
                const v2u xb = *(const LAS v2u*)(lds + OXB + (16 * tl + fr) * S32 + (32 * tpC + 16 * j + 4 * fq) * 2); \
                const v2u zr = j ? zq1 : zq0;                                 \
                float yz[4]; \
                yz[0] = (yd[0] + eal * yo[0] + Dh * bflo(xb.x)) * bflo(zr.x); yz[1] = (yd[1] + eal * yo[1] + Dh * bfhi(xb.x)) * bfhi(zr.x); \
                yz[2] = (yd[2] + eal * yo[2] + Dh * bflo(xb.y)) * bflo(zr.y); yz[3] = (yd[3] + eal * yo[3] + Dh * bfhi(xb.y)) * bfhi(zr.y); \
                *(v2u*)(pZ + (size_t)(c) * (L * PITCH * 2) + ozy + 32 * j) = (v2u){cvtpk(yz[0], yz[1]), cvtpk(yz[2], yz[3])}; \
                float q = (yz[0] * yz[0] + yz[1] * yz[1]) + (yz[2] * yz[2] + yz[3] * yz[3]); \
                q += __shfl_xor(q, 16); q += __shfl_xor(q, 32); \
                if (fq == 0) pSQ[((size_t)(c) * L + 16 * tl + fr) * 64 + 2 * tpC + j] = q; } \
        } \
          \
        cur ^= 1; } while (0)
    SSD_LOAD(0, 0); SSD_LOAD(1, 1);
    int cur = 0;
#pragma unroll 1
    for (int c = 0; c < SEQ / L; c += 2) { SSD_STEP(c, 0); SSD_STEP(c + 1, 1); }
    __syncthreads();
#undef SSD_STEP
#undef SSD_LOAD
}
#undef LD128
#undef MFMA16
#undef TRRD
#undef TRWAIT
#undef CAT8
}


__device__ __forceinline__ void ssd_phase(Frame& F, int layer) {
    if ((F.vcu & 1) == 0) for (int it = F.vcu >> 1; it < BATCH * NSH; it += (F.G + 1) >> 1) ssd::item(F.lds + RING_OFF, F.wave, layer, it >> 4, it & 15);
}


namespace moba {
typedef float f32x16 __attribute__((ext_vector_type(16)));
typedef short s16x4 __attribute__((ext_vector_type(4)));
typedef unsigned u32x4 __attribute__((ext_vector_type(4)));
constexpr int NW = 8, QBLK = 32, KVBLK = 64, QB = NW * QBLK;
constexpr int SHM_V = KVBLK * HD * 2, SHM_K = KVBLK * HD * 2;
constexpr int OFF_V = 0, OFF_K = 3 * SHM_V, OFF_WS = 3 * SHM_V + 3 * SHM_K, OFF_KM = OFF_WS + NW * 64 * 4;
constexpr int ATTN_LDS = OFF_KM + 32 * 256;
constexpr float SCALE = 0.08838834764831845f, LOG2E = 1.4426950408889634f;

#define KSWZ(row, colB) ((row) * 256 + ((colB) ^ (((row) & 7) << 4)))
#define SBAR() __builtin_amdgcn_sched_barrier(0)
__device__ __forceinline__ int v_st(int k, int c) { const int kk = (k & ~0xC) | ((k & 4) << 1) | ((k & 8) >> 1); return ((kk >> 3) * 4 + (c >> 5)) * 512 + ((kk & 7) * 32 + (c & 31)) * 2; }
__device__ __forceinline__ int v_rd_base(int lane) { return ((lane & 3) << 3) | (((lane >> 2) & 3) << 6) | (((lane >> 4) & 1) << 5) | (((lane >> 5) & 1) << 8); }
constexpr int v_rd_off(int d0, int ks, int half) { return d0 * 512 + ks * 4096 + half * 2048; }
__device__ __forceinline__ int crow(int r, int hi) { return (r & 3) + 8 * (r >> 2) + 4 * hi; }
typedef __bf16 bf16x2n __attribute__((ext_vector_type(2)));
__device__ __forceinline__ unsigned cvtpk(float lo, float hi) { bf16x2n v = {(__bf16)lo, (__bf16)hi}; return __builtin_bit_cast(unsigned, v); }

struct Unit { const bf16* Q; const bf16* K; const bf16* V; const float* KM; int qb, h, jlo;
#if PROBE_MEM2 == 1
    long dum; __device__ __forceinline__ long dumv() const { return dum; }
#else
    __device__ __forceinline__ long dumv() const { return 0; }
#endif
};
struct Seam { bf16x8 qr[8]; bf16x8 st_v0, st_v1, st_k0, st_k1; };
constexpr int OFF_ORD = 108 * 1024, OFF_TK = OFF_ORD + 2048, OFF_WT = OFF_TK + 16;
struct Queue { unsigned* ctr; bf16* PROJ; const float* KM; };
__device__ __forceinline__ bool unit_from_ticket(unsigned t, const Queue& q, const LAS char* lds, Unit& u) {
    if (t >= (unsigned)(BATCH * NH * NBLK)) return false;
    const int id = __builtin_amdgcn_readfirstlane((int)((const LAS unsigned short*)(lds + OFF_ORD))[t]), b = id >> 7, h = (id >> 4) & 7, qb = id & 15;
    const int w = __builtin_amdgcn_readfirstlane(((const LAS int*)(lds + OFF_WT))[h]);
    const bf16* base = q.PROJ + (size_t)b * SEQ * PITCH + h * HD;
    u.Q = base + (size_t)qb * MOBA * PITCH + C_Q; u.K = base + C_K; u.V = base + C_V; u.KM = q.KM + (size_t)(b * NH + h) * NBLK * HD; u.qb = qb; u.h = h;
    u.jlo = qb > w ? 4 * (qb - w) : 0;
#if PROBE_MEM2 == 1
    u.dum = (b < 4 ? 1 : -1) * (long)(4 * SEQ) * PITCH * 2;
#endif
    return true;
}

__device__ __forceinline__ void mask_tile(f32x16& p0, f32x16& p1, int dq) {
    const float NEG = -__builtin_inff();
#pragma unroll
    for (int r = 0; r < 16; ++r) { const int c = (r & 3) + 8 * (r >> 2); if (dq - c < 0) p0[r] = NEG; if (dq - c - 32 < 0) p1[r] = NEG; }
}
__device__ __forceinline__ void partialSM(f32x16& p0, f32x16& p1, float base, float slope2) {
    constexpr float C2 = LOG2E * SCALE;
#pragma unroll
    for (int r = 0; r < 16; ++r) { const float c = (float)((r & 3) + 8 * (r >> 2)); p0[r] = fmaf(p0[r], C2, fmaf(slope2, c, base)); p1[r] = fmaf(p1[r], C2, fmaf(slope2, c + 32.f, base)); }
#pragma unroll
    for (int r = 0; r < 16; ++r) p0[r] = __builtin_amdgcn_exp2f(p0[r]);
}
__device__ __forceinline__ void finishSM(f32x16& p0, f32x16& p1, float& l_reg, bf16x8& pa0, bf16x8& pa1, bf16x8& pa2, bf16x8& pa3) {
#pragma unroll
    for (int r = 0; r < 16; ++r) p1[r] = __builtin_amdgcn_exp2f(p1[r]);
    float ps = 0;
#pragma unroll
    for (int r = 0; r < 16; ++r) ps += p0[r];
#pragma unroll
    for (int r = 0; r < 16; ++r) ps += p1[r];
    { auto rr = __builtin_amdgcn_permlane32_swap(__float_as_uint(ps), __float_as_uint(ps), false, false); ps = __uint_as_float(rr[0]) + __uint_as_float(rr[1]); }
    l_reg += ps;
#define PK4(P, B_, OUT) do { unsigned a0 = cvtpk(P[B_+0], P[B_+1]), a1 = cvtpk(P[B_+2], P[B_+3]); unsigned b0 = cvtpk(P[B_+4], P[B_+5]), b1 = cvtpk(P[B_+6], P[B_+7]); \
        auto r0 = __builtin_amdgcn_permlane32_swap(a0, b0, false, false); auto r1 = __builtin_amdgcn_permlane32_swap(a1, b1, false, false); \
        u32x4 w = {r0[0], r1[0], r0[1], r1[1]}; OUT = *reinterpret_cast<bf16x8*>(&w); } while (0)
    PK4(p0, 0, pa0); PK4(p0, 8, pa1); PK4(p1, 0, pa2); PK4(p1, 8, pa3);
#undef PK4
}
__device__ __forceinline__ void qkt(f32x16& p0, f32x16& p1, const LAS char* const (&kbase)[4], int kslot, const bf16x8* qr) {
    p0 = f32x16{}; p1 = f32x16{};
#pragma unroll
    for (int d0 = 0; d0 < 8; ++d0) { const LAS char* a = kbase[d0 & 3] + kslot + (d0 >> 2) * 128;
        bf16x8 b0 = *reinterpret_cast<const LAS bf16x8*>(a);
        bf16x8 b1 = *reinterpret_cast<const LAS bf16x8*>(a + 32 * 256);
        p0 = __builtin_amdgcn_mfma_f32_32x32x16_bf16(b0, qr[d0], p0, 0, 0, 0);
        p1 = __builtin_amdgcn_mfma_f32_32x32x16_bf16(b1, qr[d0], p1, 0, 0, 0); }
}
__device__ __forceinline__ void pv_tile(f32x16* o, int vb0, bf16x8 pa0, bf16x8 pa1, bf16x8 pa2, bf16x8 pa3) {
#define TRRD(dst, off) asm volatile("ds_read_b64_tr_b16 %0, %1 offset:%2" : "=&v"(dst) : "v"(vb0), "i"(off) : "memory")
#define PV_D0(d0) do { s16x4 l0, l1, l2, l3, h0, h1, h2, h3; constexpr int b_ = v_rd_off(d0, 0, 0); \
        TRRD(l0, b_); TRRD(h0, b_ + 2048); TRRD(l1, b_ + 4096); TRRD(h1, b_ + 6144); TRRD(l2, b_ + 8192); TRRD(h2, b_ + 10240); TRRD(l3, b_ + 12288); TRRD(h3, b_ + 14336); \
        asm volatile("s_waitcnt lgkmcnt(0)" ::: "memory"); SBAR(); \
        o[d0] = __builtin_amdgcn_mfma_f32_32x32x16_bf16(pa0, (bf16x8){l0[0], l0[1], l0[2], l0[3], h0[0], h0[1], h0[2], h0[3]}, o[d0], 0, 0, 0); \
        o[d0] = __builtin_amdgcn_mfma_f32_32x32x16_bf16(pa1, (bf16x8){l1[0], l1[1], l1[2], l1[3], h1[0], h1[1], h1[2], h1[3]}, o[d0], 0, 0, 0); \
        o[d0] = __builtin_amdgcn_mfma_f32_32x32x16_bf16(pa2, (bf16x8){l2[0], l2[1], l2[2], l2[3], h2[0], h2[1], h2[2], h2[3]}, o[d0], 0, 0, 0); \
        o[d0] = __builtin_amdgcn_mfma_f32_32x32x16_bf16(pa3, (bf16x8){l3[0], l3[1], l3[2], l3[3], h3[0], h3[1], h3[2], h3[3]}, o[d0], 0, 0, 0); } while (0)
    PV_D0(0); PV_D0(1); PV_D0(2); PV_D0(3);
#undef PV_D0
#undef TRRD
}

#define TILEP(p, k0) ((const char*)((p) + (size_t)(k0) * PITCH))
#define VMW() asm volatile("s_waitcnt vmcnt(0)" ::: "memory")
#define VMWN(n) asm volatile("s_waitcnt vmcnt(%0)" :: "i"(n) : "memory")
#define LD8(p) (*reinterpret_cast<const bf16x8*>(p))
#define LD8O(base, off) (*reinterpret_cast<const bf16x8*>((base) + (off)))
#if PROBE_MEM2 == 1
#define DUMV cur.dum
#define SLOAD_DUM(vt_, kt_) do { LAS unsigned* dl_ = (LAS unsigned*)(lds + 114688 + wid * 1024); \
        __builtin_amdgcn_global_load_lds((const unsigned*)(vt_ + DUMV + roff0), dl_, 16, 0, 0); __builtin_amdgcn_global_load_lds((const unsigned*)(vt_ + DUMV + roff1), dl_, 16, 0, 0); \
        __builtin_amdgcn_global_load_lds((const unsigned*)(kt_ + DUMV + roff0), dl_, 16, 0, 0); __builtin_amdgcn_global_load_lds((const unsigned*)(kt_ + DUMV + roff1), dl_, 16, 0, 0); } while (0)
#define SLOAD_DUMN(vt_, kt_) do { LAS unsigned* dl_ = (LAS unsigned*)(lds + 114688 + wid * 1024); \
        __builtin_amdgcn_global_load_lds((const unsigned*)(vt_ + dumn_ + roff0), dl_, 16, 0, 0); __builtin_amdgcn_global_load_lds((const unsigned*)(vt_ + dumn_ + roff1), dl_, 16, 0, 0); \
        __builtin_amdgcn_global_load_lds((const unsigned*)(kt_ + dumn_ + roff0), dl_, 16, 0, 0); __builtin_amdgcn_global_load_lds((const unsigned*)(kt_ + dumn_ + roff1), dl_, 16, 0, 0); } while (0)
#else
#define SLOAD_DUM(vt_, kt_) do { } while (0)
#define SLOAD_DUMN(vt_, kt_) do { } while (0)
#endif
#define SLOAD_HN(Kp, Vp, k0) do { const char* vt_ = TILEP(Vp, k0); const char* kt_ = TILEP(Kp, k0); S.st_v0 = LD8O(vt_, roff0); S.st_v1 = LD8O(vt_, roff1); S.st_k0 = LD8O(kt_, roff0); S.st_k1 = LD8O(kt_, roff1); SLOAD_DUMN(vt_, kt_); } while (0)
#if PROBE_MEM2 == 2
#define SLOAD_H(Kp, Vp, k0) do { const char* vt_ = TILEP(Vp, k0); const char* kt_ = TILEP(Kp, k0); S.st_v0 = LD8O(vt_, roff0); S.st_v1 = LD8O(vt_, roff1); S.st_k0 = LD8O(kt_, roff0); S.st_k1 = LD8O(kt_, roff1); \
        { const int kp_ = min((k0) + PFD * KVBLK, kmax_); const char* vp_ = TILEP(Vp, kp_); const char* kq_ = TILEP(Kp, kp_); LAS unsigned* dl_ = (LAS unsigned*)(lds + 114688 + wid * 1024); \
          __builtin_amdgcn_global_load_lds((const unsigned*)(vp_ + roff0), dl_, 16, 0, 0); __builtin_amdgcn_global_load_lds((const unsigned*)(vp_ + roff1), dl_, 16, 0, 0); \
          __builtin_amdgcn_global_load_lds((const unsigned*)(kq_ + roff0), dl_, 16, 0, 0); __builtin_amdgcn_global_load_lds((const unsigned*)(kq_ + roff1), dl_, 16, 0, 0); } } while (0)
#else
#define SLOAD_H(Kp, Vp, k0) do { const char* vt_ = TILEP(Vp, k0); const char* kt_ = TILEP(Kp, k0); S.st_v0 = LD8O(vt_, roff0); S.st_v1 = LD8O(vt_, roff1); S.st_k0 = LD8O(kt_, roff0); S.st_k1 = LD8O(kt_, roff1); SLOAD_DUM(vt_, kt_); } while (0)
#endif
#define SWRITE_HK(so) do { *(LAS bf16x8*)(K_lds + (so) + kws) = S.st_k0; *(LAS bf16x8*)(K_lds + (so) + kws + 32 * 256) = S.st_k1; } while (0)
#define SWRITE_HV(so) do { *(LAS bf16x8*)(V_lds + (so) + vst0) = S.st_v0; *(LAS bf16x8*)(V_lds + (so) + vst1) = S.st_v1; } while (0)
#define SWRITE_H(so) do { SWRITE_HV(so); SWRITE_HK(so); } while (0)

__device__ __forceinline__ void prime(const Unit& cur, LAS char* lds, Seam& S, int wave_) {
    int z_ = 0; asm volatile("" : "+v"(z_)); const int tid = wave_ * 64 + (int)__builtin_amdgcn_mbcnt_hi(~0u, __builtin_amdgcn_mbcnt_lo(~0u, (unsigned)z_));
    const int wid = __builtin_amdgcn_readfirstlane(tid >> 6), lane = tid & 63, r32 = lane & 31, hi = lane >> 5;
    const int sr = tid >> 4, sc = (tid & 15) * 8, kws = KSWZ(sr, sc * 2); LAS char* K_lds = lds + OFF_K;
    const unsigned roff0 = (unsigned)(sr * PITCH + sc) * 2u, roff1 = roff0 + 32u * PITCH * 2u, qoff = (unsigned)(r32 * PITCH + hi * 8) * 2u;
    { const char* qb_ = (const char*)(cur.Q + (size_t)(wid * QBLK) * PITCH);
#pragma unroll
    for (int d0 = 0; d0 < 8; ++d0) S.qr[d0] = LD8O(qb_, qoff + d0 * 32); }
    const int kmax_ = (4 * (cur.qb + 1) - 1) * KVBLK; (void)kmax_;
    SLOAD_H(cur.K, cur.V, cur.jlo * KVBLK); VMW(); SWRITE_HK(0);
    __syncthreads();
}
__device__ __forceinline__ void block(const Unit& cur, Unit& nxt, bool& more, const Queue& Qd, float slope2, float M2, LAS char* lds, Seam& S, int wave_, unsigned long long& pacc) {
#define PS0(k) unsigned long long pt##k##_ = 0; if (PROBE_SEC == (k)) pt##k##_ = __builtin_amdgcn_s_memtime()
#define PS1(k) do { if (PROBE_SEC == (k)) pacc += __builtin_amdgcn_s_memtime() - pt##k##_; } while (0)
    PS0(6); PS0(4);
    int z_ = 0; asm volatile("" : "+v"(z_)); const int tid = wave_ * 64 + (int)__builtin_amdgcn_mbcnt_hi(~0u, __builtin_amdgcn_mbcnt_lo(~0u, (unsigned)z_));
    const int wid = __builtin_amdgcn_readfirstlane(tid >> 6), lane = tid & 63, r32 = lane & 31, hi = lane >> 5;
    const unsigned roff0 = (unsigned)((tid >> 4) * PITCH + (tid & 15) * 8) * 2u, roff1 = roff0 + 32u * PITCH * 2u, qoff = (unsigned)(r32 * PITCH + hi * 8) * 2u;
    const int jlo = cur.jlo, NT = 4 * (cur.qb + 1) - jlo;
    LAS char* V_lds = lds + OFF_V; LAS char* K_lds = lds + OFF_K;
    LAS float* li_l = (LAS float*)(lds + OFF_WS) + wid * 64;
    float l_reg = 0; f32x16 o[4] = {};
    const int sr = tid >> 4, sc = (tid & 15) * 8, vst0 = v_st(sr, sc), vst1 = v_st(32 + sr, sc), kws = KSWZ(sr, sc * 2);
    const int vb0 = (int)(unsigned)(size_t)V_lds + v_rd_base(lane);
    const bf16* Kh = cur.K; const bf16* Vh = cur.V; const int kmax_ = (4 * (cur.qb + 1) - 1) * KVBLK; (void)kmax_;
    const int tq = cur.qb * QB + wid * QBLK + r32;
    {
        const int n = sr & 15; const float* kp = cur.KM + n * HD + sc;
        const f32x4 a = *(const f32x4*)kp, b = *(const f32x4*)(kp + 4);
        float v[8] = {a.x, a.y, a.z, a.w, b.x, b.y, b.z, b.w}; unsigned w[4];
#pragma unroll
        for (int e = 0; e < 4; ++e) { const unsigned h0 = f2bf(v[2 * e]), h1 = f2bf(v[2 * e + 1]);
            if (sr < 16) w[e] = h0 | (h1 << 16); else w[e] = pk2(v[2 * e] - bflo(h0), v[2 * e + 1] - bflo(h1)); }
        *(LAS u32x4*)(lds + OFF_KM + KSWZ(sr, sc * 2)) = (u32x4){w[0], w[1], w[2], w[3]};
    }
    if (tid == 0) *(LAS unsigned*)(lds + OFF_TK) = __hip_atomic_fetch_add(Qd.ctr, 1u, __ATOMIC_RELAXED, __HIP_MEMORY_SCOPE_AGENT);
    __syncthreads();
    { const unsigned tnext = (unsigned)__builtin_amdgcn_readfirstlane((int)*(const LAS unsigned*)(lds + OFF_TK));
      more = unit_from_ticket(tnext, Qd, lds, nxt); if (!more) nxt = cur; }
    unsigned selmask = 0;
    {
        f32x16 pg = f32x16{};
#pragma unroll
        for (int d0 = 0; d0 < 8; ++d0) { const bf16x8 a = *reinterpret_cast<const LAS bf16x8*>(lds + OFF_KM + KSWZ(r32, (d0 * 16 + hi * 8) * 2));
            pg = __builtin_amdgcn_mfma_f32_32x32x16_bf16(a, S.qr[d0], pg, 0, 0, 0); }
        float g[16];
#pragma unroll
        for (int j = 0; j < 8; ++j) { const float mine = pg[j] + pg[j + 8], oth = __shfl_xor(mine, 32); const int n0 = (j & 3) + 8 * (j >> 2);
            g[n0] = hi ? oth : mine; g[n0 + 4] = hi ? mine : oth; }
        float v0 = -__builtin_inff(), v1 = v0, v2 = v0; int i0 = 0, i1 = 0, i2 = 0;
#pragma unroll
        for (int n = 0; n < 16; ++n) { const float gt = n < cur.qb ? g[n] : -__builtin_inff();
            if (gt > v0) { v2 = v1; i2 = i1; v1 = v0; i1 = i0; v0 = gt; i0 = n; }
            else if (gt > v1) { v2 = v1; i2 = i1; v1 = gt; i1 = n; }
            else if (gt > v2) { v2 = gt; i2 = n; } }
        if (v0 > -__builtin_inff()) selmask |= 1u << i0;
        if (v1 > -__builtin_inff()) selmask |= 1u << i1;
        if (v2 > -__builtin_inff()) selmask |= 1u << i2;
    }
    const float basec = -M2 + slope2 * (float)(4 * hi - tq);
    const int ownt = 4 * cur.qb - jlo;
#define KBASE(t) ((jlo + (t)) * KVBLK)
#define TBASE(t) (((t) >= ownt || ((selmask >> ((jlo + (t)) >> 2)) & 1u)) ? fmaf(slope2, (float)KBASE(t), basec) : -__builtin_inff())
#define MASKT(P0_, P1_, t) do { if ((t) >= ownt && KBASE(t) + KVBLK - 1 > cur.qb * QB + wid * QBLK) mask_tile(P0_, P1_, tq - 4 * hi - KBASE(t)); } while (0)
    f32x16 pA0, pA1, pB0, pB1; bf16x8 pa0, pa1, pa2, pa3;
    const LAS char* kbase[4];
#pragma unroll
    for (int dd = 0; dd < 4; ++dd) kbase[dd] = K_lds + KSWZ(r32, (dd * 16 + hi * 8) * 2);
    SWRITE_HV(0); SBAR();
    SLOAD_H(Kh, Vh, KBASE(1));
    SBAR(); qkt(pA0, pA1, kbase, 0, S.qr);
    MASKT(pA0, pA1, 0); partialSM(pA0, pA1, TBASE(0), slope2);
    VMW(); SWRITE_H(SHM_K); SBAR(); SLOAD_H(Kh, Vh, KBASE(2));
    __syncthreads();
    int sp = 0, scur = SHM_K, sn = 2 * SHM_K;
    bf16x8 kf0[2], kf1[2]; s16x4 vA[8], vB[8]; float psa, psb; unsigned ra0_, ra1_;
#define KRD(d0_, s_) do { const LAS char* a_ = kbase[(d0_) & 3] + scur + ((d0_) >> 2) * 128; kf0[s_] = *reinterpret_cast<const LAS bf16x8*>(a_); kf1[s_] = *reinterpret_cast<const LAS bf16x8*>(a_ + 32 * 256); } while (0)
#define TRRD2(dst, off) asm volatile("ds_read_b64_tr_b16 %0, %1 offset:%2" : "=&v"(dst) : "v"(vaddr_), "i"(off) : "memory")
#define FINC(k, Y0, Y1) do { \
        if ((k) < 8) { Y1[2 * ((k) & 7)] = __builtin_amdgcn_exp2f(Y1[2 * ((k) & 7)]); Y1[2 * ((k) & 7) + 1] = __builtin_amdgcn_exp2f(Y1[2 * ((k) & 7) + 1]); \
            if ((k) == 0) { psa = Y0[0]; psb = Y0[1]; } else { psa += Y0[2 * ((k) & 7)]; psb += Y0[2 * ((k) & 7) + 1]; } } \
        else { constexpr int j_ = (k) & 7, m_ = j_ >> 1, b_ = (m_ & 1) * 8; psa += Y1[2 * j_]; psb += Y1[2 * j_ + 1]; \
            if ((j_ & 1) == 0) { const unsigned a0_ = m_ < 2 ? cvtpk(Y0[b_], Y0[b_ + 1]) : cvtpk(Y1[b_], Y1[b_ + 1]), b0_ = m_ < 2 ? cvtpk(Y0[b_ + 4], Y0[b_ + 5]) : cvtpk(Y1[b_ + 4], Y1[b_ + 5]); \
                auto r_ = __builtin_amdgcn_permlane32_swap(a0_, b0_, false, false); ra0_ = r_[0]; ra1_ = r_[1]; } \
            else { const unsigned a1_ = m_ < 2 ? cvtpk(Y0[b_ + 2], Y0[b_ + 3]) : cvtpk(Y1[b_ + 2], Y1[b_ + 3]), b1_ = m_ < 2 ? cvtpk(Y0[b_ + 6], Y0[b_ + 7]) : cvtpk(Y1[b_ + 6], Y1[b_ + 7]); \
                auto r_ = __builtin_amdgcn_permlane32_swap(a1_, b1_, false, false); u32x4 w_ = {ra0_, r_[0], ra1_, r_[1]}; \
                if (m_ == 0) pa0 = *reinterpret_cast<bf16x8*>(&w_); else if (m_ == 1) pa1 = *reinterpret_cast<bf16x8*>(&w_); else if (m_ == 2) pa2 = *reinterpret_cast<bf16x8*>(&w_); else pa3 = *reinterpret_cast<bf16x8*>(&w_); } } \
        if ((k) >= 12) { constexpr int f_ = 2 * ((k) - 12), o_ = v_rd_off(0, 0, 0) + 2048 * f_; TRRD2(vA[f_ & 7], o_ & 0xffff); TRRD2(vA[(f_ + 1) & 7], (o_ + 2048) & 0xffff); } } while (0)
#define QKG(d0, PX0, PX1, PY0, PY1) do { \
        if ((d0) < 7) KRD(((d0) + 1) & 7, ((d0) + 1) & 1); \
        SBAR(); \
        PX0 = __builtin_amdgcn_mfma_f32_32x32x16_bf16(kf0[(d0) & 1], S.qr[d0], (d0) == 0 ? f32x16{} : PX0, 0, 0, 0); \
        SBAR(); FINC(2 * (d0), PY0, PY1); SBAR(); \
        PX1 = __builtin_amdgcn_mfma_f32_32x32x16_bf16(kf1[(d0) & 1], S.qr[d0], (d0) == 0 ? f32x16{} : PX1, 0, 0, 0); \
        SBAR(); FINC(2 * (d0) + 1, PY0, PY1); SBAR(); } while (0)
#define SMC(k, X0, X1) do { constexpr float c_ = (float)(((k) & 3) + 8 * ((k) >> 2)); \
        X0[k] = __builtin_amdgcn_exp2f(fmaf(X0[k], LOG2E * SCALE, fmaf(slope2, c_, tb_))); X1[k] = fmaf(X1[k], LOG2E * SCALE, fmaf(slope2, c_ + 32.f, tb_)); asm volatile("" :: "v"(X1[k])); } while (0)
#define FRV(A, j) (bf16x8){A[2 * (j)][0], A[2 * (j)][1], A[2 * (j)][2], A[2 * (j)][3], A[2 * (j) + 1][0], A[2 * (j) + 1][1], A[2 * (j) + 1][2], A[2 * (j) + 1][3]}
#define PVG(d0, CUR, NXT, X0, X1) do { constexpr int n_ = v_rd_off(((d0) + 1) & 3, 0, 0); \
        asm volatile("s_waitcnt lgkmcnt(0)" ::: "memory"); SBAR(); \
        o[d0] = __builtin_amdgcn_mfma_f32_32x32x16_bf16(pa0, FRV(CUR, 0), o[d0], 0, 0, 0); SBAR(); \
        if ((d0) < 3) { TRRD2(NXT[0], n_); TRRD2(NXT[1], n_ + 2048); TRRD2(NXT[2], n_ + 4096); TRRD2(NXT[3], n_ + 6144); } SMC(4 * (d0) + 0, X0, X1); SBAR(); \
        o[d0] = __builtin_amdgcn_mfma_f32_32x32x16_bf16(pa1, FRV(CUR, 1), o[d0], 0, 0, 0); SBAR(); \
        if ((d0) < 3) { TRRD2(NXT[4], n_ + 8192); TRRD2(NXT[5], n_ + 10240); TRRD2(NXT[6], n_ + 12288); TRRD2(NXT[7], n_ + 14336); } SMC(4 * (d0) + 1, X0, X1); SBAR(); \
        o[d0] = __builtin_amdgcn_mfma_f32_32x32x16_bf16(pa2, FRV(CUR, 2), o[d0], 0, 0, 0); SBAR(); SMC(4 * (d0) + 2, X0, X1); SBAR(); \
        o[d0] = __builtin_amdgcn_mfma_f32_32x32x16_bf16(pa3, FRV(CUR, 3), o[d0], 0, 0, 0); SBAR(); SMC(4 * (d0) + 3, X0, X1); SBAR(); } while (0)
#define STEP(PX0, PX1, PY0, PY1, t, LAST) do { \
        PS0(0); KRD(0, 0); const float tb_ = TBASE(t); const int vaddr_ = vb0 + sp; \
        if (!(LAST)) { VMW(); SWRITE_H(sn); SBAR(); if ((t) + 2 < NT) SLOAD_H(Kh, Vh, KBASE((t) + 2)); } \
        PS1(0); PS0(1); QKG(0, PX0, PX1, PY0, PY1); QKG(1, PX0, PX1, PY0, PY1); QKG(2, PX0, PX1, PY0, PY1); QKG(3, PX0, PX1, PY0, PY1); \
        QKG(4, PX0, PX1, PY0, PY1); QKG(5, PX0, PX1, PY0, PY1); QKG(6, PX0, PX1, PY0, PY1); QKG(7, PX0, PX1, PY0, PY1); \
        { float ps_ = psa + psb; auto rr_ = __builtin_amdgcn_permlane32_swap(__float_as_uint(ps_), __float_as_uint(ps_), false, false); l_reg += __uint_as_float(rr_[0]) + __uint_as_float(rr_[1]); } \
        asm volatile("" : "+v"(pa0), "+v"(pa1), "+v"(pa2), "+v"(pa3), "+v"(l_reg)); PS1(1); PS0(2); \
        if (LAST) { SBAR(); const char* nq_ = (const char*)(nxt.Q + (size_t)(wid * QBLK) * PITCH); \
            _Pragma("unroll") for (int d0 = 0; d0 < 8; ++d0) S.qr[d0] = LD8O(nq_, qoff + d0 * 32); SBAR(); \
            { const long dumn_ = PROBE_MEM2 == 1 ? nxt.dumv() : 0; (void)dumn_; SLOAD_HN(nxt.K, nxt.V, nxt.jlo * KVBLK); } SBAR(); }                   \
        MASKT(PX0, PX1, (t)); \
        PVG(0, vA, vB, PX0, PX1); PVG(1, vB, vA, PX0, PX1); PVG(2, vA, vB, PX0, PX1); PVG(3, vB, vA, PX0, PX1); \
        asm volatile("" : "+v"(PX0), "+v"(PX1)); PS1(2); PS0(3); \
        __syncthreads(); PS1(3); \
        { const int r_ = sp; sp = scur; scur = sn; sn = r_; } } while (0)
    PS1(4);
    int t = 1;
    for (; t + 1 < NT; t += 2) { STEP(pB0, pB1, pA0, pA1, t, false); STEP(pA0, pA1, pB0, pB1, t + 1, false); }
    STEP(pB0, pB1, pA0, pA1, t, true);
#undef STEP
#undef PVG
#undef FRV
#undef SMC
#undef QKG
#undef FINC
#undef TRRD2
#undef KRD
    PS0(5);
    finishSM(pB0, pB1, l_reg, pa0, pa1, pa2, pa3); SBAR();
    pv_tile(o, vb0 + sp, pa0, pa1, pa2, pa3);
    SBAR(); VMW(); SWRITE_HK(0); SBAR();
    if (hi == 0) li_l[r32] = l_reg;
    char* Ow = (char*)(const_cast<bf16*>(cur.Q) + (size_t)(wid * QBLK) * PITCH);
    const char* Gw = Ow + (C_G - C_Q) * 2;
    u32x4 gv[8];
#pragma unroll
    for (int i = 0; i < 8; ++i) { const int j = (i & 1) * 64 + lane; gv[i] = *(const u32x4*)(Gw + (unsigned)((j >> 2) * PITCH + (i >> 1) * 32 + (j & 3) * 8) * 2u); }
    asm volatile("s_waitcnt lgkmcnt(0)" ::: "memory");
    float rl[16];
#pragma unroll
    for (int r = 0; r < 16; ++r) rl[r] = __builtin_amdgcn_rcpf(li_l[crow(r, hi)]);
    LAS float* stg = (LAS float*)(lds + OFF_K + SHM_K + wid * 4096);
#pragma unroll
    for (int d0 = 0; d0 < 4; ++d0) {
#pragma unroll
        for (int r = 0; r < 16; ++r) stg[crow(r, hi) * 32 + r32] = o[d0][r] * rl[r];
#pragma unroll
        for (int k = 0; k < 2; ++k) { const int j = k * 64 + lane, row = j >> 2, cq = j & 3;
            const f32x4 a = *(const LAS f32x4*)(stg + row * 32 + cq * 8), b = *(const LAS f32x4*)(stg + row * 32 + cq * 8 + 4);
            const u32x4 g = gv[d0 * 2 + k]; u32x4 w;
            w.x = cvtpk(a[0] * bflo(g.x & 0xffffu), a[1] * __uint_as_float(g.x & 0xffff0000u)); w.y = cvtpk(a[2] * bflo(g.y & 0xffffu), a[3] * __uint_as_float(g.y & 0xffff0000u));
            w.z = cvtpk(b[0] * bflo(g.z & 0xffffu), b[1] * __uint_as_float(g.z & 0xffff0000u)); w.w = cvtpk(b[2] * bflo(g.w & 0xffffu), b[3] * __uint_as_float(g.w & 0xffff0000u));
            *(u32x4*)(Ow + (unsigned)(row * PITCH + d0 * 32 + cq * 8) * 2u) = w; }
    }
    __syncthreads();
    PS1(5); PS1(6);
#undef PS0
#undef PS1
#undef KBASE
#undef TBASE
#undef MASKT
#undef HALF_STEP
}
#undef TILEP
#undef LD8O
#undef VMW
#undef VMWN
#undef LD8
#undef SLOAD_H
#undef SWRITE_HK
#undef SWRITE_HV
#undef SWRITE_H
#undef KSWZ
#undef SBAR
}

__device__ __forceinline__ int attn_window(float slope2, float M2) {
    int w = 0;
#pragma unroll 1
    for (int j = 0; j < 15; ++j) if (slope2 * (float)(256 * j + 1) < 2.f * M2 + 48.f) w = j + 1;
    return w;
}
__device__ __forceinline__ void attn_phase(Frame& F, int layer) {
    bf16* const PROJ = WSP(bf16, WS_PROJ); const float* const KM = WSP(float, WS_KM);
    const float* qw = in_ptr(3) + layer * HD; const float* kw = in_ptr(4) + layer * HD;
    const float mq = wave_max(fmaxf(fabsf(qw[2 * F.lane]), fabsf(qw[2 * F.lane + 1]))), mk = wave_max(fmaxf(fabsf(kw[2 * F.lane]), fabsf(kw[2 * F.lane + 1])));
    float m2v_ = 11.313708499f * mq * mk * 1.02f * moba::LOG2E; asm volatile("" : "+v"(m2v_));
    const float M2 = __uint_as_float((unsigned)__builtin_amdgcn_readfirstlane((int)__float_as_uint(m2v_)));
    LAS char* lds = (LAS char*)(F.lds + RING_OFF);
    {
        int W[8];
#pragma unroll
        for (int h = 0; h < 8; ++h) W[h] = attn_window(exp2f(-(float)(h + 1)) * moba::LOG2E, M2);
        if (F.tid < 8) { int w = 0;
#pragma unroll
            for (int h = 0; h < 8; ++h) w = (F.tid == h) ? W[h] : w;
            ((LAS int*)(lds + moba::OFF_WT))[F.tid] = w; }
#define NCOST(c, hh) (((c) - 1 < W[hh]) ? 1 : (((c) - 1 == W[hh]) ? 16 - W[hh] : 0))
#pragma unroll 1
        for (int u = F.tid; u < BATCH * NH * NBLK; u += NWAVES * 64) {
            const int b = u >> 7, h = (u >> 4) & 7, qb = u & 15;
            int wh = 0;
#pragma unroll
            for (int hh = 0; hh < 8; ++hh) wh = (h == hh) ? W[hh] : wh;
            const int c = (qb < wh ? qb : wh) + 1;
            int pos = 0;
#pragma unroll 1
            for (int cc = c + 1; cc <= 16; ++cc) { int n = 0;
#pragma unroll
                for (int hh = 0; hh < 8; ++hh) n += NCOST(cc, hh);
                pos += BATCH * n; }
            int nall = 0, nbefore = 0;
#pragma unroll
            for (int hh = 0; hh < 8; ++hh) { const int n = NCOST(c, hh); nall += n; nbefore += (hh < h) ? n : 0; }
            pos += b * nall + nbefore + ((c - 1 == wh) ? qb - wh : 0);
            ((LAS unsigned short*)(lds + moba::OFF_ORD))[pos] = (unsigned short)u;
        }
#undef NCOST
    }
    moba::Queue Qd{WSP(unsigned, WS_CTL) + CW_AQ + 64 * layer, PROJ, KM};
    if (F.tid == 0) *(LAS unsigned*)(lds + moba::OFF_TK) = __hip_atomic_fetch_add(Qd.ctr, 1u, __ATOMIC_RELAXED, __HIP_MEMORY_SCOPE_AGENT);
    __syncthreads();
    moba::Unit cur, nxt; moba::Seam S;
    { const unsigned t0 = (unsigned)__builtin_amdgcn_readfirstlane((int)*(const LAS unsigned*)(lds + moba::OFF_TK));
      if (!moba::unit_from_ticket(t0, Qd, lds, cur)) return; }
    __syncthreads();
    moba::prime(cur, lds, S, F.wave);
    unsigned long long pacc = 0;
    for (;;) {
        bool more;
        const float slope2 = exp2f(-(float)(cur.h + 1)) * moba::LOG2E;
        moba::block(cur, nxt, more, Qd, slope2, M2, lds, S, F.wave, pacc);
        if (!more) break;
        cur = nxt;
    }
    if (PROBE_SEC >= 0) { const unsigned long long t0 = __builtin_amdgcn_s_memtime(); while (__builtin_amdgcn_s_memtime() - t0 < pacc) __builtin_amdgcn_s_sleep(8); }
}

__global__ void __launch_bounds__(NWAVES * 64, 2) mk_fwd(Args args) {
    extern __shared__ __attribute__((aligned(16))) unsigned char lds[];
    Frame F;
    F.lds = (LAS unsigned char*)lds;
    F.MISC = (volatile LAS unsigned*)(F.lds + MISC_OFF);
    F.tid = threadIdx.x; F.lane = F.tid & 63; F.wave = __builtin_amdgcn_readfirstlane(F.tid >> 6);
    F.G = gridDim.x; { const int bx = blockIdx.x; F.vcu = (F.G % 8 == 0) ? (bx % 8) * (F.G / 8) + bx / 8 : bx; }
    for (int u = F.tid; u < (LDS_BYTES - LDSCTL_OFF) / 4; u += NWAVES * 64) ((LAS unsigned*)(F.lds + LDSCTL_OFF))[u] = 0u;
    __syncthreads();
    XcdBarrier bar; bar.bar = nullptr; bar.x = 0; bar.st = nullptr;
    if (N_LAUNCHES == 1) bar = xcd_barrier_post(WSP(unsigned, WS_CTL) + CW_BAR, F.MISC + 8);
    const int lo = args.ph_lo, hi = args.ph_hi;
#define IN(k) (lo <= (k) && (k) < hi)
#define REFRESH() do { int z_ = 0; asm volatile("" : "+v"(z_)); asm volatile("" : "+s"(F.wave), "+s"(F.vcu), "+s"(F.G)); \
        F.lane = (int)__builtin_amdgcn_mbcnt_hi(~0u, __builtin_amdgcn_mbcnt_lo(~0u, (unsigned)z_)); F.tid = F.wave * 64 + F.lane; } while (0)
#define SEAM(k) do { if (IN(k) && IN((k) + 1)) { bar.bar = WSP(unsigned, WS_CTL) + CW_BAR; xcd_barrier(bar, F.wave); } } while (0)
#define PROBE_T0(ph) unsigned long long pt0_ = 0; if (PROBE_PH == (ph)) pt0_ = __builtin_amdgcn_s_memrealtime()
#define PROBE_T1(ph) do { if (PROBE_PH == (ph)) { const unsigned long long pt1_ = __builtin_amdgcn_s_memrealtime(); while (__builtin_amdgcn_s_memrealtime() - pt1_ < pt1_ - pt0_) __builtin_amdgcn_s_sleep(8); } } while (0)

#pragma unroll 1
    for (int layer = 0; layer < DEPTH; ++layer) {
        const int pb = layer * 6;
        { PROBE_T0(0); if (IN(pb + 0)) { REFRESH(); phase_a(F, layer); } SEAM(pb + 0); PROBE_T1(0); }
        { PROBE_T0(1); if (IN(pb + 1)) {
            REFRESH();
            pg8::Gemm g{WSP(bf16, WS_A), WSP(bf16, WS_WIN), M, PITCH, DM, DM}; pg8::StaticOrder S; S.init(M, PITCH, F.G, (int)blockIdx.x);
            if (F.tid < 256) ((LAS float*)(F.lds + RING_BYTES + 10240))[F.tid] = (F.tid < 128 ? in_ptr(3) + layer * HD : in_ptr(4) + layer * HD - 128)[F.tid];
            __syncthreads();
            pg8::EpiProj E{WSP(bf16, WS_PROJ), PITCH, in_ptr(3) + layer * HD, in_ptr(4) + layer * HD, WSP(float, WS_KM), F.lds + RING_BYTES, EPS, WSP(float, WS_RSTD)};
            static_assert(GEMM1_ALIGN, "EpiProj's in-epilogue barriers need both half-workgroups in the epilogue together");
            pg8::gemm_phase<pg8::EpiProj, pg8::StaticOrder, GEMM1_ALIGN, GEMM1_SP2>(F.lds + RING_OFF, g, S, E, F.tid);
        } SEAM(pb + 1); PROBE_T1(1); }
        { PROBE_T0(2); if (IN(pb + 2)) { REFRESH(); phase_c(F, layer); } SEAM(pb + 2); PROBE_T1(2); }
        { PROBE_T0(3); if (IN(pb + 3)) {
            { PROBE_T0(6); REFRESH(); ssd_phase(F, layer); __syncthreads(); PROBE_T1(6); }
            { PROBE_T0(7); REFRESH(); attn_phase(F, layer); PROBE_T1(7); }
        } if (IN(pb + 3) && IN(pb + 5)) { bar.bar = WSP(unsigned, WS_CTL) + CW_BAR; xcd_barrier(bar, F.wave); } PROBE_T1(3); }
        { PROBE_T0(5); if (IN(pb + 5)) {
            REFRESH();
            float* const OUTP = out_ptr(); const float* base = layer == 0 ? in_ptr(0) : OUTP;
            pg8::Gemm g{WSP(bf16, WS_PROJ), WSP(bf16, WS_WOUT), M, DM, 2048, PITCH}; pg8::StaticOrder S; S.init(M, DM, F.G, (int)blockIdx.x);
            pg8::EpiResScale E{base, OUTP, DM, WSP(float, WS_SSQ), F.lds + RING_BYTES, EPS, layer == DEPTH - 1};
            pg8::gemm_phase<pg8::EpiResScale, pg8::StaticOrder, GEMM2_ALIGN, GEMM2_SP2>(F.lds + RING_OFF, g, S, E, F.tid);
        } SEAM(pb + 5); PROBE_T1(5); }
    }
#undef IN
#undef SEAM
}

extern "C" void kernel_launch(void* const* d_in, const int* in_sizes, int n_in, void* d_out, int out_size, void* d_ws, size_t ws_size, hipStream_t stream) {
    static int grid = 0;
    if (grid == 0) {
        if (n_in != 12 || in_sizes[0] != M * DM || out_size != M * DM || ws_size < WS_END) {
            fprintf(stderr, "kernel_launch: unexpected shapes (n_in %d, in0 %d, out %d, ws %zu); nothing launched\n", n_in, n_in > 0 ? in_sizes[0] : -1, out_size, ws_size); grid = -1; return; }
        int dev = 0, cus = 0, per_cu = 0;
        if (hipGetDevice(&dev) != hipSuccess || hipDeviceGetAttribute(&cus, hipDeviceAttributeMultiprocessorCount, dev) != hipSuccess) { grid = -1; return; }
        if (hipFuncSetAttribute((const void*)mk_fwd, hipFuncAttributeMaxDynamicSharedMemorySize, LDS_BYTES) != hipSuccess) { fprintf(stderr, "kernel_launch: hipFuncSetAttribute failed\n"); grid = -1; return; }
        if (hipOccupancyMaxActiveBlocksPerMultiprocessor(&per_cu, (const void*)mk_fwd, NWAVES * 64, LDS_BYTES) != hipSuccess || per_cu < 1) {
            fprintf(stderr, "kernel_launch: occupancy query reports %d workgroups per CU; nothing launched\n", per_cu); (void)hipGetLastError(); grid = -1; return; }
        grid = cus;
    }
    if (grid < 0) return;
    if (hipMemsetAsync((char*)d_ws + WS_CTL, 0, CTL_ZERO_BYTES, stream) != hipSuccess) { fprintf(stderr, "kernel_launch: hipMemsetAsync failed\n"); return; }
    Args a{};
    for (int i = 0; i < 12; ++i) a.in[i] = (const float*)d_in[i];
    a.out = (float*)d_out; a.ws = (unsigned char*)d_ws;
    for (int li = 0; li < N_LAUNCHES; ++li) {
        a.ph_lo = (N_LAUNCHES == 1) ? 0 : li; a.ph_hi = (N_LAUNCHES == 1) ? N_PHASES : li + 1; a.li = li;
        hipLaunchKernelGGL(mk_fwd, dim3(grid), dim3(NWAVES * 64), LDS_BYTES, stream, a);
        const hipError_t le = hipPeekAtLastError();
        if (le != hipSuccess) { fprintf(stderr, "kernel_launch: launch %d failed: %s\n", li, hipGetErrorName(le)); break; }
    }
}
```

```cpp
#include <hip/hip_runtime.h>
#include <cstdio>
#include <cstdint>
namespace pg8 {
#define PG8_LAS __attribute__((address_space(3)))
typedef unsigned short bf16_t;
typedef short bf16x8 __attribute__((ext_vector_type(8)));
typedef float f32x4 __attribute__((ext_vector_type(4)));
typedef unsigned u32x4 __attribute__((ext_vector_type(4)));
constexpr int BM = 256, BK = 64, HALF = 128, HTB = HALF * BK * 2  , STAGE_BYTES = 8 * HTB, NXCD = 8, WGM = 8;

__host__ __device__ __forceinline__ int lds_byte(int r, int c) { const int st = (r >> 4) * 2 + (c >> 5), rr = r & 15, cc = c & 31, ob = rr * 64 + cc * 2; return st * 1024 + (ob ^ (((ob >> 9) & 1) << 5)); }
__host__ __device__ __forceinline__ void stage_rc(int b, int& R, int& C) { const int st = b / 1024, sb = b % 1024, swz = sb ^ (((sb >> 9) & 1) << 5); R = (st >> 1) * 16 + swz / 64; C = (st & 1) * 32 + (swz % 64) / 2; }
__host__ __device__ __forceinline__ int perm32(int rho) { const int n = rho >> 4, i = rho & 15; return 8 * (i >> 2) + 4 * n + (i & 3); }

struct Unit { int pm, pn; };
struct Gemm { const bf16_t* A; const bf16_t* Bt; int M, N, K, lda; };

struct StaticOrder {
    int nM, nN, nwg, G, c;
    __host__ __device__ void init(int M, int N, int G_, int c_) { nM = M / BM; nN = N / BM; nwg = nM * nN; G = G_; c = c_; }
    __host__ __device__ bool next(int i, Unit& u) const {
        const long L = (long)i * G + c; if (L >= nwg) return false;
        int wgid = (int)L; { const int q = nwg / NXCD, r = nwg % NXCD, xcd = wgid % NXCD, off = wgid / NXCD; wgid = (xcd < r ? xcd * (q + 1) : r * (q + 1) + (xcd - r) * q) + off; }
        const int nig = WGM * nN, gid = wgid / nig, fm = gid * WGM, gsz = (nM - fm) < WGM ? (nM - fm) : WGM;
        u.pm = fm + ((wgid % nig) % gsz); u.pn = (wgid % nig) / gsz; return true;
    }
    __device__ __forceinline__ void a_ready(const Unit&) const {}
    __device__ __forceinline__ void done(const Unit&) const {}
};

__device__ __forceinline__ unsigned cvt_pk_bf16(float lo, float hi) { unsigned r; asm volatile("v_cvt_pk_bf16_f32 %0, %1, %2" : "=v"(r) : "v"(lo), "v"(hi)); return r; }
typedef float f32x2 __attribute__((ext_vector_type(2)));
__device__ __forceinline__ f32x2 gelu_pk(f32x2 v) {
    const f32x2 av = __builtin_elementwise_abs(v), d = av * 0.2316418882f + 1.0f;
    f32x2 t; t.x = __builtin_amdgcn_rcpf(d.x); t.y = __builtin_amdgcn_rcpf(d.y);
    f32x2 q = t * 0.5307027145f + (-0.7265760135f); q = q * t + 0.7107068705f; q = q * t + (-0.142248368f); q = q * t + 0.127414796f; q = q * t;
    const f32x2 s = (v * v) * (-0.72134752044f);
    f32x2 e; e.x = __builtin_amdgcn_exp2f(s.x); e.y = __builtin_amdgcn_exp2f(s.y);
    const f32x2 m = v * (q * e), r = v - m;
    f32x2 o; o.x = v.x < 0.f ? m.x : r.x; o.y = v.y < 0.f ? m.y : r.y; return o;
}

template <int ACT  > struct EpiBf16 {
    static constexpr bool PERM = true, AFTER_DRAIN = false; static_assert(ACT == 0 || ACT == 1, "EpiBf16: ACT is 0 (none) or 1 (gelu_pk)");
    bf16_t* O; int ldc; const float* bias; int split_cols; size_t split_stride; float scale0;
    __device__ __forceinline__ void operator()(const f32x4 (&acc)[2][2][4][2], const Unit& u, int wr, int wc, int fr, int fq) const {
        const int row0 = u.pm * BM + wr * 64 + fr; int colt = u.pn * BM; bf16_t* base = O;
        float sc = 1.f; if (split_cols) { const int t = colt / split_cols; base += (size_t)t * split_stride; colt -= t * split_cols; if (t == 0) sc = scale0; }
        const int col0 = colt + wc * 32 + 8 * fq, bcol0 = u.pn * BM + wc * 32 + 8 * fq;
        f32x4 bv[2][2];
#pragma unroll
        for (int bj = 0; bj < 2; ++bj)
#pragma unroll
            for (int n = 0; n < 2; ++n) bv[bj][n] = bias ? *(const f32x4*)(bias + bcol0 + bj * HALF + 4 * n) : (f32x4){0.f, 0.f, 0.f, 0.f};
#pragma unroll
        for (int ai = 0; ai < 2; ++ai)
#pragma unroll
            for (int m = 0; m < 4; ++m) { bf16_t* rowp = base + (size_t)(row0 + ai * HALF + m * 16) * ldc + col0;
#pragma unroll
                for (int bj = 0; bj < 2; ++bj) { f32x4 v0 = acc[ai][bj][m][0] + bv[bj][0], v1 = acc[ai][bj][m][1] + bv[bj][1];
                    if (ACT == 1) { f32x2 a = gelu_pk((f32x2){v0[0], v0[1]}), b = gelu_pk((f32x2){v0[2], v0[3]}), c = gelu_pk((f32x2){v1[0], v1[1]}), d = gelu_pk((f32x2){v1[2], v1[3]});
                        v0 = (f32x4){a.x, a.y, b.x, b.y}; v1 = (f32x4){c.x, c.y, d.x, d.y}; }
                    v0 = v0 * sc; v1 = v1 * sc; u32x4 w; w.x = cvt_pk_bf16(v0[0], v0[1]); w.y = cvt_pk_bf16(v0[2], v0[3]); w.z = cvt_pk_bf16(v1[0], v1[1]); w.w = cvt_pk_bf16(v1[2], v1[3]);
                    *(u32x4*)(rowp + bj * HALF) = w; } }
    }
};
template <class Epi, class Sched, bool ALIGN_EPI = false, bool SP2 = false>
__device__ __forceinline__ void gemm_phase(PG8_LAS unsigned char* lds, const Gemm g, const Sched& S, const Epi& E, int ptid_) {
    int tid_ = ptid_; asm volatile("" : "+v"(tid_));
    const int tid = tid_, wid = __builtin_amdgcn_readfirstlane(tid >> 6), lane = tid & 63, wr = wid >> 2, wc = wid & 3, fr = lane & 15, fq = lane >> 4;
    const int K = g.K, nt = K / BK;
    unsigned voffA[2], voffB[2];
#pragma unroll
    for (int i = 0; i < 2; ++i) { int R, C; stage_rc(tid * 16 + i * 8192, R, C); const int Rb = Epi::PERM ? ((R & ~31) + perm32(R & 31)) : R;
        voffA[i] = (unsigned)(R * g.lda + C) * 2u; voffB[i] = (unsigned)(Rb * K + C) * 2u; }
    const size_t kstep = (size_t)(BK * 2);
    const size_t hstep = (size_t)HALF * K * 2;
    const size_t tstep = 2 * hstep; const size_t hstepA = (size_t)HALF * g.lda * 2, tstepA = 2 * hstepA;
    const unsigned ldsw = (unsigned)wid * 1024u;
    const int aoff = lds_byte(wr * 64 + fr, fq * 8), boff = lds_byte(wc * 32 + fr, fq * 8);
#define PG8_SA(b, h) (((b) * 2 + (h)) * HTB)
#define PG8_SB(b, h) ((4 + (b) * 2 + (h)) * HTB)
#define PG8_STAGE(bufoff, gbase, voff) do { _Pragma("unroll") for (int _i = 0; _i < 2; ++_i) \
        __builtin_amdgcn_global_load_lds((const unsigned*)((const char*)(gbase) + (voff)[_i]), (PG8_LAS unsigned*)(lds + (bufoff) + ldsw + _i * 8192), 16, 0, 0); } while (0)
#define PG8_LDA(dst, b, h) do { _Pragma("unroll") for (int m = 0; m < 4; ++m) _Pragma("unroll") for (int k = 0; k < 2; ++k) dst[m][k] = *(const PG8_LAS bf16x8*)(lds + PG8_SA(b, h) + aoff + m * 2048 + k * 1024); } while (0)
#define PG8_LDB(dst, b, h) do { _Pragma("unroll") for (int n = 0; n < 2; ++n) _Pragma("unroll") for (int k = 0; k < 2; ++k) dst[n][k] = *(const PG8_LAS bf16x8*)(lds + PG8_SB(b, h) + boff + n * 2048 + k * 1024); } while (0)
#define PG8_MMA(ai, bj, At, Bt) do { __builtin_amdgcn_s_setprio(1); _Pragma("unroll") for (int m = 0; m < 4; ++m) _Pragma("unroll") for (int n = 0; n < 2; ++n) _Pragma("unroll") for (int k = 0; k < 2; ++k) \
        acc[ai][bj][m][n] = __builtin_amdgcn_mfma_f32_16x16x32_bf16(Bt[n][k], At[m][k], acc[ai][bj][m][n], 0, 0, 0); __builtin_amdgcn_s_setprio(0); } while (0)
#define PG8_WAIT_V(n) asm volatile("s_waitcnt vmcnt(" #n ")" ::: "memory")
#define PG8_WAIT_L(n) asm volatile("s_waitcnt lgkmcnt(" #n ")" ::: "memory")
#define PG8_BAR __builtin_amdgcn_s_barrier()
#define PG8_SCHED __builtin_amdgcn_sched_barrier(0)
    Unit cur, nxt; int ui = 0;
    if (!S.next(0, cur)) return;
    f32x4 acc[2][2][4][2];
#pragma unroll
    for (int a = 0; a < 2; ++a)
#pragma unroll
        for (int b = 0; b < 2; ++b)
#pragma unroll
            for (int m = 0; m < 4; ++m)
#pragma unroll
                for (int n = 0; n < 2; ++n) acc[a][b][m][n] = (f32x4){0.f, 0.f, 0.f, 0.f};
    bf16x8 At[4][2], B0[2][2], B1[2][2];
    const char* cA = (const char*)g.A + (size_t)cur.pm * tstepA; const char* cB = (const char*)g.Bt + (size_t)cur.pn * tstep;
    S.a_ready(cur);
    if constexpr (Epi::KHOOK) E.unit_begin(cur, ui, tid);
    if constexpr (SP2) {
        PG8_STAGE(PG8_SB(0, 0), cB, voffB); PG8_STAGE(PG8_SB(0, 1), cB + hstep, voffB); PG8_STAGE(PG8_SA(0, 0), cA, voffA); PG8_STAGE(PG8_SA(0, 1), cA + hstepA, voffA);
        if (wr == 1) PG8_BAR;
        PG8_WAIT_V(2); PG8_BAR;
        PG8_STAGE(PG8_SB(1, 0), cB + kstep, voffB); PG8_STAGE(PG8_SA(1, 0), cA + kstep, voffA); PG8_STAGE(PG8_SB(1, 1), cB + hstep + kstep, voffB);
        PG8_WAIT_V(6); PG8_BAR;
    } else {
        PG8_STAGE(PG8_SB(0, 0), cB, voffB); PG8_STAGE(PG8_SA(0, 0), cA, voffA); PG8_STAGE(PG8_SB(0, 1), cB + hstep, voffB); PG8_STAGE(PG8_SA(0, 1), cA + hstepA, voffA);
        if (wr == 1) PG8_BAR;
        PG8_WAIT_V(4); PG8_BAR;
        PG8_STAGE(PG8_SB(1, 0), cB + kstep, voffB); PG8_STAGE(PG8_SA(1, 0), cA + kstep, voffA); PG8_STAGE(PG8_SB(1, 1), cB + hstep + kstep, voffB);
        PG8_WAIT_V(6); PG8_BAR;
    }
    for (;;) {
        const bool has_next = S.next(ui + 1, nxt);
        const char* nA = has_next ? (const char*)g.A + (size_t)nxt.pm * tstepA : cA; const char* nB = has_next ? (const char*)g.Bt + (size_t)nxt.pn * tstep : cB;
        for (int t = 0; t < nt; t += 2) {
            if constexpr (Epi::KHOOK) { if (t == Epi::KH0 || t == Epi::KH1) E.khook(acc, t, ui, wr, fr); }
            const bool last = (t == nt - 2);
            const char* a1 = cA + (size_t)(t + 1) * kstep;
            const char* a2 = last ? nA : cA + (size_t)(t + 2) * kstep; const char* b2 = last ? nB : cB + (size_t)(t + 2) * kstep;
            const char* a3 = a2 + kstep; const char* b3 = b2 + kstep;
            if (last && has_next) S.a_ready(nxt);
            if constexpr (SP2) {
            PG8_LDB(B0, 0, 0); PG8_LDB(B1, 0, 1); PG8_SCHED; PG8_LDA(At, 0, 0); PG8_STAGE(PG8_SA(1, 1), a1 + hstepA, voffA);
            PG8_WAIT_V(8); PG8_WAIT_L(0); PG8_BAR; PG8_MMA(0, 0, At, B0); PG8_MMA(0, 1, At, B1); PG8_BAR; PG8_SCHED;
            PG8_LDA(At, 0, 1); PG8_STAGE(PG8_SB(0, 0), b2, voffB); PG8_STAGE(PG8_SB(0, 1), b2 + hstep, voffB); PG8_STAGE(PG8_SA(0, 0), a2, voffA);
            PG8_WAIT_V(8); PG8_WAIT_L(0); PG8_BAR; PG8_MMA(1, 0, At, B0); PG8_MMA(1, 1, At, B1); PG8_BAR; PG8_SCHED;
            PG8_LDB(B0, 1, 0); PG8_LDB(B1, 1, 1); PG8_SCHED; PG8_LDA(At, 1, 0); PG8_STAGE(PG8_SA(0, 1), a2 + hstepA, voffA);
            PG8_WAIT_V(8); PG8_WAIT_L(0); PG8_BAR; PG8_MMA(0, 0, At, B0); PG8_MMA(0, 1, At, B1); PG8_BAR; PG8_SCHED;
            PG8_LDA(At, 1, 1); PG8_STAGE(PG8_SB(1, 0), b3, voffB); PG8_STAGE(PG8_SB(1, 1), b3 + hstep, voffB); PG8_STAGE(PG8_SA(1, 0), a3, voffA);
            PG8_WAIT_V(8); PG8_WAIT_L(0); PG8_BAR; PG8_MMA(1, 0, At, B0); PG8_MMA(1, 1, At, B1); PG8_BAR; PG8_SCHED;
            } else {
            PG8_LDB(B0, 0, 0); PG8_SCHED; PG8_LDA(At, 0, 0); PG8_STAGE(PG8_SA(1, 1), a1 + hstepA, voffA);
            PG8_WAIT_L(8); PG8_BAR; PG8_WAIT_L(0); PG8_MMA(0, 0, At, B0); PG8_BAR; PG8_SCHED;
            PG8_LDB(B1, 0, 1); PG8_STAGE(PG8_SB(0, 0), b2, voffB);
            PG8_BAR; PG8_WAIT_L(0); PG8_MMA(0, 1, At, B1); PG8_BAR;
            PG8_LDA(At, 0, 1); PG8_STAGE(PG8_SA(0, 0), a2, voffA);
            PG8_BAR; PG8_WAIT_L(0); PG8_MMA(1, 0, At, B0); PG8_BAR; PG8_SCHED;
            PG8_STAGE(PG8_SB(0, 1), b2 + hstep, voffB);
            PG8_WAIT_V(6); PG8_BAR; PG8_MMA(1, 1, At, B1); PG8_BAR;
            PG8_LDB(B0, 1, 0); PG8_SCHED; PG8_LDA(At, 1, 0); PG8_STAGE(PG8_SA(0, 1), a2 + hstepA, voffA);
            PG8_WAIT_L(8); PG8_BAR; PG8_WAIT_L(0); PG8_MMA(0, 0, At, B0); PG8_BAR; PG8_SCHED;
            PG8_LDB(B1, 1, 1); PG8_STAGE(PG8_SB(1, 0), b3, voffB);
            PG8_BAR; PG8_WAIT_L(0); PG8_MMA(0, 1, At, B1); PG8_BAR;
            PG8_LDA(At, 1, 1); PG8_STAGE(PG8_SA(1, 0), a3, voffA);
            PG8_BAR; PG8_WAIT_L(0); PG8_MMA(1, 0, At, B0); PG8_BAR; PG8_SCHED;
            PG8_STAGE(PG8_SB(1, 1), b3 + hstep, voffB);
            PG8_WAIT_V(6); PG8_BAR; PG8_MMA(1, 1, At, B1); PG8_BAR;
            }
        }
        if constexpr (ALIGN_EPI) { if (wr == 0) PG8_BAR; }
        if constexpr (Epi::KHOOK) { E.epi(acc, cur, ui, wr, wc, fr, fq); S.done(cur); } else if constexpr (!Epi::AFTER_DRAIN) { E(acc, cur, wr, wc, fr, fq); S.done(cur); }
        if (!has_next) break;
#pragma unroll
        for (int a = 0; a < 2; ++a)
#pragma unroll
            for (int b = 0; b < 2; ++b)
#pragma unroll
                for (int m = 0; m < 4; ++m)
#pragma unroll
                    for (int n = 0; n < 2; ++n) acc[a][b][m][n] = (f32x4){0.f, 0.f, 0.f, 0.f};
        cur = nxt; cA = nA; cB = nB; ++ui;
        if constexpr (Epi::KHOOK) E.unit_begin(cur, ui, tid);
        if constexpr (ALIGN_EPI) { if (wr == 1) PG8_BAR; }
    }
    PG8_WAIT_V(0);
    if constexpr (!ALIGN_EPI) { if (wr == 0) PG8_BAR; }
    PG8_BAR;
    if constexpr (Epi::AFTER_DRAIN) { E.fused(acc, cur, wr, wc, fr, fq, lds, wid, lane); S.done(cur); }
#undef PG8_SA
#undef PG8_SB
#undef PG8_STAGE
#undef PG8_LDA
#undef PG8_LDB
#undef PG8_MMA
#undef PG8_WAIT_V
#undef PG8_WAIT_L
#undef PG8_BAR
#undef PG8_SCHED
}
}

namespace pg8 {
struct EpiResF32 {
    static constexpr bool PERM = false, AFTER_DRAIN = false, KHOOK = false;
    const float* base; float* out; int ldc;
    __device__ __forceinline__ void operator()(const f32x4 (&acc)[2][2][4][2], const Unit& u, int wr, int wc, int fr, int fq) const {
        const int col0 = u.pn * BM + wc * 32 + 4 * fq;
#pragma unroll
        for (int ai = 0; ai < 2; ++ai)
#pragma unroll
            for (int m = 0; m < 4; ++m) { const size_t off = (size_t)(u.pm * BM + ai * HALF + wr * 64 + m * 16 + fr) * ldc + col0;
#pragma unroll
                for (int bj = 0; bj < 2; ++bj)
#pragma unroll
                    for (int n = 0; n < 2; ++n) { const f32x4 bs = *(const f32x4*)(base + off + bj * HALF + n * 16); *(f32x4*)(out + off + bj * HALF + n * 16) = bs + acc[ai][bj][m][n]; } }
    }
};

struct EpiProj {
    static constexpr bool PERM = true, AFTER_DRAIN = false, KHOOK = true; static constexpr int KH0 = -1, KH1 = -1;
    bf16_t* O; int ldc; const float* qw; const float* kw; float* KM; PG8_LAS unsigned char* xlds; float eps; const float* RSTD;
    __device__ __forceinline__ PG8_LAS float* rtab(int ui) const { return (PG8_LAS float*)(xlds + 11264) + (ui & 1) * 256; }
    __device__ __forceinline__ void unit_begin(const Unit& u, int ui, int tid) const { if (tid < 256) rtab(ui)[tid] = RSTD[u.pm * BM + tid]; }
    __device__ __forceinline__ void khook(f32x4 (&)[2][2][4][2], int, int, int, int) const {}
    __device__ __forceinline__ void bar() const { asm volatile("s_waitcnt lgkmcnt(0)" ::: "memory"); __builtin_amdgcn_s_barrier(); asm volatile("" ::: "memory"); }
    __device__ __forceinline__ void epi(const f32x4 (&acc)[2][2][4][2], const Unit& u, int ui, int wr, int wc, int fr, int fq) const {
        const int row0 = u.pm * BM + wr * 64 + fr, colt = u.pn * BM, col0 = colt + wc * 32 + 8 * fq;
        const PG8_LAS float* RT = rtab(ui) + wr * 64 + fr;
        const int kind = colt < 1024 ? 1 : ((colt >= 2048 && colt < 3072) ? 2 : 0);
        const bool gate = (colt >= 1024 && colt < 2048) || (colt >= 4096 && colt < 5120);
        if (kind == 0) {
#pragma unroll
            for (int ai = 0; ai < 2; ++ai)
#pragma unroll
                for (int m = 0; m < 4; ++m) { bf16_t* rowp = O + (size_t)(row0 + ai * HALF + m * 16) * ldc + col0; const float rr = RT[ai * HALF + m * 16];
#pragma unroll
                    for (int bj = 0; bj < 2; ++bj) { f32x4 v0 = acc[ai][bj][m][0] * rr, v1 = acc[ai][bj][m][1] * rr;
                        if (gate) {
#pragma unroll
                            for (int e = 0; e < 4; ++e) { v0[e] = v0[e] * __builtin_amdgcn_rcpf(1.0f + __expf(-v0[e])); v1[e] = v1[e] * __builtin_amdgcn_rcpf(1.0f + __expf(-v1[e])); } }
                        u32x4 w; w.x = cvt_pk_bf16(v0[0], v0[1]); w.y = cvt_pk_bf16(v0[2], v0[3]); w.z = cvt_pk_bf16(v1[0], v1[1]); w.w = cvt_pk_bf16(v1[2], v1[3]);
                        *(u32x4*)(rowp + bj * HALF) = w; } }
            return;
        }
        PG8_LAS float* P = (PG8_LAS float*)xlds;
        PG8_LAS float* KS = (PG8_LAS float*)(xlds + 8192);
#pragma unroll
        for (int ai = 0; ai < 2; ++ai)
#pragma unroll
            for (int m = 0; m < 4; ++m)
#pragma unroll
                for (int bj = 0; bj < 2; ++bj) { const float rr = RT[ai * HALF + m * 16]; const f32x4 a = acc[ai][bj][m][0] * rr, b = acc[ai][bj][m][1] * rr;
                    float s = ((a[0] * a[0] + a[1] * a[1]) + (a[2] * a[2] + a[3] * a[3])) + ((b[0] * b[0] + b[1] * b[1]) + (b[2] * b[2] + b[3] * b[3]));
                    s += __shfl_xor(s, 16); s += __shfl_xor(s, 32);
                    if (fq == 0) P[((ai * HALF + wr * 64 + m * 16 + fr) * 2 + bj) * 4 + wc] = s;
                    if (bj) asm volatile("" ::: "memory"); }
        bar();
        const PG8_LAS float* wp = (const PG8_LAS float*)(xlds + 10240) + (kind == 1 ? 0 : 128) + wc * 32 + 8 * fq;
        const f32x4 w0 = *(const PG8_LAS f32x4*)wp, w1 = *(const PG8_LAS f32x4*)(wp + 4);
        f32x4 ks[2][2] = {};
#pragma unroll
        for (int ai = 0; ai < 2; ++ai)
#pragma unroll
            for (int m = 0; m < 4; ++m) { bf16_t* rowp = O + (size_t)(row0 + ai * HALF + m * 16) * ldc + col0;
#pragma unroll
                for (int bj = 0; bj < 2; ++bj) { const f32x4 p = *(const PG8_LAS f32x4*)(P + ((ai * HALF + wr * 64 + m * 16 + fr) * 2 + bj) * 4);
                    const float rs = RT[ai * HALF + m * 16] / sqrtf(((p[0] + p[1]) + (p[2] + p[3])) * (1.0f / 128.0f) + eps);
                    const f32x4 v0 = acc[ai][bj][m][0] * rs * w0, v1 = acc[ai][bj][m][1] * rs * w1;
                    ks[bj][0] += v0; ks[bj][1] += v1;
                    u32x4 w; w.x = cvt_pk_bf16(v0[0], v0[1]); w.y = cvt_pk_bf16(v0[2], v0[3]); w.z = cvt_pk_bf16(v1[0], v1[1]); w.w = cvt_pk_bf16(v1[2], v1[3]);
                    *(u32x4*)(rowp + bj * HALF) = w; }
                asm volatile("" : "+v"(ks[0][0]), "+v"(ks[0][1]), "+v"(ks[1][0]), "+v"(ks[1][1]) :: "memory"); }
        if (kind == 2) {
            float v[16];
#pragma unroll
            for (int bj = 0; bj < 2; ++bj)
#pragma unroll
                for (int n = 0; n < 2; ++n)
#pragma unroll
                    for (int j = 0; j < 4; ++j) v[bj * 8 + n * 4 + j] = ks[bj][n][j];
            { const bool up = (fr & 8) != 0;
#pragma unroll
              for (int c = 0; c < 8; ++c) { const float snd = up ? v[c] : v[c + 8], keep = up ? v[c + 8] : v[c]; v[c] = keep + __shfl_xor(snd, 8); } }
            { const bool up = (fr & 4) != 0;
#pragma unroll
              for (int c = 0; c < 4; ++c) { const float snd = up ? v[c] : v[c + 4], keep = up ? v[c + 4] : v[c]; v[c] = keep + __shfl_xor(snd, 4); } }
            { const bool up = (fr & 2) != 0;
#pragma unroll
              for (int c = 0; c < 2; ++c) { const float snd = up ? v[c] : v[c + 2], keep = up ? v[c + 2] : v[c]; v[c] = keep + __shfl_xor(snd, 2); } }
            { const bool up = (fr & 1) != 0; const float snd = up ? v[0] : v[1], keep = up ? v[1] : v[0]; v[0] = keep + __shfl_xor(snd, 1); }
            KS[wr * 256 + 128 * (fr >> 3) + 32 * wc + 8 * fq + (fr & 7)] = v[0];
            bar();
            const int t = (wr * 4 + wc) * 64 + fq * 16 + fr;
            if (t < 256) { const int b = u.pm >> 4, nb = u.pm & 15, head = 2 * (u.pn & 3) + (t >> 7);
                KM[(((size_t)b * 8 + head) * 16 + nb) * 128 + (t & 127)] = (KS[t] + KS[256 + t]) * (1.0f / 256.0f); }
        }
    }
};

struct EpiResScale {
    static constexpr bool PERM = false, AFTER_DRAIN = false, KHOOK = true; static constexpr int KH0 = 16, KH1 = 24;
    const float* base; float* out; int ldc; const float* SSQ; PG8_LAS unsigned char* xlds; float eps; bool last;
    __device__ __forceinline__ PG8_LAS float* tab(int ui) const { return (PG8_LAS float*)xlds + (ui & 1) * 768; }
    __device__ __forceinline__ void unit_begin(const Unit& u, int ui, int tid) const {
        if (tid < 256) { const f32x4* sp = (const f32x4*)(SSQ + (size_t)(u.pm * BM + tid) * 64); float s0 = 0.f, s1 = 0.f;
#pragma unroll
            for (int i = 0; i < 8; ++i) { const f32x4 a = sp[i], b = sp[8 + i]; s0 += (a[0] + a[1]) + (a[2] + a[3]); s1 += (b[0] + b[1]) + (b[2] + b[3]); }
            const float m0 = s0 * (1.0f / 512.0f) + eps, m1 = s1 * (1.0f / 512.0f) + eps; PG8_LAS float* T = tab(ui);
            T[tid] = sqrtf(m0); T[256 + tid] = sqrtf(m1 / m0); T[512 + tid] = 1.0f / sqrtf(m1); }
    }
    __device__ __forceinline__ void khook(f32x4 (&acc)[2][2][4][2], int t, int ui, int wr, int fr) const {
        const PG8_LAS float* T = tab(ui) + (t == KH0 ? 0 : 256) + wr * 64 + fr;
#pragma unroll
        for (int ai = 0; ai < 2; ++ai)
#pragma unroll
            for (int m = 0; m < 4; ++m) { const float f = T[ai * HALF + m * 16];
#pragma unroll
                for (int bj = 0; bj < 2; ++bj)
#pragma unroll
                    for (int n = 0; n < 2; ++n) acc[ai][bj][m][n] = acc[ai][bj][m][n] * f; }
    }
    __device__ __forceinline__ void epi(const f32x4 (&acc)[2][2][4][2], const Unit& u, int ui, int wr, int wc, int fr, int fq) const {
        const int col0 = u.pn * BM + wc * 32 + 4 * fq; const PG8_LAS float* T = tab(ui) + 512 + wr * 64 + fr;
#pragma unroll
        for (int ai = 0; ai < 2; ++ai)
#pragma unroll
            for (int m = 0; m < 4; ++m) { const size_t off = (size_t)(u.pm * BM + ai * HALF + wr * 64 + m * 16 + fr) * ldc + col0; const float f = T[ai * HALF + m * 16];
#pragma unroll
                for (int bj = 0; bj < 2; ++bj)
#pragma unroll
                    for (int n = 0; n < 2; ++n) { const f32x4* bp = (const f32x4*)(base + off + bj * HALF + n * 16); f32x4* op = (f32x4*)(out + off + bj * HALF + n * 16);
                        if (last) { const f32x4 bs = __builtin_nontemporal_load(bp); __builtin_nontemporal_store(bs + acc[ai][bj][m][n] * f, op); }
                        else { const f32x4 bs = *bp; *op = bs + acc[ai][bj][m][n] * f; } } }
    }
};
}

#ifndef GEMM1_ALIGN
#define GEMM1_ALIGN true
#endif
#ifndef GEMM1_SP2
#define GEMM1_SP2 true
#endif
#ifndef GEMM2_ALIGN
#define GEMM2_ALIGN true
#endif
#ifndef GEMM2_SP2
#define GEMM2_SP2 true
#endif
#ifndef PFD
#define PFD 2
#endif
#ifndef PROBE_SEC
#define PROBE_SEC -1
#endif
#ifndef ATT_PRIO
#define ATT_PRIO 0
#endif
#ifndef PROBE_SSDFIX
#define PROBE_SSDFIX 0
#endif
#ifndef BSKEW_N
#define BSKEW_N 2
#endif
#ifndef WOUT_IN_B
#define WOUT_IN_B 1
#endif
#ifndef PROBE_BSKEW
#define PROBE_BSKEW 0
#endif
#ifndef PROBE_SSEC
#define PROBE_SSEC -1
#endif
#ifndef PROBE_MEM2
#define PROBE_MEM2 0
#endif
#ifndef PROBE_PH
#define PROBE_PH -1
#endif
constexpr int NWAVES = 8;
#ifndef MK_N_LAUNCHES
#define MK_N_LAUNCHES 1
#endif
constexpr int N_PHASES = 12;
constexpr int N_LAUNCHES = MK_N_LAUNCHES;

constexpr int BATCH = 8, SEQ = 4096, DM = 1024, DEPTH = 2;
constexpr int M = BATCH * SEQ;
constexpr int NH = 8, HD = 128;
constexpr int NSH = 16, SHD = 64, NST = 128;
constexpr int NIN = 6672;
constexpr int PITCH = 6656;
constexpr int C_Q = 0, C_Z = 1024, C_K = 2048, C_V = 3072, C_G = 4096, C_X = 5120, C_B = 6144, C_C = 6400;
constexpr int MOBA = 256, NBLK = SEQ / MOBA;
constexpr float EPS = 1e-6f;

constexpr size_t MiB = 1u << 20;
constexpr size_t WS_CTL = 0, CTL_ZERO_BYTES = 64 * 1024;
constexpr size_t WS_WIN = 1 * MiB;
constexpr size_t WS_WOUT = 14 * MiB;
constexpr size_t WS_KM = 18 * MiB;
constexpr size_t WS_DT = 19 * MiB;
constexpr size_t WS_SSQ = 21 * MiB;
constexpr size_t WS_RSTD = 31 * MiB;
constexpr size_t WS_ACS = 29 * MiB;
constexpr size_t WS_A = 32 * MiB;
constexpr size_t WS_PROJ = 96 * MiB;
constexpr size_t WS_END = 512 * MiB;
static_assert(WS_PROJ + (size_t)M * PITCH * 2 <= WS_END, "d_ws map");
constexpr int CW_TMO = 0;
constexpr int CW_BAR = 4096;
constexpr int CW_AQ = 8192;   static_assert((CW_AQ + 128) * 4 <= (int)CTL_ZERO_BYTES && (CW_BAR + 3456) <= CW_AQ, "control words inside the zeroed region");
constexpr int CW_AQ_ = 0;

constexpr int RING_OFF = 0, RING_BYTES = 131072;
constexpr int LDSCTL_OFF = 146944, MISC_OFF = LDSCTL_OFF + 320;
constexpr int LDS_BYTES = 147456;
static_assert(MISC_OFF + 128 <= LDS_BYTES && RING_BYTES <= LDSCTL_OFF, "LDS map");

#define GAS __attribute__((address_space(1)))
#define LAS __attribute__((address_space(3)))
typedef unsigned short bf16;
typedef unsigned v4u __attribute__((ext_vector_type(4)));
typedef unsigned v2u __attribute__((ext_vector_type(2)));
typedef float f32x4 __attribute__((ext_vector_type(4)));
typedef short bf16x8 __attribute__((ext_vector_type(8)));
typedef GAS unsigned gu32;
#define RLX_AGENT __ATOMIC_RELAXED, __HIP_MEMORY_SCOPE_AGENT
#define LDS_WAIT() asm volatile("s_waitcnt lgkmcnt(0)" ::: "memory")
#define VM_WAIT() asm volatile("s_waitcnt vmcnt(0)" ::: "memory")
__device__ __forceinline__ unsigned f2bf(float f) { unsigned u = __builtin_bit_cast(unsigned, f); return (u + 0x7fffu + ((u >> 16) & 1u)) >> 16; }
typedef __bf16 bf16x2_n __attribute__((ext_vector_type(2)));
__device__ __forceinline__ unsigned pk2(float lo, float hi) { bf16x2_n v = {(__bf16)lo, (__bf16)hi}; return __builtin_bit_cast(unsigned, v); }
__device__ __forceinline__ float bflo(unsigned u) { return __builtin_bit_cast(float, u << 16); }
__device__ __forceinline__ float bfhi(unsigned u) { return __builtin_bit_cast(float, u & 0xffff0000u); }
__device__ __forceinline__ float silu_f(float v) { return v * __builtin_amdgcn_rcpf(1.f + __expf(-v)); }
__device__ __forceinline__ float wave_sum(float v) {
#pragma unroll
    for (int o = 1; o < 64; o <<= 1) v += __shfl_xor(v, o);
    return v;
}
__device__ __forceinline__ float wave_max(float v) {
#pragma unroll
    for (int o = 1; o < 64; o <<= 1) v = fmaxf(v, __shfl_xor(v, o));
    return v;
}

#define XB_TMO      128
#define XB_XCNT(j)  (256  + 64 * (j))
#define XB_XSUB(j)  (1280 + 64 * (j))
#define XB_XGEN(j)  (2304 + 64 * (j))
#define XB_TOP      3328
#define XB_TOPGEN   3392
#define XCD_BAR_WORDS 3456
#define XB_SPIN_CAP (1u << 22)

__device__ __forceinline__ unsigned xb_ld(unsigned* p)              { return __hip_atomic_load(p, __ATOMIC_RELAXED, __HIP_MEMORY_SCOPE_AGENT); }
__device__ __forceinline__ unsigned xb_add(unsigned* p, unsigned v) { return __hip_atomic_fetch_add(p, v, __ATOMIC_RELAXED, __HIP_MEMORY_SCOPE_AGENT); }
__device__ __forceinline__ unsigned xb_xcc_id() { return (unsigned)__builtin_amdgcn_s_getreg((3 << 11) | 20) & 0xFu; }
#define XB_SPIN(cond, bar) do { unsigned _sp = 0; while (cond) { __builtin_amdgcn_s_sleep(1); \
    if ((++_sp & 255u) == 0u) { if (xb_ld(&(bar)[XB_TMO])) break; if (_sp > XB_SPIN_CAP) { atomicAdd(&(bar)[XB_TMO], 1u); break; } } } } while (0)

struct XcdBarrier { unsigned* bar; unsigned x; volatile LAS unsigned* st; };

__device__ __forceinline__ XcdBarrier xcd_barrier_post(unsigned* bar, volatile LAS unsigned* st) {
    XcdBarrier b; b.bar = bar; b.x = xb_xcc_id(); b.st = st;
    if (threadIdx.x == 0) (void)xb_add(&bar[XB_XCNT(b.x)], 1u);
    return b;
}
__device__ __forceinline__ void xcd_barrier_complete(unsigned* bar, unsigned x, unsigned& nloc, unsigned& nx) {
    const unsigned G = gridDim.x * gridDim.y * gridDim.z;
    unsigned sum, cnt, mine, sp = 0u;
    for (;;) {
        sum = 0u; cnt = 0u; mine = 0u;
#pragma unroll
        for (unsigned j = 0; j < 16; ++j) { const unsigned c = xb_ld(&bar[XB_XCNT(j)]); sum += c; cnt += (c > 0u) ? 1u : 0u; mine = (j == x) ? c : mine; }
        if (sum == G) break;
        __builtin_amdgcn_s_sleep(1);
        if ((++sp & 255u) == 0u) { if (xb_ld(&bar[XB_TMO])) break; if (sp > XB_SPIN_CAP) { atomicAdd(&bar[XB_TMO], 1u); break; } }
    }
    nloc = mine > 0u ? mine : 1u; nx = cnt > 0u ? cnt : 1u;
}
__device__ __forceinline__ void xcd_barrier(const XcdBarrier& b, int wave) {
    asm volatile("s_waitcnt vmcnt(0)" ::: "memory");
    __syncthreads();
    int z_ = 0; asm volatile("" : "+v"(z_));
    if (wave == 0 && __builtin_amdgcn_mbcnt_hi(~0u, __builtin_amdgcn_mbcnt_lo(~0u, (unsigned)z_)) == 0u) {
        unsigned* bar = b.bar;
        __builtin_amdgcn_s_waitcnt(0);
        unsigned nloc = b.st[0], nx = b.st[1];
        if (nloc == 0u) { xcd_barrier_complete(bar, b.x, nloc, nx); b.st[0] = nloc; b.st[1] = nx; }
        const unsigned old = xb_add(&bar[XB_XSUB(b.x)], 1u);
        const unsigned gen = old / nloc;
        if (old + 1u == (gen + 1u) * nloc) {
            __builtin_amdgcn_fence(__ATOMIC_RELEASE, "agent");
            asm volatile("s_waitcnt vmcnt(0)" ::: "memory");
            const unsigned og = xb_add(&bar[XB_TOP], 1u);
            const unsigned tg = og / nx;
            if (og + 1u == (tg + 1u) * nx) xb_add(&bar[XB_TOPGEN], 1u);
            else XB_SPIN(xb_ld(&bar[XB_TOPGEN]) == tg, bar);
            __builtin_amdgcn_fence(__ATOMIC_ACQUIRE, "agent");
            xb_add(&bar[XB_XGEN(b.x)], 1u);
            asm volatile("s_waitcnt vmcnt(0)" ::: "memory");
        } else {
            XB_SPIN(xb_ld(&bar[XB_XGEN(b.x)]) == gen, bar);
            __builtin_amdgcn_fence(__ATOMIC_ACQUIRE, "agent");
            asm volatile("s_waitcnt vmcnt(0)" ::: "memory");
        }
    }
    __syncthreads();
}

struct Frame {
    LAS unsigned char* lds;
    volatile LAS unsigned* MISC;
    int tid, lane, wave;
    int vcu, G;
};
struct Args { const float* in[12]; float* out; unsigned char* ws; int ph_lo, ph_hi, li, pad; };
template <class T> __device__ __forceinline__ T* karg_ptr(int byte_off) {
    const char __attribute__((address_space(4)))* p = (const char __attribute__((address_space(4)))*)__builtin_amdgcn_kernarg_segment_ptr();
    int o = byte_off; asm volatile("" : "+s"(o));
    return *(T* const __attribute__((address_space(4)))*)(p + o);
}
__device__ __forceinline__ const float* in_ptr(int i) { return karg_ptr<const float>(8 * i); }
__device__ __forceinline__ float* out_ptr() { return karg_ptr<float>(96); }
__device__ __forceinline__ unsigned char* ws_ptr() { return karg_ptr<unsigned char>(104); }
#define WSP(T, off) ((T*)(ws_ptr() + (off)))

__device__ __forceinline__ void transpose_item(const float* Wsrc, int ldw, int K, int ncols, bf16* WT, int row_off, LAS float* scr, int item, int lane, const float* kscale = nullptr, int kmin = 0) {
    const int nblk = ncols / 32, kb = item / nblk, nb = item % nblk, k0 = 64 * kb, n0 = 32 * nb;
#pragma unroll
    for (int i = 0; i < 8; ++i) { const int kk = (lane >> 3) + 8 * i, c4 = lane & 7;
        f32x4 v = *(const f32x4*)(Wsrc + (size_t)(k0 + kk) * ldw + n0 + 4 * c4);
        if (kscale && k0 + kk >= kmin) v = v * kscale[k0 + kk - kmin];
        LAS float* d = scr + kk * 33 + 4 * c4; d[0] = v.x; d[1] = v.y; d[2] = v.z; d[3] = v.w; }
    LDS_WAIT(); asm volatile("" ::: "memory");
    const int c = lane & 7;
#pragma unroll
    for (int j = 0; j < 4; ++j) { const int n = (lane >> 3) + 8 * j; const LAS float* s = scr + (8 * c) * 33 + n;
        v4u o; o.x = pk2(s[0 * 33], s[1 * 33]); o.y = pk2(s[2 * 33], s[3 * 33]); o.z = pk2(s[4 * 33], s[5 * 33]); o.w = pk2(s[6 * 33], s[7 * 33]);
        *(v4u*)(WT + (size_t)(row_off + n0 + n) * K + k0 + 8 * c) = o; }
    LDS_WAIT(); asm volatile("" ::: "memory");
}

__device__ __forceinline__ void phase_a(Frame& F, int layer) {
    bf16* const WinT = WSP(bf16, WS_WIN); bf16* const WoutT = WSP(bf16, WS_WOUT); bf16* const XN = WSP(bf16, WS_A); float* const DT = WSP(float, WS_DT); const float* const OUTP = out_ptr();
    const int gw = F.vcu * NWAVES + F.wave, NGW = F.G * NWAVES;
    {
        LAS float* scr = (LAS float*)(F.lds + RING_OFF + F.wave * 16384);
        const float* win = in_ptr(2) + (size_t)layer * DM * NIN;
        const float* wout = in_ptr(11) + (size_t)layer * 2048 * DM;
        constexpr int KB_IN = DM / 64;
        constexpr int I_1K = KB_IN * (1024 / 32), I_X = KB_IN * (1536 / 32), I_OUT = (2048 / 64) * (1024 / 32);
        constexpr int NITEMS = 5 * I_1K + I_X + (WOUT_IN_B ? 0 : I_OUT);
        for (int it = gw; it < NITEMS; it += NGW) {
            int r = it;
            if (r < I_1K) { transpose_item(win + 0,    NIN, DM, 1024, WinT, C_Q, scr, r, F.lane); continue; } r -= I_1K;
            if (r < I_1K) { transpose_item(win + 4096, NIN, DM, 1024, WinT, C_Z, scr, r, F.lane); continue; } r -= I_1K;
            if (r < I_1K) { transpose_item(win + 1024, NIN, DM, 1024, WinT, C_K, scr, r, F.lane); continue; } r -= I_1K;
            if (r < I_1K) { transpose_item(win + 2048, NIN, DM, 1024, WinT, C_V, scr, r, F.lane); continue; } r -= I_1K;
            if (r < I_1K) { transpose_item(win + 3072, NIN, DM, 1024, WinT, C_G, scr, r, F.lane); continue; } r -= I_1K;
            if (r < I_X)  { transpose_item(win + 5120, NIN, DM, 1536, WinT, C_X, scr, r, F.lane); continue; } r -= I_X;
            transpose_item(wout, DM, 2048, 1024, WoutT, 0, scr, r, F.lane, in_ptr(10) + (size_t)layer * 1024, 1024);
        }
    }
    __syncthreads();
    LAS unsigned short* wdb = (LAS unsigned short*)(F.lds + RING_OFF); LAS float* lnl = (LAS float*)(F.lds + RING_OFF + 32768);
    {
        const float* win = in_ptr(2) + (size_t)layer * DM * NIN + 6656; const float* lnw = in_ptr(1) + layer * DM;
        for (int i = F.tid; i < 16 * 1024; i += NWAVES * 64) { const int k = i >> 4, c = i & 15; wdb[c * 1024 + k] = (unsigned short)f2bf(win[(size_t)k * NIN + c]); }
        for (int i = F.tid; i < 1024; i += NWAVES * 64) lnl[i] = lnw[i];
    }
    __syncthreads();
    const float* xin = layer == 0 ? in_ptr(0) : OUTP;
    const float* dtb = in_ptr(7) + layer * NSH;
    float* const RSTD = WSP(float, WS_RSTD);
    const int r = F.lane & 15, g4 = F.lane >> 4;
    for (int grp = gw; grp < M / 16; grp += NGW) {
        asm volatile("" ::: "memory");
        const size_t m0 = (size_t)grp * 16;
        const char* xb = (const char*)(xin + (m0 + r) * DM + 8 * g4); char* ob = (char*)(XN + (m0 + r) * DM + 8 * g4);
        f32x4 acc = {0.f, 0.f, 0.f, 0.f}; float ssq = 0.f;
#pragma unroll 8
        for (int kk = 0; kk < 32; ++kk) {
            const f32x4 a = __builtin_nontemporal_load((const f32x4*)(xb + kk * 128)), b = __builtin_nontemporal_load((const f32x4*)(xb + kk * 128 + 16));
            const f32x4 la = *(const LAS f32x4*)(lnl + 32 * kk + 8 * g4), lb = *(const LAS f32x4*)(lnl + 32 * kk + 8 * g4 + 4);
            ssq += ((a.x * a.x + a.y * a.y) + (a.z * a.z + a.w * a.w)) + ((b.x * b.x + b.y * b.y) + (b.z * b.z + b.w * b.w));
            const f32x4 ha = a * la, hb = b * lb;
            v4u pk; pk.x = pk2(ha.x, ha.y); pk.y = pk2(ha.z, ha.w); pk.z = pk2(hb.x, hb.y); pk.w = pk2(hb.z, hb.w);
            *(v4u*)(ob + kk * 64) = pk;
            const bf16x8 wf = *(const LAS bf16x8*)(wdb + r * 1024 + 32 * kk + 8 * g4);
            acc = __builtin_amdgcn_mfma_f32_16x16x32_bf16(wf, __builtin_bit_cast(bf16x8, pk), acc, 0, 0, 0);
        }
        ssq += __shfl_xor(ssq, 16); ssq += __shfl_xor(ssq, 32);
        const float rstd = 1.f / sqrtf(ssq * (1.f / DM) + EPS);
        if (g4 == 0) RSTD[m0 + r] = rstd;
        f32x4 o;
#pragma unroll
        for (int i = 0; i < 4; ++i) { const float a = acc[i] * rstd + dtb[4 * g4 + i], u = __expf(-fabsf(a));
            o[i] = fmaxf(a, 0.f) + (u < 1e-3f ? u * (1.f - u * (0.5f - 0.33333334f * u)) : __logf(1.f + u)); }
        *(f32x4*)(DT + (m0 + r) * 16 + 4 * g4) = o;
    }
}

__device__ __forceinline__ void phase_c(Frame& F, int layer) {
    bf16* const PROJ = WSP(bf16, WS_PROJ); bf16* const BCc = WSP(bf16, WS_A); float* const KM = WSP(float, WS_KM);
    {
        const float* const DT = WSP(float, WS_DT); float* const ACS = WSP(float, WS_ACS); const float* alog = in_ptr(8) + layer * NSH;
        const int gw = F.vcu * NWAVES + F.wave, NGW = F.G * NWAVES;
        for (int i = gw; i < (M / 64) * NSH; i += NGW) {
            const int h = i & 15; const size_t idx = ((size_t)(i >> 4) * 64 + F.lane) * 16 + h;
            float a = DT[idx] * -__expf(alog[h]);
#pragma unroll
            for (int o = 1; o < 64; o <<= 1) { const float t = __shfl_up(a, o); if (F.lane >= o) a += t; }
            ACS[idx] = a;
        }
    }
    const float* cw = in_ptr(5) + (size_t)layer * 4 * 1536 + 1024;
    const float* cb = in_ptr(6) + (size_t)layer * 1536 + 1024;
    const int gt = F.vcu * (NWAVES * 64) + F.tid, NGT = F.G * NWAVES * 64;
    for (int i = gt; i < M * 64; i += NGT) {
        const int m = i >> 6, c8 = (i & 63) * 8, t = m & (SEQ - 1);
        float acc[8];
#pragma unroll
        for (int e = 0; e < 8; ++e) acc[e] = cb[c8 + e];
#pragma unroll
        for (int k = 0; k < 4; ++k) {
            if (t - 3 + k >= 0) {
                const v4u u = *(const v4u*)(PROJ + (size_t)(m - 3 + k) * PITCH + C_B + c8);
                const float* w = cw + k * 1536 + c8;
                acc[0] += w[0] * bflo(u.x); acc[1] += w[1] * bfhi(u.x); acc[2] += w[2] * bflo(u.y); acc[3] += w[3] * bfhi(u.y);
                acc[4] += w[4] * bflo(u.z); acc[5] += w[5] * bfhi(u.z); acc[6] += w[6] * bflo(u.w); acc[7] += w[7] * bfhi(u.w);
            }
        }
        v4u o; o.x = pk2(silu_f(acc[0]), silu_f(acc[1])); o.y = pk2(silu_f(acc[2]), silu_f(acc[3])); o.z = pk2(silu_f(acc[4]), silu_f(acc[5])); o.w = pk2(silu_f(acc[6]), silu_f(acc[7]));
        *(v4u*)(BCc + (size_t)m * 512 + c8) = o;
    }
}


namespace ssd {
typedef float f32x4v __attribute__((ext_vector_type(4)));
typedef short s16x4v __attribute__((ext_vector_type(4)));
constexpr int L = 64, S256 = 272, S64 = 144, S32 = 144;
constexpr int O_BS = 0, O_CS = O_BS + 64 * S256, O_XB = O_CS + 64 * S256, O_XW = O_XB + 64 * S32, O_MT = O_XW + 64 * S32, O_ST = O_MT + 64 * S64,
              O_TB = O_ST + 2 * 64 * S256, O_CS2 = O_TB + NWAVES * 1024, O_XB2 = O_CS2 + 64 * S256, O_END = O_XB2 + 64 * S32;
static_assert(O_END <= LDSCTL_OFF, "SSD LDS map");
#define LD128(off) (*(const LAS bf16x8*)(lds + (off)))
#define MFMA16(a, b, c) __builtin_amdgcn_mfma_f32_16x16x32_bf16(a, b, c, 0, 0, 0)
#define TRRD(dst, addr, off) asm volatile("ds_read_b64_tr_b16 %0, %1 offset:%2" : "=&v"(dst) : "v"(addr), "i"(off) : "memory")
#define TRWAIT() do { asm volatile("s_waitcnt lgkmcnt(0)" ::: "memory"); __builtin_amdgcn_sched_barrier(0); } while (0)
#define CAT8(lo, hi) ((bf16x8){lo[0], lo[1], lo[2], lo[3], hi[0], hi[1], hi[2], hi[3]})
typedef __bf16 bf16x2n __attribute__((ext_vector_type(2)));
__device__ __forceinline__ unsigned cvtpk(float lo, float hi) { bf16x2n v = {(__bf16)lo, (__bf16)hi}; return __builtin_bit_cast(unsigned, v); }
__device__ __forceinline__ float silu_fast(float v) { return v * __builtin_amdgcn_rcpf(1.f + __expf(-v)); }

__device__ __forceinline__ void item(LAS unsigned char* lds, int wave_, int layer, int b, int h) {
    int z_ = 0; asm volatile("" : "+v"(z_));
    const int wid = wave_, lane = (int)__builtin_amdgcn_mbcnt_hi(~0u, __builtin_amdgcn_mbcnt_lo(~0u, (unsigned)z_)), tid = wid * 64 + lane, fr = lane & 15, fq = lane >> 4;
    const int g = h >> 3;
    const float Dh = in_ptr(9)[layer * NSH + h];
    const int brow = tid >> 4, bch = tid & 15;
    const int xl = tid >> 3, xpg = tid & 7;
    const int xcol = h * SHD + 4 * xpg;
    float cw[2][4][4], cbv[2][4];
    { const float* cwp = in_ptr(5) + (size_t)layer * 4 * 1536 + xcol; const float* cbp = in_ptr(6) + (size_t)layer * 1536 + xcol;
#pragma unroll
      for (int j = 0; j < 2; ++j) {
#pragma unroll
      for (int k = 0; k < 4; ++k)
#pragma unroll
          for (int e = 0; e < 4; ++e) cw[j][k][e] = cwp[k * 1536 + 32 * j + e];
#pragma unroll
      for (int e = 0; e < 4; ++e) cbv[j][e] = cbp[32 * j + e]; } }
    const char* pBC = (const char*)(WSP(bf16, WS_A) + (size_t)b * SEQ * 512 + g * 128);
    const char* pX = (const char*)(WSP(bf16, WS_PROJ) + (size_t)b * SEQ * PITCH + C_X);
    char* pZ = (char*)(WSP(bf16, WS_PROJ) + (size_t)b * SEQ * PITCH + C_Z + h * SHD);
    const char* pDT = (const char*)(WSP(float, WS_DT) + (size_t)b * SEQ * 16 + h);
    const char* pAC = (const char*)(WSP(float, WS_ACS) + (size_t)b * SEQ * 16 + h);
    float* pSQ = WSP(float, WS_SSQ) + (size_t)b * SEQ * 64 + h * 4;
    const unsigned obc = (unsigned)(brow * 512 + bch * 8) * 2u;
    const int oxr = (xl - 3) * PITCH * 2 + xcol * 2;
    const unsigned odt = (unsigned)lane * 64u;
    const int tl = wid >> 1, ts0 = 2 * (wid & 1), tpC = wid & 1, tn = wid;
    const unsigned ozy = (unsigned)((16 * tl + fr) * PITCH + 32 * tpC + 4 * fq) * 2u;
    const int trq = fr >> 2, trp = fr & 3;
    const int aXB = (int)(unsigned)(size_t)(lds + O_XB) + (8 * fq + trq) * S32 + (4 * trp) * 2;
    const int aXBc = aXB + 64 * tpC;
    const int aXW = (int)(unsigned)(size_t)(lds + O_XW) + (8 * fq + trq) * S32 + (4 * trp) * 2;
    const int aBS = (int)(unsigned)(size_t)(lds + O_BS) + (8 * fq + trq) * S256 + (16 * tn + 4 * trp) * 2;
    f32x4v accS[4] = {};
    for (int i = tid; i < 64 * S256 / 4; i += NWAVES * 64) ((LAS unsigned*)(lds + O_ST))[i] = 0u;
    LAS float* const tb = (LAS float*)(lds + O_TB + wid * 1024);
    v4u bu0_0, bu1_0, cu0_0, cu1_0, bu0_1, bu1_1, cu0_1, cu1_1; v2u xr_0[2][4], xr_1[2][4], zr_0[2], zr_1[2]; float dtn_0, dtn_1, acn_0, acn_1;
#define SSD_LOAD(c, S_) do { const char* bc_ = pBC + (size_t)(c) * (L * 512 * 2); const char* px_ = pX + (size_t)(c) * (L * PITCH * 2); \
        bu0_##S_ = *(const v4u*)(bc_ + obc); bu1_##S_ = *(const v4u*)(bc_ + obc + 32 * 512 * 2); cu0_##S_ = *(const v4u*)(bc_ + obc + 512); cu1_##S_ = *(const v4u*)(bc_ + obc + 32 * 512 * 2 + 512); \
        _Pragma("unroll") for (int j = 0; j < 2; ++j) _Pragma("unroll") for (int k = 0; k < 4; ++k) xr_##S_[j][k] = ((c) * L + xl - 3 + k >= 0) ? *(const v2u*)(px_ + (oxr + k * PITCH * 2 + 64 * j)) : (v2u){0u, 0u}; \
        dtn_##S_ = *(const float*)(pDT + (size_t)(c) * (L * 64) + odt); acn_##S_ = *(const float*)(pAC + (size_t)(c) * (L * 64) + odt); \
        zr_##S_[0] = *(const v2u*)(pZ + (size_t)(c) * (L * PITCH * 2) + ozy); zr_##S_[1] = *(const v2u*)(pZ + (size_t)(c) * (L * PITCH * 2) + ozy + 32); } while (0)
#define SSD_STEP(c, S_) do { \
        QS0(0); \
        constexpr int OCS = (S_) ? O_CS2 : O_CS, OXB = (S_) ? O_XB2 : O_XB;     \
        const int aXBs = aXBc + (OXB - O_XB); \
          \
        const float dtv = dtn_##S_, acs = acn_##S_; \
        const float tot = __builtin_bit_cast(float, __builtin_amdgcn_readlane(__builtin_bit_cast(int, acs), 63)); \
        const float ea = __expf(acs); \
        tb[lane] = acs; tb[64 + lane] = dtv; tb[128 + lane] = __expf(tot - acs) * dtv; tb[192 + lane] = ea; \
        const v2u zq0 = zr_##S_[0], zq1 = zr_##S_[1]; \
          \
        { \
            *(LAS v4u*)(lds + O_BS + brow * S256 + bch * 16) = bu0_##S_; *(LAS v4u*)(lds + O_BS + (32 + brow) * S256 + bch * 16) = bu1_##S_; \
            *(LAS v4u*)(lds + OCS + brow * S256 + bch * 16) = cu0_##S_; *(LAS v4u*)(lds + OCS + (32 + brow) * S256 + bch * 16) = cu1_##S_; \
            asm volatile("s_waitcnt lgkmcnt(0)" ::: "memory"); \
            const float wl = tb[128 + xl]; \
            _Pragma("unroll") for (int j = 0; j < 2; ++j) { \
                float xv[4]; \
                _Pragma("unroll") for (int e = 0; e < 4; ++e) xv[e] = cbv[j][e]; \
                _Pragma("unroll") for (int k = 0; k < 4; ++k) { xv[0] += cw[j][k][0] * bflo(xr_##S_[j][k].x); xv[1] += cw[j][k][1] * bfhi(xr_##S_[j][k].x); xv[2] += cw[j][k][2] * bflo(xr_##S_[j][k].y); xv[3] += cw[j][k][3] * bfhi(xr_##S_[j][k].y); } \
                _Pragma("unroll") for (int e = 0; e < 4; ++e) xv[e] = silu_fast(xv[e]); \
                *(LAS v2u*)(lds + OXB + xl * S32 + xpg * 8 + 64 * j) = (v2u){cvtpk(xv[0], xv[1]), cvtpk(xv[2], xv[3])}; \
                *(LAS v2u*)(lds + O_XW + xl * S32 + xpg * 8 + 64 * j) = (v2u){cvtpk(xv[0] * wl, xv[1] * wl), cvtpk(xv[2] * wl, xv[3] * wl)}; } \
        } \
        QS1(0); QS0(1); __syncthreads(); QS1(1); QS0(2); \
        if ((c) + 2 < SEQ / L) SSD_LOAD((c) + 2, S_);                          \
          \
        { \
            bf16x8 cf[4]; \
            _Pragma("unroll") for (int kk = 0; kk < 4; ++kk) cf[kk] = LD128(OCS + (16 * tl + fr) * S256 + (32 * kk + 8 * fq) * 2); \
            const float al = tb[16 * tl + fr];                                 \
            const int l = 16 * tl + fr; \
            _Pragma("unroll") for (int j = 0; j < 2; ++j) { \
                const int ts = ts0 + j; \
                if (ts <= tl) { \
                    f32x4v gacc = {}; \
                    _Pragma("unroll") for (int kk = 0; kk < 4; ++kk) gacc = MFMA16(LD128(O_BS + (16 * ts + fr) * S256 + (32 * kk + 8 * fq) * 2), cf[kk], gacc);     \
                    const f32x4v as4 = *(const LAS f32x4v*)(tb + 16 * ts + 4 * fq), ds4 = *(const LAS f32x4v*)(tb + 64 + 16 * ts + 4 * fq); \
                    float mv[4]; \
                    _Pragma("unroll") for (int r = 0; r < 4; ++r) mv[r] = (16 * ts + 4 * fq + r <= l) ? gacc[r] * __expf(al - as4[r]) * ds4[r] : 0.f; \
                    *(LAS v2u*)(lds + O_MT + l * S64 + (16 * ts + 4 * fq) * 2) = (v2u){cvtpk(mv[0], mv[1]), cvtpk(mv[2], mv[3])}; \
                } else { \
                    *(LAS v2u*)(lds + O_MT + l * S64 + (16 * ts + 4 * fq) * 2) = (v2u){0u, 0u}; \
                } \
            } \
            const float dec = __expf(tot); \
            s16x4v b0, b1, b2, b3; \
            TRRD(b0, aBS, 0); TRRD(b1, aBS, 4 * S256); TRRD(b2, aBS, 32 * S256); TRRD(b3, aBS, 36 * S256); \
            _Pragma("unroll") for (int tp = 0; tp < 4; ++tp) { s16x4v x0, x1, x2, x3; \
                TRRD(x0, aXW, 32 * tp); TRRD(x1, aXW, 4 * S32 + 32 * tp); TRRD(x2, aXW, 32 * S32 + 32 * tp); TRRD(x3, aXW, 36 * S32 + 32 * tp); \
                TRWAIT(); \
                accS[tp] = accS[tp] * dec; \
                accS[tp] = MFMA16(CAT8(b0, b1), CAT8(x0, x1), accS[tp]); accS[tp] = MFMA16(CAT8(b2, b3), CAT8(x2, x3), accS[tp]);     \
            } \
            _Pragma("unroll") for (int tp = 0; tp < 4; ++tp) \
                *(LAS v2u*)(lds + O_ST + (cur ^ 1) * 64 * S256 + (16 * tp + fr) * S256 + (16 * tn + 4 * fq) * 2) = (v2u){cvtpk(accS[tp][0], accS[tp][1]), cvtpk(accS[tp][2], accS[tp][3])}; \
        } \
        QS1(2); QS0(3); __syncthreads(); QS1(3); QS0(4); \
          \
        { \
            const bf16x8 m0f = LD128(O_MT + (16 * tl + fr) * S64 + (8 * fq) * 2), m1f = LD128(O_MT + (16 * tl + fr) * S64 + (32 + 8 * fq) * 2); \
            bf16x8 cfr[4]; \
            _Pragma("unroll") for (int kk = 0; kk < 4; ++kk) cfr[kk] = LD128(OCS + (16 * tl + fr) * S256 + (32 * kk + 8 * fq) * 2); \
            const float eal = tb[192 + 16 * tl + fr]; \
            _Pragma("unroll") for (int j = 0; j < 2; ++j) { \
                s16x4v x0, x1, x2, x3; \
                TRRD(x0, aXBs, 32 * j); TRRD(x1, aXBs, 4 * S32 + 32 * j); TRRD(x2, aXBs, 32 * S32 + 32 * j); TRRD(x3, aXBs, 36 * S32 + 32 * j); \
                TRWAIT(); \
                f32x4v yd = {}, yo = {}; \
                yd = MFMA16(CAT8(x0, x1), m0f, yd); yd = MFMA16(CAT8(x2, x3), m1f, yd); \
                _Pragma("unroll") for (int kk = 0; kk < 4; ++kk) yo = MFMA16(LD128(O_ST + cur * 64 * S256 + (32 * tpC + 16 * j + fr) * S256 + (32 * kk + 8 * fq) * 2), cfr[kk], yo); \
                const v2u xb = *(const LAS v2u*)(lds + OXB + (16 * tl + fr) * S32 + (32 * tpC + 16 * j + 4 * fq) * 2); \
                const v2u zr = j ? zq1 : zq0;                                 \
                float yz[4]; \
                yz[0] = (yd[0] + eal * yo[0] + Dh * bflo(xb.x)) * bflo(zr.x); yz[1] = (yd[1] + eal * yo[1] + Dh * bfhi(xb.x)) * bfhi(zr.x); \
                yz[2] = (yd[2] + eal * yo[2] + Dh * bflo(xb.y)) * bflo(zr.y); yz[3] = (yd[3] + eal * yo[3] + Dh * bfhi(xb.y)) * bfhi(zr.y); \
                *(v2u*)(pZ + (size_t)(c) * (L * PITCH * 2) + ozy + 32 * j) = (v2u){cvtpk(yz[0], yz[1]), cvtpk(yz[2], yz[3])}; \
                float q = (yz[0] * yz[0] + yz[1] * yz[1]) + (yz[2] * yz[2] + yz[3] * yz[3]); \
                q += __shfl_xor(q, 16); q += __shfl_xor(q, 32); \
                if (fq == 0) pSQ[((size_t)(c) * L + 16 * tl + fr) * 64 + 2 * tpC + j] = q; } \
        } \
          \
        QS1(4); cur ^= 1; } while (0)
    unsigned long long qacc = 0;
#define QS0(k) unsigned long long qt##k##_ = 0; if (PROBE_SSEC == (k)) qt##k##_ = __builtin_amdgcn_s_memtime()
#define QS1(k) do { if (PROBE_SSEC == (k)) qacc += __builtin_amdgcn_s_memtime() - qt##k##_; } while (0)
    SSD_LOAD(0, 0); SSD_LOAD(1, 1);
    int cur = 0;
#pragma unroll 1
    for (int c = 0; c < SEQ / L; c += 2) { SSD_STEP(c, 0); SSD_STEP(c + 1, 1); }
    if (PROBE_SSEC >= 0) { const unsigned long long t0 = __builtin_amdgcn_s_memtime(); while (__builtin_amdgcn_s_memtime() - t0 < qacc) __builtin_amdgcn_s_sleep(8); }
    __syncthreads();
#undef QS0
#undef QS1
#undef SSD_STEP
#undef SSD_LOAD
}
#undef LD128
#undef MFMA16
#undef TRRD
#undef TRWAIT
#undef CAT8
}


__device__ __forceinline__ void ssd_phase(Frame& F, int layer) {
    if ((F.vcu & 1) == 0) for (int it = F.vcu >> 1; it < BATCH * NSH; it += (F.G + 1) >> 1) ssd::item(F.lds + RING_OFF, F.wave, layer, it >> 4, it & 15);
}


namespace moba {
typedef float f32x16 __attribute__((ext_vector_type(16)));
typedef short s16x4 __attribute__((ext_vector_type(4)));
typedef unsigned u32x4 __attribute__((ext_vector_type(4)));
constexpr int NW = 8, QBLK = 32, KVBLK = 64, QB = NW * QBLK;
constexpr int SHM_V = KVBLK * HD * 2, SHM_K = KVBLK * HD * 2;
constexpr int OFF_V = 0, OFF_K = 3 * SHM_V, OFF_WS = 3 * SHM_V + 3 * SHM_K, OFF_KM = OFF_WS + NW * 64 * 4;
constexpr int ATTN_LDS = OFF_KM + 32 * 256;
constexpr float SCALE = 0.08838834764831845f, LOG2E = 1.4426950408889634f;

#define KSWZ(row, colB) ((row) * 256 + ((colB) ^ (((row) & 7) << 4)))
#define SBAR() __builtin_amdgcn_sched_barrier(0)
__device__ __forceinline__ int v_st(int k, int c) { const int kk = (k & ~0xC) | ((k & 4) << 1) | ((k & 8) >> 1); return ((kk >> 3) * 4 + (c >> 5)) * 512 + ((kk & 7) * 32 + (c & 31)) * 2; }
__device__ __forceinline__ int v_rd_base(int lane) { return ((lane & 3) << 3) | (((lane >> 2) & 3) << 6) | (((lane >> 4) & 1) << 5) | (((lane >> 5) & 1) << 8); }
constexpr int v_rd_off(int d0, int ks, int half) { return d0 * 512 + ks * 4096 + half * 2048; }
__device__ __forceinline__ int crow(int r, int hi) { return (r & 3) + 8 * (r >> 2) + 4 * hi; }
typedef __bf16 bf16x2n __attribute__((ext_vector_type(2)));
__device__ __forceinline__ unsigned cvtpk(float lo, float hi) { bf16x2n v = {(__bf16)lo, (__bf16)hi}; return __builtin_bit_cast(unsigned, v); }

struct Unit { const bf16* Q; const bf16* K; const bf16* V; const float* KM; int qb, h, jlo;
#if PROBE_MEM2 == 1
    long dum; __device__ __forceinline__ long dumv() const { return dum; }
#else
    __device__ __forceinline__ long dumv() const { return 0; }
#endif
};
struct Seam { bf16x8 qr[8]; bf16x8 st_v0, st_v1, st_k0, st_k1; };
constexpr int OFF_ORD = 108 * 1024, OFF_TK = OFF_ORD + 2048, OFF_WT = OFF_TK + 16;
struct Queue { unsigned* ctr; bf16* PROJ; const float* KM; };
__device__ __forceinline__ bool unit_from_ticket(unsigned t, const Queue& q, const LAS char* lds, Unit& u) {
    if (t >= (unsigned)(BATCH * NH * NBLK)) return false;
    const int id = __builtin_amdgcn_readfirstlane((int)((const LAS unsigned short*)(lds + OFF_ORD))[t]), b = id >> 7, h = (id >> 4) & 7, qb = id & 15;
    const int w = __builtin_amdgcn_readfirstlane(((const LAS int*)(lds + OFF_WT))[h]);
    const bf16* base = q.PROJ + (size_t)b * SEQ * PITCH + h * HD;
    u.Q = base + (size_t)qb * MOBA * PITCH + C_Q; u.K = base + C_K; u.V = base + C_V; u.KM = q.KM + (size_t)(b * NH + h) * NBLK * HD; u.qb = qb; u.h = h;
    u.jlo = qb > w ? 4 * (qb - w) : 0;
#if PROBE_MEM2 == 1
    u.dum = (b < 4 ? 1 : -1) * (long)(4 * SEQ) * PITCH * 2;
#endif
    return true;
}

__device__ __forceinline__ void mask_tile(f32x16& p0, f32x16& p1, int dq) {
    const float NEG = -__builtin_inff();
#pragma unroll
    for (int r = 0; r < 16; ++r) { const int c = (r & 3) + 8 * (r >> 2); if (dq - c < 0) p0[r] = NEG; if (dq - c - 32 < 0) p1[r] = NEG; }
}
__device__ __forceinline__ void partialSM(f32x16& p0, f32x16& p1, float base, float slope2) {
    constexpr float C2 = LOG2E * SCALE;
#pragma unroll
    for (int r = 0; r < 16; ++r) { const float c = (float)((r & 3) + 8 * (r >> 2)); p0[r] = fmaf(p0[r], C2, fmaf(slope2, c, base)); p1[r] = fmaf(p1[r], C2, fmaf(slope2, c + 32.f, base)); }
#pragma unroll
    for (int r = 0; r < 16; ++r) p0[r] = __builtin_amdgcn_exp2f(p0[r]);
}
__device__ __forceinline__ void finishSM(f32x16& p0, f32x16& p1, float& l_reg, bf16x8& pa0, bf16x8& pa1, bf16x8& pa2, bf16x8& pa3) {
#pragma unroll
    for (int r = 0; r < 16; ++r) p1[r] = __builtin_amdgcn_exp2f(p1[r]);
    float ps = 0;
#pragma unroll
    for (int r = 0; r < 16; ++r) ps += p0[r];
#pragma unroll
    for (int r = 0; r < 16; ++r) ps += p1[r];
    { auto rr = __builtin_amdgcn_permlane32_swap(__float_as_uint(ps), __float_as_uint(ps), false, false); ps = __uint_as_float(rr[0]) + __uint_as_float(rr[1]); }
    l_reg += ps;
#define PK4(P, B_, OUT) do { unsigned a0 = cvtpk(P[B_+0], P[B_+1]), a1 = cvtpk(P[B_+2], P[B_+3]); unsigned b0 = cvtpk(P[B_+4], P[B_+5]), b1 = cvtpk(P[B_+6], P[B_+7]); \
        auto r0 = __builtin_amdgcn_permlane32_swap(a0, b0, false, false); auto r1 = __builtin_amdgcn_permlane32_swap(a1, b1, false, false); \
        u32x4 w = {r0[0], r1[0], r0[1], r1[1]}; OUT = *reinterpret_cast<bf16x8*>(&w); } while (0)
    PK4(p0, 0, pa0); PK4(p0, 8, pa1); PK4(p1, 0, pa2); PK4(p1, 8, pa3);
#undef PK4
}
__device__ __forceinline__ void qkt(f32x16& p0, f32x16& p1, const LAS char* const (&kbase)[4], int kslot, const bf16x8* qr) {
    p0 = f32x16{}; p1 = f32x16{};
#pragma unroll
    for (int d0 = 0; d0 < 8; ++d0) { const LAS char* a = kbase[d0 & 3] + kslot + (d0 >> 2) * 128;
        bf16x8 b0 = *reinterpret_cast<const LAS bf16x8*>(a);
        bf16x8 b1 = *reinterpret_cast<const LAS bf16x8*>(a + 32 * 256);
        p0 = __builtin_amdgcn_mfma_f32_32x32x16_bf16(b0, qr[d0], p0, 0, 0, 0);
        p1 = __builtin_amdgcn_mfma_f32_32x32x16_bf16(b1, qr[d0], p1, 0, 0, 0); }
}
__device__ __forceinline__ void pv_tile(f32x16* o, int vb0, bf16x8 pa0, bf16x8 pa1, bf16x8 pa2, bf16x8 pa3) {
#define TRRD(dst, off) asm volatile("ds_read_b64_tr_b16 %0, %1 offset:%2" : "=&v"(dst) : "v"(vb0), "i"(off) : "memory")
#define PV_D0(d0) do { s16x4 l0, l1, l2, l3, h0, h1, h2, h3; constexpr int b_ = v_rd_off(d0, 0, 0); \
        TRRD(l0, b_); TRRD(h0, b_ + 2048); TRRD(l1, b_ + 4096); TRRD(h1, b_ + 6144); TRRD(l2, b_ + 8192); TRRD(h2, b_ + 10240); TRRD(l3, b_ + 12288); TRRD(h3, b_ + 14336); \
        asm volatile("s_waitcnt lgkmcnt(0)" ::: "memory"); SBAR(); \
        o[d0] = __builtin_amdgcn_mfma_f32_32x32x16_bf16(pa0, (bf16x8){l0[0], l0[1], l0[2], l0[3], h0[0], h0[1], h0[2], h0[3]}, o[d0], 0, 0, 0); \
        o[d0] = __builtin_amdgcn_mfma_f32_32x32x16_bf16(pa1, (bf16x8){l1[0], l1[1], l1[2], l1[3], h1[0], h1[1], h1[2], h1[3]}, o[d0], 0, 0, 0); \
        o[d0] = __builtin_amdgcn_mfma_f32_32x32x16_bf16(pa2, (bf16x8){l2[0], l2[1], l2[2], l2[3], h2[0], h2[1], h2[2], h2[3]}, o[d0], 0, 0, 0); \
        o[d0] = __builtin_amdgcn_mfma_f32_32x32x16_bf16(pa3, (bf16x8){l3[0], l3[1], l3[2], l3[3], h3[0], h3[1], h3[2], h3[3]}, o[d0], 0, 0, 0); } while (0)
    PV_D0(0); PV_D0(1); PV_D0(2); PV_D0(3);
#undef PV_D0
#undef TRRD
}

#define TILEP(p, k0) ((const char*)((p) + (size_t)(k0) * PITCH))
#define VMW() asm volatile("s_waitcnt vmcnt(0)" ::: "memory")
#define VMWN(n) asm volatile("s_waitcnt vmcnt(%0)" :: "i"(n) : "memory")
#define LD8(p) (*reinterpret_cast<const bf16x8*>(p))
#define LD8O(base, off) (*reinterpret_cast<const bf16x8*>((base) + (off)))
#if PROBE_MEM2 == 1
#define DUMV cur.dum
#define SLOAD_DUM(vt_, kt_) do { LAS unsigned* dl_ = (LAS unsigned*)(lds + 114688 + wid * 1024); \
        __builtin_amdgcn_global_load_lds((const unsigned*)(vt_ + DUMV + roff0), dl_, 16, 0, 0); __builtin_amdgcn_global_load_lds((const unsigned*)(vt_ + DUMV + roff1), dl_, 16, 0, 0); \
        __builtin_amdgcn_global_load_lds((const unsigned*)(kt_ + DUMV + roff0), dl_, 16, 0, 0); __builtin_amdgcn_global_load_lds((const unsigned*)(kt_ + DUMV + roff1), dl_, 16, 0, 0); } while (0)
#define SLOAD_DUMN(vt_, kt_) do { LAS unsigned* dl_ = (LAS unsigned*)(lds + 114688 + wid * 1024); \
        __builtin_amdgcn_global_load_lds((const unsigned*)(vt_ + dumn_ + roff0), dl_, 16, 0, 0); __builtin_amdgcn_global_load_lds((const unsigned*)(vt_ + dumn_ + roff1), dl_, 16, 0, 0); \
        __builtin_amdgcn_global_load_lds((const unsigned*)(kt_ + dumn_ + roff0), dl_, 16, 0, 0); __builtin_amdgcn_global_load_lds((const unsigned*)(kt_ + dumn_ + roff1), dl_, 16, 0, 0); } while (0)
#else
#define SLOAD_DUM(vt_, kt_) do { } while (0)
#define SLOAD_DUMN(vt_, kt_) do { } while (0)
#endif
#define SLOAD_HN(Kp, Vp, k0) do { const char* vt_ = TILEP(Vp, k0); const char* kt_ = TILEP(Kp, k0); S.st_v0 = LD8O(vt_, roff0); S.st_v1 = LD8O(vt_, roff1); S.st_k0 = LD8O(kt_, roff0); S.st_k1 = LD8O(kt_, roff1); SLOAD_DUMN(vt_, kt_); } while (0)
#if PROBE_MEM2 == 2
#define SLOAD_H(Kp, Vp, k0) do { const char* vt_ = TILEP(Vp, k0); const char* kt_ = TILEP(Kp, k0); S.st_v0 = LD8O(vt_, roff0); S.st_v1 = LD8O(vt_, roff1); S.st_k0 = LD8O(kt_, roff0); S.st_k1 = LD8O(kt_, roff1); \
        { const int kp_ = min((k0) + PFD * KVBLK, kmax_); const char* vp_ = TILEP(Vp, kp_); const char* kq_ = TILEP(Kp, kp_); LAS unsigned* dl_ = (LAS unsigned*)(lds + 114688 + wid * 1024); \
          __builtin_amdgcn_global_load_lds((const unsigned*)(vp_ + roff0), dl_, 16, 0, 0); __builtin_amdgcn_global_load_lds((const unsigned*)(vp_ + roff1), dl_, 16, 0, 0); \
          __builtin_amdgcn_global_load_lds((const unsigned*)(kq_ + roff0), dl_, 16, 0, 0); __builtin_amdgcn_global_load_lds((const unsigned*)(kq_ + roff1), dl_, 16, 0, 0); } } while (0)
#else
#define SLOAD_H(Kp, Vp, k0) do { const char* vt_ = TILEP(Vp, k0); const char* kt_ = TILEP(Kp, k0); S.st_v0 = LD8O(vt_, roff0); S.st_v1 = LD8O(vt_, roff1); S.st_k0 = LD8O(kt_, roff0); S.st_k1 = LD8O(kt_, roff1); SLOAD_DUM(vt_, kt_); } while (0)
#endif
#define SWRITE_HK(so) do { *(LAS bf16x8*)(K_lds + (so) + kws) = S.st_k0; *(LAS bf16x8*)(K_lds + (so) + kws + 32 * 256) = S.st_k1; } while (0)
#define SWRITE_HV(so) do { *(LAS bf16x8*)(V_lds + (so) + vst0) = S.st_v0; *(LAS bf16x8*)(V_lds + (so) + vst1) = S.st_v1; } while (0)
#define SWRITE_H(so) do { SWRITE_HV(so); SWRITE_HK(so); } while (0)

__device__ __forceinline__ void prime(const Unit& cur, LAS char* lds, Seam& S, int wave_) {
    int z_ = 0; asm volatile("" : "+v"(z_)); const int tid = wave_ * 64 + (int)__builtin_amdgcn_mbcnt_hi(~0u, __builtin_amdgcn_mbcnt_lo(~0u, (unsigned)z_));
    const int wid = __builtin_amdgcn_readfirstlane(tid >> 6), lane = tid & 63, r32 = lane & 31, hi = lane >> 5;
    const int sr = tid >> 4, sc = (tid & 15) * 8, kws = KSWZ(sr, sc * 2); LAS char* K_lds = lds + OFF_K;
    const unsigned roff0 = (unsigned)(sr * PITCH + sc) * 2u, roff1 = roff0 + 32u * PITCH * 2u, qoff = (unsigned)(r32 * PITCH + hi * 8) * 2u;
    { const char* qb_ = (const char*)(cur.Q + (size_t)(wid * QBLK) * PITCH);
#pragma unroll
    for (int d0 = 0; d0 < 8; ++d0) S.qr[d0] = LD8O(qb_, qoff + d0 * 32); }
    const int kmax_ = (4 * (cur.qb + 1) - 1) * KVBLK; (void)kmax_;
    SLOAD_H(cur.K, cur.V, cur.jlo * KVBLK); VMW(); SWRITE_HK(0);
    __syncthreads();
}
__device__ __forceinline__ void block(const Unit& cur, Unit& nxt, bool& more, const Queue& Qd, float slope2, float M2, LAS char* lds, Seam& S, int wave_, unsigned long long& pacc) {
#define PS0(k) unsigned long long pt##k##_ = 0; if (PROBE_SEC == (k)) pt##k##_ = __builtin_amdgcn_s_memtime()
#define PS1(k) do { if (PROBE_SEC == (k)) pacc += __builtin_amdgcn_s_memtime() - pt##k##_; } while (0)
    PS0(6); PS0(4);
    int z_ = 0; asm volatile("" : "+v"(z_)); const int tid = wave_ * 64 + (int)__builtin_amdgcn_mbcnt_hi(~0u, __builtin_amdgcn_mbcnt_lo(~0u, (unsigned)z_));
    const int wid = __builtin_amdgcn_readfirstlane(tid >> 6), lane = tid & 63, r32 = lane & 31, hi = lane >> 5;
    const unsigned roff0 = (unsigned)((tid >> 4) * PITCH + (tid & 15) * 8) * 2u, roff1 = roff0 + 32u * PITCH * 2u, qoff = (unsigned)(r32 * PITCH + hi * 8) * 2u;
    const int jlo = cur.jlo, NT = 4 * (cur.qb + 1) - jlo;
    LAS char* V_lds = lds + OFF_V; LAS char* K_lds = lds + OFF_K;
    LAS float* li_l = (LAS float*)(lds + OFF_WS) + wid * 64;
    float l_reg = 0; f32x16 o[4] = {};
    const int sr = tid >> 4, sc = (tid & 15) * 8, vst0 = v_st(sr, sc), vst1 = v_st(32 + sr, sc), kws = KSWZ(sr, sc * 2);
    const int vb0 = (int)(unsigned)(size_t)V_lds + v_rd_base(lane);
    const bf16* Kh = cur.K; const bf16* Vh = cur.V; const int kmax_ = (4 * (cur.qb + 1) - 1) * KVBLK; (void)kmax_;
    const int tq = cur.qb * QB + wid * QBLK + r32;
    {
        const int n = sr & 15; const float* kp = cur.KM + n * HD + sc;
        const f32x4 a = *(const f32x4*)kp, b = *(const f32x4*)(kp + 4);
        float v[8] = {a.x, a.y, a.z, a.w, b.x, b.y, b.z, b.w}; unsigned w[4];
#pragma unroll
        for (int e = 0; e < 4; ++e) { const unsigned h0 = f2bf(v[2 * e]), h1 = f2bf(v[2 * e + 1]);
            if (sr < 16) w[e] = h0 | (h1 << 16); else w[e] = pk2(v[2 * e] - bflo(h0), v[2 * e + 1] - bflo(h1)); }
        *(LAS u32x4*)(lds + OFF_KM + KSWZ(sr, sc * 2)) = (u32x4){w[0], w[1], w[2], w[3]};
    }
    if (tid == 0) *(LAS unsigned*)(lds + OFF_TK) = __hip_atomic_fetch_add(Qd.ctr, 1u, __ATOMIC_RELAXED, __HIP_MEMORY_SCOPE_AGENT);
    __syncthreads();
    { const unsigned tnext = (unsigned)__builtin_amdgcn_readfirstlane((int)*(const LAS unsigned*)(lds + OFF_TK));
      more = unit_from_ticket(tnext, Qd, lds, nxt); if (!more) nxt = cur; }
    unsigned selmask = 0;
    {
        f32x16 pg = f32x16{};
#pragma unroll
        for (int d0 = 0; d0 < 8; ++d0) { const bf16x8 a = *reinterpret_cast<const LAS bf16x8*>(lds + OFF_KM + KSWZ(r32, (d0 * 16 + hi * 8) * 2));
            pg = __builtin_amdgcn_mfma_f32_32x32x16_bf16(a, S.qr[d0], pg, 0, 0, 0); }
        float g[16];
#pragma unroll
        for (int j = 0; j < 8; ++j) { const float mine = pg[j] + pg[j + 8], oth = __shfl_xor(mine, 32); const int n0 = (j & 3) + 8 * (j >> 2);
            g[n0] = hi ? oth : mine; g[n0 + 4] = hi ? mine : oth; }
        float v0 = -__builtin_inff(), v1 = v0, v2 = v0; int i0 = 0, i1 = 0, i2 = 0;
#pragma unroll
        for (int n = 0; n < 16; ++n) { const float gt = n < cur.qb ? g[n] : -__builtin_inff();
            if (gt > v0) { v2 = v1; i2 = i1; v1 = v0; i1 = i0; v0 = gt; i0 = n; }
            else if (gt > v1) { v2 = v1; i2 = i1; v1 = gt; i1 = n; }
            else if (gt > v2) { v2 = gt; i2 = n; } }
        if (v0 > -__builtin_inff()) selmask |= 1u << i0;
        if (v1 > -__builtin_inff()) selmask |= 1u << i1;
        if (v2 > -__builtin_inff()) selmask |= 1u << i2;
    }
    const float basec = -M2 + slope2 * (float)(4 * hi - tq);
    const int ownt = 4 * cur.qb - jlo;
#define KBASE(t) ((jlo + (t)) * KVBLK)
#define TBASE(t) (((t) >= ownt || ((selmask >> ((jlo + (t)) >> 2)) & 1u)) ? fmaf(slope2, (float)KBASE(t), basec) : -__builtin_inff())
#define MASKT(P0_, P1_, t) do { if ((t) >= ownt && KBASE(t) + KVBLK - 1 > cur.qb * QB + wid * QBLK) mask_tile(P0_, P1_, tq - 4 * hi - KBASE(t)); } while (0)
    f32x16 pA0, pA1, pB0, pB1; bf16x8 pa0, pa1, pa2, pa3;
    const LAS char* kbase[4];
#pragma unroll
    for (int dd = 0; dd < 4; ++dd) kbase[dd] = K_lds + KSWZ(r32, (dd * 16 + hi * 8) * 2);
    SWRITE_HV(0); SBAR();
    SLOAD_H(Kh, Vh, KBASE(1));
    SBAR(); qkt(pA0, pA1, kbase, 0, S.qr);
    MASKT(pA0, pA1, 0); partialSM(pA0, pA1, TBASE(0), slope2);
    VMW(); SWRITE_H(SHM_K); SBAR(); SLOAD_H(Kh, Vh, KBASE(2));
    __syncthreads();
    int sp = 0, scur = SHM_K, sn = 2 * SHM_K;
    bf16x8 kf0[2], kf1[2]; s16x4 vA[8], vB[8]; float psa, psb; unsigned ra0_, ra1_;
#define KRD(d0_, s_) do { const LAS char* a_ = kbase[(d0_) & 3] + scur + ((d0_) >> 2) * 128; kf0[s_] = *reinterpret_cast<const LAS bf16x8*>(a_); kf1[s_] = *reinterpret_cast<const LAS bf16x8*>(a_ + 32 * 256); } while (0)
#define TRRD2(dst, off) asm volatile("ds_read_b64_tr_b16 %0, %1 offset:%2" : "=&v"(dst) : "v"(vaddr_), "i"(off) : "memory")
#define FINC(k, Y0, Y1) do { \
        if ((k) < 8) { Y1[2 * ((k) & 7)] = __builtin_amdgcn_exp2f(Y1[2 * ((k) & 7)]); Y1[2 * ((k) & 7) + 1] = __builtin_amdgcn_exp2f(Y1[2 * ((k) & 7) + 1]); \
            if ((k) == 0) { psa = Y0[0]; psb = Y0[1]; } else { psa += Y0[2 * ((k) & 7)]; psb += Y0[2 * ((k) & 7) + 1]; } } \
        else { constexpr int j_ = (k) & 7, m_ = j_ >> 1, b_ = (m_ & 1) * 8; psa += Y1[2 * j_]; psb += Y1[2 * j_ + 1]; \
            if ((j_ & 1) == 0) { const unsigned a0_ = m_ < 2 ? cvtpk(Y0[b_], Y0[b_ + 1]) : cvtpk(Y1[b_], Y1[b_ + 1]), b0_ = m_ < 2 ? cvtpk(Y0[b_ + 4], Y0[b_ + 5]) : cvtpk(Y1[b_ + 4], Y1[b_ + 5]); \
                auto r_ = __builtin_amdgcn_permlane32_swap(a0_, b0_, false, false); ra0_ = r_[0]; ra1_ = r_[1]; } \
            else { const unsigned a1_ = m_ < 2 ? cvtpk(Y0[b_ + 2], Y0[b_ + 3]) : cvtpk(Y1[b_ + 2], Y1[b_ + 3]), b1_ = m_ < 2 ? cvtpk(Y0[b_ + 6], Y0[b_ + 7]) : cvtpk(Y1[b_ + 6], Y1[b_ + 7]); \
                auto r_ = __builtin_amdgcn_permlane32_swap(a1_, b1_, false, false); u32x4 w_ = {ra0_, r_[0], ra1_, r_[1]}; \
                if (m_ == 0) pa0 = *reinterpret_cast<bf16x8*>(&w_); else if (m_ == 1) pa1 = *reinterpret_cast<bf16x8*>(&w_); else if (m_ == 2) pa2 = *reinterpret_cast<bf16x8*>(&w_); else pa3 = *reinterpret_cast<bf16x8*>(&w_); } } \
        if ((k) >= 12) { constexpr int f_ = 2 * ((k) - 12), o_ = v_rd_off(0, 0, 0) + 2048 * f_; TRRD2(vA[f_ & 7], o_ & 0xffff); TRRD2(vA[(f_ + 1) & 7], (o_ + 2048) & 0xffff); } } while (0)
#define QKG(d0, PX0, PX1, PY0, PY1) do { \
        if ((d0) < 7) KRD(((d0) + 1) & 7, ((d0) + 1) & 1); \
        SBAR(); \
        PX0 = __builtin_amdgcn_mfma_f32_32x32x16_bf16(kf0[(d0) & 1], S.qr[d0], (d0) == 0 ? f32x16{} : PX0, 0, 0, 0); \
        SBAR(); FINC(2 * (d0), PY0, PY1); SBAR(); \
        PX1 = __builtin_amdgcn_mfma_f32_32x32x16_bf16(kf1[(d0) & 1], S.qr[d0], (d0) == 0 ? f32x16{} : PX1, 0, 0, 0); \
        SBAR(); FINC(2 * (d0) + 1, PY0, PY1); SBAR(); } while (0)
#define SMC(k, X0, X1) do { constexpr float c_ = (float)(((k) & 3) + 8 * ((k) >> 2)); \
        X0[k] = __builtin_amdgcn_exp2f(fmaf(X0[k], LOG2E * SCALE, fmaf(slope2, c_, tb_))); X1[k] = fmaf(X1[k], LOG2E * SCALE, fmaf(slope2, c_ + 32.f, tb_)); asm volatile("" :: "v"(X1[k])); } while (0)
#define FRV(A, j) (bf16x8){A[2 * (j)][0], A[2 * (j)][1], A[2 * (j)][2], A[2 * (j)][3], A[2 * (j) + 1][0], A[2 * (j) + 1][1], A[2 * (j) + 1][2], A[2 * (j) + 1][3]}
#define PVG(d0, CUR, NXT, X0, X1) do { constexpr int n_ = v_rd_off(((d0) + 1) & 3, 0, 0); \
        asm volatile("s_waitcnt lgkmcnt(0)" ::: "memory"); SBAR(); \
        o[d0] = __builtin_amdgcn_mfma_f32_32x32x16_bf16(pa0, FRV(CUR, 0), o[d0], 0, 0, 0); SBAR(); \
        if ((d0) < 3) { TRRD2(NXT[0], n_); TRRD2(NXT[1], n_ + 2048); TRRD2(NXT[2], n_ + 4096); TRRD2(NXT[3], n_ + 6144); } SMC(4 * (d0) + 0, X0, X1); SBAR(); \
        o[d0] = __builtin_amdgcn_mfma_f32_32x32x16_bf16(pa1, FRV(CUR, 1), o[d0], 0, 0, 0); SBAR(); \
        if ((d0) < 3) { TRRD2(NXT[4], n_ + 8192); TRRD2(NXT[5], n_ + 10240); TRRD2(NXT[6], n_ + 12288); TRRD2(NXT[7], n_ + 14336); } SMC(4 * (d0) + 1, X0, X1); SBAR(); \
        o[d0] = __builtin_amdgcn_mfma_f32_32x32x16_bf16(pa2, FRV(CUR, 2), o[d0], 0, 0, 0); SBAR(); SMC(4 * (d0) + 2, X0, X1); SBAR(); \
        o[d0] = __builtin_amdgcn_mfma_f32_32x32x16_bf16(pa3, FRV(CUR, 3), o[d0], 0, 0, 0); SBAR(); SMC(4 * (d0) + 3, X0, X1); SBAR(); } while (0)
#define STEP(PX0, PX1, PY0, PY1, t, LAST) do { \
        PS0(0); KRD(0, 0); const float tb_ = TBASE(t); const int vaddr_ = vb0 + sp; \
        if (!(LAST)) { VMW(); SWRITE_H(sn); SBAR(); if ((t) + 2 < NT) SLOAD_H(Kh, Vh, KBASE((t) + 2)); } \
        PS1(0); PS0(1); QKG(0, PX0, PX1, PY0, PY1); QKG(1, PX0, PX1, PY0, PY1); QKG(2, PX0, PX1, PY0, PY1); QKG(3, PX0, PX1, PY0, PY1); \
        QKG(4, PX0, PX1, PY0, PY1); QKG(5, PX0, PX1, PY0, PY1); QKG(6, PX0, PX1, PY0, PY1); QKG(7, PX0, PX1, PY0, PY1); \
        { float ps_ = psa + psb; auto rr_ = __builtin_amdgcn_permlane32_swap(__float_as_uint(ps_), __float_as_uint(ps_), false, false); l_reg += __uint_as_float(rr_[0]) + __uint_as_float(rr_[1]); } \
        asm volatile("" : "+v"(pa0), "+v"(pa1), "+v"(pa2), "+v"(pa3), "+v"(l_reg)); PS1(1); PS0(2); \
        if (LAST) { SBAR(); const char* nq_ = (const char*)(nxt.Q + (size_t)(wid * QBLK) * PITCH); \
            _Pragma("unroll") for (int d0 = 0; d0 < 8; ++d0) S.qr[d0] = LD8O(nq_, qoff + d0 * 32); SBAR(); \
            { const long dumn_ = PROBE_MEM2 == 1 ? nxt.dumv() : 0; (void)dumn_; SLOAD_HN(nxt.K, nxt.V, nxt.jlo * KVBLK); } SBAR(); }                   \
        MASKT(PX0, PX1, (t)); \
        PVG(0, vA, vB, PX0, PX1); PVG(1, vB, vA, PX0, PX1); PVG(2, vA, vB, PX0, PX1); PVG(3, vB, vA, PX0, PX1); \
        asm volatile("" : "+v"(PX0), "+v"(PX1)); PS1(2); PS0(3); \
        __syncthreads(); PS1(3); \
        { const int r_ = sp; sp = scur; scur = sn; sn = r_; } } while (0)
    PS1(4);
    int t = 1;
    for (; t + 1 < NT; t += 2) { STEP(pB0, pB1, pA0, pA1, t, false); STEP(pA0, pA1, pB0, pB1, t + 1, false); }
    STEP(pB0, pB1, pA0, pA1, t, true);
#undef STEP
#undef PVG
#undef FRV
#undef SMC
#undef QKG
#undef FINC
#undef TRRD2
#undef KRD
    PS0(5);
    finishSM(pB0, pB1, l_reg, pa0, pa1, pa2, pa3); SBAR();
    pv_tile(o, vb0 + sp, pa0, pa1, pa2, pa3);
    SBAR(); VMW(); SWRITE_HK(0); SBAR();
    if (hi == 0) li_l[r32] = l_reg;
    char* Ow = (char*)(const_cast<bf16*>(cur.Q) + (size_t)(wid * QBLK) * PITCH);
    const char* Gw = Ow + (C_G - C_Q) * 2;
    u32x4 gv[8];
#pragma unroll
    for (int i = 0; i < 8; ++i) { const int j = (i & 1) * 64 + lane; gv[i] = *(const u32x4*)(Gw + (unsigned)((j >> 2) * PITCH + (i >> 1) * 32 + (j & 3) * 8) * 2u); }
    asm volatile("s_waitcnt lgkmcnt(0)" ::: "memory");
    float rl[16];
#pragma unroll
    for (int r = 0; r < 16; ++r) rl[r] = __builtin_amdgcn_rcpf(li_l[crow(r, hi)]);
    LAS float* stg = (LAS float*)(lds + OFF_K + SHM_K + wid * 4096);
#pragma unroll
    for (int d0 = 0; d0 < 4; ++d0) {
#pragma unroll
        for (int r = 0; r < 16; ++r) stg[crow(r, hi) * 32 + r32] = o[d0][r] * rl[r];
#pragma unroll
        for (int k = 0; k < 2; ++k) { const int j = k * 64 + lane, row = j >> 2, cq = j & 3;
            const f32x4 a = *(const LAS f32x4*)(stg + row * 32 + cq * 8), b = *(const LAS f32x4*)(stg + row * 32 + cq * 8 + 4);
            const u32x4 g = gv[d0 * 2 + k]; u32x4 w;
            w.x = cvtpk(a[0] * bflo(g.x & 0xffffu), a[1] * __uint_as_float(g.x & 0xffff0000u)); w.y = cvtpk(a[2] * bflo(g.y & 0xffffu), a[3] * __uint_as_float(g.y & 0xffff0000u));
            w.z = cvtpk(b[0] * bflo(g.z & 0xffffu), b[1] * __uint_as_float(g.z & 0xffff0000u)); w.w = cvtpk(b[2] * bflo(g.w & 0xffffu), b[3] * __uint_as_float(g.w & 0xffff0000u));
            *(u32x4*)(Ow + (unsigned)(row * PITCH + d0 * 32 + cq * 8) * 2u) = w; }
    }
    __syncthreads();
    PS1(5); PS1(6);
#undef PS0
#undef PS1
#undef KBASE
#undef TBASE
#undef MASKT
#undef HALF_STEP
}
#undef TILEP
#undef LD8O
#undef VMW
#undef VMWN
#undef LD8
#undef SLOAD_H
#undef SWRITE_HK
#undef SWRITE_HV
#undef SWRITE_H
#undef KSWZ
#undef SBAR
}

__device__ __forceinline__ int attn_window(float slope2, float M2) {
    int w = 0;
#pragma unroll 1
    for (int j = 0; j < 15; ++j) if (slope2 * (float)(256 * j + 1) < 2.f * M2 + 48.f) w = j + 1;
    return w;
}
__device__ __forceinline__ void attn_phase(Frame& F, int layer) {
    unsigned long long pt7_ = 0; if (PROBE_SEC == 7) pt7_ = __builtin_amdgcn_s_memtime();
    bf16* const PROJ = WSP(bf16, WS_PROJ); const float* const KM = WSP(float, WS_KM);
    const float* qw = in_ptr(3) + layer * HD; const float* kw = in_ptr(4) + layer * HD;
    const float mq = wave_max(fmaxf(fabsf(qw[2 * F.lane]), fabsf(qw[2 * F.lane + 1]))), mk = wave_max(fmaxf(fabsf(kw[2 * F.lane]), fabsf(kw[2 * F.lane + 1])));
    float m2v_ = 11.313708499f * mq * mk * 1.02f * moba::LOG2E; asm volatile("" : "+v"(m2v_));
    const float M2 = __uint_as_float((unsigned)__builtin_amdgcn_readfirstlane((int)__float_as_uint(m2v_)));
    LAS char* lds = (LAS char*)(F.lds + RING_OFF);
    {
        LAS int* const WT = (LAS int*)(lds + moba::OFF_WT); LAS int* const CNT = WT + 8;
        if (F.tid < 8) WT[F.tid] = attn_window(exp2f(-(float)(F.tid + 1)) * moba::LOG2E, M2);
        __syncthreads();
        int W[8];
        { const v4u w0 = *(const LAS v4u*)WT, w1 = *(const LAS v4u*)(WT + 4); W[0] = (int)w0.x; W[1] = (int)w0.y; W[2] = (int)w0.z; W[3] = (int)w0.w; W[4] = (int)w1.x; W[5] = (int)w1.y; W[6] = (int)w1.z; W[7] = (int)w1.w; }
#define NCOST(c, hh) (((c) - 1 < W[hh]) ? 1 : (((c) - 1 == W[hh]) ? 16 - W[hh] : 0))
        if (F.tid < 17) { int n = 0;
#pragma unroll
            for (int hh = 0; hh < 8; ++hh) n += NCOST(F.tid, hh);
            CNT[F.tid] = F.tid == 0 ? 0 : n; }
        __syncthreads();
#pragma unroll 1
        for (int u = F.tid; u < BATCH * NH * NBLK; u += NWAVES * 64) {
            const int b = u >> 7, h = (u >> 4) & 7, qb = u & 15;
            int wh = 0;
#pragma unroll
            for (int hh = 0; hh < 8; ++hh) wh = (h == hh) ? W[hh] : wh;
            const int c = (qb < wh ? qb : wh) + 1;
            int above = 0;
#pragma unroll
            for (int cc = 2; cc <= 16; ++cc) above += (cc > c) ? CNT[cc] : 0;
            int nbefore = 0;
#pragma unroll
            for (int hh = 0; hh < 8; ++hh) nbefore += (hh < h) ? NCOST(c, hh) : 0;
            const int pos = BATCH * above + b * CNT[c] + nbefore + ((c - 1 == wh) ? qb - wh : 0);
            ((LAS unsigned short*)(lds + moba::OFF_ORD))[pos] = (unsigned short)u;
        }
#undef NCOST
    }
    moba::Queue Qd{WSP(unsigned, WS_CTL) + CW_AQ + 64 * layer, PROJ, KM};
    if (F.tid == 0) *(LAS unsigned*)(lds + moba::OFF_TK) = __hip_atomic_fetch_add(Qd.ctr, 1u, __ATOMIC_RELAXED, __HIP_MEMORY_SCOPE_AGENT);
    __syncthreads();
    moba::Unit cur, nxt; moba::Seam S;
    { const unsigned t0 = (unsigned)__builtin_amdgcn_readfirstlane((int)*(const LAS unsigned*)(lds + moba::OFF_TK));
      if (!moba::unit_from_ticket(t0, Qd, lds, cur)) return; }
    __syncthreads();
    moba::prime(cur, lds, S, F.wave);
    if (ATT_PRIO && F.wave >= 4) __builtin_amdgcn_s_setprio(1);
    unsigned long long pacc = 0; if (PROBE_SEC == 7) pacc = __builtin_amdgcn_s_memtime() - pt7_;
    for (;;) {
        bool more;
        const float slope2 = exp2f(-(float)(cur.h + 1)) * moba::LOG2E;
        moba::block(cur, nxt, more, Qd, slope2, M2, lds, S, F.wave, pacc);
        if (!more) break;
        cur = nxt;
    }
    if (ATT_PRIO) __builtin_amdgcn_s_setprio(0);
    if (PROBE_SEC >= 0) { const unsigned long long t0 = __builtin_amdgcn_s_memtime(); while (__builtin_amdgcn_s_memtime() - t0 < pacc) __builtin_amdgcn_s_sleep(8); }
}

__global__ void __launch_bounds__(NWAVES * 64, 2) mk_fwd(Args args) {
    extern __shared__ __attribute__((aligned(16))) unsigned char lds[];
    Frame F;
    F.lds = (LAS unsigned char*)lds;
    F.MISC = (volatile LAS unsigned*)(F.lds + MISC_OFF);
    F.tid = threadIdx.x; F.lane = F.tid & 63; F.wave = __builtin_amdgcn_readfirstlane(F.tid >> 6);
    F.G = gridDim.x; { const int bx = blockIdx.x; F.vcu = (F.G % 8 == 0) ? (bx % 8) * (F.G / 8) + bx / 8 : bx; }
    for (int u = F.tid; u < (LDS_BYTES - LDSCTL_OFF) / 4; u += NWAVES * 64) ((LAS unsigned*)(F.lds + LDSCTL_OFF))[u] = 0u;
    __syncthreads();
    XcdBarrier bar; bar.bar = nullptr; bar.x = 0; bar.st = nullptr;
    if (N_LAUNCHES == 1) bar = xcd_barrier_post(WSP(unsigned, WS_CTL) + CW_BAR, F.MISC + 8);
    const int lo = args.ph_lo, hi = args.ph_hi;
#define IN(k) (lo <= (k) && (k) < hi)
#define REFRESH() do { int z_ = 0; asm volatile("" : "+v"(z_)); asm volatile("" : "+s"(F.wave), "+s"(F.vcu), "+s"(F.G)); \
        F.lane = (int)__builtin_amdgcn_mbcnt_hi(~0u, __builtin_amdgcn_mbcnt_lo(~0u, (unsigned)z_)); F.tid = F.wave * 64 + F.lane; } while (0)
#define SEAM(k) do { if (IN(k) && IN((k) + 1)) { bar.bar = WSP(unsigned, WS_CTL) + CW_BAR; xcd_barrier(bar, F.wave); } } while (0)
#define PROBE_T0(ph) unsigned long long pt0_ = 0; if (PROBE_PH == (ph)) pt0_ = __builtin_amdgcn_s_memrealtime()
#define PROBE_T1(ph) do { if (PROBE_PH == (ph)) { const unsigned long long pt1_ = __builtin_amdgcn_s_memrealtime(); while (__builtin_amdgcn_s_memrealtime() - pt1_ < pt1_ - pt0_) __builtin_amdgcn_s_sleep(8); } } while (0)

#pragma unroll 1
    for (int layer = 0; layer < DEPTH; ++layer) {
        const int pb = layer * 6;
        { PROBE_T0(0); if (IN(pb + 0)) { REFRESH(); phase_a(F, layer); } SEAM(pb + 0); PROBE_T1(0); }
        { PROBE_T0(1); if (IN(pb + 1)) {
            REFRESH();
            pg8::Gemm g{WSP(bf16, WS_A), WSP(bf16, WS_WIN), M, PITCH, DM, DM}; pg8::StaticOrder S; S.init(M, PITCH, F.G, (int)blockIdx.x);
            if (F.tid < 256) ((LAS float*)(F.lds + RING_BYTES + 10240))[F.tid] = (F.tid < 128 ? in_ptr(3) + layer * HD : in_ptr(4) + layer * HD - 128)[F.tid];
            __syncthreads();
            pg8::EpiProj E{WSP(bf16, WS_PROJ), PITCH, in_ptr(3) + layer * HD, in_ptr(4) + layer * HD, WSP(float, WS_KM), F.lds + RING_BYTES, EPS, WSP(float, WS_RSTD)};
            static_assert(GEMM1_ALIGN, "EpiProj's in-epilogue barriers need both half-workgroups in the epilogue together");
            if (WOUT_IN_B && (F.vcu & 1)) {
                LAS float* scr = (LAS float*)(F.lds + RING_OFF + F.wave * 16384);
                const float* wout = in_ptr(11) + (size_t)layer * 2048 * DM; bf16* const WoutT = WSP(bf16, WS_WOUT);
                for (int it = (F.vcu >> 1) * NWAVES + F.wave; it < (2048 / 64) * (1024 / 32); it += (F.G >> 1) * NWAVES)
                    transpose_item(wout, DM, 2048, 1024, WoutT, 0, scr, it, F.lane, in_ptr(10) + (size_t)layer * 1024, 1024);
                __syncthreads();
            }
            if (PROBE_BSKEW > 0 && (F.vcu & (BSKEW_N - 1))) { const unsigned long long t0_ = __builtin_amdgcn_s_memrealtime(); while (__builtin_amdgcn_s_memrealtime() - t0_ < (unsigned long long)(PROBE_BSKEW * (F.vcu & (BSKEW_N - 1))) * 10) __builtin_amdgcn_s_sleep(8); }
            pg8::gemm_phase<pg8::EpiProj, pg8::StaticOrder, GEMM1_ALIGN, GEMM1_SP2>(F.lds + RING_OFF, g, S, E, F.tid);
        } SEAM(pb + 1); PROBE_T1(1); }
        { PROBE_T0(2); if (IN(pb + 2)) { REFRESH(); phase_c(F, layer); } SEAM(pb + 2); PROBE_T1(2); }
        { PROBE_T0(3); if (IN(pb + 3)) {
            { PROBE_T0(6); REFRESH(); ssd_phase(F, layer); __syncthreads(); PROBE_T1(6);
              if ((PROBE_SSDFIX > 0 && (F.vcu & 1) == 0) || (PROBE_SSDFIX < 0 && (F.vcu & 1) == 1)) { const unsigned long long t0_ = __builtin_amdgcn_s_memrealtime(); while (__builtin_amdgcn_s_memrealtime() - t0_ < (unsigned long long)(PROBE_SSDFIX < 0 ? -PROBE_SSDFIX : PROBE_SSDFIX) * 100) __builtin_amdgcn_s_sleep(8); } }
            { PROBE_T0(7); REFRESH(); attn_phase(F, layer); PROBE_T1(7); }
        } if (IN(pb + 3) && IN(pb + 5)) { bar.bar = WSP(unsigned, WS_CTL) + CW_BAR; xcd_barrier(bar, F.wave); } PROBE_T1(3); }
        { PROBE_T0(5); if (IN(pb + 5)) {
            REFRESH();
            float* const OUTP = out_ptr(); const float* base = layer == 0 ? in_ptr(0) : OUTP;
            pg8::Gemm g{WSP(bf16, WS_PROJ), WSP(bf16, WS_WOUT), M, DM, 2048, PITCH}; pg8::StaticOrder S; S.init(M, DM, F.G, (int)blockIdx.x);
            pg8::EpiResScale E{base, OUTP, DM, WSP(float, WS_SSQ), F.lds + RING_BYTES, EPS, layer == DEPTH - 1};
            pg8::gemm_phase<pg8::EpiResScale, pg8::StaticOrder, GEMM2_ALIGN, GEMM2_SP2>(F.lds + RING_OFF, g, S, E, F.tid);
        } SEAM(pb + 5); PROBE_T1(5); }
    }
#undef IN
#undef SEAM
}

extern "C" void kernel_launch(void* const* d_in, const int* in_sizes, int n_in, void* d_out, int out_size, void* d_ws, size_t ws_size, hipStream_t stream) {
    static int grid = 0;
    if (grid == 0) {
        if (n_in != 12 || in_sizes[0] != M * DM || out_size != M * DM || ws_size < WS_END) {
            fprintf(stderr, "kernel_launch: unexpected shapes (n_in %d, in0 %d, out %d, ws %zu); nothing launched\n", n_in, n_in > 0 ? in_sizes[0] : -1, out_size, ws_size); grid = -1; return; }
        int dev = 0, cus = 0, per_cu = 0;
        if (hipGetDevice(&dev) != hipSuccess || hipDeviceGetAttribute(&cus, hipDeviceAttributeMultiprocessorCount, dev) != hipSuccess) { grid = -1; return; }
        if (hipFuncSetAttribute((const void*)mk_fwd, hipFuncAttributeMaxDynamicSharedMemorySize, LDS_BYTES) != hipSuccess) { fprintf(stderr, "kernel_launch: hipFuncSetAttribute failed\n"); grid = -1; return; }
        if (hipOccupancyMaxActiveBlocksPerMultiprocessor(&per_cu, (const void*)mk_fwd, NWAVES * 64, LDS_BYTES) != hipSuccess || per_cu < 1) {
            fprintf(stderr, "kernel_launch: occupancy query reports %d workgroups per CU; nothing launched\n", per_cu); (void)hipGetLastError(); grid = -1; return; }
        grid = cus;
    }
    if (grid < 0) return;
    if (hipMemsetAsync((char*)d_ws + WS_CTL, 0, CTL_ZERO_BYTES, stream) != hipSuccess) { fprintf(stderr, "kernel_launch: hipMemsetAsync failed\n"); return; }
    Args a{};
    for (int i = 0; i < 12; ++i) a.in[i] = (const float*)d_in[i];
    a.out = (float*)d_out; a.ws = (unsigned char*)d_ws;
    for (int li = 0; li < N_LAUNCHES; ++li) {
        a.ph_lo = (N_LAUNCHES == 1) ? 0 : li; a.ph_hi = (N_LAUNCHES == 1) ? N_PHASES : li + 1; a.li = li;
        hipLaunchKernelGGL(mk_fwd, dim3(grid), dim3(NWAVES * 64), LDS_BYTES, stream, a);
        const hipError_t le = hipPeekAtLastError();
        if (le != hipSuccess) { fprintf(stderr, "kernel_launch: launch %d failed: %s\n", li, hipGetErrorName(le)); break; }
    }
}
```

```cpp
#include <hip/hip_runtime.h>
#include <cstdio>
#include <cstdint>
namespace pg8 {
#define PG8_LAS __attribute__((address_space(3)))
typedef unsigned short bf16_t;
typedef short bf16x8 __attribute__((ext_vector_type(8)));
typedef float f32x4 __attribute__((ext_vector_type(4)));
typedef unsigned u32x4 __attribute__((ext_vector_type(4)));
constexpr int BM = 256, BK = 64, HALF = 128, HTB = HALF * BK * 2  , STAGE_BYTES = 8 * HTB, NXCD = 8, WGM = 8;

__host__ __device__ __forceinline__ int lds_byte(int r, int c) { const int st = (r >> 4) * 2 + (c >> 5), rr = r & 15, cc = c & 31, ob = rr * 64 + cc * 2; return st * 1024 + (ob ^ (((ob >> 9) & 1) << 5)); }
__host__ __device__ __forceinline__ void stage_rc(int b, int& R, int& C) { const int st = b / 1024, sb = b % 1024, swz = sb ^ (((sb >> 9) & 1) << 5); R = (st >> 1) * 16 + swz / 64; C = (st & 1) * 32 + (swz % 64) / 2; }
__host__ __device__ __forceinline__ int perm32(int rho) { const int n = rho >> 4, i = rho & 15; return 8 * (i >> 2) + 4 * n + (i & 3); }

struct Unit { int pm, pn; };
struct Gemm { const bf16_t* A; const bf16_t* Bt; int M, N, K, lda; };

struct StaticOrder {
    int nM, nN, nwg, G, c;
    __host__ __device__ void init(int M, int N, int G_, int c_) { nM = M / BM; nN = N / BM; nwg = nM * nN; G = G_; c = c_; }
    __host__ __device__ bool next(int i, Unit& u) const {
        const long L = (long)i * G + c; if (L >= nwg) return false;
        int wgid = (int)L; { const int q = nwg / NXCD, r = nwg % NXCD, xcd = wgid % NXCD, off = wgid / NXCD; wgid = (xcd < r ? xcd * (q + 1) : r * (q + 1) + (xcd - r) * q) + off; }
        const int nig = WGM * nN, gid = wgid / nig, fm = gid * WGM, gsz = (nM - fm) < WGM ? (nM - fm) : WGM;
        u.pm = fm + ((wgid % nig) % gsz); u.pn = (wgid % nig) / gsz; return true;
    }
    __device__ __forceinline__ void a_ready(const Unit&) const {}
    __device__ __forceinline__ void done(const Unit&) const {}
};

__device__ __forceinline__ unsigned cvt_pk_bf16(float lo, float hi) { unsigned r; asm volatile("v_cvt_pk_bf16_f32 %0, %1, %2" : "=v"(r) : "v"(lo), "v"(hi)); return r; }
typedef float f32x2 __attribute__((ext_vector_type(2)));
__device__ __forceinline__ f32x2 gelu_pk(f32x2 v) {
    const f32x2 av = __builtin_elementwise_abs(v), d = av * 0.2316418882f + 1.0f;
    f32x2 t; t.x = __builtin_amdgcn_rcpf(d.x); t.y = __builtin_amdgcn_rcpf(d.y);
    f32x2 q = t * 0.5307027145f + (-0.7265760135f); q = q * t + 0.7107068705f; q = q * t + (-0.142248368f); q = q * t + 0.127414796f; q = q * t;
    const f32x2 s = (v * v) * (-0.72134752044f);
    f32x2 e; e.x = __builtin_amdgcn_exp2f(s.x); e.y = __builtin_amdgcn_exp2f(s.y);
    const f32x2 m = v * (q * e), r = v - m;
    f32x2 o; o.x = v.x < 0.f ? m.x : r.x; o.y = v.y < 0.f ? m.y : r.y; return o;
}

template <int ACT  > struct EpiBf16 {
    static constexpr bool PERM = true, AFTER_DRAIN = false; static_assert(ACT == 0 || ACT == 1, "EpiBf16: ACT is 0 (none) or 1 (gelu_pk)");
    bf16_t* O; int ldc; const float* bias; int split_cols; size_t split_stride; float scale0;
    __device__ __forceinline__ void operator()(const f32x4 (&acc)[2][2][4][2], const Unit& u, int wr, int wc, int fr, int fq) const {
        const int row0 = u.pm * BM + wr * 64 + fr; int colt = u.pn * BM; bf16_t* base = O;
        float sc = 1.f; if (split_cols) { const int t = colt / split_cols; base += (size_t)t * split_stride; colt -= t * split_cols; if (t == 0) sc = scale0; }
        const int col0 = colt + wc * 32 + 8 * fq, bcol0 = u.pn * BM + wc * 32 + 8 * fq;
        f32x4 bv[2][2];
#pragma unroll
        for (int bj = 0; bj < 2; ++bj)
#pragma unroll
            for (int n = 0; n < 2; ++n) bv[bj][n] = bias ? *(const f32x4*)(bias + bcol0 + bj * HALF + 4 * n) : (f32x4){0.f, 0.f, 0.f, 0.f};
#pragma unroll
        for (int ai = 0; ai < 2; ++ai)
#pragma unroll
            for (int m = 0; m < 4; ++m) { bf16_t* rowp = base + (size_t)(row0 + ai * HALF + m * 16) * ldc + col0;
#pragma unroll
                for (int bj = 0; bj < 2; ++bj) { f32x4 v0 = acc[ai][bj][m][0] + bv[bj][0], v1 = acc[ai][bj][m][1] + bv[bj][1];
                    if (ACT == 1) { f32x2 a = gelu_pk((f32x2){v0[0], v0[1]}), b = gelu_pk((f32x2){v0[2], v0[3]}), c = gelu_pk((f32x2){v1[0], v1[1]}), d = gelu_pk((f32x2){v1[2], v1[3]});
                        v0 = (f32x4){a.x, a.y, b.x, b.y}; v1 = (f32x4){c.x, c.y, d.x, d.y}; }
                    v0 = v0 * sc; v1 = v1 * sc; u32x4 w; w.x = cvt_pk_bf16(v0[0], v0[1]); w.y = cvt_pk_bf16(v0[2], v0[3]); w.z = cvt_pk_bf16(v1[0], v1[1]); w.w = cvt_pk_bf16(v1[2], v1[3]);
                    *(u32x4*)(rowp + bj * HALF) = w; } }
    }
};
template <class Epi, class Sched, bool ALIGN_EPI = false, bool SP2 = false>
__device__ __forceinline__ void gemm_phase(PG8_LAS unsigned char* lds, const Gemm g, const Sched& S, const Epi& E, int ptid_) {
    int tid_ = ptid_; asm volatile("" : "+v"(tid_));
    const int tid = tid_, wid = __builtin_amdgcn_readfirstlane(tid >> 6), lane = tid & 63, wr = wid >> 2, wc = wid & 3, fr = lane & 15, fq = lane >> 4;
    const int K = g.K, nt = K / BK;
    unsigned voffA[2], voffB[2];
#pragma unroll
    for (int i = 0; i < 2; ++i) { int R, C; stage_rc(tid * 16 + i * 8192, R, C); const int Rb = Epi::PERM ? ((R & ~31) + perm32(R & 31)) : R;
        voffA[i] = (unsigned)(R * g.lda + C) * 2u; voffB[i] = (unsigned)(Rb * K + C) * 2u; }
    const size_t kstep = (size_t)(BK * 2);
    const size_t hstep = (size_t)HALF * K * 2;
    const size_t tstep = 2 * hstep; const size_t hstepA = (size_t)HALF * g.lda * 2, tstepA = 2 * hstepA;
    const unsigned ldsw = (unsigned)wid * 1024u;
    const int aoff = lds_byte(wr * 64 + fr, fq * 8), boff = lds_byte(wc * 32 + fr, fq * 8);
#define PG8_SA(b, h) (((b) * 2 + (h)) * HTB)
#define PG8_SB(b, h) ((4 + (b) * 2 + (h)) * HTB)
#define PG8_STAGE(bufoff, gbase, voff) do { _Pragma("unroll") for (int _i = 0; _i < 2; ++_i) \
        __builtin_amdgcn_global_load_lds((const unsigned*)((const char*)(gbase) + (voff)[_i]), (PG8_LAS unsigned*)(lds + (bufoff) + ldsw + _i * 8192), 16, 0, 0); } while (0)
#define PG8_LDA(dst, b, h) do { _Pragma("unroll") for (int m = 0; m < 4; ++m) _Pragma("unroll") for (int k = 0; k < 2; ++k) dst[m][k] = *(const PG8_LAS bf16x8*)(lds + PG8_SA(b, h) + aoff + m * 2048 + k * 1024); } while (0)
#define PG8_LDB(dst, b, h) do { _Pragma("unroll") for (int n = 0; n < 2; ++n) _Pragma("unroll") for (int k = 0; k < 2; ++k) dst[n][k] = *(const PG8_LAS bf16x8*)(lds + PG8_SB(b, h) + boff + n * 2048 + k * 1024); } while (0)
#define PG8_MMA(ai, bj, At, Bt) do { __builtin_amdgcn_s_setprio(1); _Pragma("unroll") for (int m = 0; m < 4; ++m) _Pragma("unroll") for (int n = 0; n < 2; ++n) _Pragma("unroll") for (int k = 0; k < 2; ++k) \
        acc[ai][bj][m][n] = __builtin_amdgcn_mfma_f32_16x16x32_bf16(Bt[n][k], At[m][k], acc[ai][bj][m][n], 0, 0, 0); __builtin_amdgcn_s_setprio(0); } while (0)
#define PG8_WAIT_V(n) asm volatile("s_waitcnt vmcnt(" #n ")" ::: "memory")
#define PG8_WAIT_L(n) asm volatile("s_waitcnt lgkmcnt(" #n ")" ::: "memory")
#define PG8_BAR __builtin_amdgcn_s_barrier()
#define PG8_SCHED __builtin_amdgcn_sched_barrier(0)
    Unit cur, nxt; int ui = 0;
    if (!S.next(0, cur)) return;
    f32x4 acc[2][2][4][2];
#pragma unroll
    for (int a = 0; a < 2; ++a)
#pragma unroll
        for (int b = 0; b < 2; ++b)
#pragma unroll
            for (int m = 0; m < 4; ++m)
#pragma unroll
                for (int n = 0; n < 2; ++n) acc[a][b][m][n] = (f32x4){0.f, 0.f, 0.f, 0.f};
    bf16x8 At[4][2], B0[2][2], B1[2][2];
    const char* cA = (const char*)g.A + (size_t)cur.pm * tstepA; const char* cB = (const char*)g.Bt + (size_t)cur.pn * tstep;
    S.a_ready(cur);
    if constexpr (Epi::KHOOK) E.unit_begin(cur, ui, tid);
    if constexpr (SP2) {
        PG8_STAGE(PG8_SB(0, 0), cB, voffB); PG8_STAGE(PG8_SB(0, 1), cB + hstep, voffB); PG8_STAGE(PG8_SA(0, 0), cA, voffA); PG8_STAGE(PG8_SA(0, 1), cA + hstepA, voffA);
        if (wr == 1) PG8_BAR;
        PG8_WAIT_V(2); PG8_BAR;
        PG8_STAGE(PG8_SB(1, 0), cB + kstep, voffB); PG8_STAGE(PG8_SA(1, 0), cA + kstep, voffA); PG8_STAGE(PG8_SB(1, 1), cB + hstep + kstep, voffB);
        PG8_WAIT_V(6); PG8_BAR;
    } else {
        PG8_STAGE(PG8_SB(0, 0), cB, voffB); PG8_STAGE(PG8_SA(0, 0), cA, voffA); PG8_STAGE(PG8_SB(0, 1), cB + hstep, voffB); PG8_STAGE(PG8_SA(0, 1), cA + hstepA, voffA);
        if (wr == 1) PG8_BAR;
        PG8_WAIT_V(4); PG8_BAR;
        PG8_STAGE(PG8_SB(1, 0), cB + kstep, voffB); PG8_STAGE(PG8_SA(1, 0), cA + kstep, voffA); PG8_STAGE(PG8_SB(1, 1), cB + hstep + kstep, voffB);
        PG8_WAIT_V(6); PG8_BAR;
    }
    for (;;) {
        const bool has_next = S.next(ui + 1, nxt);
        const char* nA = has_next ? (const char*)g.A + (size_t)nxt.pm * tstepA : cA; const char* nB = has_next ? (const char*)g.Bt + (size_t)nxt.pn * tstep : cB;
        for (int t = 0; t < nt; t += 2) {
            if constexpr (Epi::KHOOK) { if (t == Epi::KH0 || t == Epi::KH1) E.khook(acc, t, ui, wr, fr); }
            const bool last = (t == nt - 2);
            const char* a1 = cA + (size_t)(t + 1) * kstep;
            const char* a2 = last ? nA : cA + (size_t)(t + 2) * kstep; const char* b2 = last ? nB : cB + (size_t)(t + 2) * kstep;
            const char* a3 = a2 + kstep; const char* b3 = b2 + kstep;
            if (last && has_next) S.a_ready(nxt);
            if constexpr (SP2) {
            PG8_LDB(B0, 0, 0); PG8_LDB(B1, 0, 1); PG8_SCHED; PG8_LDA(At, 0, 0); PG8_STAGE(PG8_SA(1, 1), a1 + hstepA, voffA);
            PG8_WAIT_V(8); PG8_WAIT_L(0); PG8_BAR; PG8_MMA(0, 0, At, B0); PG8_MMA(0, 1, At, B1); PG8_BAR; PG8_SCHED;
            PG8_LDA(At, 0, 1); PG8_STAGE(PG8_SB(0, 0), b2, voffB); PG8_STAGE(PG8_SB(0, 1), b2 + hstep, voffB); PG8_STAGE(PG8_SA(0, 0), a2, voffA);
            PG8_WAIT_V(8); PG8_WAIT_L(0); PG8_BAR; PG8_MMA(1, 0, At, B0); PG8_MMA(1, 1, At, B1); PG8_BAR; PG8_SCHED;
            PG8_LDB(B0, 1, 0); PG8_LDB(B1, 1, 1); PG8_SCHED; PG8_LDA(At, 1, 0); PG8_STAGE(PG8_SA(0, 1), a2 + hstepA, voffA);
            PG8_WAIT_V(8); PG8_WAIT_L(0); PG8_BAR; PG8_MMA(0, 0, At, B0); PG8_MMA(0, 1, At, B1); PG8_BAR; PG8_SCHED;
            PG8_LDA(At, 1, 1); PG8_STAGE(PG8_SB(1, 0), b3, voffB); PG8_STAGE(PG8_SB(1, 1), b3 + hstep, voffB); PG8_STAGE(PG8_SA(1, 0), a3, voffA);
            PG8_WAIT_V(8); PG8_WAIT_L(0); PG8_BAR; PG8_MMA(1, 0, At, B0); PG8_MMA(1, 1, At, B1); PG8_BAR; PG8_SCHED;
            } else {
            PG8_LDB(B0, 0, 0); PG8_SCHED; PG8_LDA(At, 0, 0); PG8_STAGE(PG8_SA(1, 1), a1 + hstepA, voffA);
            PG8_WAIT_L(8); PG8_BAR; PG8_WAIT_L(0); PG8_MMA(0, 0, At, B0); PG8_BAR; PG8_SCHED;
            PG8_LDB(B1, 0, 1); PG8_STAGE(PG8_SB(0, 0), b2, voffB);
            PG8_BAR; PG8_WAIT_L(0); PG8_MMA(0, 1, At, B1); PG8_BAR;
            PG8_LDA(At, 0, 1); PG8_STAGE(PG8_SA(0, 0), a2, voffA);
            PG8_BAR; PG8_WAIT_L(0); PG8_MMA(1, 0, At, B0); PG8_BAR; PG8_SCHED;
            PG8_STAGE(PG8_SB(0, 1), b2 + hstep, voffB);
            PG8_WAIT_V(6); PG8_BAR; PG8_MMA(1, 1, At, B1); PG8_BAR;
            PG8_LDB(B0, 1, 0); PG8_SCHED; PG8_LDA(At, 1, 0); PG8_STAGE(PG8_SA(0, 1), a2 + hstepA, voffA);
            PG8_WAIT_L(8); PG8_BAR; PG8_WAIT_L(0); PG8_MMA(0, 0, At, B0); PG8_BAR; PG8_SCHED;
            PG8_LDB(B1, 1, 1); PG8_STAGE(PG8_SB(1, 0), b3, voffB);
            PG8_BAR; PG8_WAIT_L(0); PG8_MMA(0, 1, At, B1); PG8_BAR;
            PG8_LDA(At, 1, 1); PG8_STAGE(PG8_SA(1, 0), a3, voffA);
            PG8_BAR; PG8_WAIT_L(0); PG8_MMA(1, 0, At, B0); PG8_BAR; PG8_SCHED;
            PG8_STAGE(PG8_SB(1, 1), b3 + hstep, voffB);
            PG8_WAIT_V(6); PG8_BAR; PG8_MMA(1, 1, At, B1); PG8_BAR;
            }
        }
        if constexpr (ALIGN_EPI) { if (wr == 0) PG8_BAR; }
        if constexpr (Epi::KHOOK) { E.epi(acc, cur, ui, wr, wc, fr, fq); S.done(cur); } else if constexpr (!Epi::AFTER_DRAIN) { E(acc, cur, wr, wc, fr, fq); S.done(cur); }
        if (!has_next) break;
#pragma unroll
        for (int a = 0; a < 2; ++a)
#pragma unroll
            for (int b = 0; b < 2; ++b)
#pragma unroll
                for (int m = 0; m < 4; ++m)
#pragma unroll
                    for (int n = 0; n < 2; ++n) acc[a][b][m][n] = (f32x4){0.f, 0.f, 0.f, 0.f};
        cur = nxt; cA = nA; cB = nB; ++ui;
        if constexpr (Epi::KHOOK) E.unit_begin(cur, ui, tid);
        if constexpr (ALIGN_EPI) { if (wr == 1) PG8_BAR; }
    }
    PG8_WAIT_V(0);
    if constexpr (!ALIGN_EPI) { if (wr == 0) PG8_BAR; }
    PG8_BAR;
    if constexpr (Epi::AFTER_DRAIN) { E.fused(acc, cur, wr, wc, fr, fq, lds, wid, lane); S.done(cur); }
#undef PG8_SA
#undef PG8_SB
#undef PG8_STAGE
#undef PG8_LDA
#undef PG8_LDB
#undef PG8_MMA
#undef PG8_WAIT_V
#undef PG8_WAIT_L
#undef PG8_BAR
#undef PG8_SCHED
}
}

namespace pg8 {
struct EpiResF32 {
    static constexpr bool PERM = false, AFTER_DRAIN = false, KHOOK = false;
    const float* base; float* out; int ldc;
    __device__ __forceinline__ void operator()(const f32x4 (&acc)[2][2][4][2], const Unit& u, int wr, int wc, int fr, int fq) const {
        const int col0 = u.pn * BM + wc * 32 + 4 * fq;
#pragma unroll
        for (int ai = 0; ai < 2; ++ai)
#pragma unroll
            for (int m = 0; m < 4; ++m) { const size_t off = (size_t)(u.pm * BM + ai * HALF + wr * 64 + m * 16 + fr) * ldc + col0;
#pragma unroll
                for (int bj = 0; bj < 2; ++bj)
#pragma unroll
                    for (int n = 0; n < 2; ++n) { const f32x4 bs = *(const f32x4*)(base + off + bj * HALF + n * 16); *(f32x4*)(out + off + bj * HALF + n * 16) = bs + acc[ai][bj][m][n]; } }
    }
};

struct EpiProj {
    static constexpr bool PERM = true, AFTER_DRAIN = false, KHOOK = true; static constexpr int KH0 = -1, KH1 = -1;
    bf16_t* O; int ldc; const float* qw; const float* kw; float* KM; PG8_LAS unsigned char* xlds; float eps; const float* RSTD;
    __device__ __forceinline__ PG8_LAS float* rtab(int ui) const { return (PG8_LAS float*)(xlds + 11264) + (ui & 1) * 256; }
    __device__ __forceinline__ void unit_begin(const Unit& u, int ui, int tid) const { if (tid < 256) rtab(ui)[tid] = RSTD[u.pm * BM + tid]; }
    __device__ __forceinline__ void khook(f32x4 (&)[2][2][4][2], int, int, int, int) const {}
    __device__ __forceinline__ void bar() const { asm volatile("s_waitcnt lgkmcnt(0)" ::: "memory"); __builtin_amdgcn_s_barrier(); asm volatile("" ::: "memory"); }
    __device__ __forceinline__ void epi(const f32x4 (&acc)[2][2][4][2], const Unit& u, int ui, int wr, int wc, int fr, int fq) const {
        const int row0 = u.pm * BM + wr * 64 + fr, colt = u.pn * BM, col0 = colt + wc * 32 + 8 * fq;
        const PG8_LAS float* RT = rtab(ui) + wr * 64 + fr;
        const int kind = colt < 1024 ? 1 : ((colt >= 2048 && colt < 3072) ? 2 : 0);
        const bool gate = (colt >= 1024 && colt < 2048) || (colt >= 4096 && colt < 5120);
        if (kind == 0) {
#pragma unroll
            for (int ai = 0; ai < 2; ++ai)
#pragma unroll
                for (int m = 0; m < 4; ++m) { bf16_t* rowp = O + (size_t)(row0 + ai * HALF + m * 16) * ldc + col0; const float rr = RT[ai * HALF + m * 16];
#pragma unroll
                    for (int bj = 0; bj < 2; ++bj) { f32x4 v0 = acc[ai][bj][m][0] * rr, v1 = acc[ai][bj][m][1] * rr;
                        if (gate) {
#pragma unroll
                            for (int e = 0; e < 4; ++e) { v0[e] = v0[e] * __builtin_amdgcn_rcpf(1.0f + __expf(-v0[e])); v1[e] = v1[e] * __builtin_amdgcn_rcpf(1.0f + __expf(-v1[e])); } }
                        u32x4 w; w.x = cvt_pk_bf16(v0[0], v0[1]); w.y = cvt_pk_bf16(v0[2], v0[3]); w.z = cvt_pk_bf16(v1[0], v1[1]); w.w = cvt_pk_bf16(v1[2], v1[3]);
                        *(u32x4*)(rowp + bj * HALF) = w; } }
            return;
        }
        PG8_LAS float* P = (PG8_LAS float*)xlds;
        PG8_LAS float* KS = (PG8_LAS float*)(xlds + 8192);
#pragma unroll
        for (int ai = 0; ai < 2; ++ai)
#pragma unroll
            for (int m = 0; m < 4; ++m)
#pragma unroll
                for (int bj = 0; bj < 2; ++bj) { const float rr = RT[ai * HALF + m * 16]; const f32x4 a = acc[ai][bj][m][0] * rr, b = acc[ai][bj][m][1] * rr;
                    float s = ((a[0] * a[0] + a[1] * a[1]) + (a[2] * a[2] + a[3] * a[3])) + ((b[0] * b[0] + b[1] * b[1]) + (b[2] * b[2] + b[3] * b[3]));
                    s += __shfl_xor(s, 16); s += __shfl_xor(s, 32);
                    if (fq == 0) P[((ai * HALF + wr * 64 + m * 16 + fr) * 2 + bj) * 4 + wc] = s;
                    if (bj) asm volatile("" ::: "memory"); }
        bar();
        const PG8_LAS float* wp = (const PG8_LAS float*)(xlds + 10240) + (kind == 1 ? 0 : 128) + wc * 32 + 8 * fq;
        const f32x4 w0 = *(const PG8_LAS f32x4*)wp, w1 = *(const PG8_LAS f32x4*)(wp + 4);
        f32x4 ks[2][2] = {};
#pragma unroll
        for (int ai = 0; ai < 2; ++ai)
#pragma unroll
            for (int m = 0; m < 4; ++m) { bf16_t* rowp = O + (size_t)(row0 + ai * HALF + m * 16) * ldc + col0;
#pragma unroll
                for (int bj = 0; bj < 2; ++bj) { const f32x4 p = *(const PG8_LAS f32x4*)(P + ((ai * HALF + wr * 64 + m * 16 + fr) * 2 + bj) * 4);
                    const float rs = RT[ai * HALF + m * 16] / sqrtf(((p[0] + p[1]) + (p[2] + p[3])) * (1.0f / 128.0f) + eps);
                    const f32x4 v0 = acc[ai][bj][m][0] * rs * w0, v1 = acc[ai][bj][m][1] * rs * w1;
                    ks[bj][0] += v0; ks[bj][1] += v1;
                    u32x4 w; w.x = cvt_pk_bf16(v0[0], v0[1]); w.y = cvt_pk_bf16(v0[2], v0[3]); w.z = cvt_pk_bf16(v1[0], v1[1]); w.w = cvt_pk_bf16(v1[2], v1[3]);
                    *(u32x4*)(rowp + bj * HALF) = w; }
                asm volatile("" : "+v"(ks[0][0]), "+v"(ks[0][1]), "+v"(ks[1][0]), "+v"(ks[1][1]) :: "memory"); }
        if (kind == 2) {
            float v[16];
#pragma unroll
            for (int bj = 0; bj < 2; ++bj)
#pragma unroll
                for (int n = 0; n < 2; ++n)
#pragma unroll
                    for (int j = 0; j < 4; ++j) v[bj * 8 + n * 4 + j] = ks[bj][n][j];
            { const bool up = (fr & 8) != 0;
#pragma unroll
              for (int c = 0; c < 8; ++c) { const float snd = up ? v[c] : v[c + 8], keep = up ? v[c + 8] : v[c]; v[c] = keep + __shfl_xor(snd, 8); } }
            { const bool up = (fr & 4) != 0;
#pragma unroll
              for (int c = 0; c < 4; ++c) { const float snd = up ? v[c] : v[c + 4], keep = up ? v[c + 4] : v[c]; v[c] = keep + __shfl_xor(snd, 4); } }
            { const bool up = (fr & 2) != 0;
#pragma unroll
              for (int c = 0; c < 2; ++c) { const float snd = up ? v[c] : v[c + 2], keep = up ? v[c + 2] : v[c]; v[c] = keep + __shfl_xor(snd, 2); } }
            { const bool up = (fr & 1) != 0; const float snd = up ? v[0] : v[1], keep = up ? v[1] : v[0]; v[0] = keep + __shfl_xor(snd, 1); }
            KS[wr * 256 + 128 * (fr >> 3) + 32 * wc + 8 * fq + (fr & 7)] = v[0];
            bar();
            const int t = (wr * 4 + wc) * 64 + fq * 16 + fr;
            if (t < 256) { const int b = u.pm >> 4, nb = u.pm & 15, head = 2 * (u.pn & 3) + (t >> 7);
                KM[(((size_t)b * 8 + head) * 16 + nb) * 128 + (t & 127)] = (KS[t] + KS[256 + t]) * (1.0f / 256.0f); }
        }
    }
};

struct EpiResScale {
    static constexpr bool PERM = false, AFTER_DRAIN = false, KHOOK = true; static constexpr int KH0 = 16, KH1 = 24;
    const float* base; float* out; int ldc; const float* SSQ; PG8_LAS unsigned char* xlds; float eps; bool last;
    __device__ __forceinline__ PG8_LAS float* tab(int ui) const { return (PG8_LAS float*)xlds + (ui & 1) * 768; }
    __device__ __forceinline__ void unit_begin(const Unit& u, int ui, int tid) const {
        if (tid < 256) { const f32x4* sp = (const f32x4*)(SSQ + (size_t)(u.pm * BM + tid) * 64); float s0 = 0.f, s1 = 0.f;
#pragma unroll
            for (int i = 0; i < 8; ++i) { const f32x4 a = sp[i], b = sp[8 + i]; s0 += (a[0] + a[1]) + (a[2] + a[3]); s1 += (b[0] + b[1]) + (b[2] + b[3]); }
            const float m0 = s0 * (1.0f / 512.0f) + eps, m1 = s1 * (1.0f / 512.0f) + eps; PG8_LAS float* T = tab(ui);
            T[tid] = sqrtf(m0); T[256 + tid] = sqrtf(m1 / m0); T[512 + tid] = 1.0f / sqrtf(m1); }
    }
    __device__ __forceinline__ void khook(f32x4 (&acc)[2][2][4][2], int t, int ui, int wr, int fr) const {
        const PG8_LAS float* T = tab(ui) + (t == KH0 ? 0 : 256) + wr * 64 + fr;
#pragma unroll
        for (int ai = 0; ai < 2; ++ai)
#pragma unroll
            for (int m = 0; m < 4; ++m) { const float f = T[ai * HALF + m * 16];
#pragma unroll
                for (int bj = 0; bj < 2; ++bj)
#pragma unroll
                    for (int n = 0; n < 2; ++n) acc[ai][bj][m][n] = acc[ai][bj][m][n] * f; }
    }
    __device__ __forceinline__ void epi(const f32x4 (&acc)[2][2][4][2], const Unit& u, int ui, int wr, int wc, int fr, int fq) const {
        const int col0 = u.pn * BM + wc * 32 + 4 * fq; const PG8_LAS float* T = tab(ui) + 512 + wr * 64 + fr;
#pragma unroll
        for (int ai = 0; ai < 2; ++ai)
#pragma unroll
            for (int m = 0; m < 4; ++m) { const size_t off = (size_t)(u.pm * BM + ai * HALF + wr * 64 + m * 16 + fr) * ldc + col0; const float f = T[ai * HALF + m * 16];
#pragma unroll
                for (int bj = 0; bj < 2; ++bj)
#pragma unroll
                    for (int n = 0; n < 2; ++n) { const f32x4* bp = (const f32x4*)(base + off + bj * HALF + n * 16); f32x4* op = (f32x4*)(out + off + bj * HALF + n * 16);
                        if (last) { const f32x4 bs = __builtin_nontemporal_load(bp); __builtin_nontemporal_store(bs + acc[ai][bj][m][n] * f, op); }
                        else { const f32x4 bs = *bp; *op = bs + acc[ai][bj][m][n] * f; } } }
    }
};
}

#ifndef GEMM1_ALIGN
#define GEMM1_ALIGN true
#endif
#ifndef GEMM1_SP2
#define GEMM1_SP2 true
#endif
#ifndef GEMM2_ALIGN
#define GEMM2_ALIGN true
#endif
#ifndef GEMM2_SP2
#define GEMM2_SP2 true
#endif
#ifndef PFD
#define PFD 2
#endif
#ifndef PROBE_SEC
#define PROBE_SEC -1
#endif
#ifndef ATT_PRIO
#define ATT_PRIO 0
#endif
#ifndef PROBE_SSDFIX
#define PROBE_SSDFIX 0
#endif
#ifndef BSKEW_N
#define BSKEW_N 2
#endif
#ifndef WOUT_IN_B
#define WOUT_IN_B 1
#endif
#ifndef PROBE_FSKEW
#define PROBE_FSKEW 0
#endif
#ifndef PROBE_BSKEW
#define PROBE_BSKEW 0
#endif
#ifndef PROBE_SSEC
#define PROBE_SSEC -1
#endif
#ifndef PROBE_MEM2
#define PROBE_MEM2 0
#endif
#ifndef PROBE_PH
#define PROBE_PH -1
#endif
constexpr int NWAVES = 8;
#ifndef MK_N_LAUNCHES
#define MK_N_LAUNCHES 1
#endif
constexpr int N_PHASES = 12;
constexpr int N_LAUNCHES = MK_N_LAUNCHES;

constexpr int BATCH = 8, SEQ = 4096, DM = 1024, DEPTH = 2;
constexpr int M = BATCH * SEQ;
constexpr int NH = 8, HD = 128;
constexpr int NSH = 16, SHD = 64, NST = 128;
constexpr int NIN = 6672;
constexpr int PITCH = 6656;
constexpr int C_Q = 0, C_Z = 1024, C_K = 2048, C_V = 3072, C_G = 4096, C_X = 5120, C_B = 6144, C_C = 6400;
constexpr int MOBA = 256, NBLK = SEQ / MOBA;
constexpr float EPS = 1e-6f;

constexpr size_t MiB = 1u << 20;
constexpr size_t WS_CTL = 0, CTL_ZERO_BYTES = 64 * 1024;
constexpr size_t WS_WIN = 1 * MiB;
constexpr size_t WS_WOUT = 14 * MiB;
constexpr size_t WS_KM = 18 * MiB;
constexpr size_t WS_DT = 19 * MiB;
constexpr size_t WS_SSQ = 21 * MiB;
constexpr size_t WS_RSTD = 31 * MiB;
constexpr size_t WS_ACS = 29 * MiB;
constexpr size_t WS_A = 32 * MiB;
constexpr size_t WS_PROJ = 96 * MiB;
constexpr size_t WS_END = 512 * MiB;
static_assert(WS_PROJ + (size_t)M * PITCH * 2 <= WS_END, "d_ws map");
constexpr int CW_TMO = 0;
constexpr int CW_BAR = 4096;
constexpr int CW_AQ = 8192;   static_assert((CW_AQ + 128) * 4 <= (int)CTL_ZERO_BYTES && (CW_BAR + 3456) <= CW_AQ, "control words inside the zeroed region");
constexpr int CW_AQ_ = 0;

constexpr int RING_OFF = 0, RING_BYTES = 131072;
constexpr int LDSCTL_OFF = 146944, MISC_OFF = LDSCTL_OFF + 320;
constexpr int LDS_BYTES = 147456;
static_assert(MISC_OFF + 128 <= LDS_BYTES && RING_BYTES <= LDSCTL_OFF, "LDS map");

#define GAS __attribute__((address_space(1)))
#define LAS __attribute__((address_space(3)))
typedef unsigned short bf16;
typedef unsigned v4u __attribute__((ext_vector_type(4)));
typedef unsigned v2u __attribute__((ext_vector_type(2)));
typedef float f32x4 __attribute__((ext_vector_type(4)));
typedef short bf16x8 __attribute__((ext_vector_type(8)));
typedef GAS unsigned gu32;
#define RLX_AGENT __ATOMIC_RELAXED, __HIP_MEMORY_SCOPE_AGENT
#define LDS_WAIT() asm volatile("s_waitcnt lgkmcnt(0)" ::: "memory")
#define VM_WAIT() asm volatile("s_waitcnt vmcnt(0)" ::: "memory")
__device__ __forceinline__ unsigned f2bf(float f) { unsigned u = __builtin_bit_cast(unsigned, f); return (u + 0x7fffu + ((u >> 16) & 1u)) >> 16; }
typedef __bf16 bf16x2_n __attribute__((ext_vector_type(2)));
__device__ __forceinline__ unsigned pk2(float lo, float hi) { bf16x2_n v = {(__bf16)lo, (__bf16)hi}; return __builtin_bit_cast(unsigned, v); }
__device__ __forceinline__ float bflo(unsigned u) { return __builtin_bit_cast(float, u << 16); }
__device__ __forceinline__ float bfhi(unsigned u) { return __builtin_bit_cast(float, u & 0xffff0000u); }
__device__ __forceinline__ float silu_f(float v) { return v * __builtin_amdgcn_rcpf(1.f + __expf(-v)); }
__device__ __forceinline__ float wave_sum(float v) {
#pragma unroll
    for (int o = 1; o < 64; o <<= 1) v += __shfl_xor(v, o);
    return v;
}
__device__ __forceinline__ float wave_max(float v) {
#pragma unroll
    for (int o = 1; o < 64; o <<= 1) v = fmaxf(v, __shfl_xor(v, o));
    return v;
}

#define XB_TMO      128
#define XB_XCNT(j)  (256  + 64 * (j))
#define XB_XSUB(j)  (1280 + 64 * (j))
#define XB_XGEN(j)  (2304 + 64 * (j))
#define XB_TOP      3328
#define XB_TOPGEN   3392
#define XCD_BAR_WORDS 3456
#define XB_SPIN_CAP (1u << 22)

__device__ __forceinline__ unsigned xb_ld(unsigned* p)              { return __hip_atomic_load(p, __ATOMIC_RELAXED, __HIP_MEMORY_SCOPE_AGENT); }
__device__ __forceinline__ unsigned xb_add(unsigned* p, unsigned v) { return __hip_atomic_fetch_add(p, v, __ATOMIC_RELAXED, __HIP_MEMORY_SCOPE_AGENT); }
__device__ __forceinline__ unsigned xb_xcc_id() { return (unsigned)__builtin_amdgcn_s_getreg((3 << 11) | 20) & 0xFu; }
#define XB_SPIN(cond, bar) do { unsigned _sp = 0; while (cond) { __builtin_amdgcn_s_sleep(1); \
    if ((++_sp & 255u) == 0u) { if (xb_ld(&(bar)[XB_TMO])) break; if (_sp > XB_SPIN_CAP) { atomicAdd(&(bar)[XB_TMO], 1u); break; } } } } while (0)

struct XcdBarrier { unsigned* bar; unsigned x; volatile LAS unsigned* st; };

__device__ __forceinline__ XcdBarrier xcd_barrier_post(unsigned* bar, volatile LAS unsigned* st) {
    XcdBarrier b; b.bar = bar; b.x = xb_xcc_id(); b.st = st;
    if (threadIdx.x == 0) (void)xb_add(&bar[XB_XCNT(b.x)], 1u);
    return b;
}
__device__ __forceinline__ void xcd_barrier_complete(unsigned* bar, unsigned x, unsigned& nloc, unsigned& nx) {
    const unsigned G = gridDim.x * gridDim.y * gridDim.z;
    unsigned sum, cnt, mine, sp = 0u;
    for (;;) {
        sum = 0u; cnt = 0u; mine = 0u;
#pragma unroll
        for (unsigned j = 0; j < 16; ++j) { const unsigned c = xb_ld(&bar[XB_XCNT(j)]); sum += c; cnt += (c > 0u) ? 1u : 0u; mine = (j == x) ? c : mine; }
        if (sum == G) break;
        __builtin_amdgcn_s_sleep(1);
        if ((++sp & 255u) == 0u) { if (xb_ld(&bar[XB_TMO])) break; if (sp > XB_SPIN_CAP) { atomicAdd(&bar[XB_TMO], 1u); break; } }
    }
    nloc = mine > 0u ? mine : 1u; nx = cnt > 0u ? cnt : 1u;
}
__device__ __forceinline__ void xcd_barrier(const XcdBarrier& b, int wave) {
    asm volatile("s_waitcnt vmcnt(0)" ::: "memory");
    __syncthreads();
    int z_ = 0; asm volatile("" : "+v"(z_));
    if (wave == 0 && __builtin_amdgcn_mbcnt_hi(~0u, __builtin_amdgcn_mbcnt_lo(~0u, (unsigned)z_)) == 0u) {
        unsigned* bar = b.bar;
        __builtin_amdgcn_s_waitcnt(0);
        unsigned nloc = b.st[0], nx = b.st[1];
        if (nloc == 0u) { xcd_barrier_complete(bar, b.x, nloc, nx); b.st[0] = nloc; b.st[1] = nx; }
        const unsigned old = xb_add(&bar[XB_XSUB(b.x)], 1u);
        const unsigned gen = old / nloc;
        if (old + 1u == (gen + 1u) * nloc) {
            __builtin_amdgcn_fence(__ATOMIC_RELEASE, "agent");
            asm volatile("s_waitcnt vmcnt(0)" ::: "memory");
            const unsigned og = xb_add(&bar[XB_TOP], 1u);
            const unsigned tg = og / nx;
            if (og + 1u == (tg + 1u) * nx) xb_add(&bar[XB_TOPGEN], 1u);
            else XB_SPIN(xb_ld(&bar[XB_TOPGEN]) == tg, bar);
            __builtin_amdgcn_fence(__ATOMIC_ACQUIRE, "agent");
            xb_add(&bar[XB_XGEN(b.x)], 1u);
            asm volatile("s_waitcnt vmcnt(0)" ::: "memory");
        } else {
            XB_SPIN(xb_ld(&bar[XB_XGEN(b.x)]) == gen, bar);
            __builtin_amdgcn_fence(__ATOMIC_ACQUIRE, "agent");
            asm volatile("s_waitcnt vmcnt(0)" ::: "memory");
        }
    }
    __syncthreads();
}

struct Frame {
    LAS unsigned char* lds;
    volatile LAS unsigned* MISC;
    int tid, lane, wave;
    int vcu, G;
};
struct Args { const float* in[12]; float* out; unsigned char* ws; int ph_lo, ph_hi, li, pad; };
template <class T> __device__ __forceinline__ T* karg_ptr(int byte_off) {
    const char __attribute__((address_space(4)))* p = (const char __attribute__((address_space(4)))*)__builtin_amdgcn_kernarg_segment_ptr();
    int o = byte_off; asm volatile("" : "+s"(o));
    return *(T* const __attribute__((address_space(4)))*)(p + o);
}
__device__ __forceinline__ const float* in_ptr(int i) { return karg_ptr<const float>(8 * i); }
__device__ __forceinline__ float* out_ptr() { return karg_ptr<float>(96); }
__device__ __forceinline__ unsigned char* ws_ptr() { return karg_ptr<unsigned char>(104); }
#define WSP(T, off) ((T*)(ws_ptr() + (off)))

__device__ __forceinline__ void transpose_item(const float* Wsrc, int ldw, int K, int ncols, bf16* WT, int row_off, LAS float* scr, int item, int lane, const float* kscale = nullptr, int kmin = 0) {
    const int nblk = ncols / 32, kb = item / nblk, nb = item % nblk, k0 = 64 * kb, n0 = 32 * nb;
#pragma unroll
    for (int i = 0; i < 8; ++i) { const int kk = (lane >> 3) + 8 * i, c4 = lane & 7;
        f32x4 v = *(const f32x4*)(Wsrc + (size_t)(k0 + kk) * ldw + n0 + 4 * c4);
        if (kscale && k0 + kk >= kmin) v = v * kscale[k0 + kk - kmin];
        LAS float* d = scr + kk * 33 + 4 * c4; d[0] = v.x; d[1] = v.y; d[2] = v.z; d[3] = v.w; }
    LDS_WAIT(); asm volatile("" ::: "memory");
    const int c = lane & 7;
#pragma unroll
    for (int j = 0; j < 4; ++j) { const int n = (lane >> 3) + 8 * j; const LAS float* s = scr + (8 * c) * 33 + n;
        v4u o; o.x = pk2(s[0 * 33], s[1 * 33]); o.y = pk2(s[2 * 33], s[3 * 33]); o.z = pk2(s[4 * 33], s[5 * 33]); o.w = pk2(s[6 * 33], s[7 * 33]);
        *(v4u*)(WT + (size_t)(row_off + n0 + n) * K + k0 + 8 * c) = o; }
    LDS_WAIT(); asm volatile("" ::: "memory");
}

__device__ __forceinline__ void phase_a(Frame& F, int layer) {
    bf16* const WinT = WSP(bf16, WS_WIN); bf16* const WoutT = WSP(bf16, WS_WOUT); bf16* const XN = WSP(bf16, WS_A); float* const DT = WSP(float, WS_DT); const float* const OUTP = out_ptr();
    const int gw = F.vcu * NWAVES + F.wave, NGW = F.G * NWAVES;
    {
        LAS float* scr = (LAS float*)(F.lds + RING_OFF + F.wave * 16384);
        const float* win = in_ptr(2) + (size_t)layer * DM * NIN;
        const float* wout = in_ptr(11) + (size_t)layer * 2048 * DM;
        constexpr int KB_IN = DM / 64;
        constexpr int I_1K = KB_IN * (1024 / 32), I_X = KB_IN * (1536 / 32), I_OUT = (2048 / 64) * (1024 / 32);
        constexpr int NITEMS = 5 * I_1K + I_X + (WOUT_IN_B ? 0 : I_OUT);
        for (int it = gw; it < NITEMS; it += NGW) {
            int r = it;
            if (r < I_1K) { transpose_item(win + 0,    NIN, DM, 1024, WinT, C_Q, scr, r, F.lane); continue; } r -= I_1K;
            if (r < I_1K) { transpose_item(win + 4096, NIN, DM, 1024, WinT, C_Z, scr, r, F.lane); continue; } r -= I_1K;
            if (r < I_1K) { transpose_item(win + 1024, NIN, DM, 1024, WinT, C_K, scr, r, F.lane); continue; } r -= I_1K;
            if (r < I_1K) { transpose_item(win + 2048, NIN, DM, 1024, WinT, C_V, scr, r, F.lane); continue; } r -= I_1K;
            if (r < I_1K) { transpose_item(win + 3072, NIN, DM, 1024, WinT, C_G, scr, r, F.lane); continue; } r -= I_1K;
            if (r < I_X)  { transpose_item(win + 5120, NIN, DM, 1536, WinT, C_X, scr, r, F.lane); continue; } r -= I_X;
            transpose_item(wout, DM, 2048, 1024, WoutT, 0, scr, r, F.lane, in_ptr(10) + (size_t)layer * 1024, 1024);
        }
    }
    __syncthreads();
    LAS unsigned short* wdb = (LAS unsigned short*)(F.lds + RING_OFF); LAS float* lnl = (LAS float*)(F.lds + RING_OFF + 32768);
    {
        const float* win = in_ptr(2) + (size_t)layer * DM * NIN + 6656; const float* lnw = in_ptr(1) + layer * DM;
        for (int i = F.tid; i < 16 * 1024; i += NWAVES * 64) { const int k = i >> 4, c = i & 15; wdb[c * 1024 + k] = (unsigned short)f2bf(win[(size_t)k * NIN + c]); }
        for (int i = F.tid; i < 1024; i += NWAVES * 64) lnl[i] = lnw[i];
    }
    __syncthreads();
    const float* xin = layer == 0 ? in_ptr(0) : OUTP;
    const float* dtb = in_ptr(7) + layer * NSH;
    float* const RSTD = WSP(float, WS_RSTD);
    const int r = F.lane & 15, g4 = F.lane >> 4;
    for (int grp = gw; grp < M / 16; grp += NGW) {
        asm volatile("" ::: "memory");
        const size_t m0 = (size_t)grp * 16;
        const char* xb = (const char*)(xin + (m0 + r) * DM + 8 * g4); char* ob = (char*)(XN + (m0 + r) * DM + 8 * g4);
        f32x4 acc = {0.f, 0.f, 0.f, 0.f}; float ssq = 0.f;
#pragma unroll 8
        for (int kk = 0; kk < 32; ++kk) {
            const f32x4 a = __builtin_nontemporal_load((const f32x4*)(xb + kk * 128)), b = __builtin_nontemporal_load((const f32x4*)(xb + kk * 128 + 16));
            const f32x4 la = *(const LAS f32x4*)(lnl + 32 * kk + 8 * g4), lb = *(const LAS f32x4*)(lnl + 32 * kk + 8 * g4 + 4);
            ssq += ((a.x * a.x + a.y * a.y) + (a.z * a.z + a.w * a.w)) + ((b.x * b.x + b.y * b.y) + (b.z * b.z + b.w * b.w));
            const f32x4 ha = a * la, hb = b * lb;
            v4u pk; pk.x = pk2(ha.x, ha.y); pk.y = pk2(ha.z, ha.w); pk.z = pk2(hb.x, hb.y); pk.w = pk2(hb.z, hb.w);
            *(v4u*)(ob + kk * 64) = pk;
            const bf16x8 wf = *(const LAS bf16x8*)(wdb + r * 1024 + 32 * kk + 8 * g4);
            acc = __builtin_amdgcn_mfma_f32_16x16x32_bf16(wf, __builtin_bit_cast(bf16x8, pk), acc, 0, 0, 0);
        }
        ssq += __shfl_xor(ssq, 16); ssq += __shfl_xor(ssq, 32);
        const float rstd = 1.f / sqrtf(ssq * (1.f / DM) + EPS);
        if (g4 == 0) RSTD[m0 + r] = rstd;
        f32x4 o;
#pragma unroll
        for (int i = 0; i < 4; ++i) { const float a = acc[i] * rstd + dtb[4 * g4 + i], u = __expf(-fabsf(a));
            o[i] = fmaxf(a, 0.f) + (u < 1e-3f ? u * (1.f - u * (0.5f - 0.33333334f * u)) : __logf(1.f + u)); }
        *(f32x4*)(DT + (m0 + r) * 16 + 4 * g4) = o;
    }
}

__device__ __forceinline__ void phase_c(Frame& F, int layer) {
    bf16* const PROJ = WSP(bf16, WS_PROJ); bf16* const BCc = WSP(bf16, WS_A);
    const int gw = F.vcu * NWAVES + F.wave, NGW = F.G * NWAVES;
    {
        const int c8 = F.lane * 8;
        const float* cw = in_ptr(5) + (size_t)layer * 4 * 1536 + 1024 + c8;
        const float* cb = in_ptr(6) + (size_t)layer * 1536 + 1024 + c8;
        f32x4 w[4][2], bias[2];
#pragma unroll
        for (int k = 0; k < 4; ++k) { w[k][0] = *(const f32x4*)(cw + k * 1536); w[k][1] = *(const f32x4*)(cw + k * 1536 + 4); }
        bias[0] = *(const f32x4*)cb; bias[1] = *(const f32x4*)(cb + 4);
#pragma unroll 1
        for (int run = gw; run < M / 16; run += NGW) {
            const int m0 = run * 16; const bool head = (m0 & (SEQ - 1)) == 0;
            const bf16* src = PROJ + (size_t)m0 * PITCH + C_B + c8;
            v4u x[19];
#pragma unroll
            for (int j = 0; j < 19; ++j) { if (j < 3 && head) x[j] = (v4u){0u, 0u, 0u, 0u}; else x[j] = *(const v4u*)(src + (j - 3) * PITCH); }
#pragma unroll
            for (int i = 0; i < 16; ++i) {
                f32x4 a0 = bias[0], a1 = bias[1];
#pragma unroll
                for (int k = 0; k < 4; ++k) { const v4u u = x[i + k];
                    a0 += w[k][0] * (f32x4){bflo(u.x), bfhi(u.x), bflo(u.y), bfhi(u.y)}; a1 += w[k][1] * (f32x4){bflo(u.z), bfhi(u.z), bflo(u.w), bfhi(u.w)}; }
                v4u o; o.x = pk2(silu_f(a0.x), silu_f(a0.y)); o.y = pk2(silu_f(a0.z), silu_f(a0.w)); o.z = pk2(silu_f(a1.x), silu_f(a1.y)); o.w = pk2(silu_f(a1.z), silu_f(a1.w));
                *(v4u*)(BCc + (size_t)(m0 + i) * 512 + c8) = o;
            }
        }
    }
    if ((gw & 3) == 0) {
        const float* const DT = WSP(float, WS_DT); float* const ACS = WSP(float, WS_ACS); const float* alog = in_ptr(8) + layer * NSH;
#pragma unroll 1
        for (int c = gw >> 2; c < M / 64; c += NGW >> 2) {
            const size_t idx = ((size_t)c * 64 + F.lane) * 16;
            f32x4 a[4];
#pragma unroll
            for (int q = 0; q < 4; ++q) { a[q] = *(const f32x4*)(DT + idx + 4 * q);
#pragma unroll
                for (int e = 0; e < 4; ++e) a[q][e] *= -__expf(alog[4 * q + e]); }
#pragma unroll
            for (int o = 1; o < 64; o <<= 1)
#pragma unroll
                for (int q = 0; q < 4; ++q)
#pragma unroll
                    for (int e = 0; e < 4; ++e) { const float t = __shfl_up(a[q][e], o); if (F.lane >= o) a[q][e] += t; }
#pragma unroll
            for (int q = 0; q < 4; ++q) *(f32x4*)(ACS + idx + 4 * q) = a[q];
        }
    }
}


namespace ssd {
typedef float f32x4v __attribute__((ext_vector_type(4)));
typedef short s16x4v __attribute__((ext_vector_type(4)));
constexpr int L = 64, S256 = 272, S64 = 144, S32 = 144;
constexpr int O_BS = 0, O_CS = O_BS + 64 * S256, O_XB = O_CS + 64 * S256, O_XW = O_XB + 64 * S32, O_MT = O_XW + 64 * S32, O_ST = O_MT + 64 * S64,
              O_TB = O_ST + 2 * 64 * S256, O_CS2 = O_TB + NWAVES * 1024, O_XB2 = O_CS2 + 64 * S256, O_END = O_XB2 + 64 * S32;
static_assert(O_END <= LDSCTL_OFF, "SSD LDS map");
#define LD128(off) (*(const LAS bf16x8*)(lds + (off)))
#define MFMA16(a, b, c) __builtin_amdgcn_mfma_f32_16x16x32_bf16(a, b, c, 0, 0, 0)
#define TRRD(dst, addr, off) asm volatile("ds_read_b64_tr_b16 %0, %1 offset:%2" : "=&v"(dst) : "v"(addr), "i"(off) : "memory")
#define TRWAIT() do { asm volatile("s_waitcnt lgkmcnt(0)" ::: "memory"); __builtin_amdgcn_sched_barrier(0); } while (0)
#define CAT8(lo, hi) ((bf16x8){lo[0], lo[1], lo[2], lo[3], hi[0], hi[1], hi[2], hi[3]})
typedef __bf16 bf16x2n __attribute__((ext_vector_type(2)));
__device__ __forceinline__ unsigned cvtpk(float lo, float hi) { bf16x2n v = {(__bf16)lo, (__bf16)hi}; return __builtin_bit_cast(unsigned, v); }
__device__ __forceinline__ float silu_fast(float v) { return v * __builtin_amdgcn_rcpf(1.f + __expf(-v)); }

__device__ __forceinline__ void item(LAS unsigned char* lds, int wave_, int layer, int b, int h) {
    int z_ = 0; asm volatile("" : "+v"(z_));
    const int wid = wave_, lane = (int)__builtin_amdgcn_mbcnt_hi(~0u, __builtin_amdgcn_mbcnt_lo(~0u, (unsigned)z_)), tid = wid * 64 + lane, fr = lane & 15, fq = lane >> 4;
    const int g = h >> 3;
    const float Dh = in_ptr(9)[layer * NSH + h];
    const int brow = tid >> 4, bch = tid & 15;
    const int xl = tid >> 3, xpg = tid & 7;
    const int xcol = h * SHD + 4 * xpg;
    float cw[2][4][4], cbv[2][4];
    { const float* cwp = in_ptr(5) + (size_t)layer * 4 * 1536 + xcol; const float* cbp = in_ptr(6) + (size_t)layer * 1536 + xcol;
#pragma unroll
      for (int j = 0; j < 2; ++j) {
#pragma unroll
      for (int k = 0; k < 4; ++k)
#pragma unroll
          for (int e = 0; e < 4; ++e) cw[j][k][e] = cwp[k * 1536 + 32 * j + e];
#pragma unroll
      for (int e = 0; e < 4; ++e) cbv[j][e] = cbp[32 * j + e]; } }
    const char* pBC = (const char*)(WSP(bf16, WS_A) + (size_t)b * SEQ * 512 + g * 128);
    const char* pX = (const char*)(WSP(bf16, WS_PROJ) + (size_t)b * SEQ * PITCH + C_X);
    char* pZ = (char*)(WSP(bf16, WS_PROJ) + (size_t)b * SEQ * PITCH + C_Z + h * SHD);
    const char* pDT = (const char*)(WSP(float, WS_DT) + (size_t)b * SEQ * 16 + h);
    const char* pAC = (const char*)(WSP(float, WS_ACS) + (size_t)b * SEQ * 16 + h);
    float* pSQ = WSP(float, WS_SSQ) + (size_t)b * SEQ * 64 + h * 4;
    const unsigned obc = (unsigned)(brow * 512 + bch * 8) * 2u;
    const int oxr = (xl - 3) * PITCH * 2 + xcol * 2;
    const unsigned odt = (unsigned)lane * 64u;
    const int tl = wid >> 1, ts0 = 2 * (wid & 1), tpC = wid & 1, tn = wid;
    const unsigned ozy = (unsigned)((16 * tl + fr) * PITCH + 32 * tpC + 4 * fq) * 2u;
    const int trq = fr >> 2, trp = fr & 3;
    const int aXB = (int)(unsigned)(size_t)(lds + O_XB) + (8 * fq + trq) * S32 + (4 * trp) * 2;
    const int aXBc = aXB + 64 * tpC;
    const int aXW = (int)(unsigned)(size_t)(lds + O_XW) + (8 * fq + trq) * S32 + (4 * trp) * 2;
    const int aBS = (int)(unsigned)(size_t)(lds + O_BS) + (8 * fq + trq) * S256 + (16 * tn + 4 * trp) * 2;
    f32x4v accS[4] = {};
    for (int i = tid; i < 64 * S256 / 4; i += NWAVES * 64) ((LAS unsigned*)(lds + O_ST))[i] = 0u;
    LAS float* const tb = (LAS float*)(lds + O_TB + wid * 1024);
    v4u bu0_0, bu1_0, cu0_0, cu1_0, bu0_1, bu1_1, cu0_1, cu1_1; v2u xr_0[2][4], xr_1[2][4], zr_0[2], zr_1[2]; float dtn_0, dtn_1, acn_0, acn_1;
#define SSD_LOAD(c, S_) do { const char* bc_ = pBC + (size_t)(c) * (L * 512 * 2); const char* px_ = pX + (size_t)(c) * (L * PITCH * 2); \
        bu0_##S_ = *(const v4u*)(bc_ + obc); bu1_##S_ = *(const v4u*)(bc_ + obc + 32 * 512 * 2); cu0_##S_ = *(const v4u*)(bc_ + obc + 512); cu1_##S_ = *(const v4u*)(bc_ + obc + 32 * 512 * 2 + 512); \
        _Pragma("unroll") for (int j = 0; j < 2; ++j) _Pragma("unroll") for (int k = 0; k < 4; ++k) xr_##S_[j][k] = ((c) * L + xl - 3 + k >= 0) ? *(const v2u*)(px_ + (oxr + k * PITCH * 2 + 64 * j)) : (v2u){0u, 0u}; \
        dtn_##S_ = *(const float*)(pDT + (size_t)(c) * (L * 64) + odt); acn_##S_ = *(const float*)(pAC + (size_t)(c) * (L * 64) + odt); \
        zr_##S_[0] = *(const v2u*)(pZ + (size_t)(c) * (L * PITCH * 2) + ozy); zr_##S_[1] = *(const v2u*)(pZ + (size_t)(c) * (L * PITCH * 2) + ozy + 32); } while (0)
#define SSD_STEP(c, S_) do { \
        QS0(0); \
        constexpr int OCS = (S_) ? O_CS2 : O_CS, OXB = (S_) ? O_XB2 : O_XB;     \
        const int aXBs = aXBc + (OXB - O_XB); \
          \
        const float dtv = dtn_##S_, acs = acn_##S_; \
        const float tot = __builtin_bit_cast(float, __builtin_amdgcn_readlane(__builtin_bit_cast(int, acs), 63)); \
        const float ea = __expf(acs); \
        tb[lane] = acs; tb[64 + lane] = dtv; tb[128 + lane] = __expf(tot - acs) * dtv; tb[192 + lane] = ea; \
        const v2u zq0 = zr_##S_[0], zq1 = zr_##S_[1]; \
          \
        { \
            *(LAS v4u*)(lds + O_BS + brow * S256 + bch * 16) = bu0_##S_; *(LAS v4u*)(lds + O_BS + (32 + brow) * S256 + bch * 16) = bu1_##S_; \
            *(LAS v4u*)(lds + OCS + brow * S256 + bch * 16) = cu0_##S_; *(LAS v4u*)(lds + OCS + (32 + brow) * S256 + bch * 16) = cu1_##S_; \
            asm volatile("s_waitcnt lgkmcnt(0)" ::: "memory"); \
            const float wl = tb[128 + xl]; \
            _Pragma("unroll") for (int j = 0; j < 2; ++j) { \
                float xv[4]; \
                _Pragma("unroll") for (int e = 0; e < 4; ++e) xv[e] = cbv[j][e]; \
                _Pragma("unroll") for (int k = 0; k < 4; ++k) { xv[0] += cw[j][k][0] * bflo(xr_##S_[j][k].x); xv[1] += cw[j][k][1] * bfhi(xr_##S_[j][k].x); xv[2] += cw[j][k][2] * bflo(xr_##S_[j][k].y); xv[3] += cw[j][k][3] * bfhi(xr_##S_[j][k].y); } \
                _Pragma("unroll") for (int e = 0; e < 4; ++e) xv[e] = silu_fast(xv[e]); \
                *(LAS v2u*)(lds + OXB + xl * S32 + xpg * 8 + 64 * j) = (v2u){cvtpk(xv[0], xv[1]), cvtpk(xv[2], xv[3])}; \
                *(LAS v2u*)(lds + O_XW + xl * S32 + xpg * 8 + 64 * j) = (v2u){cvtpk(xv[0] * wl, xv[1] * wl), cvtpk(xv[2] * wl, xv[3] * wl)}; } \
        } \
        QS1(0); QS0(1); __syncthreads(); QS1(1); QS0(2); \
        if ((c) + 2 < SEQ / L) SSD_LOAD((c) + 2, S_);                          \
          \
        { \
            bf16x8 cf[4]; \
            _Pragma("unroll") for (int kk = 0; kk < 4; ++kk) cf[kk] = LD128(OCS + (16 * tl + fr) * S256 + (32 * kk + 8 * fq) * 2); \
            const float al = tb[16 * tl + fr];                                 \
            const int l = 16 * tl + fr; \
            _Pragma("unroll") for (int j = 0; j < 2; ++j) { \
                const int ts = ts0 + j; \
                if (ts <= tl) { \
                    f32x4v gacc = {}; \
                    _Pragma("unroll") for (int kk = 0; kk < 4; ++kk) gacc = MFMA16(LD128(O_BS + (16 * ts + fr) * S256 + (32 * kk + 8 * fq) * 2), cf[kk], gacc);     \
                    const f32x4v as4 = *(const LAS f32x4v*)(tb + 16 * ts + 4 * fq), ds4 = *(const LAS f32x4v*)(tb + 64 + 16 * ts + 4 * fq); \
                    float mv[4]; \
                    _Pragma("unroll") for (int r = 0; r < 4; ++r) mv[r] = (16 * ts + 4 * fq + r <= l) ? gacc[r] * __expf(al - as4[r]) * ds4[r] : 0.f; \
                    *(LAS v2u*)(lds + O_MT + l * S64 + (16 * ts + 4 * fq) * 2) = (v2u){cvtpk(mv[0], mv[1]), cvtpk(mv[2], mv[3])}; \
                } else { \
                    *(LAS v2u*)(lds + O_MT + l * S64 + (16 * ts + 4 * fq) * 2) = (v2u){0u, 0u}; \
                } \
            } \
            const float dec = __expf(tot); \
            s16x4v b0, b1, b2, b3; \
            TRRD(b0, aBS, 0); TRRD(b1, aBS, 4 * S256); TRRD(b2, aBS, 32 * S256); TRRD(b3, aBS, 36 * S256); \
            _Pragma("unroll") for (int tp = 0; tp < 4; ++tp) { s16x4v x0, x1, x2, x3; \
                TRRD(x0, aXW, 32 * tp); TRRD(x1, aXW, 4 * S32 + 32 * tp); TRRD(x2, aXW, 32 * S32 + 32 * tp); TRRD(x3, aXW, 36 * S32 + 32 * tp); \
                TRWAIT(); \
                accS[tp] = accS[tp] * dec; \
                accS[tp] = MFMA16(CAT8(b0, b1), CAT8(x0, x1), accS[tp]); accS[tp] = MFMA16(CAT8(b2, b3), CAT8(x2, x3), accS[tp]);     \
            } \
            _Pragma("unroll") for (int tp = 0; tp < 4; ++tp) \
                *(LAS v2u*)(lds + O_ST + (cur ^ 1) * 64 * S256 + (16 * tp + fr) * S256 + (16 * tn + 4 * fq) * 2) = (v2u){cvtpk(accS[tp][0], accS[tp][1]), cvtpk(accS[tp][2], accS[tp][3])}; \
        } \
        QS1(2); QS0(3); __syncthreads(); QS1(3); QS0(4); \
          \
        { \
            const bf16x8 m0f = LD128(O_MT + (16 * tl + fr) * S64 + (8 * fq) * 2), m1f = LD128(O_MT + (16 * tl + fr) * S64 + (32 + 8 * fq) * 2); \
            bf16x8 cfr[4]; \
            _Pragma("unroll") for (int kk = 0; kk < 4; ++kk) cfr[kk] = LD128(OCS + (16 * tl + fr) * S256 + (32 * kk + 8 * fq) * 2); \
            const float eal = tb[192 + 16 * tl + fr]; \
            _Pragma("unroll") for (int j = 0; j < 2; ++j) { \
                s16x4v x0, x1, x2, x3; \
                TRRD(x0, aXBs, 32 * j); TRRD(x1, aXBs, 4 * S32 + 32 * j); TRRD(x2, aXBs, 32 * S32 + 32 * j); TRRD(x3, aXBs, 36 * S32 + 32 * j); \
                TRWAIT(); \
                f32x4v yd = {}, yo = {}; \
                yd = MFMA16(CAT8(x0, x1), m0f, yd); yd = MFMA16(CAT8(x2, x3), m1f, yd); \
                _Pragma("unroll") for (int kk = 0; kk < 4; ++kk) yo = MFMA16(LD128(O_ST + cur * 64 * S256 + (32 * tpC + 16 * j + fr) * S256 + (32 * kk + 8 * fq) * 2), cfr[kk], yo); \
                const v2u xb = *(const LAS v2u*)(lds + OXB + (16 * tl + fr) * S32 + (32 * tpC + 16 * j + 4 * fq) * 2); \
                const v2u zr = j ? zq1 : zq0;                                 \
                float yz[4]; \
                yz[0] = (yd[0] + eal * yo[0] + Dh * bflo(xb.x)) * bflo(zr.x); yz[1] = (yd[1] + eal * yo[1] + Dh * bfhi(xb.x)) * bfhi(zr.x); \
                yz[2] = (yd[2] + eal * yo[2] + Dh * bflo(xb.y)) * bflo(zr.y); yz[3] = (yd[3] + eal * yo[3] + Dh * bfhi(xb.y)) * bfhi(zr.y); \
                *(v2u*)(pZ + (size_t)(c) * (L * PITCH * 2) + ozy + 32 * j) = (v2u){cvtpk(yz[0], yz[1]), cvtpk(yz[2], yz[3])}; \
                float q = (yz[0] * yz[0] + yz[1] * yz[1]) + (yz[2] * yz[2] + yz[3] * yz[3]); \
                q += __shfl_xor(q, 16); q += __shfl_xor(q, 32); \
                if (fq == 0) pSQ[((size_t)(c) * L + 16 * tl + fr) * 64 + 2 * tpC + j] = q; } \
        } \
          \
        QS1(4); cur ^= 1; } while (0)
    unsigned long long qacc = 0;
#define QS0(k) unsigned long long qt##k##_ = 0; if (PROBE_SSEC == (k)) qt##k##_ = __builtin_amdgcn_s_memtime()
#define QS1(k) do { if (PROBE_SSEC == (k)) qacc += __builtin_amdgcn_s_memtime() - qt##k##_; } while (0)
    SSD_LOAD(0, 0); SSD_LOAD(1, 1);
    int cur = 0;
#pragma unroll 1
    for (int c = 0; c < SEQ / L; c += 2) { SSD_STEP(c, 0); SSD_STEP(c + 1, 1); }
    if (PROBE_SSEC >= 0) { const unsigned long long t0 = __builtin_amdgcn_s_memtime(); while (__builtin_amdgcn_s_memtime() - t0 < qacc) __builtin_amdgcn_s_sleep(8); }
    __syncthreads();
#undef QS0
#undef QS1
#undef SSD_STEP
#undef SSD_LOAD
}
#undef LD128
#undef MFMA16
#undef TRRD
#undef TRWAIT
#undef CAT8
}


__device__ __forceinline__ void ssd_phase(Frame& F, int layer) {
    if ((F.vcu & 1) == 0) for (int it = F.vcu >> 1; it < BATCH * NSH; it += (F.G + 1) >> 1) ssd::item(F.lds + RING_OFF, F.wave, layer, it >> 4, it & 15);
}


namespace moba {
typedef float f32x16 __attribute__((ext_vector_type(16)));
typedef short s16x4 __attribute__((ext_vector_type(4)));
typedef unsigned u32x4 __attribute__((ext_vector_type(4)));
constexpr int NW = 8, QBLK = 32, KVBLK = 64, QB = NW * QBLK;
constexpr int SHM_V = KVBLK * HD * 2, SHM_K = KVBLK * HD * 2;
constexpr int OFF_V = 0, OFF_K = 3 * SHM_V, OFF_WS = 3 * SHM_V + 3 * SHM_K, OFF_KM = OFF_WS + NW * 64 * 4;
constexpr int ATTN_LDS = OFF_KM + 32 * 256;
constexpr float SCALE = 0.08838834764831845f, LOG2E = 1.4426950408889634f;

#define KSWZ(row, colB) ((row) * 256 + ((colB) ^ (((row) & 7) << 4)))
#define SBAR() __builtin_amdgcn_sched_barrier(0)
__device__ __forceinline__ int v_st(int k, int c) { const int kk = (k & ~0xC) | ((k & 4) << 1) | ((k & 8) >> 1); return ((kk >> 3) * 4 + (c >> 5)) * 512 + ((kk & 7) * 32 + (c & 31)) * 2; }
__device__ __forceinline__ int v_rd_base(int lane) { return ((lane & 3) << 3) | (((lane >> 2) & 3) << 6) | (((lane >> 4) & 1) << 5) | (((lane >> 5) & 1) << 8); }
constexpr int v_rd_off(int d0, int ks, int half) { return d0 * 512 + ks * 4096 + half * 2048; }
__device__ __forceinline__ int crow(int r, int hi) { return (r & 3) + 8 * (r >> 2) + 4 * hi; }
typedef __bf16 bf16x2n __attribute__((ext_vector_type(2)));
__device__ __forceinline__ unsigned cvtpk(float lo, float hi) { bf16x2n v = {(__bf16)lo, (__bf16)hi}; return __builtin_bit_cast(unsigned, v); }

struct Unit { const bf16* Q; const bf16* K; const bf16* V; const float* KM; int qb, h, jlo;
#if PROBE_MEM2 == 1
    long dum; __device__ __forceinline__ long dumv() const { return dum; }
#else
    __device__ __forceinline__ long dumv() const { return 0; }
#endif
};
struct Seam { bf16x8 qr[8]; bf16x8 st_v0, st_v1, st_k0, st_k1; };
constexpr int OFF_ORD = 108 * 1024, OFF_TK = OFF_ORD + 2048, OFF_WT = OFF_TK + 16;
struct Queue { unsigned* ctr; bf16* PROJ; const float* KM; };
__device__ __forceinline__ bool unit_from_ticket(unsigned t, const Queue& q, const LAS char* lds, Unit& u) {
    if (t >= (unsigned)(BATCH * NH * NBLK)) return false;
    const int id = __builtin_amdgcn_readfirstlane((int)((const LAS unsigned short*)(lds + OFF_ORD))[t]), b = id >> 7, h = (id >> 4) & 7, qb = id & 15;
    const int w = __builtin_amdgcn_readfirstlane(((const LAS int*)(lds + OFF_WT))[h]);
    const bf16* base = q.PROJ + (size_t)b * SEQ * PITCH + h * HD;
    u.Q = base + (size_t)qb * MOBA * PITCH + C_Q; u.K = base + C_K; u.V = base + C_V; u.KM = q.KM + (size_t)(b * NH + h) * NBLK * HD; u.qb = qb; u.h = h;
    u.jlo = qb > w ? 4 * (qb - w) : 0;
#if PROBE_MEM2 == 1
    u.dum = (b < 4 ? 1 : -1) * (long)(4 * SEQ) * PITCH * 2;
#endif
    return true;
}

__device__ __forceinline__ void mask_tile(f32x16& p0, f32x16& p1, int dq) {
    const float NEG = -__builtin_inff();
#pragma unroll
    for (int r = 0; r < 16; ++r) { const int c = (r & 3) + 8 * (r >> 2); if (dq - c < 0) p0[r] = NEG; if (dq - c - 32 < 0) p1[r] = NEG; }
}
__device__ __forceinline__ void partialSM(f32x16& p0, f32x16& p1, float base, float slope2) {
    constexpr float C2 = LOG2E * SCALE;
#pragma unroll
    for (int r = 0; r < 16; ++r) { const float c = (float)((r & 3) + 8 * (r >> 2)); p0[r] = fmaf(p0[r], C2, fmaf(slope2, c, base)); p1[r] = fmaf(p1[r], C2, fmaf(slope2, c + 32.f, base)); }
#pragma unroll
    for (int r = 0; r < 16; ++r) p0[r] = __builtin_amdgcn_exp2f(p0[r]);
}
__device__ __forceinline__ void finishSM(f32x16& p0, f32x16& p1, float& l_reg, bf16x8& pa0, bf16x8& pa1, bf16x8& pa2, bf16x8& pa3) {
#pragma unroll
    for (int r = 0; r < 16; ++r) p1[r] = __builtin_amdgcn_exp2f(p1[r]);
    float ps = 0;
#pragma unroll
    for (int r = 0; r < 16; ++r) ps += p0[r];
#pragma unroll
    for (int r = 0; r < 16; ++r) ps += p1[r];
    { auto rr = __builtin_amdgcn_permlane32_swap(__float_as_uint(ps), __float_as_uint(ps), false, false); ps = __uint_as_float(rr[0]) + __uint_as_float(rr[1]); }
    l_reg += ps;
#define PK4(P, B_, OUT) do { unsigned a0 = cvtpk(P[B_+0], P[B_+1]), a1 = cvtpk(P[B_+2], P[B_+3]); unsigned b0 = cvtpk(P[B_+4], P[B_+5]), b1 = cvtpk(P[B_+6], P[B_+7]); \
        auto r0 = __builtin_amdgcn_permlane32_swap(a0, b0, false, false); auto r1 = __builtin_amdgcn_permlane32_swap(a1, b1, false, false); \
        u32x4 w = {r0[0], r1[0], r0[1], r1[1]}; OUT = *reinterpret_cast<bf16x8*>(&w); } while (0)
    PK4(p0, 0, pa0); PK4(p0, 8, pa1); PK4(p1, 0, pa2); PK4(p1, 8, pa3);
#undef PK4
}
__device__ __forceinline__ void qkt(f32x16& p0, f32x16& p1, const LAS char* const (&kbase)[4], int kslot, const bf16x8* qr) {
    p0 = f32x16{}; p1 = f32x16{};
#pragma unroll
    for (int d0 = 0; d0 < 8; ++d0) { const LAS char* a = kbase[d0 & 3] + kslot + (d0 >> 2) * 128;
        bf16x8 b0 = *reinterpret_cast<const LAS bf16x8*>(a);
        bf16x8 b1 = *reinterpret_cast<const LAS bf16x8*>(a + 32 * 256);
        p0 = __builtin_amdgcn_mfma_f32_32x32x16_bf16(b0, qr[d0], p0, 0, 0, 0);
        p1 = __builtin_amdgcn_mfma_f32_32x32x16_bf16(b1, qr[d0], p1, 0, 0, 0); }
}
__device__ __forceinline__ void pv_tile(f32x16* o, int vb0, bf16x8 pa0, bf16x8 pa1, bf16x8 pa2, bf16x8 pa3) {
#define TRRD(dst, off) asm volatile("ds_read_b64_tr_b16 %0, %1 offset:%2" : "=&v"(dst) : "v"(vb0), "i"(off) : "memory")
#define PV_D0(d0) do { s16x4 l0, l1, l2, l3, h0, h1, h2, h3; constexpr int b_ = v_rd_off(d0, 0, 0); \
        TRRD(l0, b_); TRRD(h0, b_ + 2048); TRRD(l1, b_ + 4096); TRRD(h1, b_ + 6144); TRRD(l2, b_ + 8192); TRRD(h2, b_ + 10240); TRRD(l3, b_ + 12288); TRRD(h3, b_ + 14336); \
        asm volatile("s_waitcnt lgkmcnt(0)" ::: "memory"); SBAR(); \
        o[d0] = __builtin_amdgcn_mfma_f32_32x32x16_bf16(pa0, (bf16x8){l0[0], l0[1], l0[2], l0[3], h0[0], h0[1], h0[2], h0[3]}, o[d0], 0, 0, 0); \
        o[d0] = __builtin_amdgcn_mfma_f32_32x32x16_bf16(pa1, (bf16x8){l1[0], l1[1], l1[2], l1[3], h1[0], h1[1], h1[2], h1[3]}, o[d0], 0, 0, 0); \
        o[d0] = __builtin_amdgcn_mfma_f32_32x32x16_bf16(pa2, (bf16x8){l2[0], l2[1], l2[2], l2[3], h2[0], h2[1], h2[2], h2[3]}, o[d0], 0, 0, 0); \
        o[d0] = __builtin_amdgcn_mfma_f32_32x32x16_bf16(pa3, (bf16x8){l3[0], l3[1], l3[2], l3[3], h3[0], h3[1], h3[2], h3[3]}, o[d0], 0, 0, 0); } while (0)
    PV_D0(0); PV_D0(1); PV_D0(2); PV_D0(3);
#undef PV_D0
#undef TRRD
}

#define TILEP(p, k0) ((const char*)((p) + (size_t)(k0) * PITCH))
#define VMW() asm volatile("s_waitcnt vmcnt(0)" ::: "memory")
#define VMWN(n) asm volatile("s_waitcnt vmcnt(%0)" :: "i"(n) : "memory")
#define LD8(p) (*reinterpret_cast<const bf16x8*>(p))
#define LD8O(base, off) (*reinterpret_cast<const bf16x8*>((base) + (off)))
#if PROBE_MEM2 == 1
#define DUMV cur.dum
#define SLOAD_DUM(vt_, kt_) do { LAS unsigned* dl_ = (LAS unsigned*)(lds + 114688 + wid * 1024); \
        __builtin_amdgcn_global_load_lds((const unsigned*)(vt_ + DUMV + roff0), dl_, 16, 0, 0); __builtin_amdgcn_global_load_lds((const unsigned*)(vt_ + DUMV + roff1), dl_, 16, 0, 0); \
        __builtin_amdgcn_global_load_lds((const unsigned*)(kt_ + DUMV + roff0), dl_, 16, 0, 0); __builtin_amdgcn_global_load_lds((const unsigned*)(kt_ + DUMV + roff1), dl_, 16, 0, 0); } while (0)
#define SLOAD_DUMN(vt_, kt_) do { LAS unsigned* dl_ = (LAS unsigned*)(lds + 114688 + wid * 1024); \
        __builtin_amdgcn_global_load_lds((const unsigned*)(vt_ + dumn_ + roff0), dl_, 16, 0, 0); __builtin_amdgcn_global_load_lds((const unsigned*)(vt_ + dumn_ + roff1), dl_, 16, 0, 0); \
        __builtin_amdgcn_global_load_lds((const unsigned*)(kt_ + dumn_ + roff0), dl_, 16, 0, 0); __builtin_amdgcn_global_load_lds((const unsigned*)(kt_ + dumn_ + roff1), dl_, 16, 0, 0); } while (0)
#else
#define SLOAD_DUM(vt_, kt_) do { } while (0)
#define SLOAD_DUMN(vt_, kt_) do { } while (0)
#endif
#define SLOAD_HN(Kp, Vp, k0) do { const char* vt_ = TILEP(Vp, k0); const char* kt_ = TILEP(Kp, k0); S.st_v0 = LD8O(vt_, roff0); S.st_v1 = LD8O(vt_, roff1); S.st_k0 = LD8O(kt_, roff0); S.st_k1 = LD8O(kt_, roff1); SLOAD_DUMN(vt_, kt_); } while (0)
#if PROBE_MEM2 == 2
#define SLOAD_H(Kp, Vp, k0) do { const char* vt_ = TILEP(Vp, k0); const char* kt_ = TILEP(Kp, k0); S.st_v0 = LD8O(vt_, roff0); S.st_v1 = LD8O(vt_, roff1); S.st_k0 = LD8O(kt_, roff0); S.st_k1 = LD8O(kt_, roff1); \
        { const int kp_ = min((k0) + PFD * KVBLK, kmax_); const char* vp_ = TILEP(Vp, kp_); const char* kq_ = TILEP(Kp, kp_); LAS unsigned* dl_ = (LAS unsigned*)(lds + 114688 + wid * 1024); \
          __builtin_amdgcn_global_load_lds((const unsigned*)(vp_ + roff0), dl_, 16, 0, 0); __builtin_amdgcn_global_load_lds((const unsigned*)(vp_ + roff1), dl_, 16, 0, 0); \
          __builtin_amdgcn_global_load_lds((const unsigned*)(kq_ + roff0), dl_, 16, 0, 0); __builtin_amdgcn_global_load_lds((const unsigned*)(kq_ + roff1), dl_, 16, 0, 0); } } while (0)
#else
#define SLOAD_H(Kp, Vp, k0) do { const char* vt_ = TILEP(Vp, k0); const char* kt_ = TILEP(Kp, k0); S.st_v0 = LD8O(vt_, roff0); S.st_v1 = LD8O(vt_, roff1); S.st_k0 = LD8O(kt_, roff0); S.st_k1 = LD8O(kt_, roff1); SLOAD_DUM(vt_, kt_); } while (0)
#endif
#define SWRITE_HK(so) do { *(LAS bf16x8*)(K_lds + (so) + kws) = S.st_k0; *(LAS bf16x8*)(K_lds + (so) + kws + 32 * 256) = S.st_k1; } while (0)
#define SWRITE_HV(so) do { *(LAS bf16x8*)(V_lds + (so) + vst0) = S.st_v0; *(LAS bf16x8*)(V_lds + (so) + vst1) = S.st_v1; } while (0)
#define SWRITE_H(so) do { SWRITE_HV(so); SWRITE_HK(so); } while (0)

__device__ __forceinline__ void prime(const Unit& cur, LAS char* lds, Seam& S, int wave_) {
    int z_ = 0; asm volatile("" : "+v"(z_)); const int tid = wave_ * 64 + (int)__builtin_amdgcn_mbcnt_hi(~0u, __builtin_amdgcn_mbcnt_lo(~0u, (unsigned)z_));
    const int wid = __builtin_amdgcn_readfirstlane(tid >> 6), lane = tid & 63, r32 = lane & 31, hi = lane >> 5;
    const int sr = tid >> 4, sc = (tid & 15) * 8, kws = KSWZ(sr, sc * 2); LAS char* K_lds = lds + OFF_K;
    const unsigned roff0 = (unsigned)(sr * PITCH + sc) * 2u, roff1 = roff0 + 32u * PITCH * 2u, qoff = (unsigned)(r32 * PITCH + hi * 8) * 2u;
    { const char* qb_ = (const char*)(cur.Q + (size_t)(wid * QBLK) * PITCH);
#pragma unroll
    for (int d0 = 0; d0 < 8; ++d0) S.qr[d0] = LD8O(qb_, qoff + d0 * 32); }
    const int kmax_ = (4 * (cur.qb + 1) - 1) * KVBLK; (void)kmax_;
    SLOAD_H(cur.K, cur.V, cur.jlo * KVBLK); VMW(); SWRITE_HK(0);
    __syncthreads();
}
__device__ __forceinline__ void block(const Unit& cur, Unit& nxt, bool& more, const Queue& Qd, float slope2, float M2, LAS char* lds, Seam& S, int wave_, unsigned long long& pacc) {
#define PS0(k) unsigned long long pt##k##_ = 0; if (PROBE_SEC == (k)) pt##k##_ = __builtin_amdgcn_s_memtime()
#define PS1(k) do { if (PROBE_SEC == (k)) pacc += __builtin_amdgcn_s_memtime() - pt##k##_; } while (0)
    PS0(6); PS0(4);
    int z_ = 0; asm volatile("" : "+v"(z_)); const int tid = wave_ * 64 + (int)__builtin_amdgcn_mbcnt_hi(~0u, __builtin_amdgcn_mbcnt_lo(~0u, (unsigned)z_));
    const int wid = __builtin_amdgcn_readfirstlane(tid >> 6), lane = tid & 63, r32 = lane & 31, hi = lane >> 5;
    const unsigned roff0 = (unsigned)((tid >> 4) * PITCH + (tid & 15) * 8) * 2u, roff1 = roff0 + 32u * PITCH * 2u, qoff = (unsigned)(r32 * PITCH + hi * 8) * 2u;
    const int jlo = cur.jlo, NT = 4 * (cur.qb + 1) - jlo;
    LAS char* V_lds = lds + OFF_V; LAS char* K_lds = lds + OFF_K;
    LAS float* li_l = (LAS float*)(lds + OFF_WS) + wid * 64;
    float l_reg = 0; f32x16 o[4] = {};
    const int sr = tid >> 4, sc = (tid & 15) * 8, vst0 = v_st(sr, sc), vst1 = v_st(32 + sr, sc), kws = KSWZ(sr, sc * 2);
    const int vb0 = (int)(unsigned)(size_t)V_lds + v_rd_base(lane);
    const bf16* Kh = cur.K; const bf16* Vh = cur.V; const int kmax_ = (4 * (cur.qb + 1) - 1) * KVBLK; (void)kmax_;
    const int tq = cur.qb * QB + wid * QBLK + r32;
    {
        const int n = sr & 15; const float* kp = cur.KM + n * HD + sc;
        const f32x4 a = *(const f32x4*)kp, b = *(const f32x4*)(kp + 4);
        float v[8] = {a.x, a.y, a.z, a.w, b.x, b.y, b.z, b.w}; unsigned w[4];
#pragma unroll
        for (int e = 0; e < 4; ++e) { const unsigned h0 = f2bf(v[2 * e]), h1 = f2bf(v[2 * e + 1]);
            if (sr < 16) w[e] = h0 | (h1 << 16); else w[e] = pk2(v[2 * e] - bflo(h0), v[2 * e + 1] - bflo(h1)); }
        *(LAS u32x4*)(lds + OFF_KM + KSWZ(sr, sc * 2)) = (u32x4){w[0], w[1], w[2], w[3]};
    }
    if (tid == 0) *(LAS unsigned*)(lds + OFF_TK) = __hip_atomic_fetch_add(Qd.ctr, 1u, __ATOMIC_RELAXED, __HIP_MEMORY_SCOPE_AGENT);
    __syncthreads();
    { const unsigned tnext = (unsigned)__builtin_amdgcn_readfirstlane((int)*(const LAS unsigned*)(lds + OFF_TK));
      more = unit_from_ticket(tnext, Qd, lds, nxt); if (!more) nxt = cur; }
    unsigned selmask = 0;
    {
        f32x16 pg = f32x16{};
#pragma unroll
        for (int d0 = 0; d0 < 8; ++d0) { const bf16x8 a = *reinterpret_cast<const LAS bf16x8*>(lds + OFF_KM + KSWZ(r32, (d0 * 16 + hi * 8) * 2));
            pg = __builtin_amdgcn_mfma_f32_32x32x16_bf16(a, S.qr[d0], pg, 0, 0, 0); }
        float g[16];
#pragma unroll
        for (int j = 0; j < 8; ++j) { const float mine = pg[j] + pg[j + 8], oth = __shfl_xor(mine, 32); const int n0 = (j & 3) + 8 * (j >> 2);
            g[n0] = hi ? oth : mine; g[n0 + 4] = hi ? mine : oth; }
        float v0 = -__builtin_inff(), v1 = v0, v2 = v0; int i0 = 0, i1 = 0, i2 = 0;
#pragma unroll
        for (int n = 0; n < 16; ++n) { const float gt = n < cur.qb ? g[n] : -__builtin_inff();
            if (gt > v0) { v2 = v1; i2 = i1; v1 = v0; i1 = i0; v0 = gt; i0 = n; }
            else if (gt > v1) { v2 = v1; i2 = i1; v1 = gt; i1 = n; }
            else if (gt > v2) { v2 = gt; i2 = n; } }
        if (v0 > -__builtin_inff()) selmask |= 1u << i0;
        if (v1 > -__builtin_inff()) selmask |= 1u << i1;
        if (v2 > -__builtin_inff()) selmask |= 1u << i2;
    }
    const float basec = -M2 + slope2 * (float)(4 * hi - tq);
    const int ownt = 4 * cur.qb - jlo;
#define KBASE(t) ((jlo + (t)) * KVBLK)
#define TBASE(t) (((t) >= ownt || ((selmask >> ((jlo + (t)) >> 2)) & 1u)) ? fmaf(slope2, (float)KBASE(t), basec) : -__builtin_inff())
#define MASKT(P0_, P1_, t) do { if ((t) >= ownt && KBASE(t) + KVBLK - 1 > cur.qb * QB + wid * QBLK) mask_tile(P0_, P1_, tq - 4 * hi - KBASE(t)); } while (0)
    f32x16 pA0, pA1, pB0, pB1; bf16x8 pa0, pa1, pa2, pa3;
    const LAS char* kbase[4];
#pragma unroll
    for (int dd = 0; dd < 4; ++dd) kbase[dd] = K_lds + KSWZ(r32, (dd * 16 + hi * 8) * 2);
    SWRITE_HV(0); SBAR();
    SLOAD_H(Kh, Vh, KBASE(1));
    SBAR(); qkt(pA0, pA1, kbase, 0, S.qr);
    MASKT(pA0, pA1, 0); partialSM(pA0, pA1, TBASE(0), slope2);
    VMW(); SWRITE_H(SHM_K); SBAR(); SLOAD_H(Kh, Vh, KBASE(2));
    __syncthreads();
    int sp = 0, scur = SHM_K, sn = 2 * SHM_K;
    bf16x8 kf0[2], kf1[2]; s16x4 vA[8], vB[8]; float psa, psb; unsigned ra0_, ra1_;
#define KRD(d0_, s_) do { const LAS char* a_ = kbase[(d0_) & 3] + scur + ((d0_) >> 2) * 128; kf0[s_] = *reinterpret_cast<const LAS bf16x8*>(a_); kf1[s_] = *reinterpret_cast<const LAS bf16x8*>(a_ + 32 * 256); } while (0)
#define TRRD2(dst, off) asm volatile("ds_read_b64_tr_b16 %0, %1 offset:%2" : "=&v"(dst) : "v"(vaddr_), "i"(off) : "memory")
#define FINC(k, Y0, Y1) do { \
        if ((k) < 8) { Y1[2 * ((k) & 7)] = __builtin_amdgcn_exp2f(Y1[2 * ((k) & 7)]); Y1[2 * ((k) & 7) + 1] = __builtin_amdgcn_exp2f(Y1[2 * ((k) & 7) + 1]); \
            if ((k) == 0) { psa = Y0[0]; psb = Y0[1]; } else { psa += Y0[2 * ((k) & 7)]; psb += Y0[2 * ((k) & 7) + 1]; } } \
        else { constexpr int j_ = (k) & 7, m_ = j_ >> 1, b_ = (m_ & 1) * 8; psa += Y1[2 * j_]; psb += Y1[2 * j_ + 1]; \
            if ((j_ & 1) == 0) { const unsigned a0_ = m_ < 2 ? cvtpk(Y0[b_], Y0[b_ + 1]) : cvtpk(Y1[b_], Y1[b_ + 1]), b0_ = m_ < 2 ? cvtpk(Y0[b_ + 4], Y0[b_ + 5]) : cvtpk(Y1[b_ + 4], Y1[b_ + 5]); \
                auto r_ = __builtin_amdgcn_permlane32_swap(a0_, b0_, false, false); ra0_ = r_[0]; ra1_ = r_[1]; } \
            else { const unsigned a1_ = m_ < 2 ? cvtpk(Y0[b_ + 2], Y0[b_ + 3]) : cvtpk(Y1[b_ + 2], Y1[b_ + 3]), b1_ = m_ < 2 ? cvtpk(Y0[b_ + 6], Y0[b_ + 7]) : cvtpk(Y1[b_ + 6], Y1[b_ + 7]); \
                auto r_ = __builtin_amdgcn_permlane32_swap(a1_, b1_, false, false); u32x4 w_ = {ra0_, r_[0], ra1_, r_[1]}; \
                if (m_ == 0) pa0 = *reinterpret_cast<bf16x8*>(&w_); else if (m_ == 1) pa1 = *reinterpret_cast<bf16x8*>(&w_); else if (m_ == 2) pa2 = *reinterpret_cast<bf16x8*>(&w_); else pa3 = *reinterpret_cast<bf16x8*>(&w_); } } \
        if ((k) >= 12) { constexpr int f_ = 2 * ((k) - 12), o_ = v_rd_off(0, 0, 0) + 2048 * f_; TRRD2(vA[f_ & 7], o_ & 0xffff); TRRD2(vA[(f_ + 1) & 7], (o_ + 2048) & 0xffff); } } while (0)
#define QKG(d0, PX0, PX1, PY0, PY1) do { \
        if ((d0) < 7) KRD(((d0) + 1) & 7, ((d0) + 1) & 1); \
        SBAR(); \
        PX0 = __builtin_amdgcn_mfma_f32_32x32x16_bf16(kf0[(d0) & 1], S.qr[d0], (d0) == 0 ? f32x16{} : PX0, 0, 0, 0); \
        SBAR(); FINC(2 * (d0), PY0, PY1); SBAR(); \
        PX1 = __builtin_amdgcn_mfma_f32_32x32x16_bf16(kf1[(d0) & 1], S.qr[d0], (d0) == 0 ? f32x16{} : PX1, 0, 0, 0); \
        SBAR(); FINC(2 * (d0) + 1, PY0, PY1); SBAR(); } while (0)
#define SMC(k, X0, X1) do { constexpr float c_ = (float)(((k) & 3) + 8 * ((k) >> 2)); \
        X0[k] = __builtin_amdgcn_exp2f(fmaf(X0[k], LOG2E * SCALE, fmaf(slope2, c_, tb_))); X1[k] = fmaf(X1[k], LOG2E * SCALE, fmaf(slope2, c_ + 32.f, tb_)); asm volatile("" :: "v"(X1[k])); } while (0)
#define FRV(A, j) (bf16x8){A[2 * (j)][0], A[2 * (j)][1], A[2 * (j)][2], A[2 * (j)][3], A[2 * (j) + 1][0], A[2 * (j) + 1][1], A[2 * (j) + 1][2], A[2 * (j) + 1][3]}
#define PVG(d0, CUR, NXT, X0, X1) do { constexpr int n_ = v_rd_off(((d0) + 1) & 3, 0, 0); \
        asm volatile("s_waitcnt lgkmcnt(0)" ::: "memory"); SBAR(); \
        o[d0] = __builtin_amdgcn_mfma_f32_32x32x16_bf16(pa0, FRV(CUR, 0), o[d0], 0, 0, 0); SBAR(); \
        if ((d0) < 3) { TRRD2(NXT[0], n_); TRRD2(NXT[1], n_ + 2048); TRRD2(NXT[2], n_ + 4096); TRRD2(NXT[3], n_ + 6144); } SMC(4 * (d0) + 0, X0, X1); SBAR(); \
        o[d0] = __builtin_amdgcn_mfma_f32_32x32x16_bf16(pa1, FRV(CUR, 1), o[d0], 0, 0, 0); SBAR(); \
        if ((d0) < 3) { TRRD2(NXT[4], n_ + 8192); TRRD2(NXT[5], n_ + 10240); TRRD2(NXT[6], n_ + 12288); TRRD2(NXT[7], n_ + 14336); } SMC(4 * (d0) + 1, X0, X1); SBAR(); \
        o[d0] = __builtin_amdgcn_mfma_f32_32x32x16_bf16(pa2, FRV(CUR, 2), o[d0], 0, 0, 0); SBAR(); SMC(4 * (d0) + 2, X0, X1); SBAR(); \
        o[d0] = __builtin_amdgcn_mfma_f32_32x32x16_bf16(pa3, FRV(CUR, 3), o[d0], 0, 0, 0); SBAR(); SMC(4 * (d0) + 3, X0, X1); SBAR(); } while (0)
#define STEP(PX0, PX1, PY0, PY1, t, LAST) do { \
        PS0(0); KRD(0, 0); const float tb_ = TBASE(t); const int vaddr_ = vb0 + sp; \
        if (!(LAST)) { VMW(); SWRITE_H(sn); SBAR(); if ((t) + 2 < NT) SLOAD_H(Kh, Vh, KBASE((t) + 2)); } \
        PS1(0); PS0(1); QKG(0, PX0, PX1, PY0, PY1); QKG(1, PX0, PX1, PY0, PY1); QKG(2, PX0, PX1, PY0, PY1); QKG(3, PX0, PX1, PY0, PY1); \
        QKG(4, PX0, PX1, PY0, PY1); QKG(5, PX0, PX1, PY0, PY1); QKG(6, PX0, PX1, PY0, PY1); QKG(7, PX0, PX1, PY0, PY1); \
        { float ps_ = psa + psb; auto rr_ = __builtin_amdgcn_permlane32_swap(__float_as_uint(ps_), __float_as_uint(ps_), false, false); l_reg += __uint_as_float(rr_[0]) + __uint_as_float(rr_[1]); } \
        asm volatile("" : "+v"(pa0), "+v"(pa1), "+v"(pa2), "+v"(pa3), "+v"(l_reg)); PS1(1); PS0(2); \
        if (LAST) { SBAR(); const char* nq_ = (const char*)(nxt.Q + (size_t)(wid * QBLK) * PITCH); \
            _Pragma("unroll") for (int d0 = 0; d0 < 8; ++d0) S.qr[d0] = LD8O(nq_, qoff + d0 * 32); SBAR(); \
            { const long dumn_ = PROBE_MEM2 == 1 ? nxt.dumv() : 0; (void)dumn_; SLOAD_HN(nxt.K, nxt.V, nxt.jlo * KVBLK); } SBAR(); }                   \
        MASKT(PX0, PX1, (t)); \
        PVG(0, vA, vB, PX0, PX1); PVG(1, vB, vA, PX0, PX1); PVG(2, vA, vB, PX0, PX1); PVG(3, vB, vA, PX0, PX1); \
        asm volatile("" : "+v"(PX0), "+v"(PX1)); PS1(2); PS0(3); \
        __syncthreads(); PS1(3); \
        { const int r_ = sp; sp = scur; scur = sn; sn = r_; } } while (0)
    PS1(4);
    int t = 1;
    for (; t + 1 < NT; t += 2) { STEP(pB0, pB1, pA0, pA1, t, false); STEP(pA0, pA1, pB0, pB1, t + 1, false); }
    STEP(pB0, pB1, pA0, pA1, t, true);
#undef STEP
#undef PVG
#undef FRV
#undef SMC
#undef QKG
#undef FINC
#undef TRRD2
#undef KRD
    PS0(5);
    finishSM(pB0, pB1, l_reg, pa0, pa1, pa2, pa3); SBAR();
    pv_tile(o, vb0 + sp, pa0, pa1, pa2, pa3);
    SBAR(); VMW(); SWRITE_HK(0); SBAR();
    if (hi == 0) li_l[r32] = l_reg;
    char* Ow = (char*)(const_cast<bf16*>(cur.Q) + (size_t)(wid * QBLK) * PITCH);
    const char* Gw = Ow + (C_G - C_Q) * 2;
    u32x4 gv[8];
#pragma unroll
    for (int i = 0; i < 8; ++i) { const int j = (i & 1) * 64 + lane; gv[i] = *(const u32x4*)(Gw + (unsigned)((j >> 2) * PITCH + (i >> 1) * 32 + (j & 3) * 8) * 2u); }
    asm volatile("s_waitcnt lgkmcnt(0)" ::: "memory");
    float rl[16];
#pragma unroll
    for (int r = 0; r < 16; ++r) rl[r] = __builtin_amdgcn_rcpf(li_l[crow(r, hi)]);
    LAS float* stg = (LAS float*)(lds + OFF_K + SHM_K + wid * 4096);
#pragma unroll
    for (int d0 = 0; d0 < 4; ++d0) {
#pragma unroll
        for (int r = 0; r < 16; ++r) stg[crow(r, hi) * 32 + r32] = o[d0][r] * rl[r];
#pragma unroll
        for (int k = 0; k < 2; ++k) { const int j = k * 64 + lane, row = j >> 2, cq = j & 3;
            const f32x4 a = *(const LAS f32x4*)(stg + row * 32 + cq * 8), b = *(const LAS f32x4*)(stg + row * 32 + cq * 8 + 4);
            const u32x4 g = gv[d0 * 2 + k]; u32x4 w;
            w.x = cvtpk(a[0] * bflo(g.x & 0xffffu), a[1] * __uint_as_float(g.x & 0xffff0000u)); w.y = cvtpk(a[2] * bflo(g.y & 0xffffu), a[3] * __uint_as_float(g.y & 0xffff0000u));
            w.z = cvtpk(b[0] * bflo(g.z & 0xffffu), b[1] * __uint_as_float(g.z & 0xffff0000u)); w.w = cvtpk(b[2] * bflo(g.w & 0xffffu), b[3] * __uint_as_float(g.w & 0xffff0000u));
            *(u32x4*)(Ow + (unsigned)(row * PITCH + d0 * 32 + cq * 8) * 2u) = w; }
    }
    __syncthreads();
    PS1(5); PS1(6);
#undef PS0
#undef PS1
#undef KBASE
#undef TBASE
#undef MASKT
#undef HALF_STEP
}
#undef TILEP
#undef LD8O
#undef VMW
#undef VMWN
#undef LD8
#undef SLOAD_H
#undef SWRITE_HK
#undef SWRITE_HV
#undef SWRITE_H
#undef KSWZ
#undef SBAR
}

__device__ __forceinline__ int attn_window(float slope2, float M2) {
    int w = 0;
#pragma unroll 1
    for (int j = 0; j < 15; ++j) if (slope2 * (float)(256 * j + 1) < 2.f * M2 + 48.f) w = j + 1;
    return w;
}
__device__ __forceinline__ void attn_phase(Frame& F, int layer) {
    unsigned long long pt7_ = 0; if (PROBE_SEC == 7) pt7_ = __builtin_amdgcn_s_memtime();
    bf16* const PROJ = WSP(bf16, WS_PROJ); const float* const KM = WSP(float, WS_KM);
    const float* qw = in_ptr(3) + layer * HD; const float* kw = in_ptr(4) + layer * HD;
    const float mq = wave_max(fmaxf(fabsf(qw[2 * F.lane]), fabsf(qw[2 * F.lane + 1]))), mk = wave_max(fmaxf(fabsf(kw[2 * F.lane]), fabsf(kw[2 * F.lane + 1])));
    float m2v_ = 11.313708499f * mq * mk * 1.02f * moba::LOG2E; asm volatile("" : "+v"(m2v_));
    const float M2 = __uint_as_float((unsigned)__builtin_amdgcn_readfirstlane((int)__float_as_uint(m2v_)));
    LAS char* lds = (LAS char*)(F.lds + RING_OFF);
    {
        LAS int* const WT = (LAS int*)(lds + moba::OFF_WT); LAS int* const CNT = WT + 8;
        if (F.tid < 8) WT[F.tid] = attn_window(exp2f(-(float)(F.tid + 1)) * moba::LOG2E, M2);
        __syncthreads();
        int W[8];
        { const v4u w0 = *(const LAS v4u*)WT, w1 = *(const LAS v4u*)(WT + 4); W[0] = (int)w0.x; W[1] = (int)w0.y; W[2] = (int)w0.z; W[3] = (int)w0.w; W[4] = (int)w1.x; W[5] = (int)w1.y; W[6] = (int)w1.z; W[7] = (int)w1.w; }
#define NCOST(c, hh) (((c) - 1 < W[hh]) ? 1 : (((c) - 1 == W[hh]) ? 16 - W[hh] : 0))
        if (F.tid < 17) { int n = 0;
#pragma unroll
            for (int hh = 0; hh < 8; ++hh) n += NCOST(F.tid, hh);
            CNT[F.tid] = F.tid == 0 ? 0 : n; }
        __syncthreads();
#pragma unroll 1
        for (int u = F.tid; u < BATCH * NH * NBLK; u += NWAVES * 64) {
            const int b = u >> 7, h = (u >> 4) & 7, qb = u & 15;
            int wh = 0;
#pragma unroll
            for (int hh = 0; hh < 8; ++hh) wh = (h == hh) ? W[hh] : wh;
            const int c = (qb < wh ? qb : wh) + 1;
            int above = 0;
#pragma unroll
            for (int cc = 2; cc <= 16; ++cc) above += (cc > c) ? CNT[cc] : 0;
            int nbefore = 0;
#pragma unroll
            for (int hh = 0; hh < 8; ++hh) nbefore += (hh < h) ? NCOST(c, hh) : 0;
            const int pos = BATCH * above + b * CNT[c] + nbefore + ((c - 1 == wh) ? qb - wh : 0);
            ((LAS unsigned short*)(lds + moba::OFF_ORD))[pos] = (unsigned short)u;
        }
#undef NCOST
    }
    moba::Queue Qd{WSP(unsigned, WS_CTL) + CW_AQ + 64 * layer, PROJ, KM};
    if (F.tid == 0) *(LAS unsigned*)(lds + moba::OFF_TK) = __hip_atomic_fetch_add(Qd.ctr, 1u, __ATOMIC_RELAXED, __HIP_MEMORY_SCOPE_AGENT);
    __syncthreads();
    moba::Unit cur, nxt; moba::Seam S;
    { const unsigned t0 = (unsigned)__builtin_amdgcn_readfirstlane((int)*(const LAS unsigned*)(lds + moba::OFF_TK));
      if (!moba::unit_from_ticket(t0, Qd, lds, cur)) return; }
    __syncthreads();
    moba::prime(cur, lds, S, F.wave);
    if (ATT_PRIO && F.wave >= 4) __builtin_amdgcn_s_setprio(1);
    unsigned long long pacc = 0; if (PROBE_SEC == 7) pacc = __builtin_amdgcn_s_memtime() - pt7_;
    for (;;) {
        bool more;
        const float slope2 = exp2f(-(float)(cur.h + 1)) * moba::LOG2E;
        moba::block(cur, nxt, more, Qd, slope2, M2, lds, S, F.wave, pacc);
        if (!more) break;
        cur = nxt;
    }
    if (ATT_PRIO) __builtin_amdgcn_s_setprio(0);
    if (PROBE_SEC >= 0) { const unsigned long long t0 = __builtin_amdgcn_s_memtime(); while (__builtin_amdgcn_s_memtime() - t0 < pacc) __builtin_amdgcn_s_sleep(8); }
}

__global__ void __launch_bounds__(NWAVES * 64, 2) mk_fwd(Args args) {
    extern __shared__ __attribute__((aligned(16))) unsigned char lds[];
    Frame F;
    F.lds = (LAS unsigned char*)lds;
    F.MISC = (volatile LAS unsigned*)(F.lds + MISC_OFF);
    F.tid = threadIdx.x; F.lane = F.tid & 63; F.wave = __builtin_amdgcn_readfirstlane(F.tid >> 6);
    F.G = gridDim.x; { const int bx = blockIdx.x; F.vcu = (F.G % 8 == 0) ? (bx % 8) * (F.G / 8) + bx / 8 : bx; }
    for (int u = F.tid; u < (LDS_BYTES - LDSCTL_OFF) / 4; u += NWAVES * 64) ((LAS unsigned*)(F.lds + LDSCTL_OFF))[u] = 0u;
    __syncthreads();
    XcdBarrier bar; bar.bar = nullptr; bar.x = 0; bar.st = nullptr;
    if (N_LAUNCHES == 1) bar = xcd_barrier_post(WSP(unsigned, WS_CTL) + CW_BAR, F.MISC + 8);
    const int lo = args.ph_lo, hi = args.ph_hi;
#define IN(k) (lo <= (k) && (k) < hi)
#define REFRESH() do { int z_ = 0; asm volatile("" : "+v"(z_)); asm volatile("" : "+s"(F.wave), "+s"(F.vcu), "+s"(F.G)); \
        F.lane = (int)__builtin_amdgcn_mbcnt_hi(~0u, __builtin_amdgcn_mbcnt_lo(~0u, (unsigned)z_)); F.tid = F.wave * 64 + F.lane; } while (0)
#define SEAM(k) do { if (IN(k) && IN((k) + 1)) { bar.bar = WSP(unsigned, WS_CTL) + CW_BAR; xcd_barrier(bar, F.wave); } } while (0)
#define PROBE_T0(ph) unsigned long long pt0_ = 0; if (PROBE_PH == (ph)) pt0_ = __builtin_amdgcn_s_memrealtime()
#define PROBE_T1(ph) do { if (PROBE_PH == (ph)) { const unsigned long long pt1_ = __builtin_amdgcn_s_memrealtime(); while (__builtin_amdgcn_s_memrealtime() - pt1_ < pt1_ - pt0_) __builtin_amdgcn_s_sleep(8); } } while (0)

#pragma unroll 1
    for (int layer = 0; layer < DEPTH; ++layer) {
        const int pb = layer * 6;
        { PROBE_T0(0); if (IN(pb + 0)) { REFRESH(); phase_a(F, layer); } SEAM(pb + 0); PROBE_T1(0); }
        { PROBE_T0(1); if (IN(pb + 1)) {
            REFRESH();
            pg8::Gemm g{WSP(bf16, WS_A), WSP(bf16, WS_WIN), M, PITCH, DM, DM}; pg8::StaticOrder S; S.init(M, PITCH, F.G, (int)blockIdx.x);
            if (F.tid < 256) ((LAS float*)(F.lds + RING_BYTES + 10240))[F.tid] = (F.tid < 128 ? in_ptr(3) + layer * HD : in_ptr(4) + layer * HD - 128)[F.tid];
            __syncthreads();
            pg8::EpiProj E{WSP(bf16, WS_PROJ), PITCH, in_ptr(3) + layer * HD, in_ptr(4) + layer * HD, WSP(float, WS_KM), F.lds + RING_BYTES, EPS, WSP(float, WS_RSTD)};
            static_assert(GEMM1_ALIGN, "EpiProj's in-epilogue barriers need both half-workgroups in the epilogue together");
            if (WOUT_IN_B && (F.vcu & 1)) {
                LAS float* scr = (LAS float*)(F.lds + RING_OFF + F.wave * 16384);
                const float* wout = in_ptr(11) + (size_t)layer * 2048 * DM; bf16* const WoutT = WSP(bf16, WS_WOUT);
                for (int it = (F.vcu >> 1) * NWAVES + F.wave; it < (2048 / 64) * (1024 / 32); it += (F.G >> 1) * NWAVES)
                    transpose_item(wout, DM, 2048, 1024, WoutT, 0, scr, it, F.lane, in_ptr(10) + (size_t)layer * 1024, 1024);
                __syncthreads();
            }
            if (PROBE_BSKEW > 0 && (F.vcu & (BSKEW_N - 1))) { const unsigned long long t0_ = __builtin_amdgcn_s_memrealtime(); while (__builtin_amdgcn_s_memrealtime() - t0_ < (unsigned long long)(PROBE_BSKEW * (F.vcu & (BSKEW_N - 1))) * 10) __builtin_amdgcn_s_sleep(8); }
            pg8::gemm_phase<pg8::EpiProj, pg8::StaticOrder, GEMM1_ALIGN, GEMM1_SP2>(F.lds + RING_OFF, g, S, E, F.tid);
        } SEAM(pb + 1); PROBE_T1(1); }
        { PROBE_T0(2); if (IN(pb + 2)) { REFRESH(); phase_c(F, layer); } SEAM(pb + 2); PROBE_T1(2); }
        { PROBE_T0(3); if (IN(pb + 3)) {
            { PROBE_T0(6); REFRESH(); ssd_phase(F, layer); __syncthreads(); PROBE_T1(6);
              if ((PROBE_SSDFIX > 0 && (F.vcu & 1) == 0) || (PROBE_SSDFIX < 0 && (F.vcu & 1) == 1)) { const unsigned long long t0_ = __builtin_amdgcn_s_memrealtime(); while (__builtin_amdgcn_s_memrealtime() - t0_ < (unsigned long long)(PROBE_SSDFIX < 0 ? -PROBE_SSDFIX : PROBE_SSDFIX) * 100) __builtin_amdgcn_s_sleep(8); } }
            { PROBE_T0(7); REFRESH(); attn_phase(F, layer); PROBE_T1(7); }
        } if (IN(pb + 3) && IN(pb + 5)) { bar.bar = WSP(unsigned, WS_CTL) + CW_BAR; xcd_barrier(bar, F.wave); } PROBE_T1(3); }
        { PROBE_T0(5); if (IN(pb + 5)) {
            REFRESH();
            float* const OUTP = out_ptr(); const float* base = layer == 0 ? in_ptr(0) : OUTP;
            pg8::Gemm g{WSP(bf16, WS_PROJ), WSP(bf16, WS_WOUT), M, DM, 2048, PITCH}; pg8::StaticOrder S; S.init(M, DM, F.G, (int)blockIdx.x);
            pg8::EpiResScale E{base, OUTP, DM, WSP(float, WS_SSQ), F.lds + RING_BYTES, EPS, layer == DEPTH - 1};
            if (PROBE_FSKEW > 0 && (F.vcu & 1)) { const unsigned long long t0_ = __builtin_amdgcn_s_memrealtime(); while (__builtin_amdgcn_s_memrealtime() - t0_ < (unsigned long long)PROBE_FSKEW * 100) __builtin_amdgcn_s_sleep(8); }
            pg8::gemm_phase<pg8::EpiResScale, pg8::StaticOrder, GEMM2_ALIGN, GEMM2_SP2>(F.lds + RING_OFF, g, S, E, F.tid);
        } SEAM(pb + 5); PROBE_T1(5); }
    }
#undef IN
#undef SEAM
}

extern "C" void kernel_launch(void* const* d_in, const int* in_sizes, int n_in, void* d_out, int out_size, void* d_ws, size_t ws_size, hipStream_t stream) {
    static int grid = 0;
    if (grid == 0) {
        if (n_in != 12 || in_sizes[0] != M * DM || out_size != M * DM || ws_size < WS_END) {
            fprintf(stderr, "kernel_launch: unexpected shapes (n_in %d, in0 %d, out %d, ws %zu); nothing launched\n", n_in, n_in > 0 ? in_sizes[0] : -1, out_size, ws_size); grid = -1; return; }
        int dev = 0, cus = 0, per_cu = 0;
        if (hipGetDevice(&dev) != hipSuccess || hipDeviceGetAttribute(&cus, hipDeviceAttributeMultiprocessorCount, dev) != hipSuccess) { grid = -1; return; }
        if (hipFuncSetAttribute((const void*)mk_fwd, hipFuncAttributeMaxDynamicSharedMemorySize, LDS_BYTES) != hipSuccess) { fprintf(stderr, "kernel_launch: hipFuncSetAttribute failed\n"); grid = -1; return; }
        if (hipOccupancyMaxActiveBlocksPerMultiprocessor(&per_cu, (const void*)mk_fwd, NWAVES * 64, LDS_BYTES) != hipSuccess || per_cu < 1) {
            fprintf(stderr, "kernel_launch: occupancy query reports %d workgroups per CU; nothing launched\n", per_cu); (void)hipGetLastError(); grid = -1; return; }
        grid = cus;
    }
    if (grid < 0) return;
    if (hipMemsetAsync((char*)d_ws + WS_CTL, 0, CTL_ZERO_BYTES, stream) != hipSuccess) { fprintf(stderr, "kernel_launch: hipMemsetAsync failed\n"); return; }
    Args a{};
    for (int i = 0; i < 12; ++i) a.in[i] = (const float*)d_in[i];
    a.out = (float*)d_out; a.ws = (unsigned char*)d_ws;
    for (int li = 0; li < N_LAUNCHES; ++li) {
        a.ph_lo = (N_LAUNCHES == 1) ? 0 : li; a.ph_hi = (N_LAUNCHES == 1) ? N_PHASES : li + 1; a.li = li;
        hipLaunchKernelGGL(mk_fwd, dim3(grid), dim3(NWAVES * 64), LDS_BYTES, stream, a);
        const hipError_t le = hipPeekAtLastError();
        if (le != hipSuccess) { fprintf(stderr, "kernel_launch: launch %d failed: %s\n", li, hipGetErrorName(le)); break; }
    }
}
```

```cpp
#include <hip/hip_runtime.h>
#include <cstdio>
#include <cstdint>
namespace pg8 {
#define PG8_LAS __attribute__((address_space(3)))
typedef unsigned short bf16_t;
typedef short bf16x8 __attribute__((ext_vector_type(8)));
typedef float f32x4 __attribute__((ext_vector_type(4)));
typedef unsigned u32x4 __attribute__((ext_vector_type(4)));
constexpr int BM = 256, BK = 64, HALF = 128, HTB = HALF * BK * 2  , STAGE_BYTES = 8 * HTB, NXCD = 8, WGM = 8;

__host__ __device__ __forceinline__ int lds_byte(int r, int c) { const int st = (r >> 4) * 2 + (c >> 5), rr = r & 15, cc = c & 31, ob = rr * 64 + cc * 2; return st * 1024 + (ob ^ (((ob >> 9) & 1) << 5)); }
__host__ __device__ __forceinline__ void stage_rc(int b, int& R, int& C) { const int st = b / 1024, sb = b % 1024, swz = sb ^ (((sb >> 9) & 1) << 5); R = (st >> 1) * 16 + swz / 64; C = (st & 1) * 32 + (swz % 64) / 2; }
__host__ __device__ __forceinline__ int perm32(int rho) { const int n = rho >> 4, i = rho & 15; return 8 * (i >> 2) + 4 * n + (i & 3); }

struct Unit { int pm, pn; };
struct Gemm { const bf16_t* A; const bf16_t* Bt; int M, N, K, lda; };

struct StaticOrder {
    int nM, nN, nwg, G, c;
    __host__ __device__ void init(int M, int N, int G_, int c_) { nM = M / BM; nN = N / BM; nwg = nM * nN; G = G_; c = c_; }
    __host__ __device__ bool next(int i, Unit& u) const {
        const long L = (long)i * G + c; if (L >= nwg) return false;
        int wgid = (int)L; { const int q = nwg / NXCD, r = nwg % NXCD, xcd = wgid % NXCD, off = wgid / NXCD; wgid = (xcd < r ? xcd * (q + 1) : r * (q + 1) + (xcd - r) * q) + off; }
        const int nig = WGM * nN, gid = wgid / nig, fm = gid * WGM, gsz = (nM - fm) < WGM ? (nM - fm) : WGM;
        u.pm = fm + ((wgid % nig) % gsz); u.pn = (wgid % nig) / gsz; return true;
    }
    __device__ __forceinline__ void a_ready(const Unit&) const {}
    __device__ __forceinline__ void done(const Unit&) const {}
};

__device__ __forceinline__ unsigned cvt_pk_bf16(float lo, float hi) { unsigned r; asm volatile("v_cvt_pk_bf16_f32 %0, %1, %2" : "=v"(r) : "v"(lo), "v"(hi)); return r; }
typedef float f32x2 __attribute__((ext_vector_type(2)));
__device__ __forceinline__ f32x2 gelu_pk(f32x2 v) {
    const f32x2 av = __builtin_elementwise_abs(v), d = av * 0.2316418882f + 1.0f;
    f32x2 t; t.x = __builtin_amdgcn_rcpf(d.x); t.y = __builtin_amdgcn_rcpf(d.y);
    f32x2 q = t * 0.5307027145f + (-0.7265760135f); q = q * t + 0.7107068705f; q = q * t + (-0.142248368f); q = q * t + 0.127414796f; q = q * t;
    const f32x2 s = (v * v) * (-0.72134752044f);
    f32x2 e; e.x = __builtin_amdgcn_exp2f(s.x); e.y = __builtin_amdgcn_exp2f(s.y);
    const f32x2 m = v * (q * e), r = v - m;
    f32x2 o; o.x = v.x < 0.f ? m.x : r.x; o.y = v.y < 0.f ? m.y : r.y; return o;
}

template <int ACT  > struct EpiBf16 {
    static constexpr bool PERM = true, AFTER_DRAIN = false; static_assert(ACT == 0 || ACT == 1, "EpiBf16: ACT is 0 (none) or 1 (gelu_pk)");
    bf16_t* O; int ldc; const float* bias; int split_cols; size_t split_stride; float scale0;
    __device__ __forceinline__ void operator()(const f32x4 (&acc)[2][2][4][2], const Unit& u, int wr, int wc, int fr, int fq) const {
        const int row0 = u.pm * BM + wr * 64 + fr; int colt = u.pn * BM; bf16_t* base = O;
        float sc = 1.f; if (split_cols) { const int t = colt / split_cols; base += (size_t)t * split_stride; colt -= t * split_cols; if (t == 0) sc = scale0; }
        const int col0 = colt + wc * 32 + 8 * fq, bcol0 = u.pn * BM + wc * 32 + 8 * fq;
        f32x4 bv[2][2];
#pragma unroll
        for (int bj = 0; bj < 2; ++bj)
#pragma unroll
            for (int n = 0; n < 2; ++n) bv[bj][n] = bias ? *(const f32x4*)(bias + bcol0 + bj * HALF + 4 * n) : (f32x4){0.f, 0.f, 0.f, 0.f};
#pragma unroll
        for (int ai = 0; ai < 2; ++ai)
#pragma unroll
            for (int m = 0; m < 4; ++m) { bf16_t* rowp = base + (size_t)(row0 + ai * HALF + m * 16) * ldc + col0;
#pragma unroll
                for (int bj = 0; bj < 2; ++bj) { f32x4 v0 = acc[ai][bj][m][0] + bv[bj][0], v1 = acc[ai][bj][m][1] + bv[bj][1];
                    if (ACT == 1) { f32x2 a = gelu_pk((f32x2){v0[0], v0[1]}), b = gelu_pk((f32x2){v0[2], v0[3]}), c = gelu_pk((f32x2){v1[0], v1[1]}), d = gelu_pk((f32x2){v1[2], v1[3]});
                        v0 = (f32x4){a.x, a.y, b.x, b.y}; v1 = (f32x4){c.x, c.y, d.x, d.y}; }
                    v0 = v0 * sc; v1 = v1 * sc; u32x4 w; w.x = cvt_pk_bf16(v0[0], v0[1]); w.y = cvt_pk_bf16(v0[2], v0[3]); w.z = cvt_pk_bf16(v1[0], v1[1]); w.w = cvt_pk_bf16(v1[2], v1[3]);
                    *(u32x4*)(rowp + bj * HALF) = w; } }
    }
};
template <class Epi, class Sched, bool ALIGN_EPI = false, bool SP2 = false>
__device__ __forceinline__ void gemm_phase(PG8_LAS unsigned char* lds, const Gemm g, const Sched& S, const Epi& E, int ptid_) {
    int tid_ = ptid_; asm volatile("" : "+v"(tid_));
    const int tid = tid_, wid = __builtin_amdgcn_readfirstlane(tid >> 6), lane = tid & 63, wr = wid >> 2, wc = wid & 3, fr = lane & 15, fq = lane >> 4;
    const int K = g.K, nt = K / BK;
    unsigned voffA[2], voffB[2];
#pragma unroll
    for (int i = 0; i < 2; ++i) { int R, C; stage_rc(tid * 16 + i * 8192, R, C); const int Rb = Epi::PERM ? ((R & ~31) + perm32(R & 31)) : R;
        voffA[i] = (unsigned)(R * g.lda + C) * 2u; voffB[i] = (unsigned)(Rb * K + C) * 2u; }
    const size_t kstep = (size_t)(BK * 2);
    const size_t hstep = (size_t)HALF * K * 2;
    const size_t tstep = 2 * hstep; const size_t hstepA = (size_t)HALF * g.lda * 2, tstepA = 2 * hstepA;
    const unsigned ldsw = (unsigned)wid * 1024u;
    const int aoff = lds_byte(wr * 64 + fr, fq * 8), boff = lds_byte(wc * 32 + fr, fq * 8);
#define PG8_SA(b, h) (((b) * 2 + (h)) * HTB)
#define PG8_SB(b, h) ((4 + (b) * 2 + (h)) * HTB)
#define PG8_STAGE(bufoff, gbase, voff) do { _Pragma("unroll") for (int _i = 0; _i < 2; ++_i) \
        __builtin_amdgcn_global_load_lds((const unsigned*)((const char*)(gbase) + (voff)[_i]), (PG8_LAS unsigned*)(lds + (bufoff) + ldsw + _i * 8192), 16, 0, 0); } while (0)
#define PG8_LDA(dst, b, h) do { _Pragma("unroll") for (int m = 0; m < 4; ++m) _Pragma("unroll") for (int k = 0; k < 2; ++k) dst[m][k] = *(const PG8_LAS bf16x8*)(lds + PG8_SA(b, h) + aoff + m * 2048 + k * 1024); } while (0)
#define PG8_LDB(dst, b, h) do { _Pragma("unroll") for (int n = 0; n < 2; ++n) _Pragma("unroll") for (int k = 0; k < 2; ++k) dst[n][k] = *(const PG8_LAS bf16x8*)(lds + PG8_SB(b, h) + boff + n * 2048 + k * 1024); } while (0)
#define PG8_MMA(ai, bj, At, Bt) do { __builtin_amdgcn_s_setprio(1); _Pragma("unroll") for (int m = 0; m < 4; ++m) _Pragma("unroll") for (int n = 0; n < 2; ++n) _Pragma("unroll") for (int k = 0; k < 2; ++k) \
        acc[ai][bj][m][n] = __builtin_amdgcn_mfma_f32_16x16x32_bf16(Bt[n][k], At[m][k], acc[ai][bj][m][n], 0, 0, 0); __builtin_amdgcn_s_setprio(0); } while (0)
#define PG8_WAIT_V(n) asm volatile("s_waitcnt vmcnt(" #n ")" ::: "memory")
#define PG8_WAIT_L(n) asm volatile("s_waitcnt lgkmcnt(" #n ")" ::: "memory")
#define PG8_BAR __builtin_amdgcn_s_barrier()
#define PG8_SCHED __builtin_amdgcn_sched_barrier(0)
    Unit cur, nxt; int ui = 0;
    if (!S.next(0, cur)) return;
    f32x4 acc[2][2][4][2];
#pragma unroll
    for (int a = 0; a < 2; ++a)
#pragma unroll
        for (int b = 0; b < 2; ++b)
#pragma unroll
            for (int m = 0; m < 4; ++m)
#pragma unroll
                for (int n = 0; n < 2; ++n) acc[a][b][m][n] = (f32x4){0.f, 0.f, 0.f, 0.f};
    bf16x8 At[4][2], B0[2][2], B1[2][2];
    const char* cA = (const char*)g.A + (size_t)cur.pm * tstepA; const char* cB = (const char*)g.Bt + (size_t)cur.pn * tstep;
    S.a_ready(cur);
    if constexpr (Epi::KHOOK) E.unit_begin(cur, ui, tid);
    if constexpr (SP2) {
        PG8_STAGE(PG8_SB(0, 0), cB, voffB); PG8_STAGE(PG8_SB(0, 1), cB + hstep, voffB); PG8_STAGE(PG8_SA(0, 0), cA, voffA); PG8_STAGE(PG8_SA(0, 1), cA + hstepA, voffA);
        if (wr == 1) PG8_BAR;
        PG8_WAIT_V(2); PG8_BAR;
        PG8_STAGE(PG8_SB(1, 0), cB + kstep, voffB); PG8_STAGE(PG8_SA(1, 0), cA + kstep, voffA); PG8_STAGE(PG8_SB(1, 1), cB + hstep + kstep, voffB);
        PG8_WAIT_V(6); PG8_BAR;
    } else {
        PG8_STAGE(PG8_SB(0, 0), cB, voffB); PG8_STAGE(PG8_SA(0, 0), cA, voffA); PG8_STAGE(PG8_SB(0, 1), cB + hstep, voffB); PG8_STAGE(PG8_SA(0, 1), cA + hstepA, voffA);
        if (wr == 1) PG8_BAR;
        PG8_WAIT_V(4); PG8_BAR;
        PG8_STAGE(PG8_SB(1, 0), cB + kstep, voffB); PG8_STAGE(PG8_SA(1, 0), cA + kstep, voffA); PG8_STAGE(PG8_SB(1, 1), cB + hstep + kstep, voffB);
        PG8_WAIT_V(6); PG8_BAR;
    }
    for (;;) {
        const bool has_next = S.next(ui + 1, nxt);
        const char* nA = has_next ? (const char*)g.A + (size_t)nxt.pm * tstepA : cA; const char* nB = has_next ? (const char*)g.Bt + (size_t)nxt.pn * tstep : cB;
        for (int t = 0; t < nt; t += 2) {
            if constexpr (Epi::KHOOK) { if (t == Epi::KH0 || t == Epi::KH1) E.khook(acc, t, ui, wr, fr); }
            const bool last = (t == nt - 2);
            const char* a1 = cA + (size_t)(t + 1) * kstep;
            const char* a2 = last ? nA : cA + (size_t)(t + 2) * kstep; const char* b2 = last ? nB : cB + (size_t)(t + 2) * kstep;
            const char* a3 = a2 + kstep; const char* b3 = b2 + kstep;
            if (last && has_next) S.a_ready(nxt);
            if constexpr (SP2) {
            PG8_LDB(B0, 0, 0); PG8_LDB(B1, 0, 1); PG8_SCHED; PG8_LDA(At, 0, 0); PG8_STAGE(PG8_SA(1, 1), a1 + hstepA, voffA);
            PG8_WAIT_V(8); PG8_WAIT_L(0); PG8_BAR; PG8_MMA(0, 0, At, B0); PG8_MMA(0, 1, At, B1); PG8_BAR; PG8_SCHED;
            PG8_LDA(At, 0, 1); PG8_STAGE(PG8_SB(0, 0), b2, voffB); PG8_STAGE(PG8_SB(0, 1), b2 + hstep, voffB); PG8_STAGE(PG8_SA(0, 0), a2, voffA);
            PG8_WAIT_V(8); PG8_WAIT_L(0); PG8_BAR; PG8_MMA(1, 0, At, B0); PG8_MMA(1, 1, At, B1); PG8_BAR; PG8_SCHED;
            PG8_LDB(B0, 1, 0); PG8_LDB(B1, 1, 1); PG8_SCHED; PG8_LDA(At, 1, 0); PG8_STAGE(PG8_SA(0, 1), a2 + hstepA, voffA);
            PG8_WAIT_V(8); PG8_WAIT_L(0); PG8_BAR; PG8_MMA(0, 0, At, B0); PG8_MMA(0, 1, At, B1); PG8_BAR; PG8_SCHED;
            PG8_LDA(At, 1, 1); PG8_STAGE(PG8_SB(1, 0), b3, voffB); PG8_STAGE(PG8_SB(1, 1), b3 + hstep, voffB); PG8_STAGE(PG8_SA(1, 0), a3, voffA);
            PG8_WAIT_V(8); PG8_WAIT_L(0); PG8_BAR; PG8_MMA(1, 0, At, B0); PG8_MMA(1, 1, At, B1); PG8_BAR; PG8_SCHED;
            } else {
            PG8_LDB(B0, 0, 0); PG8_SCHED; PG8_LDA(At, 0, 0); PG8_STAGE(PG8_SA(1, 1), a1 + hstepA, voffA);
            PG8_WAIT_L(8); PG8_BAR; PG8_WAIT_L(0); PG8_MMA(0, 0, At, B0); PG8_BAR; PG8_SCHED;
            PG8_LDB(B1, 0, 1); PG8_STAGE(PG8_SB(0, 0), b2, voffB);
            PG8_BAR; PG8_WAIT_L(0); PG8_MMA(0, 1, At, B1); PG8_BAR;
            PG8_LDA(At, 0, 1); PG8_STAGE(PG8_SA(0, 0), a2, voffA);
            PG8_BAR; PG8_WAIT_L(0); PG8_MMA(1, 0, At, B0); PG8_BAR; PG8_SCHED;
            PG8_STAGE(PG8_SB(0, 1), b2 + hstep, voffB);
            PG8_WAIT_V(6); PG8_BAR; PG8_MMA(1, 1, At, B1); PG8_BAR;
            PG8_LDB(B0, 1, 0); PG8_SCHED; PG8_LDA(At, 1, 0); PG8_STAGE(PG8_SA(0, 1), a2 + hstepA, voffA);
            PG8_WAIT_L(8); PG8_BAR; PG8_WAIT_L(0); PG8_MMA(0, 0, At, B0); PG8_BAR; PG8_SCHED;
            PG8_LDB(B1, 1, 1); PG8_STAGE(PG8_SB(1, 0), b3, voffB);
            PG8_BAR; PG8_WAIT_L(0); PG8_MMA(0, 1, At, B1); PG8_BAR;
            PG8_LDA(At, 1, 1); PG8_STAGE(PG8_SA(1, 0), a3, voffA);
            PG8_BAR; PG8_WAIT_L(0); PG8_MMA(1, 0, At, B0); PG8_BAR; PG8_SCHED;
            PG8_STAGE(PG8_SB(1, 1), b3 + hstep, voffB);
            PG8_WAIT_V(6); PG8_BAR; PG8_MMA(1, 1, At, B1); PG8_BAR;
            }
        }
        if constexpr (ALIGN_EPI) { if (wr == 0) PG8_BAR; }
        if constexpr (Epi::KHOOK) { E.epi(acc, cur, ui, wr, wc, fr, fq); S.done(cur); } else if constexpr (!Epi::AFTER_DRAIN) { E(acc, cur, wr, wc, fr, fq); S.done(cur); }
        if (!has_next) break;
#pragma unroll
        for (int a = 0; a < 2; ++a)
#pragma unroll
            for (int b = 0; b < 2; ++b)
#pragma unroll
                for (int m = 0; m < 4; ++m)
#pragma unroll
                    for (int n = 0; n < 2; ++n) acc[a][b][m][n] = (f32x4){0.f, 0.f, 0.f, 0.f};
        cur = nxt; cA = nA; cB = nB; ++ui;
        if constexpr (Epi::KHOOK) E.unit_begin(cur, ui, tid);
        if constexpr (ALIGN_EPI) { if (wr == 1) PG8_BAR; }
    }
    PG8_WAIT_V(0);
    if constexpr (!ALIGN_EPI) { if (wr == 0) PG8_BAR; }
    PG8_BAR;
    if constexpr (Epi::AFTER_DRAIN) { E.fused(acc, cur, wr, wc, fr, fq, lds, wid, lane); S.done(cur); }
#undef PG8_SA
#undef PG8_SB
#undef PG8_STAGE
#undef PG8_LDA
#undef PG8_LDB
#undef PG8_MMA
#undef PG8_WAIT_V
#undef PG8_WAIT_L
#undef PG8_BAR
#undef PG8_SCHED
}
}

namespace pg8 {
struct EpiResF32 {
    static constexpr bool PERM = false, AFTER_DRAIN = false, KHOOK = false;
    const float* base; float* out; int ldc;
    __device__ __forceinline__ void operator()(const f32x4 (&acc)[2][2][4][2], const Unit& u, int wr, int wc, int fr, int fq) const {
        const int col0 = u.pn * BM + wc * 32 + 4 * fq;
#pragma unroll
        for (int ai = 0; ai < 2; ++ai)
#pragma unroll
            for (int m = 0; m < 4; ++m) { const size_t off = (size_t)(u.pm * BM + ai * HALF + wr * 64 + m * 16 + fr) * ldc + col0;
#pragma unroll
                for (int bj = 0; bj < 2; ++bj)
#pragma unroll
                    for (int n = 0; n < 2; ++n) { const f32x4 bs = *(const f32x4*)(base + off + bj * HALF + n * 16); *(f32x4*)(out + off + bj * HALF + n * 16) = bs + acc[ai][bj][m][n]; } }
    }
};

struct EpiProj {
    static constexpr bool PERM = true, AFTER_DRAIN = false, KHOOK = true; static constexpr int KH0 = -1, KH1 = -1;
    bf16_t* O; int ldc; const float* qw; const float* kw; float* KM; PG8_LAS unsigned char* xlds; float eps; const float* RSTD;
    __device__ __forceinline__ PG8_LAS float* rtab(int ui) const { return (PG8_LAS float*)(xlds + 11264) + (ui & 1) * 256; }
    __device__ __forceinline__ void unit_begin(const Unit& u, int ui, int tid) const { if (tid < 256) rtab(ui)[tid] = RSTD[u.pm * BM + tid]; }
    __device__ __forceinline__ void khook(f32x4 (&)[2][2][4][2], int, int, int, int) const {}
    __device__ __forceinline__ void bar() const { asm volatile("s_waitcnt lgkmcnt(0)" ::: "memory"); __builtin_amdgcn_s_barrier(); asm volatile("" ::: "memory"); }
    __device__ __forceinline__ void epi(const f32x4 (&acc)[2][2][4][2], const Unit& u, int ui, int wr, int wc, int fr, int fq) const {
        const int row0 = u.pm * BM + wr * 64 + fr, colt = u.pn * BM, col0 = colt + wc * 32 + 8 * fq;
        const PG8_LAS float* RT = rtab(ui) + wr * 64 + fr;
        const int kind = colt < 1024 ? 1 : ((colt >= 2048 && colt < 3072) ? 2 : 0);
        const bool gate = (colt >= 1024 && colt < 2048) || (colt >= 4096 && colt < 5120);
        if (kind == 0) {
#pragma unroll
            for (int ai = 0; ai < 2; ++ai)
#pragma unroll
                for (int m = 0; m < 4; ++m) { bf16_t* rowp = O + (size_t)(row0 + ai * HALF + m * 16) * ldc + col0; const float rr = RT[ai * HALF + m * 16];
#pragma unroll
                    for (int bj = 0; bj < 2; ++bj) { f32x4 v0 = acc[ai][bj][m][0] * rr, v1 = acc[ai][bj][m][1] * rr;
                        if (gate) {
#pragma unroll
                            for (int e = 0; e < 4; ++e) { v0[e] = v0[e] * __builtin_amdgcn_rcpf(1.0f + __expf(-v0[e])); v1[e] = v1[e] * __builtin_amdgcn_rcpf(1.0f + __expf(-v1[e])); } }
                        u32x4 w; w.x = cvt_pk_bf16(v0[0], v0[1]); w.y = cvt_pk_bf16(v0[2], v0[3]); w.z = cvt_pk_bf16(v1[0], v1[1]); w.w = cvt_pk_bf16(v1[2], v1[3]);
                        *(u32x4*)(rowp + bj * HALF) = w; } }
            return;
        }
        PG8_LAS float* P = (PG8_LAS float*)xlds;
        PG8_LAS float* KS = (PG8_LAS float*)(xlds + 8192);
#pragma unroll
        for (int ai = 0; ai < 2; ++ai)
#pragma unroll
            for (int m = 0; m < 4; ++m)
#pragma unroll
                for (int bj = 0; bj < 2; ++bj) { const float rr = RT[ai * HALF + m * 16]; const f32x4 a = acc[ai][bj][m][0] * rr, b = acc[ai][bj][m][1] * rr;
                    float s = ((a[0] * a[0] + a[1] * a[1]) + (a[2] * a[2] + a[3] * a[3])) + ((b[0] * b[0] + b[1] * b[1]) + (b[2] * b[2] + b[3] * b[3]));
                    s += __shfl_xor(s, 16); s += __shfl_xor(s, 32);
                    if (fq == 0) P[((ai * HALF + wr * 64 + m * 16 + fr) * 2 + bj) * 4 + wc] = s;
                    if (bj) asm volatile("" ::: "memory"); }
        bar();
        const PG8_LAS float* wp = (const PG8_LAS float*)(xlds + 10240) + (kind == 1 ? 0 : 128) + wc * 32 + 8 * fq;
        const f32x4 w0 = *(const PG8_LAS f32x4*)wp, w1 = *(const PG8_LAS f32x4*)(wp + 4);
        f32x4 ks[2][2] = {};
#pragma unroll
        for (int ai = 0; ai < 2; ++ai)
#pragma unroll
            for (int m = 0; m < 4; ++m) { bf16_t* rowp = O + (size_t)(row0 + ai * HALF + m * 16) * ldc + col0;
#pragma unroll
                for (int bj = 0; bj < 2; ++bj) { const f32x4 p = *(const PG8_LAS f32x4*)(P + ((ai * HALF + wr * 64 + m * 16 + fr) * 2 + bj) * 4);
                    const float rs = RT[ai * HALF + m * 16] / sqrtf(((p[0] + p[1]) + (p[2] + p[3])) * (1.0f / 128.0f) + eps);
                    const f32x4 v0 = acc[ai][bj][m][0] * rs * w0, v1 = acc[ai][bj][m][1] * rs * w1;
                    ks[bj][0] += v0; ks[bj][1] += v1;
                    u32x4 w; w.x = cvt_pk_bf16(v0[0], v0[1]); w.y = cvt_pk_bf16(v0[2], v0[3]); w.z = cvt_pk_bf16(v1[0], v1[1]); w.w = cvt_pk_bf16(v1[2], v1[3]);
                    *(u32x4*)(rowp + bj * HALF) = w; }
                asm volatile("" : "+v"(ks[0][0]), "+v"(ks[0][1]), "+v"(ks[1][0]), "+v"(ks[1][1]) :: "memory"); }
        if (kind == 2) {
            float v[16];
#pragma unroll
            for (int bj = 0; bj < 2; ++bj)
#pragma unroll
                for (int n = 0; n < 2; ++n)
#pragma unroll
                    for (int j = 0; j < 4; ++j) v[bj * 8 + n * 4 + j] = ks[bj][n][j];
            { const bool up = (fr & 8) != 0;
#pragma unroll
              for (int c = 0; c < 8; ++c) { const float snd = up ? v[c] : v[c + 8], keep = up ? v[c + 8] : v[c]; v[c] = keep + __shfl_xor(snd, 8); } }
            { const bool up = (fr & 4) != 0;
#pragma unroll
              for (int c = 0; c < 4; ++c) { const float snd = up ? v[c] : v[c + 4], keep = up ? v[c + 4] : v[c]; v[c] = keep + __shfl_xor(snd, 4); } }
            { const bool up = (fr & 2) != 0;
#pragma unroll
              for (int c = 0; c < 2; ++c) { const float snd = up ? v[c] : v[c + 2], keep = up ? v[c + 2] : v[c]; v[c] = keep + __shfl_xor(snd, 2); } }
            { const bool up = (fr & 1) != 0; const float snd = up ? v[0] : v[1], keep = up ? v[1] : v[0]; v[0] = keep + __shfl_xor(snd, 1); }
            KS[wr * 256 + 128 * (fr >> 3) + 32 * wc + 8 * fq + (fr & 7)] = v[0];
            bar();
            const int t = (wr * 4 + wc) * 64 + fq * 16 + fr;
            if (t < 256) { const int b = u.pm >> 4, nb = u.pm & 15, head = 2 * (u.pn & 3) + (t >> 7);
                KM[(((size_t)b * 8 + head) * 16 + nb) * 128 + (t & 127)] = (KS[t] + KS[256 + t]) * (1.0f / 256.0f); }
        }
    }
};

struct EpiResScale {
    static constexpr bool PERM = false, AFTER_DRAIN = false, KHOOK = true; static constexpr int KH0 = 16, KH1 = 24;
    const float* base; float* out; int ldc; const float* SSQ; PG8_LAS unsigned char* xlds; float eps; bool last;
    __device__ __forceinline__ PG8_LAS float* tab(int ui) const { return (PG8_LAS float*)xlds + (ui & 1) * 768; }
    __device__ __forceinline__ void unit_begin(const Unit& u, int ui, int tid) const {
        if (tid < 256) { const f32x4* sp = (const f32x4*)(SSQ + (size_t)(u.pm * BM + tid) * 64); float s0 = 0.f, s1 = 0.f;
#pragma unroll
            for (int i = 0; i < 8; ++i) { const f32x4 a = sp[i], b = sp[8 + i]; s0 += (a[0] + a[1]) + (a[2] + a[3]); s1 += (b[0] + b[1]) + (b[2] + b[3]); }
            const float m0 = s0 * (1.0f / 512.0f) + eps, m1 = s1 * (1.0f / 512.0f) + eps; PG8_LAS float* T = tab(ui);
            T[tid] = sqrtf(m0); T[256 + tid] = sqrtf(m1 / m0); T[512 + tid] = 1.0f / sqrtf(m1); }
    }
    __device__ __forceinline__ void khook(f32x4 (&acc)[2][2][4][2], int t, int ui, int wr, int fr) const {
        const PG8_LAS float* T = tab(ui) + (t == KH0 ? 0 : 256) + wr * 64 + fr;
#pragma unroll
        for (int ai = 0; ai < 2; ++ai)
#pragma unroll
            for (int m = 0; m < 4; ++m) { const float f = T[ai * HALF + m * 16];
#pragma unroll
                for (int bj = 0; bj < 2; ++bj)
#pragma unroll
                    for (int n = 0; n < 2; ++n) acc[ai][bj][m][n] = acc[ai][bj][m][n] * f; }
    }
    __device__ __forceinline__ void epi(const f32x4 (&acc)[2][2][4][2], const Unit& u, int ui, int wr, int wc, int fr, int fq) const {
        const int col0 = u.pn * BM + wc * 32 + 4 * fq; const PG8_LAS float* T = tab(ui) + 512 + wr * 64 + fr;
#pragma unroll
        for (int ai = 0; ai < 2; ++ai)
#pragma unroll
            for (int m = 0; m < 4; ++m) { const size_t off = (size_t)(u.pm * BM + ai * HALF + wr * 64 + m * 16 + fr) * ldc + col0; const float f = T[ai * HALF + m * 16];
#pragma unroll
                for (int bj = 0; bj < 2; ++bj)
#pragma unroll
                    for (int n = 0; n < 2; ++n) { const f32x4* bp = (const f32x4*)(base + off + bj * HALF + n * 16); f32x4* op = (f32x4*)(out + off + bj * HALF + n * 16);
                        if (last) { const f32x4 bs = __builtin_nontemporal_load(bp); __builtin_nontemporal_store(bs + acc[ai][bj][m][n] * f, op); }
                        else { const f32x4 bs = *bp; *op = bs + acc[ai][bj][m][n] * f; } } }
    }
};
}

#ifndef GEMM1_ALIGN
#define GEMM1_ALIGN true
#endif
#ifndef GEMM1_SP2
#define GEMM1_SP2 true
#endif
#ifndef GEMM2_ALIGN
#define GEMM2_ALIGN true
#endif
#ifndef GEMM2_SP2
#define GEMM2_SP2 true
#endif
#ifndef PFD
#define PFD 2
#endif
#ifndef PROBE_SEC
#define PROBE_SEC -1
#endif
#ifndef ATT_PRIO
#define ATT_PRIO 0
#endif
#ifndef PROBE_SSDFIX
#define PROBE_SSDFIX 0
#endif
#ifndef BSKEW_N
#define BSKEW_N 2
#endif
#ifndef WOUT_IN_B
#define WOUT_IN_B 1
#endif
#ifndef PROBE_FSKEW
#define PROBE_FSKEW 0
#endif
#ifndef PROBE_BSKEW
#define PROBE_BSKEW 0
#endif
#ifndef PROBE_SSEC
#define PROBE_SSEC -1
#endif
#ifndef PROBE_MEM2
#define PROBE_MEM2 0
#endif
#ifndef FASTBAR
#define FASTBAR 1
#endif
#ifndef PROBE_BAR2
#define PROBE_BAR2 0
#endif
#ifndef PROBE_PH
#define PROBE_PH -1
#endif
constexpr int NWAVES = 8;
#ifndef MK_N_LAUNCHES
#define MK_N_LAUNCHES 1
#endif
constexpr int N_PHASES = 12;
constexpr int N_LAUNCHES = MK_N_LAUNCHES;

constexpr int BATCH = 8, SEQ = 4096, DM = 1024, DEPTH = 2;
constexpr int M = BATCH * SEQ;
constexpr int NH = 8, HD = 128;
constexpr int NSH = 16, SHD = 64, NST = 128;
constexpr int NIN = 6672;
constexpr int PITCH = 6656;
constexpr int C_Q = 0, C_Z = 1024, C_K = 2048, C_V = 3072, C_G = 4096, C_X = 5120, C_B = 6144, C_C = 6400;
constexpr int MOBA = 256, NBLK = SEQ / MOBA;
constexpr float EPS = 1e-6f;

constexpr size_t MiB = 1u << 20;
constexpr size_t WS_CTL = 0, CTL_ZERO_BYTES = 64 * 1024;
constexpr size_t WS_WIN = 1 * MiB;
constexpr size_t WS_WOUT = 14 * MiB;
constexpr size_t WS_KM = 18 * MiB;
constexpr size_t WS_DT = 19 * MiB;
constexpr size_t WS_SSQ = 21 * MiB;
constexpr size_t WS_RSTD = 31 * MiB;
constexpr size_t WS_ACS = 29 * MiB;
constexpr size_t WS_A = 32 * MiB;
constexpr size_t WS_PROJ = 96 * MiB;
constexpr size_t WS_END = 512 * MiB;
static_assert(WS_PROJ + (size_t)M * PITCH * 2 <= WS_END, "d_ws map");
constexpr int CW_TMO = 0;
constexpr int CW_BAR = 4096;
constexpr int CW_AQ = 8192;   static_assert((CW_AQ + 128) * 4 <= (int)CTL_ZERO_BYTES && (CW_BAR + 3456) <= CW_AQ, "control words inside the zeroed region");
constexpr int CW_AQ_ = 0;

constexpr int RING_OFF = 0, RING_BYTES = 131072;
constexpr int LDSCTL_OFF = 146944, MISC_OFF = LDSCTL_OFF + 320;
constexpr int LDS_BYTES = 147456;
static_assert(MISC_OFF + 128 <= LDS_BYTES && RING_BYTES <= LDSCTL_OFF, "LDS map");

#define GAS __attribute__((address_space(1)))
#define LAS __attribute__((address_space(3)))
typedef unsigned short bf16;
typedef unsigned v4u __attribute__((ext_vector_type(4)));
typedef unsigned v2u __attribute__((ext_vector_type(2)));
typedef float f32x4 __attribute__((ext_vector_type(4)));
typedef short bf16x8 __attribute__((ext_vector_type(8)));
typedef GAS unsigned gu32;
#define RLX_AGENT __ATOMIC_RELAXED, __HIP_MEMORY_SCOPE_AGENT
#define LDS_WAIT() asm volatile("s_waitcnt lgkmcnt(0)" ::: "memory")
#define VM_WAIT() asm volatile("s_waitcnt vmcnt(0)" ::: "memory")
__device__ __forceinline__ unsigned f2bf(float f) { unsigned u = __builtin_bit_cast(unsigned, f); return (u + 0x7fffu + ((u >> 16) & 1u)) >> 16; }
typedef __bf16 bf16x2_n __attribute__((ext_vector_type(2)));
__device__ __forceinline__ unsigned pk2(float lo, float hi) { bf16x2_n v = {(__bf16)lo, (__bf16)hi}; return __builtin_bit_cast(unsigned, v); }
__device__ __forceinline__ float bflo(unsigned u) { return __builtin_bit_cast(float, u << 16); }
__device__ __forceinline__ float bfhi(unsigned u) { return __builtin_bit_cast(float, u & 0xffff0000u); }
__device__ __forceinline__ float silu_f(float v) { return v * __builtin_amdgcn_rcpf(1.f + __expf(-v)); }
__device__ __forceinline__ float wave_sum(float v) {
#pragma unroll
    for (int o = 1; o < 64; o <<= 1) v += __shfl_xor(v, o);
    return v;
}
__device__ __forceinline__ float wave_max(float v) {
#pragma unroll
    for (int o = 1; o < 64; o <<= 1) v = fmaxf(v, __shfl_xor(v, o));
    return v;
}

#define XB_TMO      128
#define XB_XCNT(j)  (256  + 64 * (j))
#define XB_XSUB(j)  (1280 + 64 * (j))
#define XB_XGEN(j)  (2304 + 64 * (j))
#define XB_TOP      3328
#define XB_TOPGEN   3392
#define XCD_BAR_WORDS 3456
#define XB_SPIN_CAP (1u << 22)

__device__ __forceinline__ unsigned xb_ld(unsigned* p)              { return __hip_atomic_load(p, __ATOMIC_RELAXED, __HIP_MEMORY_SCOPE_AGENT); }
__device__ __forceinline__ unsigned xb_add(unsigned* p, unsigned v) { return __hip_atomic_fetch_add(p, v, __ATOMIC_RELAXED, __HIP_MEMORY_SCOPE_AGENT); }
__device__ __forceinline__ unsigned xb_xcc_id() { return (unsigned)__builtin_amdgcn_s_getreg((3 << 11) | 20) & 0xFu; }
#define XB_SPIN(cond, bar) do { unsigned _sp = 0; while (cond) { __builtin_amdgcn_s_sleep(1); \
    if ((++_sp & 255u) == 0u) { if (xb_ld(&(bar)[XB_TMO])) break; if (_sp > XB_SPIN_CAP) { atomicAdd(&(bar)[XB_TMO], 1u); break; } } } } while (0)

struct XcdBarrier { unsigned* bar; unsigned x; volatile LAS unsigned* st; };

__device__ __forceinline__ XcdBarrier xcd_barrier_post(unsigned* bar, volatile LAS unsigned* st) {
    XcdBarrier b; b.bar = bar; b.x = xb_xcc_id(); b.st = st;
    if (threadIdx.x == 0) (void)xb_add(&bar[XB_XCNT(b.x)], 1u);
    return b;
}
__device__ __forceinline__ void xcd_barrier_complete(unsigned* bar, unsigned x, unsigned& nloc, unsigned& nx) {
    const unsigned G = gridDim.x * gridDim.y * gridDim.z;
    unsigned sum, cnt, mine, sp = 0u;
    for (;;) {
        sum = 0u; cnt = 0u; mine = 0u;
#pragma unroll
        for (unsigned j = 0; j < 16; ++j) { const unsigned c = xb_ld(&bar[XB_XCNT(j)]); sum += c; cnt += (c > 0u) ? 1u : 0u; mine = (j == x) ? c : mine; }
        if (sum == G) break;
        __builtin_amdgcn_s_sleep(1);
        if ((++sp & 255u) == 0u) { if (xb_ld(&bar[XB_TMO])) break; if (sp > XB_SPIN_CAP) { atomicAdd(&bar[XB_TMO], 1u); break; } }
    }
    nloc = mine > 0u ? mine : 1u; nx = cnt > 0u ? cnt : 1u;
}
__device__ __forceinline__ void xcd_barrier(const XcdBarrier& b, int wave) {
    asm volatile("s_waitcnt vmcnt(0)" ::: "memory");
    __syncthreads();
    int z_ = 0; asm volatile("" : "+v"(z_));
    if (wave == 0 && __builtin_amdgcn_mbcnt_hi(~0u, __builtin_amdgcn_mbcnt_lo(~0u, (unsigned)z_)) == 0u) {
        unsigned* bar = b.bar;
        __builtin_amdgcn_s_waitcnt(0);
        unsigned nloc = b.st[0], nx = b.st[1];
        if (nloc == 0u) { xcd_barrier_complete(bar, b.x, nloc, nx); b.st[0] = nloc; b.st[1] = nx; }
        const unsigned old = xb_add(&bar[XB_XSUB(b.x)], 1u);
        const unsigned gen = old / nloc;
        if (FASTBAR) {
            if (old + 1u == (gen + 1u) * nloc) {
                __builtin_amdgcn_fence(__ATOMIC_RELEASE, "agent");
                asm volatile("s_waitcnt vmcnt(0)" ::: "memory");
                (void)xb_add(&bar[XB_TOP], 1u);
            }
            const unsigned target = (gen + 1u) * nx;
            XB_SPIN((int)(xb_ld(&bar[XB_TOP]) - target) < 0, bar);
            __builtin_amdgcn_fence(__ATOMIC_ACQUIRE, "agent");
            asm volatile("s_waitcnt vmcnt(0)" ::: "memory");
        } else
        if (old + 1u == (gen + 1u) * nloc) {
            __builtin_amdgcn_fence(__ATOMIC_RELEASE, "agent");
            asm volatile("s_waitcnt vmcnt(0)" ::: "memory");
            const unsigned og = xb_add(&bar[XB_TOP], 1u);
            const unsigned tg = og / nx;
            if (og + 1u == (tg + 1u) * nx) xb_add(&bar[XB_TOPGEN], 1u);
            else XB_SPIN(xb_ld(&bar[XB_TOPGEN]) == tg, bar);
            __builtin_amdgcn_fence(__ATOMIC_ACQUIRE, "agent");
            xb_add(&bar[XB_XGEN(b.x)], 1u);
            asm volatile("s_waitcnt vmcnt(0)" ::: "memory");
        } else {
            XB_SPIN(xb_ld(&bar[XB_XGEN(b.x)]) == gen, bar);
            __builtin_amdgcn_fence(__ATOMIC_ACQUIRE, "agent");
            asm volatile("s_waitcnt vmcnt(0)" ::: "memory");
        }
    }
    __syncthreads();
}

struct Frame {
    LAS unsigned char* lds;
    volatile LAS unsigned* MISC;
    int tid, lane, wave;
    int vcu, G;
};
struct Args { const float* in[12]; float* out; unsigned char* ws; int ph_lo, ph_hi, li, pad; };
template <class T> __device__ __forceinline__ T* karg_ptr(int byte_off) {
    const char __attribute__((address_space(4)))* p = (const char __attribute__((address_space(4)))*)__builtin_amdgcn_kernarg_segment_ptr();
    int o = byte_off; asm volatile("" : "+s"(o));
    return *(T* const __attribute__((address_space(4)))*)(p + o);
}
__device__ __forceinline__ const float* in_ptr(int i) { return karg_ptr<const float>(8 * i); }
__device__ __forceinline__ float* out_ptr() { return karg_ptr<float>(96); }
__device__ __forceinline__ unsigned char* ws_ptr() { return karg_ptr<unsigned char>(104); }
#define WSP(T, off) ((T*)(ws_ptr() + (off)))

__device__ __forceinline__ void transpose_item(const float* Wsrc, int ldw, int K, int ncols, bf16* WT, int row_off, LAS float* scr, int item, int lane, const float* kscale = nullptr, int kmin = 0) {
    const int nblk = ncols / 32, kb = item / nblk, nb = item % nblk, k0 = 64 * kb, n0 = 32 * nb;
#pragma unroll
    for (int i = 0; i < 8; ++i) { const int kk = (lane >> 3) + 8 * i, c4 = lane & 7;
        f32x4 v = *(const f32x4*)(Wsrc + (size_t)(k0 + kk) * ldw + n0 + 4 * c4);
        if (kscale && k0 + kk >= kmin) v = v * kscale[k0 + kk - kmin];
        LAS float* d = scr + kk * 33 + 4 * c4; d[0] = v.x; d[1] = v.y; d[2] = v.z; d[3] = v.w; }
    LDS_WAIT(); asm volatile("" ::: "memory");
    const int c = lane & 7;
#pragma unroll
    for (int j = 0; j < 4; ++j) { const int n = (lane >> 3) + 8 * j; const LAS float* s = scr + (8 * c) * 33 + n;
        v4u o; o.x = pk2(s[0 * 33], s[1 * 33]); o.y = pk2(s[2 * 33], s[3 * 33]); o.z = pk2(s[4 * 33], s[5 * 33]); o.w = pk2(s[6 * 33], s[7 * 33]);
        *(v4u*)(WT + (size_t)(row_off + n0 + n) * K + k0 + 8 * c) = o; }
    LDS_WAIT(); asm volatile("" ::: "memory");
}

__device__ __forceinline__ void phase_a(Frame& F, int layer) {
    bf16* const WinT = WSP(bf16, WS_WIN); bf16* const WoutT = WSP(bf16, WS_WOUT); bf16* const XN = WSP(bf16, WS_A); float* const DT = WSP(float, WS_DT); const float* const OUTP = out_ptr();
    const int gw = F.vcu * NWAVES + F.wave, NGW = F.G * NWAVES;
    {
        LAS float* scr = (LAS float*)(F.lds + RING_OFF + F.wave * 16384);
        const float* win = in_ptr(2) + (size_t)layer * DM * NIN;
        const float* wout = in_ptr(11) + (size_t)layer * 2048 * DM;
        constexpr int KB_IN = DM / 64;
        constexpr int I_1K = KB_IN * (1024 / 32), I_X = KB_IN * (1536 / 32), I_OUT = (2048 / 64) * (1024 / 32);
        constexpr int NITEMS = 5 * I_1K + I_X + (WOUT_IN_B ? 0 : I_OUT);
        for (int it = gw; it < NITEMS; it += NGW) {
            int r = it;
            if (r < I_1K) { transpose_item(win + 0,    NIN, DM, 1024, WinT, C_Q, scr, r, F.lane); continue; } r -= I_1K;
            if (r < I_1K) { transpose_item(win + 4096, NIN, DM, 1024, WinT, C_Z, scr, r, F.lane); continue; } r -= I_1K;
            if (r < I_1K) { transpose_item(win + 1024, NIN, DM, 1024, WinT, C_K, scr, r, F.lane); continue; } r -= I_1K;
            if (r < I_1K) { transpose_item(win + 2048, NIN, DM, 1024, WinT, C_V, scr, r, F.lane); continue; } r -= I_1K;
            if (r < I_1K) { transpose_item(win + 3072, NIN, DM, 1024, WinT, C_G, scr, r, F.lane); continue; } r -= I_1K;
            if (r < I_X)  { transpose_item(win + 5120, NIN, DM, 1536, WinT, C_X, scr, r, F.lane); continue; } r -= I_X;
            transpose_item(wout, DM, 2048, 1024, WoutT, 0, scr, r, F.lane, in_ptr(10) + (size_t)layer * 1024, 1024);
        }
    }
    __syncthreads();
    LAS unsigned short* wdb = (LAS unsigned short*)(F.lds + RING_OFF); LAS float* lnl = (LAS float*)(F.lds + RING_OFF + 32768);
    {
        const float* win = in_ptr(2) + (size_t)layer * DM * NIN + 6656; const float* lnw = in_ptr(1) + layer * DM;
        for (int i = F.tid; i < 16 * 1024; i += NWAVES * 64) { const int k = i >> 4, c = i & 15; wdb[c * 1024 + k] = (unsigned short)f2bf(win[(size_t)k * NIN + c]); }
        for (int i = F.tid; i < 1024; i += NWAVES * 64) lnl[i] = lnw[i];
    }
    __syncthreads();
    const float* xin = layer == 0 ? in_ptr(0) : OUTP;
    const float* dtb = in_ptr(7) + layer * NSH;
    float* const RSTD = WSP(float, WS_RSTD);
    const int r = F.lane & 15, g4 = F.lane >> 4;
    for (int grp = gw; grp < M / 16; grp += NGW) {
        asm volatile("" ::: "memory");
        const size_t m0 = (size_t)grp * 16;
        const char* xb = (const char*)(xin + (m0 + r) * DM + 8 * g4); char* ob = (char*)(XN + (m0 + r) * DM + 8 * g4);
        f32x4 acc = {0.f, 0.f, 0.f, 0.f}; float ssq = 0.f;
#pragma unroll 8
        for (int kk = 0; kk < 32; ++kk) {
            const f32x4 a = __builtin_nontemporal_load((const f32x4*)(xb + kk * 128)), b = __builtin_nontemporal_load((const f32x4*)(xb + kk * 128 + 16));
            const f32x4 la = *(const LAS f32x4*)(lnl + 32 * kk + 8 * g4), lb = *(const LAS f32x4*)(lnl + 32 * kk + 8 * g4 + 4);
            ssq += ((a.x * a.x + a.y * a.y) + (a.z * a.z + a.w * a.w)) + ((b.x * b.x + b.y * b.y) + (b.z * b.z + b.w * b.w));
            const f32x4 ha = a * la, hb = b * lb;
            v4u pk; pk.x = pk2(ha.x, ha.y); pk.y = pk2(ha.z, ha.w); pk.z = pk2(hb.x, hb.y); pk.w = pk2(hb.z, hb.w);
            *(v4u*)(ob + kk * 64) = pk;
            const bf16x8 wf = *(const LAS bf16x8*)(wdb + r * 1024 + 32 * kk + 8 * g4);
            acc = __builtin_amdgcn_mfma_f32_16x16x32_bf16(wf, __builtin_bit_cast(bf16x8, pk), acc, 0, 0, 0);
        }
        ssq += __shfl_xor(ssq, 16); ssq += __shfl_xor(ssq, 32);
        const float rstd = 1.f / sqrtf(ssq * (1.f / DM) + EPS);
        if (g4 == 0) RSTD[m0 + r] = rstd;
        f32x4 o;
#pragma unroll
        for (int i = 0; i < 4; ++i) { const float a = acc[i] * rstd + dtb[4 * g4 + i], u = __expf(-fabsf(a));
            o[i] = fmaxf(a, 0.f) + (u < 1e-3f ? u * (1.f - u * (0.5f - 0.33333334f * u)) : __logf(1.f + u)); }
        *(f32x4*)(DT + (m0 + r) * 16 + 4 * g4) = o;
    }
}

__device__ __forceinline__ void phase_c(Frame& F, int layer) {
    bf16* const PROJ = WSP(bf16, WS_PROJ); bf16* const BCc = WSP(bf16, WS_A);
    const int gw = F.vcu * NWAVES + F.wave, NGW = F.G * NWAVES;
    {
        const int c8 = F.lane * 8;
        const float* cw = in_ptr(5) + (size_t)layer * 4 * 1536 + 1024 + c8;
        const float* cb = in_ptr(6) + (size_t)layer * 1536 + 1024 + c8;
        f32x4 w[4][2], bias[2];
#pragma unroll
        for (int k = 0; k < 4; ++k) { w[k][0] = *(const f32x4*)(cw + k * 1536); w[k][1] = *(const f32x4*)(cw + k * 1536 + 4); }
        bias[0] = *(const f32x4*)cb; bias[1] = *(const f32x4*)(cb + 4);
#pragma unroll 1
        for (int run = gw; run < M / 16; run += NGW) {
            const int m0 = run * 16; const bool head = (m0 & (SEQ - 1)) == 0;
            const bf16* src = PROJ + (size_t)m0 * PITCH + C_B + c8;
            v4u x[19];
#pragma unroll
            for (int j = 0; j < 19; ++j) { if (j < 3 && head) x[j] = (v4u){0u, 0u, 0u, 0u}; else x[j] = *(const v4u*)(src + (j - 3) * PITCH); }
#pragma unroll
            for (int i = 0; i < 16; ++i) {
                f32x4 a0 = bias[0], a1 = bias[1];
#pragma unroll
                for (int k = 0; k < 4; ++k) { const v4u u = x[i + k];
                    a0 += w[k][0] * (f32x4){bflo(u.x), bfhi(u.x), bflo(u.y), bfhi(u.y)}; a1 += w[k][1] * (f32x4){bflo(u.z), bfhi(u.z), bflo(u.w), bfhi(u.w)}; }
                v4u o; o.x = pk2(silu_f(a0.x), silu_f(a0.y)); o.y = pk2(silu_f(a0.z), silu_f(a0.w)); o.z = pk2(silu_f(a1.x), silu_f(a1.y)); o.w = pk2(silu_f(a1.z), silu_f(a1.w));
                *(v4u*)(BCc + (size_t)(m0 + i) * 512 + c8) = o;
            }
        }
    }
    if ((gw & 3) == 0) {
        const float* const DT = WSP(float, WS_DT); float* const ACS = WSP(float, WS_ACS); const float* alog = in_ptr(8) + layer * NSH;
#pragma unroll 1
        for (int c = gw >> 2; c < M / 64; c += NGW >> 2) {
            const size_t idx = ((size_t)c * 64 + F.lane) * 16;
            f32x4 a[4];
#pragma unroll
            for (int q = 0; q < 4; ++q) { a[q] = *(const f32x4*)(DT + idx + 4 * q);
#pragma unroll
                for (int e = 0; e < 4; ++e) a[q][e] *= -__expf(alog[4 * q + e]); }
#pragma unroll
            for (int o = 1; o < 64; o <<= 1)
#pragma unroll
                for (int q = 0; q < 4; ++q)
#pragma unroll
                    for (int e = 0; e < 4; ++e) { const float t = __shfl_up(a[q][e], o); if (F.lane >= o) a[q][e] += t; }
#pragma unroll
            for (int q = 0; q < 4; ++q) *(f32x4*)(ACS + idx + 4 * q) = a[q];
        }
    }
}


namespace ssd {
typedef float f32x4v __attribute__((ext_vector_type(4)));
typedef short s16x4v __attribute__((ext_vector_type(4)));
constexpr int L = 64, S256 = 272, S64 = 144, S32 = 144;
constexpr int O_BS = 0, O_CS = O_BS + 64 * S256, O_XB = O_CS + 64 * S256, O_XW = O_XB + 64 * S32, O_MT = O_XW + 64 * S32, O_ST = O_MT + 64 * S64,
              O_TB = O_ST + 2 * 64 * S256, O_CS2 = O_TB + NWAVES * 1024, O_XB2 = O_CS2 + 64 * S256, O_END = O_XB2 + 64 * S32;
static_assert(O_END <= LDSCTL_OFF, "SSD LDS map");
#define LD128(off) (*(const LAS bf16x8*)(lds + (off)))
#define MFMA16(a, b, c) __builtin_amdgcn_mfma_f32_16x16x32_bf16(a, b, c, 0, 0, 0)
#define TRRD(dst, addr, off) asm volatile("ds_read_b64_tr_b16 %0, %1 offset:%2" : "=&v"(dst) : "v"(addr), "i"(off) : "memory")
#define TRWAIT() do { asm volatile("s_waitcnt lgkmcnt(0)" ::: "memory"); __builtin_amdgcn_sched_barrier(0); } while (0)
#define CAT8(lo, hi) ((bf16x8){lo[0], lo[1], lo[2], lo[3], hi[0], hi[1], hi[2], hi[3]})
typedef __bf16 bf16x2n __attribute__((ext_vector_type(2)));
__device__ __forceinline__ unsigned cvtpk(float lo, float hi) { bf16x2n v = {(__bf16)lo, (__bf16)hi}; return __builtin_bit_cast(unsigned, v); }
__device__ __forceinline__ float silu_fast(float v) { return v * __builtin_amdgcn_rcpf(1.f + __expf(-v)); }

__device__ __forceinline__ void item(LAS unsigned char* lds, int wave_, int layer, int b, int h) {
    int z_ = 0; asm volatile("" : "+v"(z_));
    const int wid = wave_, lane = (int)__builtin_amdgcn_mbcnt_hi(~0u, __builtin_amdgcn_mbcnt_lo(~0u, (unsigned)z_)), tid = wid * 64 + lane, fr = lane & 15, fq = lane >> 4;
    const int g = h >> 3;
    const float Dh = in_ptr(9)[layer * NSH + h];
    const int brow = tid >> 4, bch = tid & 15;
    const int xl = tid >> 3, xpg = tid & 7;
    const int xcol = h * SHD + 4 * xpg;
    float cw[2][4][4], cbv[2][4];
    { const float* cwp = in_ptr(5) + (size_t)layer * 4 * 1536 + xcol; const float* cbp = in_ptr(6) + (size_t)layer * 1536 + xcol;
#pragma unroll
      for (int j = 0; j < 2; ++j) {
#pragma unroll
      for (int k = 0; k < 4; ++k)
#pragma unroll
          for (int e = 0; e < 4; ++e) cw[j][k][e] = cwp[k * 1536 + 32 * j + e];
#pragma unroll
      for (int e = 0; e < 4; ++e) cbv[j][e] = cbp[32 * j + e]; } }
    const char* pBC = (const char*)(WSP(bf16, WS_A) + (size_t)b * SEQ * 512 + g * 128);
    const char* pX = (const char*)(WSP(bf16, WS_PROJ) + (size_t)b * SEQ * PITCH + C_X);
    char* pZ = (char*)(WSP(bf16, WS_PROJ) + (size_t)b * SEQ * PITCH + C_Z + h * SHD);
    const char* pDT = (const char*)(WSP(float, WS_DT) + (size_t)b * SEQ * 16 + h);
    const char* pAC = (const char*)(WSP(float, WS_ACS) + (size_t)b * SEQ * 16 + h);
    float* pSQ = WSP(float, WS_SSQ) + (size_t)b * SEQ * 64 + h * 4;
    const unsigned obc = (unsigned)(brow * 512 + bch * 8) * 2u;
    const int oxr = (xl - 3) * PITCH * 2 + xcol * 2;
    const unsigned odt = (unsigned)lane * 64u;
    const int tl = wid >> 1, ts0 = 2 * (wid & 1), tpC = wid & 1, tn = wid;
    const unsigned ozy = (unsigned)((16 * tl + fr) * PITCH + 32 * tpC + 4 * fq) * 2u;
    const int trq = fr >> 2, trp = fr & 3;
    const int aXB = (int)(unsigned)(size_t)(lds + O_XB) + (8 * fq + trq) * S32 + (4 * trp) * 2;
    const int aXBc = aXB + 64 * tpC;
    const int aXW = (int)(unsigned)(size_t)(lds + O_XW) + (8 * fq + trq) * S32 + (4 * trp) * 2;
    const int aBS = (int)(unsigned)(size_t)(lds + O_BS) + (8 * fq + trq) * S256 + (16 * tn + 4 * trp) * 2;
    f32x4v accS[4] = {};
    for (int i = tid; i < 64 * S256 / 4; i += NWAVES * 64) ((LAS unsigned*)(lds + O_ST))[i] = 0u;
    LAS float* const tb = (LAS float*)(lds + O_TB + wid * 1024);
    v4u bu0_0, bu1_0, cu0_0, cu1_0, bu0_1, bu1_1, cu0_1, cu1_1; v2u xr_0[2][4], xr_1[2][4], zr_0[2], zr_1[2]; float dtn_0, dtn_1, acn_0, acn_1;
#define SSD_LOAD(c, S_) do { const char* bc_ = pBC + (size_t)(c) * (L * 512 * 2); const char* px_ = pX + (size_t)(c) * (L * PITCH * 2); \
        bu0_##S_ = *(const v4u*)(bc_ + obc); bu1_##S_ = *(const v4u*)(bc_ + obc + 32 * 512 * 2); cu0_##S_ = *(const v4u*)(bc_ + obc + 512); cu1_##S_ = *(const v4u*)(bc_ + obc + 32 * 512 * 2 + 512); \
        _Pragma("unroll") for (int j = 0; j < 2; ++j) _Pragma("unroll") for (int k = 0; k < 4; ++k) xr_##S_[j][k] = ((c) * L + xl - 3 + k >= 0) ? *(const v2u*)(px_ + (oxr + k * PITCH * 2 + 64 * j)) : (v2u){0u, 0u}; \
        dtn_##S_ = *(const float*)(pDT + (size_t)(c) * (L * 64) + odt); acn_##S_ = *(const float*)(pAC + (size_t)(c) * (L * 64) + odt); \
        zr_##S_[0] = *(const v2u*)(pZ + (size_t)(c) * (L * PITCH * 2) + ozy); zr_##S_[1] = *(const v2u*)(pZ + (size_t)(c) * (L * PITCH * 2) + ozy + 32); } while (0)
#define SSD_STEP(c, S_) do { \
        QS0(0); \
        constexpr int OCS = (S_) ? O_CS2 : O_CS, OXB = (S_) ? O_XB2 : O_XB;     \
        const int aXBs = aXBc + (OXB - O_XB); \
          \
        const float dtv = dtn_##S_, acs = acn_##S_; \
        const float tot = __builtin_bit_cast(float, __builtin_amdgcn_readlane(__builtin_bit_cast(int, acs), 63)); \
        const float ea = __expf(acs); \
        tb[lane] = acs; tb[64 + lane] = dtv; tb[128 + lane] = __expf(tot - acs) * dtv; tb[192 + lane] = ea; \
        const v2u zq0 = zr_##S_[0], zq1 = zr_##S_[1]; \
          \
        { \
            *(LAS v4u*)(lds + O_BS + brow * S256 + bch * 16) = bu0_##S_; *(LAS v4u*)(lds + O_BS + (32 + brow) * S256 + bch * 16) = bu1_##S_; \
            *(LAS v4u*)(lds + OCS + brow * S256 + bch * 16) = cu0_##S_; *(LAS v4u*)(lds + OCS + (32 + brow) * S256 + bch * 16) = cu1_##S_; \
            asm volatile("s_waitcnt lgkmcnt(0)" ::: "memory"); \
            const float wl = tb[128 + xl]; \
            _Pragma("unroll") for (int j = 0; j < 2; ++j) { \
                float xv[4]; \
                _Pragma("unroll") for (int e = 0; e < 4; ++e) xv[e] = cbv[j][e]; \
                _Pragma("unroll") for (int k = 0; k < 4; ++k) { xv[0] += cw[j][k][0] * bflo(xr_##S_[j][k].x); xv[1] += cw[j][k][1] * bfhi(xr_##S_[j][k].x); xv[2] += cw[j][k][2] * bflo(xr_##S_[j][k].y); xv[3] += cw[j][k][3] * bfhi(xr_##S_[j][k].y); } \
                _Pragma("unroll") for (int e = 0; e < 4; ++e) xv[e] = silu_fast(xv[e]); \
                *(LAS v2u*)(lds + OXB + xl * S32 + xpg * 8 + 64 * j) = (v2u){cvtpk(xv[0], xv[1]), cvtpk(xv[2], xv[3])}; \
                *(LAS v2u*)(lds + O_XW + xl * S32 + xpg * 8 + 64 * j) = (v2u){cvtpk(xv[0] * wl, xv[1] * wl), cvtpk(xv[2] * wl, xv[3] * wl)}; } \
        } \
        QS1(0); QS0(1); __syncthreads(); QS1(1); QS0(2); \
        if ((c) + 2 < SEQ / L) SSD_LOAD((c) + 2, S_);                          \
          \
        { \
            bf16x8 cf[4]; \
            _Pragma("unroll") for (int kk = 0; kk < 4; ++kk) cf[kk] = LD128(OCS + (16 * tl + fr) * S256 + (32 * kk + 8 * fq) * 2); \
            const float al = tb[16 * tl + fr];                                 \
            const int l = 16 * tl + fr; \
            _Pragma("unroll") for (int j = 0; j < 2; ++j) { \
                const int ts = ts0 + j; \
                if (ts <= tl) { \
                    f32x4v gacc = {}; \
                    _Pragma("unroll") for (int kk = 0; kk < 4; ++kk) gacc = MFMA16(LD128(O_BS + (16 * ts + fr) * S256 + (32 * kk + 8 * fq) * 2), cf[kk], gacc);     \
                    const f32x4v as4 = *(const LAS f32x4v*)(tb + 16 * ts + 4 * fq), ds4 = *(const LAS f32x4v*)(tb + 64 + 16 * ts + 4 * fq); \
                    float mv[4]; \
                    _Pragma("unroll") for (int r = 0; r < 4; ++r) mv[r] = (16 * ts + 4 * fq + r <= l) ? gacc[r] * __expf(al - as4[r]) * ds4[r] : 0.f; \
                    *(LAS v2u*)(lds + O_MT + l * S64 + (16 * ts + 4 * fq) * 2) = (v2u){cvtpk(mv[0], mv[1]), cvtpk(mv[2], mv[3])}; \
                } else { \
                    *(LAS v2u*)(lds + O_MT + l * S64 + (16 * ts + 4 * fq) * 2) = (v2u){0u, 0u}; \
                } \
            } \
            const float dec = __expf(tot); \
            s16x4v b0, b1, b2, b3; \
            TRRD(b0, aBS, 0); TRRD(b1, aBS, 4 * S256); TRRD(b2, aBS, 32 * S256); TRRD(b3, aBS, 36 * S256); \
            _Pragma("unroll") for (int tp = 0; tp < 4; ++tp) { s16x4v x0, x1, x2, x3; \
                TRRD(x0, aXW, 32 * tp); TRRD(x1, aXW, 4 * S32 + 32 * tp); TRRD(x2, aXW, 32 * S32 + 32 * tp); TRRD(x3, aXW, 36 * S32 + 32 * tp); \
                TRWAIT(); \
                accS[tp] = accS[tp] * dec; \
                accS[tp] = MFMA16(CAT8(b0, b1), CAT8(x0, x1), accS[tp]); accS[tp] = MFMA16(CAT8(b2, b3), CAT8(x2, x3), accS[tp]);     \
            } \
            _Pragma("unroll") for (int tp = 0; tp < 4; ++tp) \
                *(LAS v2u*)(lds + O_ST + (cur ^ 1) * 64 * S256 + (16 * tp + fr) * S256 + (16 * tn + 4 * fq) * 2) = (v2u){cvtpk(accS[tp][0], accS[tp][1]), cvtpk(accS[tp][2], accS[tp][3])}; \
        } \
        QS1(2); QS0(3); __syncthreads(); QS1(3); QS0(4); \
          \
        { \
            const bf16x8 m0f = LD128(O_MT + (16 * tl + fr) * S64 + (8 * fq) * 2), m1f = LD128(O_MT + (16 * tl + fr) * S64 + (32 + 8 * fq) * 2); \
            bf16x8 cfr[4]; \
            _Pragma("unroll") for (int kk = 0; kk < 4; ++kk) cfr[kk] = LD128(OCS + (16 * tl + fr) * S256 + (32 * kk + 8 * fq) * 2); \
            const float eal = tb[192 + 16 * tl + fr]; \
            _Pragma("unroll") for (int j = 0; j < 2; ++j) { \
                s16x4v x0, x1, x2, x3; \
                TRRD(x0, aXBs, 32 * j); TRRD(x1, aXBs, 4 * S32 + 32 * j); TRRD(x2, aXBs, 32 * S32 + 32 * j); TRRD(x3, aXBs, 36 * S32 + 32 * j); \
                TRWAIT(); \
                f32x4v yd = {}, yo = {}; \
                yd = MFMA16(CAT8(x0, x1), m0f, yd); yd = MFMA16(CAT8(x2, x3), m1f, yd); \
                _Pragma("unroll") for (int kk = 0; kk < 4; ++kk) yo = MFMA16(LD128(O_ST + cur * 64 * S256 + (32 * tpC + 16 * j + fr) * S256 + (32 * kk + 8 * fq) * 2), cfr[kk], yo); \
                const v2u xb = *(const LAS v2u*)(lds + OXB + (16 * tl + fr) * S32 + (32 * tpC + 16 * j + 4 * fq) * 2); \
                const v2u zr = j ? zq1 : zq0;                                 \
                float yz[4]; \
                yz[0] = (yd[0] + eal * yo[0] + Dh * bflo(xb.x)) * bflo(zr.x); yz[1] = (yd[1] + eal * yo[1] + Dh * bfhi(xb.x)) * bfhi(zr.x); \
                yz[2] = (yd[2] + eal * yo[2] + Dh * bflo(xb.y)) * bflo(zr.y); yz[3] = (yd[3] + eal * yo[3] + Dh * bfhi(xb.y)) * bfhi(zr.y); \
                *(v2u*)(pZ + (size_t)(c) * (L * PITCH * 2) + ozy + 32 * j) = (v2u){cvtpk(yz[0], yz[1]), cvtpk(yz[2], yz[3])}; \
                float q = (yz[0] * yz[0] + yz[1] * yz[1]) + (yz[2] * yz[2] + yz[3] * yz[3]); \
                q += __shfl_xor(q, 16); q += __shfl_xor(q, 32); \
                if (fq == 0) pSQ[((size_t)(c) * L + 16 * tl + fr) * 64 + 2 * tpC + j] = q; } \
        } \
          \
        QS1(4); cur ^= 1; } while (0)
    unsigned long long qacc = 0;
#define QS0(k) unsigned long long qt##k##_ = 0; if (PROBE_SSEC == (k)) qt##k##_ = __builtin_amdgcn_s_memtime()
#define QS1(k) do { if (PROBE_SSEC == (k)) qacc += __builtin_amdgcn_s_memtime() - qt##k##_; } while (0)
    SSD_LOAD(0, 0); SSD_LOAD(1, 1);
    int cur = 0;
#pragma unroll 1
    for (int c = 0; c < SEQ / L; c += 2) { SSD_STEP(c, 0); SSD_STEP(c + 1, 1); }
    if (PROBE_SSEC >= 0) { const unsigned long long t0 = __builtin_amdgcn_s_memtime(); while (__builtin_amdgcn_s_memtime() - t0 < qacc) __builtin_amdgcn_s_sleep(8); }
    __syncthreads();
#undef QS0
#undef QS1
#undef SSD_STEP
#undef SSD_LOAD
}
#undef LD128
#undef MFMA16
#undef TRRD
#undef TRWAIT
#undef CAT8
}


__device__ __forceinline__ void ssd_phase(Frame& F, int layer) {
    if ((F.vcu & 1) == 0) for (int it = F.vcu >> 1; it < BATCH * NSH; it += (F.G + 1) >> 1) ssd::item(F.lds + RING_OFF, F.wave, layer, it >> 4, it & 15);
}


namespace moba {
typedef float f32x16 __attribute__((ext_vector_type(16)));
typedef short s16x4 __attribute__((ext_vector_type(4)));
typedef unsigned u32x4 __attribute__((ext_vector_type(4)));
constexpr int NW = 8, QBLK = 32, KVBLK = 64, QB = NW * QBLK;
constexpr int SHM_V = KVBLK * HD * 2, SHM_K = KVBLK * HD * 2;
constexpr int OFF_V = 0, OFF_K = 3 * SHM_V, OFF_WS = 3 * SHM_V + 3 * SHM_K, OFF_KM = OFF_WS + NW * 64 * 4;
constexpr int ATTN_LDS = OFF_KM + 32 * 256;
constexpr float SCALE = 0.08838834764831845f, LOG2E = 1.4426950408889634f;

#define KSWZ(row, colB) ((row) * 256 + ((colB) ^ (((row) & 7) << 4)))
#define SBAR() __builtin_amdgcn_sched_barrier(0)
__device__ __forceinline__ int v_st(int k, int c) { const int kk = (k & ~0xC) | ((k & 4) << 1) | ((k & 8) >> 1); return ((kk >> 3) * 4 + (c >> 5)) * 512 + ((kk & 7) * 32 + (c & 31)) * 2; }
__device__ __forceinline__ int v_rd_base(int lane) { return ((lane & 3) << 3) | (((lane >> 2) & 3) << 6) | (((lane >> 4) & 1) << 5) | (((lane >> 5) & 1) << 8); }
constexpr int v_rd_off(int d0, int ks, int half) { return d0 * 512 + ks * 4096 + half * 2048; }
__device__ __forceinline__ int crow(int r, int hi) { return (r & 3) + 8 * (r >> 2) + 4 * hi; }
typedef __bf16 bf16x2n __attribute__((ext_vector_type(2)));
__device__ __forceinline__ unsigned cvtpk(float lo, float hi) { bf16x2n v = {(__bf16)lo, (__bf16)hi}; return __builtin_bit_cast(unsigned, v); }

struct Unit { const bf16* Q; const bf16* K; const bf16* V; const float* KM; int qb, h, jlo;
#if PROBE_MEM2 == 1
    long dum; __device__ __forceinline__ long dumv() const { return dum; }
#else
    __device__ __forceinline__ long dumv() const { return 0; }
#endif
};
struct Seam { bf16x8 qr[8]; bf16x8 st_v0, st_v1, st_k0, st_k1; };
constexpr int OFF_ORD = 108 * 1024, OFF_TK = OFF_ORD + 2048, OFF_WT = OFF_TK + 16;
struct Queue { unsigned* ctr; bf16* PROJ; const float* KM; };
__device__ __forceinline__ bool unit_from_ticket(unsigned t, const Queue& q, const LAS char* lds, Unit& u) {
    if (t >= (unsigned)(BATCH * NH * NBLK)) return false;
    const int id = __builtin_amdgcn_readfirstlane((int)((const LAS unsigned short*)(lds + OFF_ORD))[t]), b = id >> 7, h = (id >> 4) & 7, qb = id & 15;
    const int w = __builtin_amdgcn_readfirstlane(((const LAS int*)(lds + OFF_WT))[h]);
    const bf16* base = q.PROJ + (size_t)b * SEQ * PITCH + h * HD;
    u.Q = base + (size_t)qb * MOBA * PITCH + C_Q; u.K = base + C_K; u.V = base + C_V; u.KM = q.KM + (size_t)(b * NH + h) * NBLK * HD; u.qb = qb; u.h = h;
    u.jlo = qb > w ? 4 * (qb - w) : 0;
#if PROBE_MEM2 == 1
    u.dum = (b < 4 ? 1 : -1) * (long)(4 * SEQ) * PITCH * 2;
#endif
    return true;
}

__device__ __forceinline__ void mask_tile(f32x16& p0, f32x16& p1, int dq) {
    const float NEG = -__builtin_inff();
#pragma unroll
    for (int r = 0; r < 16; ++r) { const int c = (r & 3) + 8 * (r >> 2); if (dq - c < 0) p0[r] = NEG; if (dq - c - 32 < 0) p1[r] = NEG; }
}
__device__ __forceinline__ void partialSM(f32x16& p0, f32x16& p1, float base, float slope2) {
    constexpr float C2 = LOG2E * SCALE;
#pragma unroll
    for (int r = 0; r < 16; ++r) { const float c = (float)((r & 3) + 8 * (r >> 2)); p0[r] = fmaf(p0[r], C2, fmaf(slope2, c, base)); p1[r] = fmaf(p1[r], C2, fmaf(slope2, c + 32.f, base)); }
#pragma unroll
    for (int r = 0; r < 16; ++r) p0[r] = __builtin_amdgcn_exp2f(p0[r]);
}
__device__ __forceinline__ void finishSM(f32x16& p0, f32x16& p1, float& l_reg, bf16x8& pa0, bf16x8& pa1, bf16x8& pa2, bf16x8& pa3) {
#pragma unroll
    for (int r = 0; r < 16; ++r) p1[r] = __builtin_amdgcn_exp2f(p1[r]);
    float ps = 0;
#pragma unroll
    for (int r = 0; r < 16; ++r) ps += p0[r];
#pragma unroll
    for (int r = 0; r < 16; ++r) ps += p1[r];
    { auto rr = __builtin_amdgcn_permlane32_swap(__float_as_uint(ps), __float_as_uint(ps), false, false); ps = __uint_as_float(rr[0]) + __uint_as_float(rr[1]); }
    l_reg += ps;
#define PK4(P, B_, OUT) do { unsigned a0 = cvtpk(P[B_+0], P[B_+1]), a1 = cvtpk(P[B_+2], P[B_+3]); unsigned b0 = cvtpk(P[B_+4], P[B_+5]), b1 = cvtpk(P[B_+6], P[B_+7]); \
        auto r0 = __builtin_amdgcn_permlane32_swap(a0, b0, false, false); auto r1 = __builtin_amdgcn_permlane32_swap(a1, b1, false, false); \
        u32x4 w = {r0[0], r1[0], r0[1], r1[1]}; OUT = *reinterpret_cast<bf16x8*>(&w); } while (0)
    PK4(p0, 0, pa0); PK4(p0, 8, pa1); PK4(p1, 0, pa2); PK4(p1, 8, pa3);
#undef PK4
}
__device__ __forceinline__ void qkt(f32x16& p0, f32x16& p1, const LAS char* const (&kbase)[4], int kslot, const bf16x8* qr) {
    p0 = f32x16{}; p1 = f32x16{};
#pragma unroll
    for (int d0 = 0; d0 < 8; ++d0) { const LAS char* a = kbase[d0 & 3] + kslot + (d0 >> 2) * 128;
        bf16x8 b0 = *reinterpret_cast<const LAS bf16x8*>(a);
        bf16x8 b1 = *reinterpret_cast<const LAS bf16x8*>(a + 32 * 256);
        p0 = __builtin_amdgcn_mfma_f32_32x32x16_bf16(b0, qr[d0], p0, 0, 0, 0);
        p1 = __builtin_amdgcn_mfma_f32_32x32x16_bf16(b1, qr[d0], p1, 0, 0, 0); }
}
__device__ __forceinline__ void pv_tile(f32x16* o, int vb0, bf16x8 pa0, bf16x8 pa1, bf16x8 pa2, bf16x8 pa3) {
#define TRRD(dst, off) asm volatile("ds_read_b64_tr_b16 %0, %1 offset:%2" : "=&v"(dst) : "v"(vb0), "i"(off) : "memory")
#define PV_D0(d0) do { s16x4 l0, l1, l2, l3, h0, h1, h2, h3; constexpr int b_ = v_rd_off(d0, 0, 0); \
        TRRD(l0, b_); TRRD(h0, b_ + 2048); TRRD(l1, b_ + 4096); TRRD(h1, b_ + 6144); TRRD(l2, b_ + 8192); TRRD(h2, b_ + 10240); TRRD(l3, b_ + 12288); TRRD(h3, b_ + 14336); \
        asm volatile("s_waitcnt lgkmcnt(0)" ::: "memory"); SBAR(); \
        o[d0] = __builtin_amdgcn_mfma_f32_32x32x16_bf16(pa0, (bf16x8){l0[0], l0[1], l0[2], l0[3], h0[0], h0[1], h0[2], h0[3]}, o[d0], 0, 0, 0); \
        o[d0] = __builtin_amdgcn_mfma_f32_32x32x16_bf16(pa1, (bf16x8){l1[0], l1[1], l1[2], l1[3], h1[0], h1[1], h1[2], h1[3]}, o[d0], 0, 0, 0); \
        o[d0] = __builtin_amdgcn_mfma_f32_32x32x16_bf16(pa2, (bf16x8){l2[0], l2[1], l2[2], l2[3], h2[0], h2[1], h2[2], h2[3]}, o[d0], 0, 0, 0); \
        o[d0] = __builtin_amdgcn_mfma_f32_32x32x16_bf16(pa3, (bf16x8){l3[0], l3[1], l3[2], l3[3], h3[0], h3[1], h3[2], h3[3]}, o[d0], 0, 0, 0); } while (0)
    PV_D0(0); PV_D0(1); PV_D0(2); PV_D0(3);
#undef PV_D0
#undef TRRD
}

#define TILEP(p, k0) ((const char*)((p) + (size_t)(k0) * PITCH))
#define VMW() asm volatile("s_waitcnt vmcnt(0)" ::: "memory")
#define VMWN(n) asm volatile("s_waitcnt vmcnt(%0)" :: "i"(n) : "memory")
#define LD8(p) (*reinterpret_cast<const bf16x8*>(p))
#define LD8O(base, off) (*reinterpret_cast<const bf16x8*>((base) + (off)))
#if PROBE_MEM2 == 1
#define DUMV cur.dum
#define SLOAD_DUM(vt_, kt_) do { LAS unsigned* dl_ = (LAS unsigned*)(lds + 114688 + wid * 1024); \
        __builtin_amdgcn_global_load_lds((const unsigned*)(vt_ + DUMV + roff0), dl_, 16, 0, 0); __builtin_amdgcn_global_load_lds((const unsigned*)(vt_ + DUMV + roff1), dl_, 16, 0, 0); \
        __builtin_amdgcn_global_load_lds((const unsigned*)(kt_ + DUMV + roff0), dl_, 16, 0, 0); __builtin_amdgcn_global_load_lds((const unsigned*)(kt_ + DUMV + roff1), dl_, 16, 0, 0); } while (0)
#define SLOAD_DUMN(vt_, kt_) do { LAS unsigned* dl_ = (LAS unsigned*)(lds + 114688 + wid * 1024); \
        __builtin_amdgcn_global_load_lds((const unsigned*)(vt_ + dumn_ + roff0), dl_, 16, 0, 0); __builtin_amdgcn_global_load_lds((const unsigned*)(vt_ + dumn_ + roff1), dl_, 16, 0, 0); \
        __builtin_amdgcn_global_load_lds((const unsigned*)(kt_ + dumn_ + roff0), dl_, 16, 0, 0); __builtin_amdgcn_global_load_lds((const unsigned*)(kt_ + dumn_ + roff1), dl_, 16, 0, 0); } while (0)
#else
#define SLOAD_DUM(vt_, kt_) do { } while (0)
#define SLOAD_DUMN(vt_, kt_) do { } while (0)
#endif
#define SLOAD_HN(Kp, Vp, k0) do { const char* vt_ = TILEP(Vp, k0); const char* kt_ = TILEP(Kp, k0); S.st_v0 = LD8O(vt_, roff0); S.st_v1 = LD8O(vt_, roff1); S.st_k0 = LD8O(kt_, roff0); S.st_k1 = LD8O(kt_, roff1); SLOAD_DUMN(vt_, kt_); } while (0)
#if PROBE_MEM2 == 2
#define SLOAD_H(Kp, Vp, k0) do { const char* vt_ = TILEP(Vp, k0); const char* kt_ = TILEP(Kp, k0); S.st_v0 = LD8O(vt_, roff0); S.st_v1 = LD8O(vt_, roff1); S.st_k0 = LD8O(kt_, roff0); S.st_k1 = LD8O(kt_, roff1); \
        { const int kp_ = min((k0) + PFD * KVBLK, kmax_); const char* vp_ = TILEP(Vp, kp_); const char* kq_ = TILEP(Kp, kp_); LAS unsigned* dl_ = (LAS unsigned*)(lds + 114688 + wid * 1024); \
          __builtin_amdgcn_global_load_lds((const unsigned*)(vp_ + roff0), dl_, 16, 0, 0); __builtin_amdgcn_global_load_lds((const unsigned*)(vp_ + roff1), dl_, 16, 0, 0); \
          __builtin_amdgcn_global_load_lds((const unsigned*)(kq_ + roff0), dl_, 16, 0, 0); __builtin_amdgcn_global_load_lds((const unsigned*)(kq_ + roff1), dl_, 16, 0, 0); } } while (0)
#else
#define SLOAD_H(Kp, Vp, k0) do { const char* vt_ = TILEP(Vp, k0); const char* kt_ = TILEP(Kp, k0); S.st_v0 = LD8O(vt_, roff0); S.st_v1 = LD8O(vt_, roff1); S.st_k0 = LD8O(kt_, roff0); S.st_k1 = LD8O(kt_, roff1); SLOAD_DUM(vt_, kt_); } while (0)
#endif
#define SWRITE_HK(so) do { *(LAS bf16x8*)(K_lds + (so) + kws) = S.st_k0; *(LAS bf16x8*)(K_lds + (so) + kws + 32 * 256) = S.st_k1; } while (0)
#define SWRITE_HV(so) do { *(LAS bf16x8*)(V_lds + (so) + vst0) = S.st_v0; *(LAS bf16x8*)(V_lds + (so) + vst1) = S.st_v1; } while (0)
#define SWRITE_H(so) do { SWRITE_HV(so); SWRITE_HK(so); } while (0)

__device__ __forceinline__ void prime(const Unit& cur, LAS char* lds, Seam& S, int wave_) {
    int z_ = 0; asm volatile("" : "+v"(z_)); const int tid = wave_ * 64 + (int)__builtin_amdgcn_mbcnt_hi(~0u, __builtin_amdgcn_mbcnt_lo(~0u, (unsigned)z_));
    const int wid = __builtin_amdgcn_readfirstlane(tid >> 6), lane = tid & 63, r32 = lane & 31, hi = lane >> 5;
    const int sr = tid >> 4, sc = (tid & 15) * 8, kws = KSWZ(sr, sc * 2); LAS char* K_lds = lds + OFF_K;
    const unsigned roff0 = (unsigned)(sr * PITCH + sc) * 2u, roff1 = roff0 + 32u * PITCH * 2u, qoff = (unsigned)(r32 * PITCH + hi * 8) * 2u;
    { const char* qb_ = (const char*)(cur.Q + (size_t)(wid * QBLK) * PITCH);
#pragma unroll
    for (int d0 = 0; d0 < 8; ++d0) S.qr[d0] = LD8O(qb_, qoff + d0 * 32); }
    const int kmax_ = (4 * (cur.qb + 1) - 1) * KVBLK; (void)kmax_;
    SLOAD_H(cur.K, cur.V, cur.jlo * KVBLK); VMW(); SWRITE_HK(0);
    __syncthreads();
}
__device__ __forceinline__ void block(const Unit& cur, Unit& nxt, bool& more, const Queue& Qd, float slope2, float M2, LAS char* lds, Seam& S, int wave_, unsigned long long& pacc) {
#define PS0(k) unsigned long long pt##k##_ = 0; if (PROBE_SEC == (k)) pt##k##_ = __builtin_amdgcn_s_memtime()
#define PS1(k) do { if (PROBE_SEC == (k)) pacc += __builtin_amdgcn_s_memtime() - pt##k##_; } while (0)
    PS0(6); PS0(4);
    int z_ = 0; asm volatile("" : "+v"(z_)); const int tid = wave_ * 64 + (int)__builtin_amdgcn_mbcnt_hi(~0u, __builtin_amdgcn_mbcnt_lo(~0u, (unsigned)z_));
    const int wid = __builtin_amdgcn_readfirstlane(tid >> 6), lane = tid & 63, r32 = lane & 31, hi = lane >> 5;
    const unsigned roff0 = (unsigned)((tid >> 4) * PITCH + (tid & 15) * 8) * 2u, roff1 = roff0 + 32u * PITCH * 2u, qoff = (unsigned)(r32 * PITCH + hi * 8) * 2u;
    const int jlo = cur.jlo, NT = 4 * (cur.qb + 1) - jlo;
    LAS char* V_lds = lds + OFF_V; LAS char* K_lds = lds + OFF_K;
    LAS float* li_l = (LAS float*)(lds + OFF_WS) + wid * 64;
    float l_reg = 0; f32x16 o[4] = {};
    const int sr = tid >> 4, sc = (tid & 15) * 8, vst0 = v_st(sr, sc), vst1 = v_st(32 + sr, sc), kws = KSWZ(sr, sc * 2);
    const int vb0 = (int)(unsigned)(size_t)V_lds + v_rd_base(lane);
    const bf16* Kh = cur.K; const bf16* Vh = cur.V; const int kmax_ = (4 * (cur.qb + 1) - 1) * KVBLK; (void)kmax_;
    const int tq = cur.qb * QB + wid * QBLK + r32;
    {
        const int n = sr & 15; const float* kp = cur.KM + n * HD + sc;
        const f32x4 a = *(const f32x4*)kp, b = *(const f32x4*)(kp + 4);
        float v[8] = {a.x, a.y, a.z, a.w, b.x, b.y, b.z, b.w}; unsigned w[4];
#pragma unroll
        for (int e = 0; e < 4; ++e) { const unsigned h0 = f2bf(v[2 * e]), h1 = f2bf(v[2 * e + 1]);
            if (sr < 16) w[e] = h0 | (h1 << 16); else w[e] = pk2(v[2 * e] - bflo(h0), v[2 * e + 1] - bflo(h1)); }
        *(LAS u32x4*)(lds + OFF_KM + KSWZ(sr, sc * 2)) = (u32x4){w[0], w[1], w[2], w[3]};
    }
    if (tid == 0) *(LAS unsigned*)(lds + OFF_TK) = __hip_atomic_fetch_add(Qd.ctr, 1u, __ATOMIC_RELAXED, __HIP_MEMORY_SCOPE_AGENT);
    __syncthreads();
    { const unsigned tnext = (unsigned)__builtin_amdgcn_readfirstlane((int)*(const LAS unsigned*)(lds + OFF_TK));
      more = unit_from_ticket(tnext, Qd, lds, nxt); if (!more) nxt = cur; }
    unsigned selmask = 0;
    {
        f32x16 pg = f32x16{};
#pragma unroll
        for (int d0 = 0; d0 < 8; ++d0) { const bf16x8 a = *reinterpret_cast<const LAS bf16x8*>(lds + OFF_KM + KSWZ(r32, (d0 * 16 + hi * 8) * 2));
            pg = __builtin_amdgcn_mfma_f32_32x32x16_bf16(a, S.qr[d0], pg, 0, 0, 0); }
        float g[16];
#pragma unroll
        for (int j = 0; j < 8; ++j) { const float mine = pg[j] + pg[j + 8], oth = __shfl_xor(mine, 32); const int n0 = (j & 3) + 8 * (j >> 2);
            g[n0] = hi ? oth : mine; g[n0 + 4] = hi ? mine : oth; }
        float v0 = -__builtin_inff(), v1 = v0, v2 = v0; int i0 = 0, i1 = 0, i2 = 0;
#pragma unroll
        for (int n = 0; n < 16; ++n) { const float gt = n < cur.qb ? g[n] : -__builtin_inff();
            if (gt > v0) { v2 = v1; i2 = i1; v1 = v0; i1 = i0; v0 = gt; i0 = n; }
            else if (gt > v1) { v2 = v1; i2 = i1; v1 = gt; i1 = n; }
            else if (gt > v2) { v2 = gt; i2 = n; } }
        if (v0 > -__builtin_inff()) selmask |= 1u << i0;
        if (v1 > -__builtin_inff()) selmask |= 1u << i1;
        if (v2 > -__builtin_inff()) selmask |= 1u << i2;
    }
    const float basec = -M2 + slope2 * (float)(4 * hi - tq);
    const int ownt = 4 * cur.qb - jlo;
#define KBASE(t) ((jlo + (t)) * KVBLK)
#define TBASE(t) (((t) >= ownt || ((selmask >> ((jlo + (t)) >> 2)) & 1u)) ? fmaf(slope2, (float)KBASE(t), basec) : -__builtin_inff())
#define MASKT(P0_, P1_, t) do { if ((t) >= ownt && KBASE(t) + KVBLK - 1 > cur.qb * QB + wid * QBLK) mask_tile(P0_, P1_, tq - 4 * hi - KBASE(t)); } while (0)
    f32x16 pA0, pA1, pB0, pB1; bf16x8 pa0, pa1, pa2, pa3;
    const LAS char* kbase[4];
#pragma unroll
    for (int dd = 0; dd < 4; ++dd) kbase[dd] = K_lds + KSWZ(r32, (dd * 16 + hi * 8) * 2);
    SWRITE_HV(0); SBAR();
    SLOAD_H(Kh, Vh, KBASE(1));
    SBAR(); qkt(pA0, pA1, kbase, 0, S.qr);
    MASKT(pA0, pA1, 0); partialSM(pA0, pA1, TBASE(0), slope2);
    VMW(); SWRITE_H(SHM_K); SBAR(); SLOAD_H(Kh, Vh, KBASE(2));
    __syncthreads();
    int sp = 0, scur = SHM_K, sn = 2 * SHM_K;
    bf16x8 kf0[2], kf1[2]; s16x4 vA[8], vB[8]; float psa, psb; unsigned ra0_, ra1_;
#define KRD(d0_, s_) do { const LAS char* a_ = kbase[(d0_) & 3] + scur + ((d0_) >> 2) * 128; kf0[s_] = *reinterpret_cast<const LAS bf16x8*>(a_); kf1[s_] = *reinterpret_cast<const LAS bf16x8*>(a_ + 32 * 256); } while (0)
#define TRRD2(dst, off) asm volatile("ds_read_b64_tr_b16 %0, %1 offset:%2" : "=&v"(dst) : "v"(vaddr_), "i"(off) : "memory")
#define FINC(k, Y0, Y1) do { \
        if ((k) < 8) { Y1[2 * ((k) & 7)] = __builtin_amdgcn_exp2f(Y1[2 * ((k) & 7)]); Y1[2 * ((k) & 7) + 1] = __builtin_amdgcn_exp2f(Y1[2 * ((k) & 7) + 1]); \
            if ((k) == 0) { psa = Y0[0]; psb = Y0[1]; } else { psa += Y0[2 * ((k) & 7)]; psb += Y0[2 * ((k) & 7) + 1]; } } \
        else { constexpr int j_ = (k) & 7, m_ = j_ >> 1, b_ = (m_ & 1) * 8; psa += Y1[2 * j_]; psb += Y1[2 * j_ + 1]; \
            if ((j_ & 1) == 0) { const unsigned a0_ = m_ < 2 ? cvtpk(Y0[b_], Y0[b_ + 1]) : cvtpk(Y1[b_], Y1[b_ + 1]), b0_ = m_ < 2 ? cvtpk(Y0[b_ + 4], Y0[b_ + 5]) : cvtpk(Y1[b_ + 4], Y1[b_ + 5]); \
                auto r_ = __builtin_amdgcn_permlane32_swap(a0_, b0_, false, false); ra0_ = r_[0]; ra1_ = r_[1]; } \
            else { const unsigned a1_ = m_ < 2 ? cvtpk(Y0[b_ + 2], Y0[b_ + 3]) : cvtpk(Y1[b_ + 2], Y1[b_ + 3]), b1_ = m_ < 2 ? cvtpk(Y0[b_ + 6], Y0[b_ + 7]) : cvtpk(Y1[b_ + 6], Y1[b_ + 7]); \
                auto r_ = __builtin_amdgcn_permlane32_swap(a1_, b1_, false, false); u32x4 w_ = {ra0_, r_[0], ra1_, r_[1]}; \
                if (m_ == 0) pa0 = *reinterpret_cast<bf16x8*>(&w_); else if (m_ == 1) pa1 = *reinterpret_cast<bf16x8*>(&w_); else if (m_ == 2) pa2 = *reinterpret_cast<bf16x8*>(&w_); else pa3 = *reinterpret_cast<bf16x8*>(&w_); } } \
        if ((k) >= 12) { constexpr int f_ = 2 * ((k) - 12), o_ = v_rd_off(0, 0, 0) + 2048 * f_; TRRD2(vA[f_ & 7], o_ & 0xffff); TRRD2(vA[(f_ + 1) & 7], (o_ + 2048) & 0xffff); } } while (0)
#define QKG(d0, PX0, PX1, PY0, PY1) do { \
        if ((d0) < 7) KRD(((d0) + 1) & 7, ((d0) + 1) & 1); \
        SBAR(); \
        PX0 = __builtin_amdgcn_mfma_f32_32x32x16_bf16(kf0[(d0) & 1], S.qr[d0], (d0) == 0 ? f32x16{} : PX0, 0, 0, 0); \
        SBAR(); FINC(2 * (d0), PY0, PY1); SBAR(); \
        PX1 = __builtin_amdgcn_mfma_f32_32x32x16_bf16(kf1[(d0) & 1], S.qr[d0], (d0) == 0 ? f32x16{} : PX1, 0, 0, 0); \
        SBAR(); FINC(2 * (d0) + 1, PY0, PY1); SBAR(); } while (0)
#define SMC(k, X0, X1) do { constexpr float c_ = (float)(((k) & 3) + 8 * ((k) >> 2)); \
        X0[k] = __builtin_amdgcn_exp2f(fmaf(X0[k], LOG2E * SCALE, fmaf(slope2, c_, tb_))); X1[k] = fmaf(X1[k], LOG2E * SCALE, fmaf(slope2, c_ + 32.f, tb_)); asm volatile("" :: "v"(X1[k])); } while (0)
#define FRV(A, j) (bf16x8){A[2 * (j)][0], A[2 * (j)][1], A[2 * (j)][2], A[2 * (j)][3], A[2 * (j) + 1][0], A[2 * (j) + 1][1], A[2 * (j) + 1][2], A[2 * (j) + 1][3]}
#define PVG(d0, CUR, NXT, X0, X1) do { constexpr int n_ = v_rd_off(((d0) + 1) & 3, 0, 0); \
        asm volatile("s_waitcnt lgkmcnt(0)" ::: "memory"); SBAR(); \
        o[d0] = __builtin_amdgcn_mfma_f32_32x32x16_bf16(pa0, FRV(CUR, 0), o[d0], 0, 0, 0); SBAR(); \
        if ((d0) < 3) { TRRD2(NXT[0], n_); TRRD2(NXT[1], n_ + 2048); TRRD2(NXT[2], n_ + 4096); TRRD2(NXT[3], n_ + 6144); } SMC(4 * (d0) + 0, X0, X1); SBAR(); \
        o[d0] = __builtin_amdgcn_mfma_f32_32x32x16_bf16(pa1, FRV(CUR, 1), o[d0], 0, 0, 0); SBAR(); \
        if ((d0) < 3) { TRRD2(NXT[4], n_ + 8192); TRRD2(NXT[5], n_ + 10240); TRRD2(NXT[6], n_ + 12288); TRRD2(NXT[7], n_ + 14336); } SMC(4 * (d0) + 1, X0, X1); SBAR(); \
        o[d0] = __builtin_amdgcn_mfma_f32_32x32x16_bf16(pa2, FRV(CUR, 2), o[d0], 0, 0, 0); SBAR(); SMC(4 * (d0) + 2, X0, X1); SBAR(); \
        o[d0] = __builtin_amdgcn_mfma_f32_32x32x16_bf16(pa3, FRV(CUR, 3), o[d0], 0, 0, 0); SBAR(); SMC(4 * (d0) + 3, X0, X1); SBAR(); } while (0)
#define STEP(PX0, PX1, PY0, PY1, t, LAST) do { \
        PS0(0); KRD(0, 0); const float tb_ = TBASE(t); const int vaddr_ = vb0 + sp; \
        if (!(LAST)) { VMW(); SWRITE_H(sn); SBAR(); if ((t) + 2 < NT) SLOAD_H(Kh, Vh, KBASE((t) + 2)); } \
        PS1(0); PS0(1); QKG(0, PX0, PX1, PY0, PY1); QKG(1, PX0, PX1, PY0, PY1); QKG(2, PX0, PX1, PY0, PY1); QKG(3, PX0, PX1, PY0, PY1); \
        QKG(4, PX0, PX1, PY0, PY1); QKG(5, PX0, PX1, PY0, PY1); QKG(6, PX0, PX1, PY0, PY1); QKG(7, PX0, PX1, PY0, PY1); \
        { float ps_ = psa + psb; auto rr_ = __builtin_amdgcn_permlane32_swap(__float_as_uint(ps_), __float_as_uint(ps_), false, false); l_reg += __uint_as_float(rr_[0]) + __uint_as_float(rr_[1]); } \
        asm volatile("" : "+v"(pa0), "+v"(pa1), "+v"(pa2), "+v"(pa3), "+v"(l_reg)); PS1(1); PS0(2); \
        if (LAST) { SBAR(); const char* nq_ = (const char*)(nxt.Q + (size_t)(wid * QBLK) * PITCH); \
            _Pragma("unroll") for (int d0 = 0; d0 < 8; ++d0) S.qr[d0] = LD8O(nq_, qoff + d0 * 32); SBAR(); \
            { const long dumn_ = PROBE_MEM2 == 1 ? nxt.dumv() : 0; (void)dumn_; SLOAD_HN(nxt.K, nxt.V, nxt.jlo * KVBLK); } SBAR(); }                   \
        MASKT(PX0, PX1, (t)); \
        PVG(0, vA, vB, PX0, PX1); PVG(1, vB, vA, PX0, PX1); PVG(2, vA, vB, PX0, PX1); PVG(3, vB, vA, PX0, PX1); \
        asm volatile("" : "+v"(PX0), "+v"(PX1)); PS1(2); PS0(3); \
        __syncthreads(); PS1(3); \
        { const int r_ = sp; sp = scur; scur = sn; sn = r_; } } while (0)
    PS1(4);
    int t = 1;
    for (; t + 1 < NT; t += 2) { STEP(pB0, pB1, pA0, pA1, t, false); STEP(pA0, pA1, pB0, pB1, t + 1, false); }
    STEP(pB0, pB1, pA0, pA1, t, true);
#undef STEP
#undef PVG
#undef FRV
#undef SMC
#undef QKG
#undef FINC
#undef TRRD2
#undef KRD
    PS0(5);
    finishSM(pB0, pB1, l_reg, pa0, pa1, pa2, pa3); SBAR();
    pv_tile(o, vb0 + sp, pa0, pa1, pa2, pa3);
    SBAR(); VMW(); SWRITE_HK(0); SBAR();
    if (hi == 0) li_l[r32] = l_reg;
    char* Ow = (char*)(const_cast<bf16*>(cur.Q) + (size_t)(wid * QBLK) * PITCH);
    const char* Gw = Ow + (C_G - C_Q) * 2;
    u32x4 gv[8];
#pragma unroll
    for (int i = 0; i < 8; ++i) { const int j = (i & 1) * 64 + lane; gv[i] = *(const u32x4*)(Gw + (unsigned)((j >> 2) * PITCH + (i >> 1) * 32 + (j & 3) * 8) * 2u); }
    asm volatile("s_waitcnt lgkmcnt(0)" ::: "memory");
    float rl[16];
#pragma unroll
    for (int r = 0; r < 16; ++r) rl[r] = __builtin_amdgcn_rcpf(li_l[crow(r, hi)]);
    LAS float* stg = (LAS float*)(lds + OFF_K + SHM_K + wid * 4096);
#pragma unroll
    for (int d0 = 0; d0 < 4; ++d0) {
#pragma unroll
        for (int r = 0; r < 16; ++r) stg[crow(r, hi) * 32 + r32] = o[d0][r] * rl[r];
#pragma unroll
        for (int k = 0; k < 2; ++k) { const int j = k * 64 + lane, row = j >> 2, cq = j & 3;
            const f32x4 a = *(const LAS f32x4*)(stg + row * 32 + cq * 8), b = *(const LAS f32x4*)(stg + row * 32 + cq * 8 + 4);
            const u32x4 g = gv[d0 * 2 + k]; u32x4 w;
            w.x = cvtpk(a[0] * bflo(g.x & 0xffffu), a[1] * __uint_as_float(g.x & 0xffff0000u)); w.y = cvtpk(a[2] * bflo(g.y & 0xffffu), a[3] * __uint_as_float(g.y & 0xffff0000u));
            w.z = cvtpk(b[0] * bflo(g.z & 0xffffu), b[1] * __uint_as_float(g.z & 0xffff0000u)); w.w = cvtpk(b[2] * bflo(g.w & 0xffffu), b[3] * __uint_as_float(g.w & 0xffff0000u));
            *(u32x4*)(Ow + (unsigned)(row * PITCH + d0 * 32 + cq * 8) * 2u) = w; }
    }
    __syncthreads();
    PS1(5); PS1(6);
#undef PS0
#undef PS1
#undef KBASE
#undef TBASE
#undef MASKT
#undef HALF_STEP
}
#undef TILEP
#undef LD8O
#undef VMW
#undef VMWN
#undef LD8
#undef SLOAD_H
#undef SWRITE_HK
#undef SWRITE_HV
#undef SWRITE_H
#undef KSWZ
#undef SBAR
}

__device__ __forceinline__ int attn_window(float slope2, float M2) {
    int w = 0;
#pragma unroll 1
    for (int j = 0; j < 15; ++j) if (slope2 * (float)(256 * j + 1) < 2.f * M2 + 48.f) w = j + 1;
    return w;
}
__device__ __forceinline__ void attn_phase(Frame& F, int layer) {
    unsigned long long pt7_ = 0; if (PROBE_SEC == 7) pt7_ = __builtin_amdgcn_s_memtime();
    bf16* const PROJ = WSP(bf16, WS_PROJ); const float* const KM = WSP(float, WS_KM);
    const float* qw = in_ptr(3) + layer * HD; const float* kw = in_ptr(4) + layer * HD;
    const float mq = wave_max(fmaxf(fabsf(qw[2 * F.lane]), fabsf(qw[2 * F.lane + 1]))), mk = wave_max(fmaxf(fabsf(kw[2 * F.lane]), fabsf(kw[2 * F.lane + 1])));
    float m2v_ = 11.313708499f * mq * mk * 1.02f * moba::LOG2E; asm volatile("" : "+v"(m2v_));
    const float M2 = __uint_as_float((unsigned)__builtin_amdgcn_readfirstlane((int)__float_as_uint(m2v_)));
    LAS char* lds = (LAS char*)(F.lds + RING_OFF);
    {
        LAS int* const WT = (LAS int*)(lds + moba::OFF_WT); LAS int* const CNT = WT + 8;
        if (F.tid < 8) WT[F.tid] = attn_window(exp2f(-(float)(F.tid + 1)) * moba::LOG2E, M2);
        __syncthreads();
        int W[8];
        { const v4u w0 = *(const LAS v4u*)WT, w1 = *(const LAS v4u*)(WT + 4); W[0] = (int)w0.x; W[1] = (int)w0.y; W[2] = (int)w0.z; W[3] = (int)w0.w; W[4] = (int)w1.x; W[5] = (int)w1.y; W[6] = (int)w1.z; W[7] = (int)w1.w; }
#define NCOST(c, hh) (((c) - 1 < W[hh]) ? 1 : (((c) - 1 == W[hh]) ? 16 - W[hh] : 0))
        if (F.tid < 17) { int n = 0;
#pragma unroll
            for (int hh = 0; hh < 8; ++hh) n += NCOST(F.tid, hh);
            CNT[F.tid] = F.tid == 0 ? 0 : n; }
        __syncthreads();
#pragma unroll 1
        for (int u = F.tid; u < BATCH * NH * NBLK; u += NWAVES * 64) {
            const int b = u >> 7, h = (u >> 4) & 7, qb = u & 15;
            int wh = 0;
#pragma unroll
            for (int hh = 0; hh < 8; ++hh) wh = (h == hh) ? W[hh] : wh;
            const int c = (qb < wh ? qb : wh) + 1;
            int above = 0;
#pragma unroll
            for (int cc = 2; cc <= 16; ++cc) above += (cc > c) ? CNT[cc] : 0;
            int nbefore = 0;
#pragma unroll
            for (int hh = 0; hh < 8; ++hh) nbefore += (hh < h) ? NCOST(c, hh) : 0;
            const int pos = BATCH * above + b * CNT[c] + nbefore + ((c - 1 == wh) ? qb - wh : 0);
            ((LAS unsigned short*)(lds + moba::OFF_ORD))[pos] = (unsigned short)u;
        }
#undef NCOST
    }
    moba::Queue Qd{WSP(unsigned, WS_CTL) + CW_AQ + 64 * layer, PROJ, KM};
    if (F.tid == 0) *(LAS unsigned*)(lds + moba::OFF_TK) = __hip_atomic_fetch_add(Qd.ctr, 1u, __ATOMIC_RELAXED, __HIP_MEMORY_SCOPE_AGENT);
    __syncthreads();
    moba::Unit cur, nxt; moba::Seam S;
    { const unsigned t0 = (unsigned)__builtin_amdgcn_readfirstlane((int)*(const LAS unsigned*)(lds + moba::OFF_TK));
      if (!moba::unit_from_ticket(t0, Qd, lds, cur)) return; }
    __syncthreads();
    moba::prime(cur, lds, S, F.wave);
    if (ATT_PRIO && F.wave >= 4) __builtin_amdgcn_s_setprio(1);
    unsigned long long pacc = 0; if (PROBE_SEC == 7) pacc = __builtin_amdgcn_s_memtime() - pt7_;
    for (;;) {
        bool more;
        const float slope2 = exp2f(-(float)(cur.h + 1)) * moba::LOG2E;
        moba::block(cur, nxt, more, Qd, slope2, M2, lds, S, F.wave, pacc);
        if (!more) break;
        cur = nxt;
    }
    if (ATT_PRIO) __builtin_amdgcn_s_setprio(0);
    if (PROBE_SEC >= 0) { const unsigned long long t0 = __builtin_amdgcn_s_memtime(); while (__builtin_amdgcn_s_memtime() - t0 < pacc) __builtin_amdgcn_s_sleep(8); }
}

__global__ void __launch_bounds__(NWAVES * 64, 2) mk_fwd(Args args) {
    extern __shared__ __attribute__((aligned(16))) unsigned char lds[];
    Frame F;
    F.lds = (LAS unsigned char*)lds;
    F.MISC = (volatile LAS unsigned*)(F.lds + MISC_OFF);
    F.tid = threadIdx.x; F.lane = F.tid & 63; F.wave = __builtin_amdgcn_readfirstlane(F.tid >> 6);
    F.G = gridDim.x; { const int bx = blockIdx.x; F.vcu = (F.G % 8 == 0) ? (bx % 8) * (F.G / 8) + bx / 8 : bx; }
    for (int u = F.tid; u < (LDS_BYTES - LDSCTL_OFF) / 4; u += NWAVES * 64) ((LAS unsigned*)(F.lds + LDSCTL_OFF))[u] = 0u;
    __syncthreads();
    XcdBarrier bar; bar.bar = nullptr; bar.x = 0; bar.st = nullptr;
    if (N_LAUNCHES == 1) bar = xcd_barrier_post(WSP(unsigned, WS_CTL) + CW_BAR, F.MISC + 8);
    const int lo = args.ph_lo, hi = args.ph_hi;
#define IN(k) (lo <= (k) && (k) < hi)
#define REFRESH() do { int z_ = 0; asm volatile("" : "+v"(z_)); asm volatile("" : "+s"(F.wave), "+s"(F.vcu), "+s"(F.G)); \
        F.lane = (int)__builtin_amdgcn_mbcnt_hi(~0u, __builtin_amdgcn_mbcnt_lo(~0u, (unsigned)z_)); F.tid = F.wave * 64 + F.lane; } while (0)
#define SEAM(k) do { if (IN(k) && IN((k) + 1)) { bar.bar = WSP(unsigned, WS_CTL) + CW_BAR; xcd_barrier(bar, F.wave); if (PROBE_BAR2) xcd_barrier(bar, F.wave); } } while (0)
#define PROBE_T0(ph) unsigned long long pt0_ = 0; if (PROBE_PH == (ph)) pt0_ = __builtin_amdgcn_s_memrealtime()
#define PROBE_T1(ph) do { if (PROBE_PH == (ph)) { const unsigned long long pt1_ = __builtin_amdgcn_s_memrealtime(); while (__builtin_amdgcn_s_memrealtime() - pt1_ < pt1_ - pt0_) __builtin_amdgcn_s_sleep(8); } } while (0)

#pragma unroll 1
    for (int layer = 0; layer < DEPTH; ++layer) {
        const int pb = layer * 6;
        { PROBE_T0(0); if (IN(pb + 0)) { REFRESH(); phase_a(F, layer); } SEAM(pb + 0); PROBE_T1(0); }
        { PROBE_T0(1); if (IN(pb + 1)) {
            REFRESH();
            pg8::Gemm g{WSP(bf16, WS_A), WSP(bf16, WS_WIN), M, PITCH, DM, DM}; pg8::StaticOrder S; S.init(M, PITCH, F.G, (int)blockIdx.x);
            if (F.tid < 256) ((LAS float*)(F.lds + RING_BYTES + 10240))[F.tid] = (F.tid < 128 ? in_ptr(3) + layer * HD : in_ptr(4) + layer * HD - 128)[F.tid];
            __syncthreads();
            pg8::EpiProj E{WSP(bf16, WS_PROJ), PITCH, in_ptr(3) + layer * HD, in_ptr(4) + layer * HD, WSP(float, WS_KM), F.lds + RING_BYTES, EPS, WSP(float, WS_RSTD)};
            static_assert(GEMM1_ALIGN, "EpiProj's in-epilogue barriers need both half-workgroups in the epilogue together");
            if (WOUT_IN_B && (F.vcu & 1)) {
                LAS float* scr = (LAS float*)(F.lds + RING_OFF + F.wave * 16384);
                const float* wout = in_ptr(11) + (size_t)layer * 2048 * DM; bf16* const WoutT = WSP(bf16, WS_WOUT);
                for (int it = (F.vcu >> 1) * NWAVES + F.wave; it < (2048 / 64) * (1024 / 32); it += (F.G >> 1) * NWAVES)
                    transpose_item(wout, DM, 2048, 1024, WoutT, 0, scr, it, F.lane, in_ptr(10) + (size_t)layer * 1024, 1024);
                __syncthreads();
            }
            if (PROBE_BSKEW > 0 && (F.vcu & (BSKEW_N - 1))) { const unsigned long long t0_ = __builtin_amdgcn_s_memrealtime(); while (__builtin_amdgcn_s_memrealtime() - t0_ < (unsigned long long)(PROBE_BSKEW * (F.vcu & (BSKEW_N - 1))) * 10) __builtin_amdgcn_s_sleep(8); }
            pg8::gemm_phase<pg8::EpiProj, pg8::StaticOrder, GEMM1_ALIGN, GEMM1_SP2>(F.lds + RING_OFF, g, S, E, F.tid);
        } SEAM(pb + 1); PROBE_T1(1); }
        { PROBE_T0(2); if (IN(pb + 2)) { REFRESH(); phase_c(F, layer); } SEAM(pb + 2); PROBE_T1(2); }
        { PROBE_T0(3); if (IN(pb + 3)) {
            { PROBE_T0(6); REFRESH(); ssd_phase(F, layer); __syncthreads(); PROBE_T1(6);
              if ((PROBE_SSDFIX > 0 && (F.vcu & 1) == 0) || (PROBE_SSDFIX < 0 && (F.vcu & 1) == 1)) { const unsigned long long t0_ = __builtin_amdgcn_s_memrealtime(); while (__builtin_amdgcn_s_memrealtime() - t0_ < (unsigned long long)(PROBE_SSDFIX < 0 ? -PROBE_SSDFIX : PROBE_SSDFIX) * 100) __builtin_amdgcn_s_sleep(8); } }
            { PROBE_T0(7); REFRESH(); attn_phase(F, layer); PROBE_T1(7); }
        } if (IN(pb + 3) && IN(pb + 5)) { bar.bar = WSP(unsigned, WS_CTL) + CW_BAR; xcd_barrier(bar, F.wave); } PROBE_T1(3); }
        { PROBE_T0(5); if (IN(pb + 5)) {
            REFRESH();
            float* const OUTP = out_ptr(); const float* base = layer == 0 ? in_ptr(0) : OUTP;
            pg8::Gemm g{WSP(bf16, WS_PROJ), WSP(bf16, WS_WOUT), M, DM, 2048, PITCH}; pg8::StaticOrder S; S.init(M, DM, F.G, (int)blockIdx.x);
            pg8::EpiResScale E{base, OUTP, DM, WSP(float, WS_SSQ), F.lds + RING_BYTES, EPS, layer == DEPTH - 1};
            if (PROBE_FSKEW > 0 && (F.vcu & 1)) { const unsigned long long t0_ = __builtin_amdgcn_s_memrealtime(); while (__builtin_amdgcn_s_memrealtime() - t0_ < (unsigned long long)PROBE_FSKEW * 100) __builtin_amdgcn_s_sleep(8); }
            pg8::gemm_phase<pg8::EpiResScale, pg8::StaticOrder, GEMM2_ALIGN, GEMM2_SP2>(F.lds + RING_OFF, g, S, E, F.tid);
        } SEAM(pb + 5); PROBE_T1(5); }
    }
#undef IN
#undef SEAM
}

extern "C" void kernel_launch(void* const* d_in, const int* in_sizes, int n_in, void* d_out, int out_size, void* d_ws, size_t ws_size, hipStream_t stream) {
    static int grid = 0;
    if (grid == 0) {
        if (n_in != 12 || in_sizes[0] != M * DM || out_size != M * DM || ws_size < WS_END) {
            fprintf(stderr, "kernel_launch: unexpected shapes (n_in %d, in0 %d, out %d, ws %zu); nothing launched\n", n_in, n_in > 0 ? in_sizes[0] : -1, out_size, ws_size); grid = -1; return; }
        int dev = 0, cus = 0, per_cu = 0;
        if (hipGetDevice(&dev) != hipSuccess || hipDeviceGetAttribute(&cus, hipDeviceAttributeMultiprocessorCount, dev) != hipSuccess) { grid = -1; return; }
        if (hipFuncSetAttribute((const void*)mk_fwd, hipFuncAttributeMaxDynamicSharedMemorySize, LDS_BYTES) != hipSuccess) { fprintf(stderr, "kernel_launch: hipFuncSetAttribute failed\n"); grid = -1; return; }
        if (hipOccupancyMaxActiveBlocksPerMultiprocessor(&per_cu, (const void*)mk_fwd, NWAVES * 64, LDS_BYTES) != hipSuccess || per_cu < 1) {
            fprintf(stderr, "kernel_launch: occupancy query reports %d workgroups per CU; nothing launched\n", per_cu); (void)hipGetLastError(); grid = -1; return; }
        grid = cus;
    }
    if (grid < 0) return;
    if (hipMemsetAsync((char*)d_ws + WS_CTL, 0, CTL_ZERO_BYTES, stream) != hipSuccess) { fprintf(stderr, "kernel_launch: hipMemsetAsync failed\n"); return; }
    Args a{};
    for (int i = 0; i < 12; ++i) a.in[i] = (const float*)d_in[i];
    a.out = (float*)d_out; a.ws = (unsigned char*)d_ws;
    for (int li = 0; li < N_LAUNCHES; ++li) {
        a.ph_lo = (N_LAUNCHES == 1) ? 0 : li; a.ph_hi = (N_LAUNCHES == 1) ? N_PHASES : li + 1; a.li = li;
        hipLaunchKernelGGL(mk_fwd, dim3(grid), dim3(NWAVES * 64), LDS_BYTES, stream, a);
        const hipError_t le = hipPeekAtLastError();
        if (le != hipSuccess) { fprintf(stderr, "kernel_launch: launch %d failed: %s\n", li, hipGetErrorName(le)); break; }
    }
}
```

```cpp
#include <hip/hip_runtime.h>
#include <cstdio>
#include <cstdint>
namespace pg8 {
#define PG8_LAS __attribute__((address_space(3)))
typedef unsigned short bf16_t;
typedef short bf16x8 __attribute__((ext_vector_type(8)));
typedef float f32x4 __attribute__((ext_vector_type(4)));
typedef unsigned u32x4 __attribute__((ext_vector_type(4)));
constexpr int BM = 256, BK = 64, HALF = 128, HTB = HALF * BK * 2  , STAGE_BYTES = 8 * HTB, NXCD = 8, WGM = 4;

__host__ __device__ __forceinline__ int lds_byte(int r, int c) { const int st = (r >> 4) * 2 + (c >> 5), rr = r & 15, cc = c & 31, ob = rr * 64 + cc * 2; return st * 1024 + (ob ^ (((ob >> 9) & 1) << 5)); }
__host__ __device__ __forceinline__ void stage_rc(int b, int& R, int& C) { const int st = b / 1024, sb = b % 1024, swz = sb ^ (((sb >> 9) & 1) << 5); R = (st >> 1) * 16 + swz / 64; C = (st & 1) * 32 + (swz % 64) / 2; }
__host__ __device__ __forceinline__ int perm32(int rho) { const int n = rho >> 4, i = rho & 15; return 8 * (i >> 2) + 4 * n + (i & 3); }

struct Unit { int pm, pn; };
struct Gemm { const bf16_t* A; const bf16_t* Bt; int M, N, K, lda; };

struct StaticOrder {
    int nM, nN, nwg, G, c;
    __host__ __device__ void init(int M, int N, int G_, int c_) { nM = M / BM; nN = N / BM; nwg = nM * nN; G = G_; c = c_; }
    __host__ __device__ bool next(int i, Unit& u) const {
        const long L = (long)i * G + c; if (L >= nwg) return false;
        int wgid = (int)L; { const int q = nwg / NXCD, r = nwg % NXCD, xcd = wgid % NXCD, off = wgid / NXCD; wgid = (xcd < r ? xcd * (q + 1) : r * (q + 1) + (xcd - r) * q) + off; }
        const int nig = WGM * nN, gid = wgid / nig, fm = gid * WGM, gsz = (nM - fm) < WGM ? (nM - fm) : WGM;
        u.pm = fm + ((wgid % nig) % gsz); u.pn = (wgid % nig) / gsz; return true;
    }
    __device__ __forceinline__ void a_ready(const Unit&) const {}
    __device__ __forceinline__ void done(const Unit&) const {}
};

__device__ __forceinline__ unsigned cvt_pk_bf16(float lo, float hi) { unsigned r; asm volatile("v_cvt_pk_bf16_f32 %0, %1, %2" : "=v"(r) : "v"(lo), "v"(hi)); return r; }
typedef float f32x2 __attribute__((ext_vector_type(2)));
__device__ __forceinline__ f32x2 gelu_pk(f32x2 v) {
    const f32x2 av = __builtin_elementwise_abs(v), d = av * 0.2316418882f + 1.0f;
    f32x2 t; t.x = __builtin_amdgcn_rcpf(d.x); t.y = __builtin_amdgcn_rcpf(d.y);
    f32x2 q = t * 0.5307027145f + (-0.7265760135f); q = q * t + 0.7107068705f; q = q * t + (-0.142248368f); q = q * t + 0.127414796f; q = q * t;
    const f32x2 s = (v * v) * (-0.72134752044f);
    f32x2 e; e.x = __builtin_amdgcn_exp2f(s.x); e.y = __builtin_amdgcn_exp2f(s.y);
    const f32x2 m = v * (q * e), r = v - m;
    f32x2 o; o.x = v.x < 0.f ? m.x : r.x; o.y = v.y < 0.f ? m.y : r.y; return o;
}

template <int ACT  > struct EpiBf16 {
    static constexpr bool PERM = true, AFTER_DRAIN = false; static_assert(ACT == 0 || ACT == 1, "EpiBf16: ACT is 0 (none) or 1 (gelu_pk)");
    bf16_t* O; int ldc; const float* bias; int split_cols; size_t split_stride; float scale0;
    __device__ __forceinline__ void operator()(const f32x4 (&acc)[2][2][4][2], const Unit& u, int wr, int wc, int fr, int fq) const {
        const int row0 = u.pm * BM + wr * 64 + fr; int colt = u.pn * BM; bf16_t* base = O;
        float sc = 1.f; if (split_cols) { const int t = colt / split_cols; base += (size_t)t * split_stride; colt -= t * split_cols; if (t == 0) sc = scale0; }
        const int col0 = colt + wc * 32 + 8 * fq, bcol0 = u.pn * BM + wc * 32 + 8 * fq;
        f32x4 bv[2][2];
#pragma unroll
        for (int bj = 0; bj < 2; ++bj)
#pragma unroll
            for (int n = 0; n < 2; ++n) bv[bj][n] = bias ? *(const f32x4*)(bias + bcol0 + bj * HALF + 4 * n) : (f32x4){0.f, 0.f, 0.f, 0.f};
#pragma unroll
        for (int ai = 0; ai < 2; ++ai)
#pragma unroll
            for (int m = 0; m < 4; ++m) { bf16_t* rowp = base + (size_t)(row0 + ai * HALF + m * 16) * ldc + col0;
#pragma unroll
                for (int bj = 0; bj < 2; ++bj) { f32x4 v0 = acc[ai][bj][m][0] + bv[bj][0], v1 = acc[ai][bj][m][1] + bv[bj][1];
                    if (ACT == 1) { f32x2 a = gelu_pk((f32x2){v0[0], v0[1]}), b = gelu_pk((f32x2){v0[2], v0[3]}), c = gelu_pk((f32x2){v1[0], v1[1]}), d = gelu_pk((f32x2){v1[2], v1[3]});
                        v0 = (f32x4){a.x, a.y, b.x, b.y}; v1 = (f32x4){c.x, c.y, d.x, d.y}; }
                    v0 = v0 * sc; v1 = v1 * sc; u32x4 w; w.x = cvt_pk_bf16(v0[0], v0[1]); w.y = cvt_pk_bf16(v0[2], v0[3]); w.z = cvt_pk_bf16(v1[0], v1[1]); w.w = cvt_pk_bf16(v1[2], v1[3]);
                    *(u32x4*)(rowp + bj * HALF) = w; } }
    }
};
template <class Epi, class Sched, bool ALIGN_EPI = false, bool SP2 = false>
__device__ __forceinline__ void gemm_phase(PG8_LAS unsigned char* lds, const Gemm g, const Sched& S, const Epi& E, int ptid_) {
    int tid_ = ptid_; asm volatile("" : "+v"(tid_));
    const int tid = tid_, wid = __builtin_amdgcn_readfirstlane(tid >> 6), lane = tid & 63, wr = wid >> 2, wc = wid & 3, fr = lane & 15, fq = lane >> 4;
    const int K = g.K, nt = K / BK;
    unsigned voffA[2], voffB[2];
#pragma unroll
    for (int i = 0; i < 2; ++i) { int R, C; stage_rc(tid * 16 + i * 8192, R, C); const int Rb = Epi::PERM ? ((R & ~31) + perm32(R & 31)) : R;
        voffA[i] = (unsigned)(R * g.lda + C) * 2u; voffB[i] = (unsigned)(Rb * K + C) * 2u; }
    const size_t kstep = (size_t)(BK * 2);
    const size_t hstep = (size_t)HALF * K * 2;
    const size_t tstep = 2 * hstep; const size_t hstepA = (size_t)HALF * g.lda * 2, tstepA = 2 * hstepA;
    const unsigned ldsw = (unsigned)wid * 1024u;
    const int aoff = lds_byte(wr * 64 + fr, fq * 8), boff = lds_byte(wc * 32 + fr, fq * 8);
#define PG8_SA(b, h) (((b) * 2 + (h)) * HTB)
#define PG8_SB(b, h) ((4 + (b) * 2 + (h)) * HTB)
#define PG8_STAGE(bufoff, gbase, voff) do { _Pragma("unroll") for (int _i = 0; _i < 2; ++_i) \
        __builtin_amdgcn_global_load_lds((const unsigned*)((const char*)(gbase) + (voff)[_i]), (PG8_LAS unsigned*)(lds + (bufoff) + ldsw + _i * 8192), 16, 0, 0); } while (0)
#define PG8_LDA(dst, b, h) do { _Pragma("unroll") for (int m = 0; m < 4; ++m) _Pragma("unroll") for (int k = 0; k < 2; ++k) dst[m][k] = *(const PG8_LAS bf16x8*)(lds + PG8_SA(b, h) + aoff + m * 2048 + k * 1024); } while (0)
#define PG8_LDB(dst, b, h) do { _Pragma("unroll") for (int n = 0; n < 2; ++n) _Pragma("unroll") for (int k = 0; k < 2; ++k) dst[n][k] = *(const PG8_LAS bf16x8*)(lds + PG8_SB(b, h) + boff + n * 2048 + k * 1024); } while (0)
#define PG8_MMA(ai, bj, At, Bt) do { __builtin_amdgcn_s_setprio(1); _Pragma("unroll") for (int m = 0; m < 4; ++m) _Pragma("unroll") for (int n = 0; n < 2; ++n) _Pragma("unroll") for (int k = 0; k < 2; ++k) \
        acc[ai][bj][m][n] = __builtin_amdgcn_mfma_f32_16x16x32_bf16(Bt[n][k], At[m][k], acc[ai][bj][m][n], 0, 0, 0); __builtin_amdgcn_s_setprio(0); } while (0)
#define PG8_WAIT_V(n) asm volatile("s_waitcnt vmcnt(" #n ")" ::: "memory")
#define PG8_WAIT_L(n) asm volatile("s_waitcnt lgkmcnt(" #n ")" ::: "memory")
#define PG8_BAR __builtin_amdgcn_s_barrier()
#define PG8_SCHED __builtin_amdgcn_sched_barrier(0)
    Unit cur, nxt; int ui = 0;
    if (!S.next(0, cur)) return;
    f32x4 acc[2][2][4][2];
#pragma unroll
    for (int a = 0; a < 2; ++a)
#pragma unroll
        for (int b = 0; b < 2; ++b)
#pragma unroll
            for (int m = 0; m < 4; ++m)
#pragma unroll
                for (int n = 0; n < 2; ++n) acc[a][b][m][n] = (f32x4){0.f, 0.f, 0.f, 0.f};
    bf16x8 At[4][2], B0[2][2], B1[2][2];
    const char* cA = (const char*)g.A + (size_t)cur.pm * tstepA; const char* cB = (const char*)g.Bt + (size_t)cur.pn * tstep;
    S.a_ready(cur);
    if constexpr (Epi::KHOOK) E.unit_begin(cur, ui, tid);
    if constexpr (SP2) {
        PG8_STAGE(PG8_SB(0, 0), cB, voffB); PG8_STAGE(PG8_SB(0, 1), cB + hstep, voffB); PG8_STAGE(PG8_SA(0, 0), cA, voffA); PG8_STAGE(PG8_SA(0, 1), cA + hstepA, voffA);
        if (wr == 1) PG8_BAR;
        PG8_WAIT_V(2); PG8_BAR;
        PG8_STAGE(PG8_SB(1, 0), cB + kstep, voffB); PG8_STAGE(PG8_SA(1, 0), cA + kstep, voffA); PG8_STAGE(PG8_SB(1, 1), cB + hstep + kstep, voffB);
        PG8_WAIT_V(6); PG8_BAR;
    } else {
        PG8_STAGE(PG8_SB(0, 0), cB, voffB); PG8_STAGE(PG8_SA(0, 0), cA, voffA); PG8_STAGE(PG8_SB(0, 1), cB + hstep, voffB); PG8_STAGE(PG8_SA(0, 1), cA + hstepA, voffA);
        if (wr == 1) PG8_BAR;
        PG8_WAIT_V(4); PG8_BAR;
        PG8_STAGE(PG8_SB(1, 0), cB + kstep, voffB); PG8_STAGE(PG8_SA(1, 0), cA + kstep, voffA); PG8_STAGE(PG8_SB(1, 1), cB + hstep + kstep, voffB);
        PG8_WAIT_V(6); PG8_BAR;
    }
    for (;;) {
        const bool has_next = S.next(ui + 1, nxt);
        const char* nA = has_next ? (const char*)g.A + (size_t)nxt.pm * tstepA : cA; const char* nB = has_next ? (const char*)g.Bt + (size_t)nxt.pn * tstep : cB;
        for (int t = 0; t < nt; t += 2) {
            if constexpr (Epi::KHOOK) { if (t == Epi::KH0 || t == Epi::KH1) E.khook(acc, t, ui, wr, fr); }
            const bool last = (t == nt - 2);
            const char* a1 = cA + (size_t)(t + 1) * kstep;
            const char* a2 = last ? nA : cA + (size_t)(t + 2) * kstep; const char* b2 = last ? nB : cB + (size_t)(t + 2) * kstep;
            const char* a3 = a2 + kstep; const char* b3 = b2 + kstep;
            if (last && has_next) S.a_ready(nxt);
            if constexpr (SP2) {
            PG8_LDB(B0, 0, 0); PG8_LDB(B1, 0, 1); PG8_SCHED; PG8_LDA(At, 0, 0); PG8_STAGE(PG8_SA(1, 1), a1 + hstepA, voffA);
            PG8_WAIT_V(8); PG8_WAIT_L(0); PG8_BAR; PG8_MMA(0, 0, At, B0); PG8_MMA(0, 1, At, B1); PG8_BAR; PG8_SCHED;
            PG8_LDA(At, 0, 1); PG8_STAGE(PG8_SB(0, 0), b2, voffB); PG8_STAGE(PG8_SB(0, 1), b2 + hstep, voffB); PG8_STAGE(PG8_SA(0, 0), a2, voffA);
            PG8_WAIT_V(8); PG8_WAIT_L(0); PG8_BAR; PG8_MMA(1, 0, At, B0); PG8_MMA(1, 1, At, B1); PG8_BAR; PG8_SCHED;
            PG8_LDB(B0, 1, 0); PG8_LDB(B1, 1, 1); PG8_SCHED; PG8_LDA(At, 1, 0); PG8_STAGE(PG8_SA(0, 1), a2 + hstepA, voffA);
            PG8_WAIT_V(8); PG8_WAIT_L(0); PG8_BAR; PG8_MMA(0, 0, At, B0); PG8_MMA(0, 1, At, B1); PG8_BAR; PG8_SCHED;
            PG8_LDA(At, 1, 1); PG8_STAGE(PG8_SB(1, 0), b3, voffB); PG8_STAGE(PG8_SB(1, 1), b3 + hstep, voffB); PG8_STAGE(PG8_SA(1, 0), a3, voffA);
            PG8_WAIT_V(8); PG8_WAIT_L(0); PG8_BAR; PG8_MMA(1, 0, At, B0); PG8_MMA(1, 1, At, B1); PG8_BAR; PG8_SCHED;
            } else {
            PG8_LDB(B0, 0, 0); PG8_SCHED; PG8_LDA(At, 0, 0); PG8_STAGE(PG8_SA(1, 1), a1 + hstepA, voffA);
            PG8_WAIT_L(8); PG8_BAR; PG8_WAIT_L(0); PG8_MMA(0, 0, At, B0); PG8_BAR; PG8_SCHED;
            PG8_LDB(B1, 0, 1); PG8_STAGE(PG8_SB(0, 0), b2, voffB);
            PG8_BAR; PG8_WAIT_L(0); PG8_MMA(0, 1, At, B1); PG8_BAR;
            PG8_LDA(At, 0, 1); PG8_STAGE(PG8_SA(0, 0), a2, voffA);
            PG8_BAR; PG8_WAIT_L(0); PG8_MMA(1, 0, At, B0); PG8_BAR; PG8_SCHED;
            PG8_STAGE(PG8_SB(0, 1), b2 + hstep, voffB);
            PG8_WAIT_V(6); PG8_BAR; PG8_MMA(1, 1, At, B1); PG8_BAR;
            PG8_LDB(B0, 1, 0); PG8_SCHED; PG8_LDA(At, 1, 0); PG8_STAGE(PG8_SA(0, 1), a2 + hstepA, voffA);
            PG8_WAIT_L(8); PG8_BAR; PG8_WAIT_L(0); PG8_MMA(0, 0, At, B0); PG8_BAR; PG8_SCHED;
            PG8_LDB(B1, 1, 1); PG8_STAGE(PG8_SB(1, 0), b3, voffB);
            PG8_BAR; PG8_WAIT_L(0); PG8_MMA(0, 1, At, B1); PG8_BAR;
            PG8_LDA(At, 1, 1); PG8_STAGE(PG8_SA(1, 0), a3, voffA);
            PG8_BAR; PG8_WAIT_L(0); PG8_MMA(1, 0, At, B0); PG8_BAR; PG8_SCHED;
            PG8_STAGE(PG8_SB(1, 1), b3 + hstep, voffB);
            PG8_WAIT_V(6); PG8_BAR; PG8_MMA(1, 1, At, B1); PG8_BAR;
            }
        }
        if constexpr (ALIGN_EPI) { if (wr == 0) PG8_BAR; }
        if constexpr (Epi::KHOOK) { E.epi(acc, cur, ui, wr, wc, fr, fq); S.done(cur); } else if constexpr (!Epi::AFTER_DRAIN) { E(acc, cur, wr, wc, fr, fq); S.done(cur); }
        if (!has_next) break;
#pragma unroll
        for (int a = 0; a < 2; ++a)
#pragma unroll
            for (int b = 0; b < 2; ++b)
#pragma unroll
                for (int m = 0; m < 4; ++m)
#pragma unroll
                    for (int n = 0; n < 2; ++n) acc[a][b][m][n] = (f32x4){0.f, 0.f, 0.f, 0.f};
        cur = nxt; cA = nA; cB = nB; ++ui;
        if constexpr (Epi::KHOOK) E.unit_begin(cur, ui, tid);
        if constexpr (ALIGN_EPI) { if (wr == 1) PG8_BAR; }
    }
    PG8_WAIT_V(0);
    if constexpr (!ALIGN_EPI) { if (wr == 0) PG8_BAR; }
    PG8_BAR;
    if constexpr (Epi::AFTER_DRAIN) { E.fused(acc, cur, wr, wc, fr, fq, lds, wid, lane); S.done(cur); }
#undef PG8_SA
#undef PG8_SB
#undef PG8_STAGE
#undef PG8_LDA
#undef PG8_LDB
#undef PG8_MMA
#undef PG8_WAIT_V
#undef PG8_WAIT_L
#undef PG8_BAR
#undef PG8_SCHED
}
}

namespace pg8 {
struct EpiResF32 {
    static constexpr bool PERM = false, AFTER_DRAIN = false, KHOOK = false;
    const float* base; float* out; int ldc;
    __device__ __forceinline__ void operator()(const f32x4 (&acc)[2][2][4][2], const Unit& u, int wr, int wc, int fr, int fq) const {
        const int col0 = u.pn * BM + wc * 32 + 4 * fq;
#pragma unroll
        for (int ai = 0; ai < 2; ++ai)
#pragma unroll
            for (int m = 0; m < 4; ++m) { const size_t off = (size_t)(u.pm * BM + ai * HALF + wr * 64 + m * 16 + fr) * ldc + col0;
#pragma unroll
                for (int bj = 0; bj < 2; ++bj)
#pragma unroll
                    for (int n = 0; n < 2; ++n) { const f32x4 bs = *(const f32x4*)(base + off + bj * HALF + n * 16); *(f32x4*)(out + off + bj * HALF + n * 16) = bs + acc[ai][bj][m][n]; } }
    }
};

struct EpiProj {
    static constexpr bool PERM = true, AFTER_DRAIN = false, KHOOK = true; static constexpr int KH0 = -1, KH1 = -1;
    bf16_t* O; int ldc; const float* qw; const float* kw; float* KM; PG8_LAS unsigned char* xlds; float eps; const float* RSTD;
    __device__ __forceinline__ PG8_LAS float* rtab(int ui) const { return (PG8_LAS float*)(xlds + 11264) + (ui & 1) * 256; }
    __device__ __forceinline__ void unit_begin(const Unit& u, int ui, int tid) const { if (tid < 256) rtab(ui)[tid] = RSTD[u.pm * BM + tid]; }
    __device__ __forceinline__ void khook(f32x4 (&)[2][2][4][2], int, int, int, int) const {}
    __device__ __forceinline__ void bar() const { asm volatile("s_waitcnt lgkmcnt(0)" ::: "memory"); __builtin_amdgcn_s_barrier(); asm volatile("" ::: "memory"); }
    __device__ __forceinline__ void epi(const f32x4 (&acc)[2][2][4][2], const Unit& u, int ui, int wr, int wc, int fr, int fq) const {
        const int row0 = u.pm * BM + wr * 64 + fr, colt = u.pn * BM, col0 = colt + wc * 32 + 8 * fq;
        const PG8_LAS float* RT = rtab(ui) + wr * 64 + fr;
        const int kind = colt < 1024 ? 1 : ((colt >= 2048 && colt < 3072) ? 2 : 0);
        const bool gate = (colt >= 1024 && colt < 2048) || (colt >= 4096 && colt < 5120);
        if (kind == 0) {
#pragma unroll
            for (int ai = 0; ai < 2; ++ai)
#pragma unroll
                for (int m = 0; m < 4; ++m) { bf16_t* rowp = O + (size_t)(row0 + ai * HALF + m * 16) * ldc + col0; const float rr = RT[ai * HALF + m * 16];
#pragma unroll
                    for (int bj = 0; bj < 2; ++bj) { f32x4 v0 = acc[ai][bj][m][0] * rr, v1 = acc[ai][bj][m][1] * rr;
                        if (gate) {
#pragma unroll
                            for (int e = 0; e < 4; ++e) { v0[e] = v0[e] * __builtin_amdgcn_rcpf(1.0f + __expf(-v0[e])); v1[e] = v1[e] * __builtin_amdgcn_rcpf(1.0f + __expf(-v1[e])); } }
                        u32x4 w; w.x = cvt_pk_bf16(v0[0], v0[1]); w.y = cvt_pk_bf16(v0[2], v0[3]); w.z = cvt_pk_bf16(v1[0], v1[1]); w.w = cvt_pk_bf16(v1[2], v1[3]);
                        *(u32x4*)(rowp + bj * HALF) = w; } }
            return;
        }
        PG8_LAS float* P = (PG8_LAS float*)xlds;
        PG8_LAS float* KS = (PG8_LAS float*)(xlds + 8192);
#pragma unroll
        for (int ai = 0; ai < 2; ++ai)
#pragma unroll
            for (int m = 0; m < 4; ++m)
#pragma unroll
                for (int bj = 0; bj < 2; ++bj) { const float rr = RT[ai * HALF + m * 16]; const f32x4 a = acc[ai][bj][m][0] * rr, b = acc[ai][bj][m][1] * rr;
                    float s = ((a[0] * a[0] + a[1] * a[1]) + (a[2] * a[2] + a[3] * a[3])) + ((b[0] * b[0] + b[1] * b[1]) + (b[2] * b[2] + b[3] * b[3]));
                    s += __shfl_xor(s, 16); s += __shfl_xor(s, 32);
                    if (fq == 0) P[((ai * HALF + wr * 64 + m * 16 + fr) * 2 + bj) * 4 + wc] = s;
                    if (bj) asm volatile("" ::: "memory"); }
        bar();
        const PG8_LAS float* wp = (const PG8_LAS float*)(xlds + 10240) + (kind == 1 ? 0 : 128) + wc * 32 + 8 * fq;
        const f32x4 w0 = *(const PG8_LAS f32x4*)wp, w1 = *(const PG8_LAS f32x4*)(wp + 4);
        const float qsc = kind == 1 ? 1.4426950408889634f * 0.08838834764831845f : 1.0f;
        f32x4 ks[2][2] = {};
#pragma unroll
        for (int ai = 0; ai < 2; ++ai)
#pragma unroll
            for (int m = 0; m < 4; ++m) { bf16_t* rowp = O + (size_t)(row0 + ai * HALF + m * 16) * ldc + col0;
#pragma unroll
                for (int bj = 0; bj < 2; ++bj) { const f32x4 p = *(const PG8_LAS f32x4*)(P + ((ai * HALF + wr * 64 + m * 16 + fr) * 2 + bj) * 4);
                    const float rs = qsc * RT[ai * HALF + m * 16] / sqrtf(((p[0] + p[1]) + (p[2] + p[3])) * (1.0f / 128.0f) + eps);
                    const f32x4 v0 = acc[ai][bj][m][0] * rs * w0, v1 = acc[ai][bj][m][1] * rs * w1;
                    ks[bj][0] += v0; ks[bj][1] += v1;
                    u32x4 w; w.x = cvt_pk_bf16(v0[0], v0[1]); w.y = cvt_pk_bf16(v0[2], v0[3]); w.z = cvt_pk_bf16(v1[0], v1[1]); w.w = cvt_pk_bf16(v1[2], v1[3]);
                    *(u32x4*)(rowp + bj * HALF) = w; }
                asm volatile("" : "+v"(ks[0][0]), "+v"(ks[0][1]), "+v"(ks[1][0]), "+v"(ks[1][1]) :: "memory"); }
        if (kind == 2) {
            float v[16];
#pragma unroll
            for (int bj = 0; bj < 2; ++bj)
#pragma unroll
                for (int n = 0; n < 2; ++n)
#pragma unroll
                    for (int j = 0; j < 4; ++j) v[bj * 8 + n * 4 + j] = ks[bj][n][j];
            { const bool up = (fr & 8) != 0;
#pragma unroll
              for (int c = 0; c < 8; ++c) { const float snd = up ? v[c] : v[c + 8], keep = up ? v[c + 8] : v[c]; v[c] = keep + __shfl_xor(snd, 8); } }
            { const bool up = (fr & 4) != 0;
#pragma unroll
              for (int c = 0; c < 4; ++c) { const float snd = up ? v[c] : v[c + 4], keep = up ? v[c + 4] : v[c]; v[c] = keep + __shfl_xor(snd, 4); } }
            { const bool up = (fr & 2) != 0;
#pragma unroll
              for (int c = 0; c < 2; ++c) { const float snd = up ? v[c] : v[c + 2], keep = up ? v[c + 2] : v[c]; v[c] = keep + __shfl_xor(snd, 2); } }
            { const bool up = (fr & 1) != 0; const float snd = up ? v[0] : v[1], keep = up ? v[1] : v[0]; v[0] = keep + __shfl_xor(snd, 1); }
            KS[wr * 256 + 128 * (fr >> 3) + 32 * wc + 8 * fq + (fr & 7)] = v[0];
            bar();
            const int t = (wr * 4 + wc) * 64 + fq * 16 + fr;
            if (t < 256) { const int b = u.pm >> 4, nb = u.pm & 15, head = 2 * (u.pn & 3) + (t >> 7);
                KM[(((size_t)b * 8 + head) * 16 + nb) * 128 + (t & 127)] = (KS[t] + KS[256 + t]) * (1.0f / 256.0f); }
        }
    }
};

struct EpiResScale {
    static constexpr bool PERM = true, AFTER_DRAIN = false, KHOOK = true; static constexpr int KH0 = 16, KH1 = 24;
    const float* base; const bf16_t* xnb; float* out; bf16_t* xno; int ldc; const float* SSQ; PG8_LAS unsigned char* xlds; float eps; bool last;
    __device__ __forceinline__ PG8_LAS float* tab(int ui) const { return (PG8_LAS float*)xlds + (ui & 1) * 768; }
    __device__ __forceinline__ const PG8_LAS float* ltab() const { return (const PG8_LAS float*)(xlds + 6144); }
    __device__ __forceinline__ const PG8_LAS float* ltab0() const { return (const PG8_LAS float*)(xlds + 10240); }
    __device__ __forceinline__ void unit_begin(const Unit& u, int ui, int tid) const { if (ui >= 2) fill(u, ui, tid); }
    __device__ __forceinline__ void fill(const Unit& u, int ui, int tid) const {
        if (tid < 256) { const f32x4* sp = (const f32x4*)(SSQ + (size_t)(u.pm * BM + tid) * 32); float s0 = 0.f, s1 = 0.f;
#pragma unroll
            for (int i = 0; i < 4; ++i) { const f32x4 a = sp[i], b = sp[4 + i]; s0 += (a[0] + a[1]) + (a[2] + a[3]); s1 += (b[0] + b[1]) + (b[2] + b[3]); }
            const float m0 = s0 * (1.0f / 512.0f) + eps, m1 = s1 * (1.0f / 512.0f) + eps; PG8_LAS float* T = tab(ui);
            T[tid] = sqrtf(m0); T[256 + tid] = sqrtf(m1 / m0); T[512 + tid] = 1.0f / sqrtf(m1); }
    }
    __device__ __forceinline__ void khook(f32x4 (&acc)[2][2][4][2], int t, int ui, int wr, int fr) const {
        const PG8_LAS float* T = tab(ui) + (t == KH0 ? 0 : 256) + wr * 64 + fr;
#pragma unroll
        for (int ai = 0; ai < 2; ++ai)
#pragma unroll
            for (int m = 0; m < 4; ++m) { const float f = T[ai * HALF + m * 16];
#pragma unroll
                for (int bj = 0; bj < 2; ++bj)
#pragma unroll
                    for (int n = 0; n < 2; ++n) acc[ai][bj][m][n] = acc[ai][bj][m][n] * f; }
    }
    __device__ __forceinline__ void epi(const f32x4 (&acc)[2][2][4][2], const Unit& u, int ui, int wr, int wc, int fr, int fq) const {
        const int col0 = u.pn * BM + wc * 32 + 8 * fq; const PG8_LAS float* T = tab(ui) + 512 + wr * 64 + fr;
        u32x4 xbv[2][4][2];
#pragma unroll
        for (int ai = 0; ai < 2; ++ai)
#pragma unroll
            for (int m = 0; m < 4; ++m) { const size_t off = (size_t)(u.pm * BM + ai * HALF + wr * 64 + m * 16 + fr) * ldc + col0;
#pragma unroll
                for (int bj = 0; bj < 2; ++bj) { if (last) xbv[ai][m][bj] = __builtin_nontemporal_load((const u32x4*)(xnb + off + bj * HALF)); else xbv[ai][m][bj] = *(const u32x4*)(xnb + off + bj * HALF); } }
        asm volatile("" ::: "memory");
#pragma unroll
        for (int ai = 0; ai < 2; ++ai)
#pragma unroll
            for (int m = 0; m < 4; ++m) { const size_t off = (size_t)(u.pm * BM + ai * HALF + wr * 64 + m * 16 + fr) * ldc + col0; const float f = T[ai * HALF + m * 16];
#pragma unroll
                for (int bj = 0; bj < 2; ++bj) {
                    const f32x4 a0 = acc[ai][bj][m][0] * f, a1 = acc[ai][bj][m][1] * f;
                    const u32x4 xb = xbv[ai][m][bj];
                    const f32x4 b0 = {__uint_as_float(xb.x << 16), __uint_as_float(xb.x & 0xffff0000u), __uint_as_float(xb.y << 16), __uint_as_float(xb.y & 0xffff0000u)};
                    const f32x4 b1 = {__uint_as_float(xb.z << 16), __uint_as_float(xb.z & 0xffff0000u), __uint_as_float(xb.w << 16), __uint_as_float(xb.w & 0xffff0000u)};
                    const f32x4 v0 = b0 + a0, v1 = b1 + a1;
                    if (last) { __builtin_nontemporal_store(v0, (f32x4*)(out + off + bj * HALF)); __builtin_nontemporal_store(v1, (f32x4*)(out + off + bj * HALF + 4)); }
                    else { u32x4 w; w.x = cvt_pk_bf16(v0[0], v0[1]); w.y = cvt_pk_bf16(v0[2], v0[3]); w.z = cvt_pk_bf16(v1[0], v1[1]); w.w = cvt_pk_bf16(v1[2], v1[3]);
                        *(u32x4*)(xno + off + bj * HALF) = w; } } }
    }
};
}

#ifndef GEMM1_ALIGN
#define GEMM1_ALIGN true
#endif
#ifndef GEMM1_SP2
#define GEMM1_SP2 true
#endif
#ifndef GEMM2_ALIGN
#define GEMM2_ALIGN true
#endif
#ifndef GEMM2_SP2
#define GEMM2_SP2 true
#endif
#ifndef PFD
#define PFD 2
#endif
#ifndef PROBE_SEC
#define PROBE_SEC -1
#endif
#ifndef ATT_PRIO
#define ATT_PRIO 0
#endif
#ifndef PROBE_SSDFIX
#define PROBE_SSDFIX 0
#endif
#ifndef BSKEW_N
#define BSKEW_N 2
#endif
#ifndef WOUT_IN_B
#define WOUT_IN_B 1
#endif
#ifndef PROBE_FSKEW
#define PROBE_FSKEW 0
#endif
#ifndef PROBE_BSKEW
#define PROBE_BSKEW 0
#endif
#ifndef PROBE_SSEC
#define PROBE_SSEC -1
#endif
#ifndef PROBE_MEM2
#define PROBE_MEM2 0
#endif
#ifndef FASTBAR
#define FASTBAR 1
#endif
#ifndef PROBE_BAR2
#define PROBE_BAR2 0
#endif
#ifndef PROBE_PH
#define PROBE_PH -1
#endif
constexpr int NWAVES = 8;
#ifndef MK_N_LAUNCHES
#define MK_N_LAUNCHES 1
#endif
constexpr int N_PHASES = 12;
constexpr int N_LAUNCHES = MK_N_LAUNCHES;

constexpr int BATCH = 8, SEQ = 4096, DM = 1024, DEPTH = 2;
constexpr int M = BATCH * SEQ;
constexpr int NH = 8, HD = 128;
constexpr int NSH = 16, SHD = 64, NST = 128;
constexpr int NIN = 6672;
constexpr int PITCH = 6656;
constexpr int C_Q = 0, C_Z = 1024, C_K = 2048, C_V = 3072, C_G = 4096, C_X = 5120, C_B = 6144, C_C = 6400;
constexpr int MOBA = 256, NBLK = SEQ / MOBA;
constexpr float EPS = 1e-6f;

constexpr size_t MiB = 1u << 20;
constexpr size_t WS_CTL = 0, CTL_ZERO_BYTES = 64 * 1024;
constexpr size_t WS_WIN = 1 * MiB;
constexpr size_t WS_WOUT = 14 * MiB;
constexpr size_t WS_KM = 18 * MiB;
constexpr size_t WS_DT = 19 * MiB;
constexpr size_t WS_SSQ = 21 * MiB;
constexpr size_t WS_RSTD = 31 * MiB;
constexpr size_t WS_ACS = 29 * MiB;
constexpr size_t WS_A = 32 * MiB;
constexpr size_t WS_PROJ = 96 * MiB;
constexpr size_t WS_END = 512 * MiB;
static_assert(WS_PROJ + (size_t)M * PITCH * 2 <= WS_END, "d_ws map");
constexpr int CW_TMO = 0;
constexpr int CW_BAR = 4096;
constexpr int CW_AQ = 8192;   static_assert((CW_AQ + 128) * 4 <= (int)CTL_ZERO_BYTES && (CW_BAR + 3456) <= CW_AQ, "control words inside the zeroed region");
constexpr int CW_AQ_ = 0;

constexpr int RING_OFF = 0, RING_BYTES = 131072;
constexpr int LDSCTL_OFF = 146944, MISC_OFF = LDSCTL_OFF + 320;
constexpr int LDS_BYTES = 147456;
static_assert(MISC_OFF + 128 <= LDS_BYTES && RING_BYTES <= LDSCTL_OFF, "LDS map");

#define GAS __attribute__((address_space(1)))
#define LAS __attribute__((address_space(3)))
typedef unsigned short bf16;
typedef unsigned v4u __attribute__((ext_vector_type(4)));
typedef unsigned v2u __attribute__((ext_vector_type(2)));
typedef float f32x4 __attribute__((ext_vector_type(4)));
typedef short bf16x8 __attribute__((ext_vector_type(8)));
typedef GAS unsigned gu32;
#define RLX_AGENT __ATOMIC_RELAXED, __HIP_MEMORY_SCOPE_AGENT
#define LDS_WAIT() asm volatile("s_waitcnt lgkmcnt(0)" ::: "memory")
#define VM_WAIT() asm volatile("s_waitcnt vmcnt(0)" ::: "memory")
__device__ __forceinline__ unsigned f2bf(float f) { unsigned u = __builtin_bit_cast(unsigned, f); return (u + 0x7fffu + ((u >> 16) & 1u)) >> 16; }
typedef __bf16 bf16x2_n __attribute__((ext_vector_type(2)));
__device__ __forceinline__ unsigned pk2(float lo, float hi) { bf16x2_n v = {(__bf16)lo, (__bf16)hi}; return __builtin_bit_cast(unsigned, v); }
__device__ __forceinline__ float bflo(unsigned u) { return __builtin_bit_cast(float, u << 16); }
__device__ __forceinline__ float bfhi(unsigned u) { return __builtin_bit_cast(float, u & 0xffff0000u); }
__device__ __forceinline__ float silu_f(float v) { return v * __builtin_amdgcn_rcpf(1.f + __expf(-v)); }
__device__ __forceinline__ float wave_sum(float v) {
#pragma unroll
    for (int o = 1; o < 64; o <<= 1) v += __shfl_xor(v, o);
    return v;
}
__device__ __forceinline__ float wave_max(float v) {
#pragma unroll
    for (int o = 1; o < 64; o <<= 1) v = fmaxf(v, __shfl_xor(v, o));
    return v;
}

#define XB_TMO      128
#define XB_XCNT(j)  (256  + 64 * (j))
#define XB_XSUB(j)  (1280 + 64 * (j))
#define XB_XGEN(j)  (2304 + 64 * (j))
#define XB_TOP      3328
#define XB_TOPGEN   3392
#define XCD_BAR_WORDS 3456
#define XB_SPIN_CAP (1u << 22)

__device__ __forceinline__ unsigned xb_ld(unsigned* p)              { return __hip_atomic_load(p, __ATOMIC_RELAXED, __HIP_MEMORY_SCOPE_AGENT); }
__device__ __forceinline__ unsigned xb_add(unsigned* p, unsigned v) { return __hip_atomic_fetch_add(p, v, __ATOMIC_RELAXED, __HIP_MEMORY_SCOPE_AGENT); }
__device__ __forceinline__ unsigned xb_xcc_id() { return (unsigned)__builtin_amdgcn_s_getreg((3 << 11) | 20) & 0xFu; }
#define XB_SPIN(cond, bar) do { unsigned _sp = 0; while (cond) { __builtin_amdgcn_s_sleep(1); \
    if ((++_sp & 255u) == 0u) { if (xb_ld(&(bar)[XB_TMO])) break; if (_sp > XB_SPIN_CAP) { atomicAdd(&(bar)[XB_TMO], 1u); break; } } } } while (0)

struct XcdBarrier { unsigned* bar; unsigned x; volatile LAS unsigned* st; };

__device__ __forceinline__ XcdBarrier xcd_barrier_post(unsigned* bar, volatile LAS unsigned* st) {
    XcdBarrier b; b.bar = bar; b.x = xb_xcc_id(); b.st = st;
    if (threadIdx.x == 0) (void)xb_add(&bar[XB_XCNT(b.x)], 1u);
    return b;
}
__device__ __forceinline__ void xcd_barrier_complete(unsigned* bar, unsigned x, unsigned& nloc, unsigned& nx) {
    const unsigned G = gridDim.x * gridDim.y * gridDim.z;
    unsigned sum, cnt, mine, sp = 0u;
    for (;;) {
        sum = 0u; cnt = 0u; mine = 0u;
#pragma unroll
        for (unsigned j = 0; j < 16; ++j) { const unsigned c = xb_ld(&bar[XB_XCNT(j)]); sum += c; cnt += (c > 0u) ? 1u : 0u; mine = (j == x) ? c : mine; }
        if (sum == G) break;
        __builtin_amdgcn_s_sleep(1);
        if ((++sp & 255u) == 0u) { if (xb_ld(&bar[XB_TMO])) break; if (sp > XB_SPIN_CAP) { atomicAdd(&bar[XB_TMO], 1u); break; } }
    }
    nloc = mine > 0u ? mine : 1u; nx = cnt > 0u ? cnt : 1u;
}
__device__ __forceinline__ void xcd_barrier(const XcdBarrier& b, int wave) {
    asm volatile("s_waitcnt vmcnt(0)" ::: "memory");
    __syncthreads();
    int z_ = 0; asm volatile("" : "+v"(z_));
    if (wave == 0 && __builtin_amdgcn_mbcnt_hi(~0u, __builtin_amdgcn_mbcnt_lo(~0u, (unsigned)z_)) == 0u) {
        unsigned* bar = b.bar;
        __builtin_amdgcn_s_waitcnt(0);
        unsigned nloc = b.st[0], nx = b.st[1];
        if (nloc == 0u) { xcd_barrier_complete(bar, b.x, nloc, nx); b.st[0] = nloc; b.st[1] = nx; }
        const unsigned old = xb_add(&bar[XB_XSUB(b.x)], 1u);
        const unsigned gen = old / nloc;
        if (FASTBAR) {
            if (old + 1u == (gen + 1u) * nloc) {
                __builtin_amdgcn_fence(__ATOMIC_RELEASE, "agent");
                asm volatile("s_waitcnt vmcnt(0)" ::: "memory");
                (void)xb_add(&bar[XB_TOP], 1u);
            }
            const unsigned target = (gen + 1u) * nx;
            XB_SPIN((int)(xb_ld(&bar[XB_TOP]) - target) < 0, bar);
            __builtin_amdgcn_fence(__ATOMIC_ACQUIRE, "agent");
            asm volatile("s_waitcnt vmcnt(0)" ::: "memory");
        } else
        if (old + 1u == (gen + 1u) * nloc) {
            __builtin_amdgcn_fence(__ATOMIC_RELEASE, "agent");
            asm volatile("s_waitcnt vmcnt(0)" ::: "memory");
            const unsigned og = xb_add(&bar[XB_TOP], 1u);
            const unsigned tg = og / nx;
            if (og + 1u == (tg + 1u) * nx) xb_add(&bar[XB_TOPGEN], 1u);
            else XB_SPIN(xb_ld(&bar[XB_TOPGEN]) == tg, bar);
            __builtin_amdgcn_fence(__ATOMIC_ACQUIRE, "agent");
            xb_add(&bar[XB_XGEN(b.x)], 1u);
            asm volatile("s_waitcnt vmcnt(0)" ::: "memory");
        } else {
            XB_SPIN(xb_ld(&bar[XB_XGEN(b.x)]) == gen, bar);
            __builtin_amdgcn_fence(__ATOMIC_ACQUIRE, "agent");
            asm volatile("s_waitcnt vmcnt(0)" ::: "memory");
        }
    }
    __syncthreads();
}

struct Frame {
    LAS unsigned char* lds;
    volatile LAS unsigned* MISC;
    int tid, lane, wave;
    int vcu, G;
};
struct Args { const float* in[12]; float* out; unsigned char* ws; int ph_lo, ph_hi, li, pad; };
template <class T> __device__ __forceinline__ T* karg_ptr(int byte_off) {
    const char __attribute__((address_space(4)))* p = (const char __attribute__((address_space(4)))*)__builtin_amdgcn_kernarg_segment_ptr();
    int o = byte_off; asm volatile("" : "+s"(o));
    return *(T* const __attribute__((address_space(4)))*)(p + o);
}
__device__ __forceinline__ const float* in_ptr(int i) { return karg_ptr<const float>(8 * i); }
__device__ __forceinline__ float* out_ptr() { return karg_ptr<float>(96); }
__device__ __forceinline__ unsigned char* ws_ptr() { return karg_ptr<unsigned char>(104); }
#define WSP(T, off) ((T*)(ws_ptr() + (off)))

__device__ __forceinline__ void transpose_item(const float* Wsrc, int ldw, int K, int ncols, bf16* WT, int row_off, LAS float* scr, int item, int lane, const float* kscale = nullptr, int kmin = 0) {
    const int nblk = ncols / 32, kb = item / nblk, nb = item % nblk, k0 = 64 * kb, n0 = 32 * nb;
    const int c = lane & 7;
    f32x4 ks0 = {1.f, 1.f, 1.f, 1.f}, ks1 = ks0;
    if (kscale && k0 >= kmin) { ks0 = *(const f32x4*)(kscale + k0 - kmin + 8 * c); ks1 = *(const f32x4*)(kscale + k0 - kmin + 8 * c + 4); }
#pragma unroll
    for (int i = 0; i < 8; ++i) { const int kk = (lane >> 3) + 8 * i, c4 = lane & 7;
        const f32x4 v = *(const f32x4*)(Wsrc + (size_t)(k0 + kk) * ldw + n0 + 4 * c4);
        LAS float* d = scr + kk * 33 + 4 * c4; d[0] = v.x; d[1] = v.y; d[2] = v.z; d[3] = v.w; }
    LDS_WAIT(); asm volatile("" ::: "memory");
#pragma unroll
    for (int j = 0; j < 4; ++j) { const int n = (lane >> 3) + 8 * j; const LAS float* s = scr + (8 * c) * 33 + n;
        v4u o; o.x = pk2(s[0 * 33] * ks0.x, s[1 * 33] * ks0.y); o.y = pk2(s[2 * 33] * ks0.z, s[3 * 33] * ks0.w); o.z = pk2(s[4 * 33] * ks1.x, s[5 * 33] * ks1.y); o.w = pk2(s[6 * 33] * ks1.z, s[7 * 33] * ks1.w);
        *(v4u*)(WT + (size_t)(row_off + n0 + n) * K + k0 + 8 * c) = o; }
    LDS_WAIT(); asm volatile("" ::: "memory");
}

__device__ __forceinline__ void phase_a(Frame& F, int layer) {
    bf16* const WinT = WSP(bf16, WS_WIN); bf16* const WoutT = WSP(bf16, WS_WOUT); bf16* const XN = WSP(bf16, WS_A); float* const DT = WSP(float, WS_DT); const float* const OUTP = out_ptr();
    const int gw = F.vcu * NWAVES + F.wave, NGW = F.G * NWAVES;
    {
        LAS float* scr = (LAS float*)(F.lds + RING_OFF + F.wave * 16384);
        const float* win = in_ptr(2) + (size_t)layer * DM * NIN;
        const float* wout = in_ptr(11) + (size_t)layer * 2048 * DM;
        const float* lnwf = in_ptr(1) + layer * DM;
        constexpr int KB_IN = DM / 64;
        constexpr int I_1K = KB_IN * (1024 / 32), I_X = KB_IN * (1536 / 32), I_OUT = (2048 / 64) * (1024 / 32);
        constexpr int NITEMS = 5 * I_1K + I_X + (WOUT_IN_B ? 0 : I_OUT);
        for (int it = gw; it < NITEMS; it += NGW) {
            int r = it;
            if (r < I_1K) { transpose_item(win + 0,    NIN, DM, 1024, WinT, C_Q, scr, r, F.lane, lnwf, 0); continue; } r -= I_1K;
            if (r < I_1K) { transpose_item(win + 4096, NIN, DM, 1024, WinT, C_Z, scr, r, F.lane, lnwf, 0); continue; } r -= I_1K;
            if (r < I_1K) { transpose_item(win + 1024, NIN, DM, 1024, WinT, C_K, scr, r, F.lane, lnwf, 0); continue; } r -= I_1K;
            if (r < I_1K) { transpose_item(win + 2048, NIN, DM, 1024, WinT, C_V, scr, r, F.lane, lnwf, 0); continue; } r -= I_1K;
            if (r < I_1K) { transpose_item(win + 3072, NIN, DM, 1024, WinT, C_G, scr, r, F.lane, lnwf, 0); continue; } r -= I_1K;
            if (r < I_X)  { transpose_item(win + 5120, NIN, DM, 1536, WinT, C_X, scr, r, F.lane, lnwf, 0); continue; } r -= I_X;
            transpose_item(wout, DM, 2048, 1024, WoutT, 0, scr, r, F.lane, in_ptr(10) + (size_t)layer * 1024, 1024);
        }
    }
    __syncthreads();
    LAS unsigned short* wdb = (LAS unsigned short*)(F.lds + RING_OFF); LAS float* lnl = (LAS float*)(F.lds + RING_OFF + 32768);
    {
        const float* win = in_ptr(2) + (size_t)layer * DM * NIN + 6656; const float* lnw = in_ptr(1) + layer * DM;
        f32x4 wv[8];
#pragma unroll
        for (int j = 0; j < 8; ++j) { const int i = F.tid + j * (NWAVES * 64), k = i >> 2, c4 = i & 3; wv[j] = *(const f32x4*)(win + (size_t)k * NIN + 4 * c4); }
#pragma unroll
        for (int j = 0; j < 8; ++j) { const int i = F.tid + j * (NWAVES * 64), k = i >> 2, c4 = i & 3;
#pragma unroll
            for (int e = 0; e < 4; ++e) wdb[(4 * c4 + e) * 1024 + k] = (unsigned short)f2bf(wv[j][e] * lnw[k]); }
        (void)lnl;
    }
    __syncthreads();
    const float* xin = in_ptr(0); (void)OUTP;
    const float* dtb = in_ptr(7) + layer * NSH;
    float* const RSTD = WSP(float, WS_RSTD);
    const int r = F.lane & 15, g4 = F.lane >> 4;
    for (int grp = gw; grp < M / 16; grp += NGW) {
        asm volatile("" ::: "memory");
        const size_t m0 = (size_t)grp * 16;
        const char* xb = (const char*)(xin + (m0 + r) * DM + 8 * g4); char* ob = (char*)(XN + (m0 + r) * DM + 8 * g4);
        f32x4 acc = {0.f, 0.f, 0.f, 0.f}; float ssq = 0.f;
        if (layer != 0) {
#pragma unroll 16
            for (int kk = 0; kk < 32; ++kk) {
                const v4u pk = *(const v4u*)(ob + kk * 64);
                const f32x4 a = (f32x4){bflo(pk.x), bfhi(pk.x), bflo(pk.y), bfhi(pk.y)}, b = (f32x4){bflo(pk.z), bfhi(pk.z), bflo(pk.w), bfhi(pk.w)};
                ssq += ((a.x * a.x + a.y * a.y) + (a.z * a.z + a.w * a.w)) + ((b.x * b.x + b.y * b.y) + (b.z * b.z + b.w * b.w));
                const bf16x8 wf = *(const LAS bf16x8*)(wdb + r * 1024 + 32 * kk + 8 * g4);
                acc = __builtin_amdgcn_mfma_f32_16x16x32_bf16(wf, __builtin_bit_cast(bf16x8, pk), acc, 0, 0, 0);
            }
        } else
        {
            f32x4 xa[2][8], xbq[2][8];
#pragma unroll
            for (int i = 0; i < 8; ++i) { xa[0][i] = __builtin_nontemporal_load((const f32x4*)(xb + i * 128)); xbq[0][i] = __builtin_nontemporal_load((const f32x4*)(xb + i * 128 + 16)); }
#pragma unroll
            for (int bt = 0; bt < 4; ++bt) {
                if (bt < 3) {
#pragma unroll
                    for (int i = 0; i < 8; ++i) { xa[(bt + 1) & 1][i] = __builtin_nontemporal_load((const f32x4*)(xb + ((bt + 1) * 8 + i) * 128)); xbq[(bt + 1) & 1][i] = __builtin_nontemporal_load((const f32x4*)(xb + ((bt + 1) * 8 + i) * 128 + 16)); } }
                asm volatile("" ::: "memory");
#pragma unroll
                for (int i = 0; i < 8; ++i) { const int kk = bt * 8 + i; const f32x4 a = xa[bt & 1][i], b = xbq[bt & 1][i];
                    ssq += ((a.x * a.x + a.y * a.y) + (a.z * a.z + a.w * a.w)) + ((b.x * b.x + b.y * b.y) + (b.z * b.z + b.w * b.w));
                    v4u pk; pk.x = pk2(a.x, a.y); pk.y = pk2(a.z, a.w); pk.z = pk2(b.x, b.y); pk.w = pk2(b.z, b.w);
                    *(v4u*)(ob + kk * 64) = pk;
                    const bf16x8 wf = *(const LAS bf16x8*)(wdb + r * 1024 + 32 * kk + 8 * g4);
                    acc = __builtin_amdgcn_mfma_f32_16x16x32_bf16(wf, __builtin_bit_cast(bf16x8, pk), acc, 0, 0, 0); }
            }
        }
        ssq += __shfl_xor(ssq, 16); ssq += __shfl_xor(ssq, 32);
        const float rstd = 1.f / sqrtf(ssq * (1.f / DM) + EPS);
        if (g4 == 0) RSTD[m0 + r] = rstd;
        f32x4 o;
#pragma unroll
        for (int i = 0; i < 4; ++i) { const float a = acc[i] * rstd + dtb[4 * g4 + i], u = __expf(-fabsf(a));
            o[i] = fmaxf(a, 0.f) + (u < 1e-3f ? u * (1.f - u * (0.5f - 0.33333334f * u)) : __logf(1.f + u)); }
        *(f32x4*)(DT + (m0 + r) * 16 + 4 * g4) = o;
    }
}

__device__ __forceinline__ void phase_c(Frame& F, int layer) {
    bf16* const PROJ = WSP(bf16, WS_PROJ); bf16* const BCc = (bf16*)out_ptr();
    const int gw = F.vcu * NWAVES + F.wave, NGW = F.G * NWAVES;
    {
        const int c8 = F.lane * 8;
        const float* cw = in_ptr(5) + (size_t)layer * 4 * 1536 + 1024 + c8;
        const float* cb = in_ptr(6) + (size_t)layer * 1536 + 1024 + c8;
        f32x4 w[4][2], bias[2];
#pragma unroll
        for (int k = 0; k < 4; ++k) { w[k][0] = *(const f32x4*)(cw + k * 1536); w[k][1] = *(const f32x4*)(cw + k * 1536 + 4); }
        bias[0] = *(const f32x4*)cb; bias[1] = *(const f32x4*)(cb + 4);
#pragma unroll 1
        for (int run = gw; run < M / 16; run += NGW) {
            const int m0 = run * 16; const bool head = (m0 & (SEQ - 1)) == 0;
            const bf16* src = PROJ + (size_t)m0 * PITCH + C_B + c8;
            v4u x[19];
#pragma unroll
            for (int j = 0; j < 19; ++j) { if (j < 3 && head) x[j] = (v4u){0u, 0u, 0u, 0u}; else x[j] = *(const v4u*)(src + (j - 3) * PITCH); }
#pragma unroll
            for (int i = 0; i < 16; ++i) {
                f32x4 a0 = bias[0], a1 = bias[1];
#pragma unroll
                for (int k = 0; k < 4; ++k) { const v4u u = x[i + k];
                    a0 += w[k][0] * (f32x4){bflo(u.x), bfhi(u.x), bflo(u.y), bfhi(u.y)}; a1 += w[k][1] * (f32x4){bflo(u.z), bfhi(u.z), bflo(u.w), bfhi(u.w)}; }
                v4u o; o.x = pk2(silu_f(a0.x), silu_f(a0.y)); o.y = pk2(silu_f(a0.z), silu_f(a0.w)); o.z = pk2(silu_f(a1.x), silu_f(a1.y)); o.w = pk2(silu_f(a1.z), silu_f(a1.w));
                *(v4u*)(BCc + (size_t)(m0 + i) * 512 + c8) = o;
            }
        }
    }
    if ((gw & 3) == 0) {
        const float* const DT = WSP(float, WS_DT); float* const ACS = WSP(float, WS_ACS); const float* alog = in_ptr(8) + layer * NSH;
#pragma unroll 1
        for (int c = gw >> 2; c < M / 64; c += NGW >> 2) {
            const size_t idx = ((size_t)c * 64 + F.lane) * 16;
            f32x4 a[4];
#pragma unroll
            for (int q = 0; q < 4; ++q) { a[q] = *(const f32x4*)(DT + idx + 4 * q);
#pragma unroll
                for (int e = 0; e < 4; ++e) a[q][e] *= -__expf(alog[4 * q + e]); }
#pragma unroll
            for (int o = 1; o < 64; o <<= 1)
#pragma unroll
                for (int q = 0; q < 4; ++q)
#pragma unroll
                    for (int e = 0; e < 4; ++e) { const float t = __shfl_up(a[q][e], o); if (F.lane >= o) a[q][e] += t; }
#pragma unroll
            for (int q = 0; q < 4; ++q) *(f32x4*)(ACS + idx + 4 * q) = a[q];
        }
    }
}


namespace ssd {
typedef float f32x4v __attribute__((ext_vector_type(4)));
typedef short s16x4v __attribute__((ext_vector_type(4)));
constexpr int L = 64, S256 = 272, S64 = 144, S32 = 144;
constexpr int O_BS = 0, O_CS = O_BS + 64 * S256, O_XB = O_CS + 64 * S256, O_XW = O_XB + 64 * S32, O_MT = O_XW + 64 * S32, O_ST = O_MT + 64 * S64,
              O_TB = O_ST + 2 * 64 * S256, O_CS2 = O_TB + NWAVES * 1024, O_XB2 = O_CS2 + 64 * S256, O_END = O_XB2 + 64 * S32;
static_assert(O_END <= LDSCTL_OFF, "SSD LDS map");
#define LD128(off) (*(const LAS bf16x8*)(lds + (off)))
#define MFMA16(a, b, c) __builtin_amdgcn_mfma_f32_16x16x32_bf16(a, b, c, 0, 0, 0)
#define TRRD(dst, addr, off) asm volatile("ds_read_b64_tr_b16 %0, %1 offset:%2" : "=&v"(dst) : "v"(addr), "i"(off) : "memory")
#define TRWAIT() do { asm volatile("s_waitcnt lgkmcnt(0)" ::: "memory"); __builtin_amdgcn_sched_barrier(0); } while (0)
#define CAT8(lo, hi) ((bf16x8){lo[0], lo[1], lo[2], lo[3], hi[0], hi[1], hi[2], hi[3]})
typedef __bf16 bf16x2n __attribute__((ext_vector_type(2)));
__device__ __forceinline__ unsigned cvtpk(float lo, float hi) { bf16x2n v = {(__bf16)lo, (__bf16)hi}; return __builtin_bit_cast(unsigned, v); }
__device__ __forceinline__ float silu_fast(float v) { return v * __builtin_amdgcn_rcpf(1.f + __expf(-v)); }

__device__ __forceinline__ void item(LAS unsigned char* lds, int wave_, int layer, int b, int h) {
    int z_ = 0; asm volatile("" : "+v"(z_));
    const int wid = wave_, lane = (int)__builtin_amdgcn_mbcnt_hi(~0u, __builtin_amdgcn_mbcnt_lo(~0u, (unsigned)z_)), tid = wid * 64 + lane, fr = lane & 15, fq = lane >> 4;
    const int g = h >> 3;
    const float Dh = in_ptr(9)[layer * NSH + h];
    const int brow = tid >> 4, bch = tid & 15;
    const int xl = tid >> 3, xpg = tid & 7;
    const int xcol = h * SHD + 4 * xpg;
    float cw[2][4][4], cbv[2][4];
    { const float* cwp = in_ptr(5) + (size_t)layer * 4 * 1536 + xcol; const float* cbp = in_ptr(6) + (size_t)layer * 1536 + xcol;
#pragma unroll
      for (int j = 0; j < 2; ++j) {
#pragma unroll
      for (int k = 0; k < 4; ++k)
#pragma unroll
          for (int e = 0; e < 4; ++e) cw[j][k][e] = cwp[k * 1536 + 32 * j + e];
#pragma unroll
      for (int e = 0; e < 4; ++e) cbv[j][e] = cbp[32 * j + e]; } }
    const char* pBC = (const char*)((const bf16*)out_ptr() + (size_t)b * SEQ * 512 + g * 128);
    const char* pX = (const char*)(WSP(bf16, WS_PROJ) + (size_t)b * SEQ * PITCH + C_X);
    char* pZ = (char*)(WSP(bf16, WS_PROJ) + (size_t)b * SEQ * PITCH + C_Z + h * SHD);
    const char* pDT = (const char*)(WSP(float, WS_DT) + (size_t)b * SEQ * 16 + h);
    const char* pAC = (const char*)(WSP(float, WS_ACS) + (size_t)b * SEQ * 16 + h);
    float* pSQ = WSP(float, WS_SSQ) + (size_t)b * SEQ * 32 + h * 2;
    const unsigned obc = (unsigned)(brow * 512 + bch * 8) * 2u;
    const int oxr = (xl - 3) * PITCH * 2 + xcol * 2;
    const unsigned odt = (unsigned)lane * 64u;
    const int tl = wid >> 1, tpC = wid & 1, tn = wid;
    const int gtlA = (int)(0x33213320u >> (4 * wid)) & 15, gtsA = (int)(0x31102000u >> (4 * wid)) & 15, gtlB = (int)(0x21211000u >> (4 * wid)) & 15, gtsB = (int)(0x33212321u >> (4 * wid)) & 15;
    const bool gB = wid == 4 || wid == 5;
    const unsigned ozy = (unsigned)((16 * tl + fr) * PITCH + 32 * tpC + 4 * fq) * 2u;
    const int trq = fr >> 2, trp = fr & 3;
    const int aXB = (int)(unsigned)(size_t)(lds + O_XB) + (8 * fq + trq) * S32 + (4 * trp) * 2;
    const int aXBc = aXB + 64 * tpC;
    const int aXW = (int)(unsigned)(size_t)(lds + O_XW) + (8 * fq + trq) * S32 + (4 * trp) * 2;
    const int aBS = (int)(unsigned)(size_t)(lds + O_BS) + (8 * fq + trq) * S256 + (16 * tn + 4 * trp) * 2;
    f32x4v accS[4] = {};
    for (int i = tid; i < 64 * S256 / 4; i += NWAVES * 64) ((LAS unsigned*)(lds + O_ST))[i] = 0u;
    LAS float* const tb = (LAS float*)(lds + O_TB + wid * 1024);
    v4u bu0_0, bu1_0, cu0_0, cu1_0, bu0_1, bu1_1, cu0_1, cu1_1; v2u xr_0[2][4], xr_1[2][4], zr_0[2], zr_1[2]; float dtn_0, dtn_1, acn_0, acn_1;
#define SSD_LOAD(c, S_) do { const char* bc_ = pBC + (size_t)(c) * (L * 512 * 2); const char* px_ = pX + (size_t)(c) * (L * PITCH * 2); \
        bu0_##S_ = *(const v4u*)(bc_ + obc); bu1_##S_ = *(const v4u*)(bc_ + obc + 32 * 512 * 2); cu0_##S_ = *(const v4u*)(bc_ + obc + 512); cu1_##S_ = *(const v4u*)(bc_ + obc + 32 * 512 * 2 + 512); \
        _Pragma("unroll") for (int j = 0; j < 2; ++j) _Pragma("unroll") for (int k = 0; k < 4; ++k) xr_##S_[j][k] = ((c) * L + xl - 3 + k >= 0) ? *(const v2u*)(px_ + (oxr + k * PITCH * 2 + 64 * j)) : (v2u){0u, 0u}; \
        dtn_##S_ = *(const float*)(pDT + (size_t)(c) * (L * 64) + odt); acn_##S_ = *(const float*)(pAC + (size_t)(c) * (L * 64) + odt); \
        zr_##S_[0] = *(const v2u*)(pZ + (size_t)(c) * (L * PITCH * 2) + ozy); zr_##S_[1] = *(const v2u*)(pZ + (size_t)(c) * (L * PITCH * 2) + ozy + 32); } while (0)
#define SSD_STEP(c, S_) do { \
        QS0(0); \
        constexpr int OCS = (S_) ? O_CS2 : O_CS, OXB = (S_) ? O_XB2 : O_XB;     \
        const int aXBs = aXBc + (OXB - O_XB); \
          \
        const float dtv = dtn_##S_, acs = acn_##S_; \
        const float tot = __builtin_bit_cast(float, __builtin_amdgcn_readlane(__builtin_bit_cast(int, acs), 63)); \
        const float ea = __expf(acs); \
        tb[lane] = acs; tb[64 + lane] = dtv; tb[128 + lane] = __expf(tot - acs) * dtv; tb[192 + lane] = ea; \
        const v2u zq0 = zr_##S_[0], zq1 = zr_##S_[1]; \
          \
        { \
            *(LAS v4u*)(lds + O_BS + brow * S256 + bch * 16) = bu0_##S_; *(LAS v4u*)(lds + O_BS + (32 + brow) * S256 + bch * 16) = bu1_##S_; \
            *(LAS v4u*)(lds + OCS + brow * S256 + bch * 16) = cu0_##S_; *(LAS v4u*)(lds + OCS + (32 + brow) * S256 + bch * 16) = cu1_##S_; \
            asm volatile("s_waitcnt lgkmcnt(0)" ::: "memory"); \
            const float wl = tb[128 + xl]; \
            _Pragma("unroll") for (int j = 0; j < 2; ++j) { \
                float xv[4]; \
                _Pragma("unroll") for (int e = 0; e < 4; ++e) xv[e] = cbv[j][e]; \
                _Pragma("unroll") for (int k = 0; k < 4; ++k) { xv[0] += cw[j][k][0] * bflo(xr_##S_[j][k].x); xv[1] += cw[j][k][1] * bfhi(xr_##S_[j][k].x); xv[2] += cw[j][k][2] * bflo(xr_##S_[j][k].y); xv[3] += cw[j][k][3] * bfhi(xr_##S_[j][k].y); } \
                _Pragma("unroll") for (int e = 0; e < 4; ++e) xv[e] = silu_fast(xv[e]); \
                *(LAS v2u*)(lds + OXB + xl * S32 + xpg * 8 + 64 * j) = (v2u){cvtpk(xv[0], xv[1]), cvtpk(xv[2], xv[3])}; \
                *(LAS v2u*)(lds + O_XW + xl * S32 + xpg * 8 + 64 * j) = (v2u){cvtpk(xv[0] * wl, xv[1] * wl), cvtpk(xv[2] * wl, xv[3] * wl)}; } \
        } \
        QS1(0); QS0(1); __syncthreads(); QS1(1); QS0(2); \
        if ((c) + 2 < SEQ / L) SSD_LOAD((c) + 2, S_);                          \
          \
        { \
              \
              \
            bf16x8 cf[4]; \
            _Pragma("unroll") for (int kk = 0; kk < 4; ++kk) cf[kk] = LD128(OCS + (16 * gtlA + fr) * S256 + (32 * kk + 8 * fq) * 2); \
            const float al = tb[16 * gtlA + fr];                               \
            const int l = 16 * gtlA + fr; \
            _Pragma("unroll") for (int j = 0; j < 2; ++j) { \
                const int ts = j ? gtsB : gtsA; \
                if (j == 0 || gB) { \
                    f32x4v gacc = {}; \
                    _Pragma("unroll") for (int kk = 0; kk < 4; ++kk) gacc = MFMA16(LD128(O_BS + (16 * ts + fr) * S256 + (32 * kk + 8 * fq) * 2), cf[kk], gacc);     \
                    const f32x4v as4 = *(const LAS f32x4v*)(tb + 16 * ts + 4 * fq), ds4 = *(const LAS f32x4v*)(tb + 64 + 16 * ts + 4 * fq); \
                    float mv[4]; \
                    _Pragma("unroll") for (int r = 0; r < 4; ++r) mv[r] = (16 * ts + 4 * fq + r <= l) ? gacc[r] * __expf(al - as4[r]) * ds4[r] : 0.f; \
                    *(LAS v2u*)(lds + O_MT + l * S64 + (16 * ts + 4 * fq) * 2) = (v2u){cvtpk(mv[0], mv[1]), cvtpk(mv[2], mv[3])}; \
                } else { \
                    { unsigned z0_ = 0u; asm volatile("" : "+v"(z0_)); *(LAS v2u*)(lds + O_MT + (16 * gtlB + fr) * S64 + (16 * ts + 4 * fq) * 2) = (v2u){z0_, z0_}; }     \
                } \
            } \
            const float dec = __expf(tot); \
            s16x4v b0, b1, b2, b3; \
            TRRD(b0, aBS, 0); TRRD(b1, aBS, 4 * S256); TRRD(b2, aBS, 32 * S256); TRRD(b3, aBS, 36 * S256); \
            _Pragma("unroll") for (int tp = 0; tp < 4; ++tp) { s16x4v x0, x1, x2, x3; \
                TRRD(x0, aXW, 32 * tp); TRRD(x1, aXW, 4 * S32 + 32 * tp); TRRD(x2, aXW, 32 * S32 + 32 * tp); TRRD(x3, aXW, 36 * S32 + 32 * tp); \
                TRWAIT(); \
                accS[tp] = accS[tp] * dec; \
                accS[tp] = MFMA16(CAT8(b0, b1), CAT8(x0, x1), accS[tp]); accS[tp] = MFMA16(CAT8(b2, b3), CAT8(x2, x3), accS[tp]);     \
            } \
            _Pragma("unroll") for (int tp = 0; tp < 4; ++tp) \
                *(LAS v2u*)(lds + O_ST + (cur ^ 1) * 64 * S256 + (16 * tp + fr) * S256 + (16 * tn + 4 * fq) * 2) = (v2u){cvtpk(accS[tp][0], accS[tp][1]), cvtpk(accS[tp][2], accS[tp][3])}; \
        } \
        QS1(2); QS0(3); __syncthreads(); QS1(3); QS0(4); \
          \
        { \
            const bf16x8 m0f = LD128(O_MT + (16 * tl + fr) * S64 + (8 * fq) * 2), m1f = LD128(O_MT + (16 * tl + fr) * S64 + (32 + 8 * fq) * 2); \
            bf16x8 cfr[4]; \
            _Pragma("unroll") for (int kk = 0; kk < 4; ++kk) cfr[kk] = LD128(OCS + (16 * tl + fr) * S256 + (32 * kk + 8 * fq) * 2); \
            const float eal = tb[192 + 16 * tl + fr]; \
            float qs_ = 0.f; \
            _Pragma("unroll") for (int j = 0; j < 2; ++j) { \
                s16x4v x0, x1, x2, x3; \
                TRRD(x0, aXBs, 32 * j); TRRD(x1, aXBs, 4 * S32 + 32 * j); TRRD(x2, aXBs, 32 * S32 + 32 * j); TRRD(x3, aXBs, 36 * S32 + 32 * j); \
                TRWAIT(); \
                f32x4v yd = {}, yo = {}; \
                yd = MFMA16(CAT8(x0, x1), m0f, yd); yd = MFMA16(CAT8(x2, x3), m1f, yd); \
                _Pragma("unroll") for (int kk = 0; kk < 4; ++kk) yo = MFMA16(LD128(O_ST + cur * 64 * S256 + (32 * tpC + 16 * j + fr) * S256 + (32 * kk + 8 * fq) * 2), cfr[kk], yo); \
                const v2u xb = *(const LAS v2u*)(lds + OXB + (16 * tl + fr) * S32 + (32 * tpC + 16 * j + 4 * fq) * 2); \
                const v2u zr = j ? zq1 : zq0;                                 \
                float yz[4]; \
                yz[0] = (yd[0] + eal * yo[0] + Dh * bflo(xb.x)) * bflo(zr.x); yz[1] = (yd[1] + eal * yo[1] + Dh * bfhi(xb.x)) * bfhi(zr.x); \
                yz[2] = (yd[2] + eal * yo[2] + Dh * bflo(xb.y)) * bflo(zr.y); yz[3] = (yd[3] + eal * yo[3] + Dh * bfhi(xb.y)) * bfhi(zr.y); \
                *(v2u*)(pZ + (size_t)(c) * (L * PITCH * 2) + ozy + 32 * j) = (v2u){cvtpk(yz[0], yz[1]), cvtpk(yz[2], yz[3])}; \
                qs_ += (yz[0] * yz[0] + yz[1] * yz[1]) + (yz[2] * yz[2] + yz[3] * yz[3]); } \
            qs_ += __shfl_xor(qs_, 16); qs_ += __shfl_xor(qs_, 32); \
            if (fq == 0) pSQ[((size_t)(c) * L + 16 * tl + fr) * 32 + tpC] = qs_; \
        } \
          \
        QS1(4); cur ^= 1; } while (0)
    unsigned long long qacc = 0;
#define QS0(k) unsigned long long qt##k##_ = 0; if (PROBE_SSEC == (k)) qt##k##_ = __builtin_amdgcn_s_memtime()
#define QS1(k) do { if (PROBE_SSEC == (k)) qacc += __builtin_amdgcn_s_memtime() - qt##k##_; } while (0)
    SSD_LOAD(0, 0); SSD_LOAD(1, 1);
    int cur = 0;
#pragma unroll 1
    for (int c = 0; c < SEQ / L; c += 2) { SSD_STEP(c, 0); SSD_STEP(c + 1, 1); }
    if (PROBE_SSEC >= 0) { const unsigned long long t0 = __builtin_amdgcn_s_memtime(); while (__builtin_amdgcn_s_memtime() - t0 < qacc) __builtin_amdgcn_s_sleep(8); }
    __syncthreads();
#undef QS0
#undef QS1
#undef SSD_STEP
#undef SSD_LOAD
}
#undef LD128
#undef MFMA16
#undef TRRD
#undef TRWAIT
#undef CAT8
}


__device__ __forceinline__ void ssd_phase(Frame& F, int layer) {
    if ((F.vcu & 1) == 0) for (int it = F.vcu >> 1; it < BATCH * NSH; it += (F.G + 1) >> 1) ssd::item(F.lds + RING_OFF, F.wave, layer, it >> 4, it & 15);
}


namespace moba {
typedef float f32x16 __attribute__((ext_vector_type(16)));
typedef short s16x4 __attribute__((ext_vector_type(4)));
typedef unsigned u32x4 __attribute__((ext_vector_type(4)));
constexpr int NW = 8, QBLK = 32, KVBLK = 64, QB = NW * QBLK;
constexpr int SHM_V = KVBLK * HD * 2, SHM_K = KVBLK * HD * 2;
constexpr int OFF_V = 0, OFF_K = 3 * SHM_V, OFF_WS = 3 * SHM_V + 3 * SHM_K, OFF_KM = OFF_WS + NW * 64 * 4;
constexpr int ATTN_LDS = OFF_KM + 32 * 256;
constexpr float SCALE = 0.08838834764831845f, LOG2E = 1.4426950408889634f;

#define KSWZ(row, colB) ((row) * 256 + ((colB) ^ (((row) & 7) << 4)))
#define SBAR() __builtin_amdgcn_sched_barrier(0)
__device__ __forceinline__ int v_st(int k, int c) { const int kk = (k & ~0xC) | ((k & 4) << 1) | ((k & 8) >> 1); return ((kk >> 3) * 4 + (c >> 5)) * 512 + ((kk & 7) * 32 + (c & 31)) * 2; }
__device__ __forceinline__ int v_rd_base(int lane) { return ((lane & 3) << 3) | (((lane >> 2) & 3) << 6) | (((lane >> 4) & 1) << 5) | (((lane >> 5) & 1) << 8); }
constexpr int v_rd_off(int d0, int ks, int half) { return d0 * 512 + ks * 4096 + half * 2048; }
__device__ __forceinline__ int crow(int r, int hi) { return (r & 3) + 8 * (r >> 2) + 4 * hi; }
typedef __bf16 bf16x2n __attribute__((ext_vector_type(2)));
__device__ __forceinline__ unsigned cvtpk(float lo, float hi) { bf16x2n v = {(__bf16)lo, (__bf16)hi}; return __builtin_bit_cast(unsigned, v); }

struct Unit { const bf16* Q; const bf16* K; const bf16* V; const float* KM; int qb, h, jlo;
#if PROBE_MEM2 == 1
    long dum; __device__ __forceinline__ long dumv() const { return dum; }
#else
    __device__ __forceinline__ long dumv() const { return 0; }
#endif
};
struct Seam { bf16x8 qr[8]; bf16x8 st_v0, st_v1, st_k0, st_k1; };
constexpr int OFF_ORD = 108 * 1024, OFF_TK = OFF_ORD + 2048, OFF_WT = OFF_TK + 16;
struct Queue { unsigned* ctr; bf16* PROJ; const float* KM; };
__device__ __forceinline__ bool unit_from_ticket(unsigned t, const Queue& q, const LAS char* lds, Unit& u) {
    if (t >= (unsigned)(BATCH * NH * NBLK)) return false;
    const int id = __builtin_amdgcn_readfirstlane((int)((const LAS unsigned short*)(lds + OFF_ORD))[t]), b = id >> 7, h = (id >> 4) & 7, qb = id & 15;
    const int w = __builtin_amdgcn_readfirstlane(((const LAS int*)(lds + OFF_WT))[h]);
    const bf16* base = q.PROJ + (size_t)b * SEQ * PITCH + h * HD;
    u.Q = base + (size_t)qb * MOBA * PITCH + C_Q; u.K = base + C_K; u.V = base + C_V; u.KM = q.KM + (size_t)(b * NH + h) * NBLK * HD; u.qb = qb; u.h = h;
    { const int jl = 4 * qb - w; u.jlo = jl > 0 ? (jl & ~1) : 0; }
#if PROBE_MEM2 == 1
    u.dum = (b < 4 ? 1 : -1) * (long)(4 * SEQ) * PITCH * 2;
#endif
    return true;
}

__device__ __forceinline__ void mask_tile(f32x16& p0, f32x16& p1, int dq) {
    const float NEG = -__builtin_inff();
#pragma unroll
    for (int r = 0; r < 16; ++r) { const int c = (r & 3) + 8 * (r >> 2); if (dq - c < 0) p0[r] = NEG; if (dq - c - 32 < 0) p1[r] = NEG; }
}
__device__ __forceinline__ void partialSM(f32x16& p0, f32x16& p1, float base, float slope2) {
    constexpr float C2 = LOG2E * SCALE;
#pragma unroll
    for (int r = 0; r < 16; ++r) { const float c = (float)((r & 3) + 8 * (r >> 2)); p0[r] = fmaf(p0[r], C2, fmaf(slope2, c, base)); p1[r] = fmaf(p1[r], C2, fmaf(slope2, c + 32.f, base)); }
#pragma unroll
    for (int r = 0; r < 16; ++r) p0[r] = __builtin_amdgcn_exp2f(p0[r]);
}
__device__ __forceinline__ void partialSM1(f32x16& p0, f32x16& p1, float base, float slope2) {
#pragma unroll
    for (int r = 0; r < 16; ++r) { const float c = (float)((r & 3) + 8 * (r >> 2)); p0[r] = p0[r] + fmaf(slope2, c, base); p1[r] = p1[r] + fmaf(slope2, c + 32.f, base); }
#pragma unroll
    for (int r = 0; r < 16; ++r) p0[r] = __builtin_amdgcn_exp2f(p0[r]);
}
__device__ __forceinline__ void finishSM(f32x16& p0, f32x16& p1, float& l_reg, bf16x8& pa0, bf16x8& pa1, bf16x8& pa2, bf16x8& pa3) {
#pragma unroll
    for (int r = 0; r < 16; ++r) p1[r] = __builtin_amdgcn_exp2f(p1[r]);
    float ps = 0;
#pragma unroll
    for (int r = 0; r < 16; ++r) ps += p0[r];
#pragma unroll
    for (int r = 0; r < 16; ++r) ps += p1[r];
    { auto rr = __builtin_amdgcn_permlane32_swap(__float_as_uint(ps), __float_as_uint(ps), false, false); ps = __uint_as_float(rr[0]) + __uint_as_float(rr[1]); }
    l_reg += ps;
#define PK4(P, B_, OUT) do { unsigned a0 = cvtpk(P[B_+0], P[B_+1]), a1 = cvtpk(P[B_+2], P[B_+3]); unsigned b0 = cvtpk(P[B_+4], P[B_+5]), b1 = cvtpk(P[B_+6], P[B_+7]); \
        auto r0 = __builtin_amdgcn_permlane32_swap(a0, b0, false, false); auto r1 = __builtin_amdgcn_permlane32_swap(a1, b1, false, false); \
        u32x4 w = {r0[0], r1[0], r0[1], r1[1]}; OUT = *reinterpret_cast<bf16x8*>(&w); } while (0)
    PK4(p0, 0, pa0); PK4(p0, 8, pa1); PK4(p1, 0, pa2); PK4(p1, 8, pa3);
#undef PK4
}
__device__ __forceinline__ void qkt(f32x16& p0, f32x16& p1, const LAS char* const (&kbase)[4], int kslot, const bf16x8* qr) {
    p0 = f32x16{}; p1 = f32x16{};
#pragma unroll
    for (int d0 = 0; d0 < 8; ++d0) { const LAS char* a = kbase[d0 & 3] + kslot + (d0 >> 2) * 128;
        bf16x8 b0 = *reinterpret_cast<const LAS bf16x8*>(a);
        bf16x8 b1 = *reinterpret_cast<const LAS bf16x8*>(a + 32 * 256);
        p0 = __builtin_amdgcn_mfma_f32_32x32x16_bf16(b0, qr[d0], p0, 0, 0, 0);
        p1 = __builtin_amdgcn_mfma_f32_32x32x16_bf16(b1, qr[d0], p1, 0, 0, 0); }
}
__device__ __forceinline__ void pv_tile(f32x16* o, int vb0, bf16x8 pa0, bf16x8 pa1, bf16x8 pa2, bf16x8 pa3) {
#define TRRD(dst, off) asm volatile("ds_read_b64_tr_b16 %0, %1 offset:%2" : "=&v"(dst) : "v"(vb0), "i"(off) : "memory")
#define PV_D0(d0) do { s16x4 l0, l1, l2, l3, h0, h1, h2, h3; constexpr int b_ = v_rd_off(d0, 0, 0); \
        TRRD(l0, b_); TRRD(h0, b_ + 2048); TRRD(l1, b_ + 4096); TRRD(h1, b_ + 6144); TRRD(l2, b_ + 8192); TRRD(h2, b_ + 10240); TRRD(l3, b_ + 12288); TRRD(h3, b_ + 14336); \
        asm volatile("s_waitcnt lgkmcnt(0)" ::: "memory"); SBAR(); \
        o[d0] = __builtin_amdgcn_mfma_f32_32x32x16_bf16(pa0, (bf16x8){l0[0], l0[1], l0[2], l0[3], h0[0], h0[1], h0[2], h0[3]}, o[d0], 0, 0, 0); \
        o[d0] = __builtin_amdgcn_mfma_f32_32x32x16_bf16(pa1, (bf16x8){l1[0], l1[1], l1[2], l1[3], h1[0], h1[1], h1[2], h1[3]}, o[d0], 0, 0, 0); \
        o[d0] = __builtin_amdgcn_mfma_f32_32x32x16_bf16(pa2, (bf16x8){l2[0], l2[1], l2[2], l2[3], h2[0], h2[1], h2[2], h2[3]}, o[d0], 0, 0, 0); \
        o[d0] = __builtin_amdgcn_mfma_f32_32x32x16_bf16(pa3, (bf16x8){l3[0], l3[1], l3[2], l3[3], h3[0], h3[1], h3[2], h3[3]}, o[d0], 0, 0, 0); } while (0)
    PV_D0(0); PV_D0(1); PV_D0(2); PV_D0(3);
#undef PV_D0
#undef TRRD
}

#define TILEP(p, k0) ((const char*)((p) + (size_t)(k0) * PITCH))
#define VMW() asm volatile("s_waitcnt vmcnt(0)" ::: "memory")
#define VMWN(n) asm volatile("s_waitcnt vmcnt(%0)" :: "i"(n) : "memory")
#define LD8(p) (*reinterpret_cast<const bf16x8*>(p))
#define LD8O(base, off) (*reinterpret_cast<const bf16x8*>((base) + (off)))
#if PROBE_MEM2 == 1
#define DUMV cur.dum
#define SLOAD_DUM(vt_, kt_) do { LAS unsigned* dl_ = (LAS unsigned*)(lds + 114688 + wid * 1024); \
        __builtin_amdgcn_global_load_lds((const unsigned*)(vt_ + DUMV + roff0), dl_, 16, 0, 0); __builtin_amdgcn_global_load_lds((const unsigned*)(vt_ + DUMV + roff1), dl_, 16, 0, 0); \
        __builtin_amdgcn_global_load_lds((const unsigned*)(kt_ + DUMV + roff0), dl_, 16, 0, 0); __builtin_amdgcn_global_load_lds((const unsigned*)(kt_ + DUMV + roff1), dl_, 16, 0, 0); } while (0)
#define SLOAD_DUMN(vt_, kt_) do { LAS unsigned* dl_ = (LAS unsigned*)(lds + 114688 + wid * 1024); \
        __builtin_amdgcn_global_load_lds((const unsigned*)(vt_ + dumn_ + roff0), dl_, 16, 0, 0); __builtin_amdgcn_global_load_lds((const unsigned*)(vt_ + dumn_ + roff1), dl_, 16, 0, 0); \
        __builtin_amdgcn_global_load_lds((const unsigned*)(kt_ + dumn_ + roff0), dl_, 16, 0, 0); __builtin_amdgcn_global_load_lds((const unsigned*)(kt_ + dumn_ + roff1), dl_, 16, 0, 0); } while (0)
#else
#define SLOAD_DUM(vt_, kt_) do { } while (0)
#define SLOAD_DUMN(vt_, kt_) do { } while (0)
#endif
#define SLOAD_HN(Kp, Vp, k0) do { const char* vt_ = TILEP(Vp, k0); const char* kt_ = TILEP(Kp, k0); S.st_v0 = LD8O(vt_, roff0); S.st_v1 = LD8O(vt_, roff1); S.st_k0 = LD8O(kt_, roff0); S.st_k1 = LD8O(kt_, roff1); SLOAD_DUMN(vt_, kt_); } while (0)
#if PROBE_MEM2 == 2
#define SLOAD_H(Kp, Vp, k0) do { const char* vt_ = TILEP(Vp, k0); const char* kt_ = TILEP(Kp, k0); S.st_v0 = LD8O(vt_, roff0); S.st_v1 = LD8O(vt_, roff1); S.st_k0 = LD8O(kt_, roff0); S.st_k1 = LD8O(kt_, roff1); \
        { const int kp_ = min((k0) + PFD * KVBLK, kmax_); const char* vp_ = TILEP(Vp, kp_); const char* kq_ = TILEP(Kp, kp_); LAS unsigned* dl_ = (LAS unsigned*)(lds + 114688 + wid * 1024); \
          __builtin_amdgcn_global_load_lds((const unsigned*)(vp_ + roff0), dl_, 16, 0, 0); __builtin_amdgcn_global_load_lds((const unsigned*)(vp_ + roff1), dl_, 16, 0, 0); \
          __builtin_amdgcn_global_load_lds((const unsigned*)(kq_ + roff0), dl_, 16, 0, 0); __builtin_amdgcn_global_load_lds((const unsigned*)(kq_ + roff1), dl_, 16, 0, 0); } } while (0)
#else
#define SLOAD_H(Kp, Vp, k0) do { const char* vt_ = TILEP(Vp, k0); const char* kt_ = TILEP(Kp, k0); S.st_v0 = LD8O(vt_, roff0); S.st_v1 = LD8O(vt_, roff1); S.st_k0 = LD8O(kt_, roff0); S.st_k1 = LD8O(kt_, roff1); SLOAD_DUM(vt_, kt_); } while (0)
#endif
#define SWRITE_HK(so) do { *(LAS bf16x8*)(K_lds + (so) + kws) = S.st_k0; *(LAS bf16x8*)(K_lds + (so) + kws + 32 * 256) = S.st_k1; } while (0)
#define SWRITE_HV(so) do { *(LAS bf16x8*)(V_lds + (so) + vst0) = S.st_v0; *(LAS bf16x8*)(V_lds + (so) + vst1) = S.st_v1; } while (0)
#define SWRITE_H(so) do { SWRITE_HV(so); SWRITE_HK(so); } while (0)

__device__ __forceinline__ void prime(const Unit& cur, LAS char* lds, Seam& S, int wave_) {
    int z_ = 0; asm volatile("" : "+v"(z_)); const int tid = wave_ * 64 + (int)__builtin_amdgcn_mbcnt_hi(~0u, __builtin_amdgcn_mbcnt_lo(~0u, (unsigned)z_));
    const int wid = __builtin_amdgcn_readfirstlane(tid >> 6), lane = tid & 63, r32 = lane & 31, hi = lane >> 5;
    const int sr = tid >> 4, sc = (tid & 15) * 8, kws = KSWZ(sr, sc * 2); LAS char* K_lds = lds + OFF_K;
    const unsigned roff0 = (unsigned)(sr * PITCH + sc) * 2u, roff1 = roff0 + 32u * PITCH * 2u, qoff = (unsigned)(r32 * PITCH + hi * 8) * 2u;
    { const char* qb_ = (const char*)(cur.Q + (size_t)(wid * QBLK) * PITCH);
#pragma unroll
    for (int d0 = 0; d0 < 8; ++d0) S.qr[d0] = LD8O(qb_, qoff + d0 * 32); }
    const int kmax_ = (4 * (cur.qb + 1) - 1) * KVBLK; (void)kmax_;
    SLOAD_H(cur.K, cur.V, cur.jlo * KVBLK); VMW(); SWRITE_HK(0);
    __syncthreads();
}
__device__ __forceinline__ void block(const Unit& cur, Unit& nxt, bool& more, const Queue& Qd, float slope2, float M2, LAS char* lds, Seam& S, int wave_, unsigned long long& pacc) {
#define PS0(k) unsigned long long pt##k##_ = 0; if (PROBE_SEC == (k)) pt##k##_ = __builtin_amdgcn_s_memtime()
#define PS1(k) do { if (PROBE_SEC == (k)) pacc += __builtin_amdgcn_s_memtime() - pt##k##_; } while (0)
    PS0(6); PS0(4);
    int z_ = 0; asm volatile("" : "+v"(z_)); const int tid = wave_ * 64 + (int)__builtin_amdgcn_mbcnt_hi(~0u, __builtin_amdgcn_mbcnt_lo(~0u, (unsigned)z_));
    const int wid = __builtin_amdgcn_readfirstlane(tid >> 6), lane = tid & 63, r32 = lane & 31, hi = lane >> 5;
    const unsigned roff0 = (unsigned)((tid >> 4) * PITCH + (tid & 15) * 8) * 2u, roff1 = roff0 + 32u * PITCH * 2u, qoff = (unsigned)(r32 * PITCH + hi * 8) * 2u;
    const int jlo = cur.jlo, NT = 4 * (cur.qb + 1) - jlo;
    LAS char* V_lds = lds + OFF_V; LAS char* K_lds = lds + OFF_K;
    LAS float* li_l = (LAS float*)(lds + OFF_WS) + wid * 64;
    float l_reg = 0; f32x16 o[4] = {};
    const int sr = tid >> 4, sc = (tid & 15) * 8, vst0 = v_st(sr, sc), vst1 = v_st(32 + sr, sc), kws = KSWZ(sr, sc * 2);
    const int vb0 = (int)(unsigned)(size_t)V_lds + v_rd_base(lane);
    const bf16* Kh = cur.K; const bf16* Vh = cur.V; const int kmax_ = (4 * (cur.qb + 1) - 1) * KVBLK; (void)kmax_;
    const int tq = cur.qb * QB + wid * QBLK + r32;
    {
        const int n = sr & 15; const float* kp = cur.KM + n * HD + sc;
        const f32x4 a = *(const f32x4*)kp, b = *(const f32x4*)(kp + 4);
        float v[8] = {a.x, a.y, a.z, a.w, b.x, b.y, b.z, b.w}; unsigned w[4];
#pragma unroll
        for (int e = 0; e < 4; ++e) { const unsigned h0 = f2bf(v[2 * e]), h1 = f2bf(v[2 * e + 1]);
            if (sr < 16) w[e] = h0 | (h1 << 16); else w[e] = pk2(v[2 * e] - bflo(h0), v[2 * e + 1] - bflo(h1)); }
        *(LAS u32x4*)(lds + OFF_KM + KSWZ(sr, sc * 2)) = (u32x4){w[0], w[1], w[2], w[3]};
    }
    if (tid == 0) *(LAS unsigned*)(lds + OFF_TK) = __hip_atomic_fetch_add(Qd.ctr, 1u, __ATOMIC_RELAXED, __HIP_MEMORY_SCOPE_AGENT);
    __syncthreads();
    { const unsigned tnext = (unsigned)__builtin_amdgcn_readfirstlane((int)*(const LAS unsigned*)(lds + OFF_TK));
      more = unit_from_ticket(tnext, Qd, lds, nxt); if (!more) nxt = cur; }
    unsigned selmask = 0;
    {
        f32x16 pg = f32x16{};
#pragma unroll
        for (int d0 = 0; d0 < 8; ++d0) { const bf16x8 a = *reinterpret_cast<const LAS bf16x8*>(lds + OFF_KM + KSWZ(r32, (d0 * 16 + hi * 8) * 2));
            pg = __builtin_amdgcn_mfma_f32_32x32x16_bf16(a, S.qr[d0], pg, 0, 0, 0); }
        float g[16];
#pragma unroll
        for (int j = 0; j < 8; ++j) { const float mine = pg[j] + pg[j + 8], oth = __shfl_xor(mine, 32); const int n0 = (j & 3) + 8 * (j >> 2);
            g[n0] = hi ? oth : mine; g[n0 + 4] = hi ? mine : oth; }
        float v0 = -__builtin_inff(), v1 = v0, v2 = v0; int i0 = 0, i1 = 0, i2 = 0;
#pragma unroll
        for (int n = 0; n < 16; ++n) { const float gt = n < cur.qb ? g[n] : -__builtin_inff();
            if (gt > v0) { v2 = v1; i2 = i1; v1 = v0; i1 = i0; v0 = gt; i0 = n; }
            else if (gt > v1) { v2 = v1; i2 = i1; v1 = gt; i1 = n; }
            else if (gt > v2) { v2 = gt; i2 = n; } }
        if (v0 > -__builtin_inff()) selmask |= 1u << i0;
        if (v1 > -__builtin_inff()) selmask |= 1u << i1;
        if (v2 > -__builtin_inff()) selmask |= 1u << i2;
    }
    const float basec = -M2 + slope2 * (float)(4 * hi - tq);
    const int ownt = 4 * cur.qb - jlo;
#define KBASE(t) ((jlo + (t)) * KVBLK)
#define TBASE(t) (((t) >= ownt || ((selmask >> ((jlo + (t)) >> 2)) & 1u)) ? fmaf(slope2, (float)KBASE(t), basec) : -__builtin_inff())
#define MASKT(P0_, P1_, t) do { if ((t) >= ownt && KBASE(t) + KVBLK - 1 > cur.qb * QB + wid * QBLK) mask_tile(P0_, P1_, tq - 4 * hi - KBASE(t)); } while (0)
    f32x16 pA0, pA1, pB0, pB1; bf16x8 pa0, pa1, pa2, pa3;
    const LAS char* kbase[4];
#pragma unroll
    for (int dd = 0; dd < 4; ++dd) kbase[dd] = K_lds + KSWZ(r32, (dd * 16 + hi * 8) * 2);
    SWRITE_HV(0); SBAR();
    SLOAD_H(Kh, Vh, KBASE(1));
    SBAR(); qkt(pA0, pA1, kbase, 0, S.qr);
    MASKT(pA0, pA1, 0); partialSM1(pA0, pA1, TBASE(0), slope2);
    { const float tb1_ = TBASE(1);
#pragma unroll
      for (int r = 0; r < 16; ++r) { const float c = (float)((r & 3) + 8 * (r >> 2)); pB0[r] = fmaf(slope2, c, tb1_); pB1[r] = fmaf(slope2, c + 32.f, tb1_); } }
    VMW(); SWRITE_H(SHM_K); SBAR(); SLOAD_H(Kh, Vh, KBASE(2));
    __syncthreads();
    int sp = 0, scur = SHM_K, sn = 2 * SHM_K;
    bf16x8 kf0[2], kf1[2]; s16x4 vA[8], vB[8]; float psa, psb; unsigned ra0_, ra1_;
#define KRD(d0_, s_) do { const LAS char* a_ = kbase[(d0_) & 3] + scur + ((d0_) >> 2) * 128; kf0[s_] = *reinterpret_cast<const LAS bf16x8*>(a_); kf1[s_] = *reinterpret_cast<const LAS bf16x8*>(a_ + 32 * 256); } while (0)
#define TRRD2(dst, off) asm volatile("ds_read_b64_tr_b16 %0, %1 offset:%2" : "=&v"(dst) : "v"(vaddr_), "i"(off) : "memory")
#define FINC(k, Y0, Y1) do { \
        if ((k) < 8) { Y1[2 * ((k) & 7)] = __builtin_amdgcn_exp2f(Y1[2 * ((k) & 7)]); Y1[2 * ((k) & 7) + 1] = __builtin_amdgcn_exp2f(Y1[2 * ((k) & 7) + 1]); \
            if ((k) == 0) { psa = Y0[0]; psb = Y0[1]; } else { psa += Y0[2 * ((k) & 7)]; psb += Y0[2 * ((k) & 7) + 1]; } } \
        else { constexpr int j_ = (k) & 7, m_ = j_ >> 1, b_ = (m_ & 1) * 8; psa += Y1[2 * j_]; psb += Y1[2 * j_ + 1]; \
            if ((j_ & 1) == 0) { const unsigned a0_ = m_ < 2 ? cvtpk(Y0[b_], Y0[b_ + 1]) : cvtpk(Y1[b_], Y1[b_ + 1]), b0_ = m_ < 2 ? cvtpk(Y0[b_ + 4], Y0[b_ + 5]) : cvtpk(Y1[b_ + 4], Y1[b_ + 5]); \
                auto r_ = __builtin_amdgcn_permlane32_swap(a0_, b0_, false, false); ra0_ = r_[0]; ra1_ = r_[1]; } \
            else { const unsigned a1_ = m_ < 2 ? cvtpk(Y0[b_ + 2], Y0[b_ + 3]) : cvtpk(Y1[b_ + 2], Y1[b_ + 3]), b1_ = m_ < 2 ? cvtpk(Y0[b_ + 6], Y0[b_ + 7]) : cvtpk(Y1[b_ + 6], Y1[b_ + 7]); \
                auto r_ = __builtin_amdgcn_permlane32_swap(a1_, b1_, false, false); u32x4 w_ = {ra0_, r_[0], ra1_, r_[1]}; \
                if (m_ == 0) pa0 = *reinterpret_cast<bf16x8*>(&w_); else if (m_ == 1) pa1 = *reinterpret_cast<bf16x8*>(&w_); else if (m_ == 2) pa2 = *reinterpret_cast<bf16x8*>(&w_); else pa3 = *reinterpret_cast<bf16x8*>(&w_); } } \
        if ((k) >= 12) { constexpr int f_ = 2 * ((k) - 12), o_ = v_rd_off(0, 0, 0) + 2048 * f_; TRRD2(vA[f_ & 7], o_ & 0xffff); TRRD2(vA[(f_ + 1) & 7], (o_ + 2048) & 0xffff); } } while (0)
#define QKG(d0, PX0, PX1, PY0, PY1) do { \
        if ((d0) < 7) KRD(((d0) + 1) & 7, ((d0) + 1) & 1); \
        SBAR(); \
        PX0 = __builtin_amdgcn_mfma_f32_32x32x16_bf16(kf0[(d0) & 1], S.qr[d0], PX0, 0, 0, 0);     \
        SBAR(); FINC(2 * (d0), PY0, PY1); SBAR(); \
        PX1 = __builtin_amdgcn_mfma_f32_32x32x16_bf16(kf1[(d0) & 1], S.qr[d0], PX1, 0, 0, 0); \
        SBAR(); FINC(2 * (d0) + 1, PY0, PY1); SBAR(); } while (0)
#define SMC(k, X0, X1, Y0, Y1) do { constexpr float c_ = (float)(((k) & 3) + 8 * ((k) >> 2)); \
        X0[k] = __builtin_amdgcn_exp2f(X0[k]);                                  \
        if (!stg_last_) { Y0[k] = fmaf(slope2, c_, tbn_); Y1[k] = fmaf(slope2, c_ + 32.f, tbn_); asm volatile("" :: "v"(Y0[k]), "v"(Y1[k])); } } while (0)
#define FRV(A, j) (bf16x8){A[2 * (j)][0], A[2 * (j)][1], A[2 * (j)][2], A[2 * (j)][3], A[2 * (j) + 1][0], A[2 * (j) + 1][1], A[2 * (j) + 1][2], A[2 * (j) + 1][3]}
#define PVG(d0, CUR, NXT, X0, X1, Y0, Y1) do { constexpr int n_ = v_rd_off(((d0) + 1) & 3, 0, 0); \
        asm volatile("s_waitcnt lgkmcnt(0)" ::: "memory"); SBAR(); \
        o[d0] = __builtin_amdgcn_mfma_f32_32x32x16_bf16(pa0, FRV(CUR, 0), o[d0], 0, 0, 0); SBAR(); \
        if ((d0) < 3) { TRRD2(NXT[0], n_); TRRD2(NXT[1], n_ + 2048); TRRD2(NXT[2], n_ + 4096); TRRD2(NXT[3], n_ + 6144); } SMC(4 * (d0) + 0, X0, X1, Y0, Y1); SBAR(); \
        o[d0] = __builtin_amdgcn_mfma_f32_32x32x16_bf16(pa1, FRV(CUR, 1), o[d0], 0, 0, 0); SBAR(); \
        if ((d0) < 3) { TRRD2(NXT[4], n_ + 8192); TRRD2(NXT[5], n_ + 10240); TRRD2(NXT[6], n_ + 12288); TRRD2(NXT[7], n_ + 14336); } SMC(4 * (d0) + 1, X0, X1, Y0, Y1); SBAR(); \
        o[d0] = __builtin_amdgcn_mfma_f32_32x32x16_bf16(pa2, FRV(CUR, 2), o[d0], 0, 0, 0); SBAR(); SMC(4 * (d0) + 2, X0, X1, Y0, Y1); SBAR(); \
        o[d0] = __builtin_amdgcn_mfma_f32_32x32x16_bf16(pa3, FRV(CUR, 3), o[d0], 0, 0, 0); SBAR(); SMC(4 * (d0) + 3, X0, X1, Y0, Y1); SBAR(); } while (0)
#define STEP(PX0, PX1, PY0, PY1, t, LAST) do { \
        PS0(0); KRD(0, 0); constexpr bool stg_last_ = (LAST); const float tbn_ = TBASE((t) + 1); const int vaddr_ = vb0 + sp; \
        if (!(LAST)) { VMW(); SWRITE_H(sn); SBAR(); if ((t) + 2 < NT) SLOAD_H(Kh, Vh, KBASE((t) + 2)); } \
        PS1(0); PS0(1); QKG(0, PX0, PX1, PY0, PY1); QKG(1, PX0, PX1, PY0, PY1); QKG(2, PX0, PX1, PY0, PY1); QKG(3, PX0, PX1, PY0, PY1); \
        QKG(4, PX0, PX1, PY0, PY1); QKG(5, PX0, PX1, PY0, PY1); QKG(6, PX0, PX1, PY0, PY1); QKG(7, PX0, PX1, PY0, PY1); \
        { float ps_ = psa + psb; auto rr_ = __builtin_amdgcn_permlane32_swap(__float_as_uint(ps_), __float_as_uint(ps_), false, false); l_reg += __uint_as_float(rr_[0]) + __uint_as_float(rr_[1]); } \
        asm volatile("" : "+v"(pa0), "+v"(pa1), "+v"(pa2), "+v"(pa3), "+v"(l_reg)); PS1(1); PS0(2); \
        if (LAST) { SBAR(); const char* nq_ = (const char*)(nxt.Q + (size_t)(wid * QBLK) * PITCH); \
            _Pragma("unroll") for (int d0 = 0; d0 < 8; ++d0) S.qr[d0] = LD8O(nq_, qoff + d0 * 32); SBAR(); \
            { const long dumn_ = PROBE_MEM2 == 1 ? nxt.dumv() : 0; (void)dumn_; SLOAD_HN(nxt.K, nxt.V, nxt.jlo * KVBLK); } SBAR(); }                   \
        MASKT(PX0, PX1, (t)); \
        PVG(0, vA, vB, PX0, PX1, PY0, PY1); PVG(1, vB, vA, PX0, PX1, PY0, PY1); PVG(2, vA, vB, PX0, PX1, PY0, PY1); PVG(3, vB, vA, PX0, PX1, PY0, PY1); \
        asm volatile("" : "+v"(PX0), "+v"(PX1)); if (!stg_last_) asm volatile("" : "+v"(PY0), "+v"(PY1)); PS1(2); PS0(3); \
        __syncthreads(); PS1(3); \
        { const int r_ = sp; sp = scur; scur = sn; sn = r_; } } while (0)
    PS1(4);
    int t = 1;
    for (; t + 1 < NT; t += 2) { STEP(pB0, pB1, pA0, pA1, t, false); STEP(pA0, pA1, pB0, pB1, t + 1, false); }
    STEP(pB0, pB1, pA0, pA1, t, true);
#undef STEP
#undef PVG
#undef FRV
#undef SMC
#undef QKG
#undef FINC
#undef TRRD2
#undef KRD
    PS0(5);
    char* Ow = (char*)(const_cast<bf16*>(cur.Q) + (size_t)(wid * QBLK) * PITCH);
    const char* Gw = Ow + (C_G - C_Q) * 2;
    u32x4 gv[8];
#pragma unroll
    for (int i = 0; i < 8; ++i) { const int j = (i & 1) * 64 + lane; gv[i] = *(const u32x4*)(Gw + (unsigned)((j >> 2) * PITCH + (i >> 1) * 32 + (j & 3) * 8) * 2u); }
    SBAR();
    finishSM(pB0, pB1, l_reg, pa0, pa1, pa2, pa3); SBAR();
    pv_tile(o, vb0 + sp, pa0, pa1, pa2, pa3);
    SBAR(); VMW(); SWRITE_HK(0); SBAR();
    if (hi == 0) li_l[r32] = l_reg;
    asm volatile("s_waitcnt lgkmcnt(0)" ::: "memory");
    float rl[16];
#pragma unroll
    for (int r = 0; r < 16; ++r) rl[r] = __builtin_amdgcn_rcpf(li_l[crow(r, hi)]);
    LAS float* stg = (LAS float*)(lds + OFF_K + SHM_K + wid * 4096);
#pragma unroll
    for (int d0 = 0; d0 < 4; ++d0) {
#pragma unroll
        for (int r = 0; r < 16; ++r) stg[crow(r, hi) * 32 + r32] = o[d0][r] * rl[r];
#pragma unroll
        for (int k = 0; k < 2; ++k) { const int j = k * 64 + lane, row = j >> 2, cq = j & 3;
            const f32x4 a = *(const LAS f32x4*)(stg + row * 32 + cq * 8), b = *(const LAS f32x4*)(stg + row * 32 + cq * 8 + 4);
            const u32x4 g = gv[d0 * 2 + k]; u32x4 w;
            w.x = cvtpk(a[0] * bflo(g.x & 0xffffu), a[1] * __uint_as_float(g.x & 0xffff0000u)); w.y = cvtpk(a[2] * bflo(g.y & 0xffffu), a[3] * __uint_as_float(g.y & 0xffff0000u));
            w.z = cvtpk(b[0] * bflo(g.z & 0xffffu), b[1] * __uint_as_float(g.z & 0xffff0000u)); w.w = cvtpk(b[2] * bflo(g.w & 0xffffu), b[3] * __uint_as_float(g.w & 0xffff0000u));
            *(u32x4*)(Ow + (unsigned)(row * PITCH + d0 * 32 + cq * 8) * 2u) = w; }
    }
    __syncthreads();
    PS1(5); PS1(6);
#undef PS0
#undef PS1
#undef KBASE
#undef TBASE
#undef MASKT
#undef HALF_STEP
}
#undef TILEP
#undef LD8O
#undef VMW
#undef VMWN
#undef LD8
#undef SLOAD_H
#undef SWRITE_HK
#undef SWRITE_HV
#undef SWRITE_H
#undef KSWZ
#undef SBAR
}

__device__ __forceinline__ int attn_window(float slope2, float M2) {
    int w = 0;
#pragma unroll 1
    for (int j = 0; j < 15; ++j) if (slope2 * (float)(256 * j + 1) < 2.f * M2 + 48.f) w = j + 1;
    return w;
}
__device__ __forceinline__ void attn_phase(Frame& F, int layer) {
    unsigned long long pt7_ = 0; if (PROBE_SEC == 7) pt7_ = __builtin_amdgcn_s_memtime();
    bf16* const PROJ = WSP(bf16, WS_PROJ); const float* const KM = WSP(float, WS_KM);
    const float* qw = in_ptr(3) + layer * HD; const float* kw = in_ptr(4) + layer * HD;
    const float mq = wave_max(fmaxf(fabsf(qw[2 * F.lane]), fabsf(qw[2 * F.lane + 1]))), mk = wave_max(fmaxf(fabsf(kw[2 * F.lane]), fabsf(kw[2 * F.lane + 1])));
    float m2v_ = 11.313708499f * mq * mk * 1.02f * moba::LOG2E; asm volatile("" : "+v"(m2v_));
    const float M2 = __uint_as_float((unsigned)__builtin_amdgcn_readfirstlane((int)__float_as_uint(m2v_)));
    LAS char* lds = (LAS char*)(F.lds + RING_OFF);
    {
        LAS int* const WT = (LAS int*)(lds + moba::OFF_WT); LAS int* const CNT = WT + 8;
        if (F.tid < 8) { const float s2 = exp2f(-(float)(F.tid + 1)) * moba::LOG2E; int w = 0;
#pragma unroll 1
            for (int j = 0; j < 60; ++j) if (s2 * (float)(64 * j + 1) < 2.f * M2 + 48.f) w = j + 1;
            WT[F.tid] = w; }
        __syncthreads();
        int W[8];
        { const v4u w0 = *(const LAS v4u*)WT, w1 = *(const LAS v4u*)(WT + 4); W[0] = (int)w0.x; W[1] = (int)w0.y; W[2] = (int)w0.z; W[3] = (int)w0.w; W[4] = (int)w1.x; W[5] = (int)w1.y; W[6] = (int)w1.z; W[7] = (int)w1.w;
#pragma unroll
          for (int hh = 0; hh < 8; ++hh) W[hh] = (W[hh] + 3) >> 2; }
#define NCOST(c, hh) (((c) - 1 < W[hh]) ? 1 : (((c) - 1 == W[hh]) ? 16 - W[hh] : 0))
        if (F.tid < 17) { int n = 0;
#pragma unroll
            for (int hh = 0; hh < 8; ++hh) n += NCOST(F.tid, hh);
            CNT[F.tid] = F.tid == 0 ? 0 : n; }
        __syncthreads();
#pragma unroll 1
        for (int u = F.tid; u < BATCH * NH * NBLK; u += NWAVES * 64) {
            const int b = u >> 7, h = (u >> 4) & 7, qb = u & 15;
            int wh = 0;
#pragma unroll
            for (int hh = 0; hh < 8; ++hh) wh = (h == hh) ? W[hh] : wh;
            const int c = (qb < wh ? qb : wh) + 1;
            int above = 0;
#pragma unroll
            for (int cc = 2; cc <= 16; ++cc) above += (cc > c) ? CNT[cc] : 0;
            int nbefore = 0;
#pragma unroll
            for (int hh = 0; hh < 8; ++hh) nbefore += (hh < h) ? NCOST(c, hh) : 0;
            const int pos = BATCH * above + b * CNT[c] + nbefore + ((c - 1 == wh) ? qb - wh : 0);
            ((LAS unsigned short*)(lds + moba::OFF_ORD))[pos] = (unsigned short)u;
        }
#undef NCOST
    }
    moba::Queue Qd{WSP(unsigned, WS_CTL) + CW_AQ + 64 * layer, PROJ, KM};
    if (F.tid == 0) *(LAS unsigned*)(lds + moba::OFF_TK) = __hip_atomic_fetch_add(Qd.ctr, 1u, __ATOMIC_RELAXED, __HIP_MEMORY_SCOPE_AGENT);
    __syncthreads();
    moba::Unit cur, nxt; moba::Seam S;
    { const unsigned t0 = (unsigned)__builtin_amdgcn_readfirstlane((int)*(const LAS unsigned*)(lds + moba::OFF_TK));
      if (!moba::unit_from_ticket(t0, Qd, lds, cur)) return; }
    __syncthreads();
    moba::prime(cur, lds, S, F.wave);
    if (ATT_PRIO && F.wave >= 4) __builtin_amdgcn_s_setprio(1);
    unsigned long long pacc = 0; if (PROBE_SEC == 7) pacc = __builtin_amdgcn_s_memtime() - pt7_;
    for (;;) {
        bool more;
        const float slope2 = exp2f(-(float)(cur.h + 1)) * moba::LOG2E;
        moba::block(cur, nxt, more, Qd, slope2, M2, lds, S, F.wave, pacc);
        if (!more) break;
        cur = nxt;
    }
    if (ATT_PRIO) __builtin_amdgcn_s_setprio(0);
    if (PROBE_SEC >= 0) { const unsigned long long t0 = __builtin_amdgcn_s_memtime(); while (__builtin_amdgcn_s_memtime() - t0 < pacc) __builtin_amdgcn_s_sleep(8); }
}

__global__ void __launch_bounds__(NWAVES * 64, 2) mk_fwd(Args args) {
    extern __shared__ __attribute__((aligned(16))) unsigned char lds[];
    Frame F;
    F.lds = (LAS unsigned char*)lds;
    F.MISC = (volatile LAS unsigned*)(F.lds + MISC_OFF);
    F.tid = threadIdx.x; F.lane = F.tid & 63; F.wave = __builtin_amdgcn_readfirstlane(F.tid >> 6);
    F.G = gridDim.x; { const int bx = blockIdx.x; F.vcu = (F.G % 8 == 0) ? (bx % 8) * (F.G / 8) + bx / 8 : bx; }
    for (int u = F.tid; u < (LDS_BYTES - LDSCTL_OFF) / 4; u += NWAVES * 64) ((LAS unsigned*)(F.lds + LDSCTL_OFF))[u] = 0u;
    __syncthreads();
    XcdBarrier bar; bar.bar = nullptr; bar.x = 0; bar.st = nullptr;
    if (N_LAUNCHES == 1) bar = xcd_barrier_post(WSP(unsigned, WS_CTL) + CW_BAR, F.MISC + 8);
    const int lo = args.ph_lo, hi = args.ph_hi;
#define IN(k) (lo <= (k) && (k) < hi)
#define REFRESH() do { int z_ = 0; asm volatile("" : "+v"(z_)); asm volatile("" : "+s"(F.wave), "+s"(F.vcu), "+s"(F.G)); \
        F.lane = (int)__builtin_amdgcn_mbcnt_hi(~0u, __builtin_amdgcn_mbcnt_lo(~0u, (unsigned)z_)); F.tid = F.wave * 64 + F.lane; } while (0)
#define SEAM(k) do { if (IN(k) && IN((k) + 1)) { bar.bar = WSP(unsigned, WS_CTL) + CW_BAR; xcd_barrier(bar, F.wave); if (PROBE_BAR2) xcd_barrier(bar, F.wave); } } while (0)
#define PROBE_T0(ph) unsigned long long pt0_ = 0; if (PROBE_PH == (ph)) pt0_ = __builtin_amdgcn_s_memrealtime()
#define PROBE_T1(ph) do { if (PROBE_PH == (ph)) { const unsigned long long pt1_ = __builtin_amdgcn_s_memrealtime(); while (__builtin_amdgcn_s_memrealtime() - pt1_ < pt1_ - pt0_) __builtin_amdgcn_s_sleep(8); } } while (0)

#pragma unroll 1
    for (int layer = 0; layer < DEPTH; ++layer) {
        const int pb = layer * 6;
        { PROBE_T0(0); if (IN(pb + 0)) { REFRESH(); phase_a(F, layer); } SEAM(pb + 0); PROBE_T1(0); }
        { PROBE_T0(1); if (IN(pb + 1)) {
            REFRESH();
            pg8::Gemm g{WSP(bf16, WS_A), WSP(bf16, WS_WIN), M, PITCH, DM, DM}; pg8::StaticOrder S; S.init(M, PITCH, F.G, (int)blockIdx.x);
            if (F.tid < 256) ((LAS float*)(F.lds + RING_BYTES + 10240))[F.tid] = (F.tid < 128 ? in_ptr(3) + layer * HD : in_ptr(4) + layer * HD - 128)[F.tid];
            __syncthreads();
            pg8::EpiProj E{WSP(bf16, WS_PROJ), PITCH, in_ptr(3) + layer * HD, in_ptr(4) + layer * HD, WSP(float, WS_KM), F.lds + RING_BYTES, EPS, WSP(float, WS_RSTD)};
            static_assert(GEMM1_ALIGN, "EpiProj's in-epilogue barriers need both half-workgroups in the epilogue together");
            if (WOUT_IN_B && (F.vcu & 1)) {
                LAS float* scr = (LAS float*)(F.lds + RING_OFF + F.wave * 16384);
                const float* wout = in_ptr(11) + (size_t)layer * 2048 * DM; bf16* const WoutT = WSP(bf16, WS_WOUT);
                for (int it = (F.vcu >> 1) * NWAVES + F.wave; it < (2048 / 64) * (1024 / 32); it += (F.G >> 1) * NWAVES)
                    transpose_item(wout, DM, 2048, 1024, WoutT, 0, scr, it, F.lane, in_ptr(10) + (size_t)layer * 1024, 1024);
                __syncthreads();
            }
            if (PROBE_BSKEW > 0 && (F.vcu & (BSKEW_N - 1))) { const unsigned long long t0_ = __builtin_amdgcn_s_memrealtime(); while (__builtin_amdgcn_s_memrealtime() - t0_ < (unsigned long long)(PROBE_BSKEW * (F.vcu & (BSKEW_N - 1))) * 10) __builtin_amdgcn_s_sleep(8); }
            pg8::gemm_phase<pg8::EpiProj, pg8::StaticOrder, GEMM1_ALIGN, GEMM1_SP2>(F.lds + RING_OFF, g, S, E, F.tid);
        } SEAM(pb + 1); PROBE_T1(1); }
        { PROBE_T0(2); if (IN(pb + 2)) { REFRESH(); phase_c(F, layer); } SEAM(pb + 2); PROBE_T1(2); }
        { PROBE_T0(3); if (IN(pb + 3)) {
            { PROBE_T0(6); REFRESH(); ssd_phase(F, layer); __syncthreads(); PROBE_T1(6);
              if ((PROBE_SSDFIX > 0 && (F.vcu & 1) == 0) || (PROBE_SSDFIX < 0 && (F.vcu & 1) == 1)) { const unsigned long long t0_ = __builtin_amdgcn_s_memrealtime(); while (__builtin_amdgcn_s_memrealtime() - t0_ < (unsigned long long)(PROBE_SSDFIX < 0 ? -PROBE_SSDFIX : PROBE_SSDFIX) * 100) __builtin_amdgcn_s_sleep(8); } }
            { PROBE_T0(7); REFRESH(); attn_phase(F, layer); PROBE_T1(7); }
        } if (IN(pb + 3) && IN(pb + 5)) { bar.bar = WSP(unsigned, WS_CTL) + CW_BAR; xcd_barrier(bar, F.wave); } PROBE_T1(3); }
        { PROBE_T0(5); if (IN(pb + 5)) {
            REFRESH();
            float* const OUTP = out_ptr();
            pg8::Gemm g{WSP(bf16, WS_PROJ), WSP(bf16, WS_WOUT), M, DM, 2048, PITCH}; pg8::StaticOrder S; S.init(M, DM, F.G, (int)blockIdx.x);
            pg8::EpiResScale E{in_ptr(0), WSP(bf16, WS_A), OUTP, WSP(bf16, WS_A), DM, WSP(float, WS_SSQ), F.lds + RING_BYTES, EPS, layer == DEPTH - 1};
            static_assert(DEPTH == 2, "the residual hand-over through XN is written for two layers");
            if (PROBE_FSKEW > 0 && (F.vcu & 1)) { const unsigned long long t0_ = __builtin_amdgcn_s_memrealtime(); while (__builtin_amdgcn_s_memrealtime() - t0_ < (unsigned long long)PROBE_FSKEW * 100) __builtin_amdgcn_s_sleep(8); }
            { pg8::Unit u_; for (int i = 0; i < 2 && S.next(i, u_); ++i) E.fill(u_, i, F.tid); }
            __syncthreads();
            pg8::gemm_phase<pg8::EpiResScale, pg8::StaticOrder, GEMM2_ALIGN, GEMM2_SP2>(F.lds + RING_OFF, g, S, E, F.tid);
        } SEAM(pb + 5); PROBE_T1(5); }
    }
#undef IN
#undef SEAM
}

extern "C" void kernel_launch(void* const* d_in, const int* in_sizes, int n_in, void* d_out, int out_size, void* d_ws, size_t ws_size, hipStream_t stream) {
    static int grid = 0;
    if (grid == 0) {
        if (n_in != 12 || in_sizes[0] != M * DM || out_size != M * DM || ws_size < WS_END) {
            fprintf(stderr, "kernel_launch: unexpected shapes (n_in %d, in0 %d, out %d, ws %zu); nothing launched\n", n_in, n_in > 0 ? in_sizes[0] : -1, out_size, ws_size); grid = -1; return; }
        int dev = 0, cus = 0, per_cu = 0;
        if (hipGetDevice(&dev) != hipSuccess || hipDeviceGetAttribute(&cus, hipDeviceAttributeMultiprocessorCount, dev) != hipSuccess) { grid = -1; return; }
        if (hipFuncSetAttribute((const void*)mk_fwd, hipFuncAttributeMaxDynamicSharedMemorySize, LDS_BYTES) != hipSuccess) { fprintf(stderr, "kernel_launch: hipFuncSetAttribute failed\n"); grid = -1; return; }
        if (hipOccupancyMaxActiveBlocksPerMultiprocessor(&per_cu, (const void*)mk_fwd, NWAVES * 64, LDS_BYTES) != hipSuccess || per_cu < 1) {
            fprintf(stderr, "kernel_launch: occupancy query reports %d workgroups per CU; nothing launched\n", per_cu); (void)hipGetLastError(); grid = -1; return; }
        grid = cus;
    }
    if (grid < 0) return;
    if (hipMemsetAsync((char*)d_ws + WS_CTL, 0, CTL_ZERO_BYTES, stream) != hipSuccess) { fprintf(stderr, "kernel_launch: hipMemsetAsync failed\n"); return; }
    Args a{};
    for (int i = 0; i < 12; ++i) a.in[i] = (const float*)d_in[i];
    a.out = (float*)d_out; a.ws = (unsigned char*)d_ws;
    for (int li = 0; li < N_LAUNCHES; ++li) {
        a.ph_lo = (N_LAUNCHES == 1) ? 0 : li; a.ph_hi = (N_LAUNCHES == 1) ? N_PHASES : li + 1; a.li = li;
        hipLaunchKernelGGL(mk_fwd, dim3(grid), dim3(NWAVES * 64), LDS_BYTES, stream, a);
        const hipError_t le = hipPeekAtLastError();
        if (le != hipSuccess) { fprintf(stderr, "kernel_launch: launch %d failed: %s\n", li, hipGetErrorName(le)); break; }
    }
}
```
